# Optimizing an MI355X kernel written in HIP

```python
import math
import jax, jax.numpy as jnp
from jax import lax
import numpy as np

D_MODEL = 2048
BATCH = 4
SEQ = 4096
DEPTH = 4

MIX_WIDTH = D_MODEL // 2
N_BRANCH = 4
Q_BLOCK = 128
DA_QK_DIM = 64
DA_V_DIM = 2 * DA_QK_DIM
DA_HEADS = MIX_WIDTH // DA_V_DIM
HG_DK = 128
HG_DV = 128
HG_HEADS = MIX_WIDTH // HG_DK
HG_CHUNK = 64
RW_HEAD = 64
RW_HEADS = MIX_WIDTH // RW_HEAD
RW_W_RANK = 64
RW_A_RANK = 64
RW_V_RANK = 32
RW_LN_EPS = 64e-5
SB_DIM = 128
SB_HEADS = MIX_WIDTH // SB_DIM
REL_BUCKETS = 32
REL_MAX_DIST = 128
LN_EPS = 1e-5
RMS_EPS = 1e-6
DEEPNORM_ALPHA = (2 * DEPTH) ** 0.25
DEEPNORM_BETA = (8 * DEPTH) ** -0.25

RW_MIX = 3 * MIX_WIDTH + RW_W_RANK + RW_A_RANK
COL_SIZES = (
    DA_HEADS * 2 * DA_QK_DIM, DA_HEADS * 2 * DA_QK_DIM, DA_HEADS * DA_V_DIM, MIX_WIDTH,
    HG_HEADS * HG_DK, HG_HEADS * HG_DK, HG_HEADS * HG_DV, MIX_WIDTH,
    RW_MIX, MIX_WIDTH,
    SB_HEADS * SB_DIM, SB_HEADS * SB_DIM, SB_HEADS * SB_DIM, MIX_WIDTH,
    N_BRANCH * D_MODEL,
)
IN_COLS = sum(COL_SIZES)
SPLIT_POINTS = tuple(int(c) for c in np.cumsum(COL_SIZES)[:-1])
RW_SPLITS = (MIX_WIDTH, 2 * MIX_WIDTH, 3 * MIX_WIDTH, 3 * MIX_WIDTH + RW_W_RANK)
MERGE_SPLITS = tuple(D_MODEL * i for i in range(1, N_BRANCH))

kernel_name = 'hybrid_gated_branch_deepnorm_trunk'


def layer_norm(x, g, b, eps=LN_EPS):
    xf = x.astype(jnp.float32)
    mu = jnp.mean(xf, -1, keepdims=True)
    var = jnp.mean(jnp.square(xf - mu), -1, keepdims=True)
    return ((xf - mu) * lax.rsqrt(var + eps) * g + b).astype(x.dtype)


def rms_norm(x, g, eps=RMS_EPS):
    xf = x.astype(jnp.float32)
    return (xf * lax.rsqrt(jnp.mean(xf * xf, -1, keepdims=True) + eps) * g).astype(x.dtype)


def token_shift(z):
    return jnp.pad(z[:, :-1], ((0, 0), (1, 0), (0, 0)))


def t5_bucket(dist):
    max_exact = REL_BUCKETS // 2
    n = jnp.maximum(dist, 0)
    nf = jnp.maximum(n, 1).astype(jnp.float32)
    large = max_exact + (jnp.log(nf / max_exact) / math.log(REL_MAX_DIST / max_exact)
                         * (REL_BUCKETS - max_exact)).astype(jnp.int32)
    large = jnp.minimum(large, REL_BUCKETS - 1)
    return jnp.where(n < max_exact, n, large)


def diff_attention(q, k, v, rel_table, lam, subln_g, layer):
    B, S, H, _, Dk = q.shape
    Dv = v.shape[-1]
    lam_init = 0.8 - 0.6 * math.exp(-0.3 * layer)
    lamf = lam.astype(jnp.float32)
    lam_full = jnp.exp(jnp.sum(lamf[0] * lamf[1])) - jnp.exp(jnp.sum(lamf[2] * lamf[3])) + lam_init
    nb = S // Q_BLOCK
    qb = q.reshape(B, nb, Q_BLOCK, H, 2, Dk).transpose(1, 0, 2, 3, 4, 5)
    kpos = jnp.arange(S)
    scale = Dk ** -0.5

    def block(args):
        qi, bi = args
        qpos = bi * Q_BLOCK + jnp.arange(Q_BLOCK)
        dist = qpos[:, None] - kpos[None, :]
        bias = rel_table[t5_bucket(dist)].astype(jnp.float32).transpose(2, 0, 1)
        s = jnp.einsum('bqhmd,bkhmd->bhmqk', qi, k).astype(jnp.float32) * scale + bias[None, :, None]
        s = jnp.where((dist >= 0)[None, None, None], s, -jnp.inf)
        p = jax.nn.softmax(s, axis=-1)
        a = p[:, :, 0] - lam_full * p[:, :, 1]
        return jnp.einsum('bhqk,bkhd->bqhd', a.astype(v.dtype), v)

    o = lax.map(block, (qb, jnp.arange(nb)))
    o = o.transpose(1, 0, 2, 3, 4).reshape(B, S, H, Dv)
    o = rms_norm(o, subln_g) * (1.0 - lam_init)
    return o.reshape(B, S, H * Dv)


def hgrn2_chunked(q, log_f, k, i):
    B, S, H, Dk = q.shape
    Dv = i.shape[-1]
    nc = S // HG_CHUNK
    f32 = jnp.float32

    def to_chunks(t):
        return t.astype(f32).reshape(B, nc, HG_CHUNK, H, t.shape[-1]).transpose(1, 0, 3, 2, 4)

    causal = jnp.tril(jnp.ones((HG_CHUNK, HG_CHUNK), dtype=bool))[:, :, None]

    def step(state, xs):
        qc, lfc, kc, ic = xs
        b = jnp.cumsum(lfc, axis=2)
        inter = jnp.einsum('bhcd,bhde->bhce', qc * jnp.exp(b), state)
        diff = b[:, :, :, None, :] - b[:, :, None, :, :]
        decay = jnp.exp(jnp.where(causal, diff, -jnp.inf))
        scores = jnp.sum(qc[:, :, :, None, :] * decay * kc[:, :, None, :, :], axis=-1)
        intra = jnp.einsum('bhts,bhse->bhte', scores, ic)
        b_last = b[:, :, -1:, :]
        state = (jnp.exp(b_last[:, :, 0, :])[..., None] * state
                 + jnp.einsum('bhsd,bhse->bhde', kc * jnp.exp(b_last - b), ic))
        return state, inter + intra

    state0 = jnp.zeros((B, H, Dk, Dv), f32)
    _, o = lax.scan(step, state0, (to_chunks(q), to_chunks(log_f), to_chunks(k), to_chunks(i)))
    return o.transpose(1, 0, 3, 2, 4).reshape(B, S, H, Dv)


def rwkv7_scan(r, w, k, v, a, b):
    B, S, H, N = r.shape

    def step(state, xs):
        rt, wt, kt, vt, at, bt = xs
        sa = jnp.einsum('bhvk,bhk->bhv', state, at)
        state = state * wt[:, :, None, :] + sa[..., None] * bt[:, :, None, :] + vt[..., None] * kt[:, :, None, :]
        return state, jnp.einsum('bhvk,bhk->bhv', state, rt)

    xs = tuple(t.transpose(1, 0, 2, 3) for t in (r, w, k, v, a, b))
    _, o = lax.scan(step, jnp.zeros((B, H, N, N), jnp.float32), xs)
    return o.transpose(1, 0, 2, 3)


def rwkv7_branch(zm, zg, v_gate_logit, v_first, mu, w0, w2, a0, a2, k_k, k_a, r_k, lnx_g, lnx_b):
    B, S, _ = zm.shape
    dt = zm.dtype
    f32 = jnp.float32
    zm = (zm + (token_shift(zm) - zm) * mu).astype(f32)
    r, k, v, wd, ad = jnp.split(zm, RW_SPLITS, axis=-1)
    w_log = -jax.nn.softplus(-(w0 + jnp.tanh(wd) @ w2)) - 0.5
    decay = jnp.exp(-jnp.exp(w_log))
    a = jax.nn.sigmoid(a0 + ad @ a2)
    if v_first is None:
        v_first = v
    else:
        v = v + (v_first - v) * jax.nn.sigmoid(v_gate_logit.astype(f32))

    def hd(t):
        return t.reshape(B, S, RW_HEADS, RW_HEAD)

    kk = hd(k * k_k)
    kk = kk / jnp.maximum(jnp.sqrt(jnp.sum(kk * kk, -1, keepdims=True)), 1e-12)
    k = k * (1.0 + (a - 1.0) * k_a)
    rh, kh, vh, ah = hd(r), hd(k), hd(v), hd(a)
    o = rwkv7_scan(rh, hd(decay), kh, vh, -kk, kk * ah)
    mu_o = jnp.mean(o, -1, keepdims=True)
    var_o = jnp.mean(jnp.square(o - mu_o), -1, keepdims=True)
    g_h = lnx_g.reshape(RW_HEADS, RW_HEAD)
    b_h = lnx_b.reshape(RW_HEADS, RW_HEAD)
    o = (o - mu_o) * lax.rsqrt(var_o + RW_LN_EPS) * g_h + b_h
    o = o + jnp.sum(rh * kh * r_k, -1, keepdims=True) * vh
    y = o.reshape(B, S, MIX_WIDTH).astype(dt) * jax.nn.silu(zg)
    return y, v_first


def stick_breaking_attention(q, k, v):
    B, S, H, D = q.shape
    nb = S // Q_BLOCK
    qb = q.reshape(B, nb, Q_BLOCK, H, D).transpose(1, 0, 2, 3, 4)
    kpos = jnp.arange(S)
    scale = D ** -0.5

    def block(args):
        qi, bi = args
        qpos = bi * Q_BLOCK + jnp.arange(Q_BLOCK)
        strict = (qpos[:, None] > kpos[None, :])[None, None]
        z = jnp.einsum('bqhd,bkhd->bhqk', qi, k).astype(jnp.float32) * scale
        log_beta = jax.nn.log_sigmoid(z)
        log_keep = jnp.where(strict, jax.nn.log_sigmoid(-z), 0.0)
        between = lax.cumsum(log_keep, axis=3, reverse=True) - log_keep
        wgt = jnp.where(strict, jnp.exp(log_beta + between), 0.0)
        return jnp.einsum('bhqk,bkhd->bqhd', wgt.astype(v.dtype), v)

    o = lax.map(block, (qb, jnp.arange(nb)))
    return o.transpose(1, 0, 2, 3, 4).reshape(B, S, H * D)


def setup_inputs(seed: int = 0) -> dict:
    key = jax.random.key(seed)
    ks = jax.random.split(key, 32)
    nrm = jax.random.normal
    f32 = jnp.float32
    L1 = DEPTH - 1
    return {
        'x': nrm(ks[0], (BATCH, SEQ, D_MODEL), f32),
        'w_in': nrm(ks[1], (DEPTH, D_MODEL, IN_COLS), f32) * D_MODEL ** -0.5,
        'rel_bias': nrm(ks[2], (REL_BUCKETS, DA_HEADS), f32) * 0.5,
        'da_lambda': nrm(ks[3], (DEPTH, 4, DA_QK_DIM), f32) * 0.1,
        'da_subln': 1.0 + 0.02 * nrm(ks[4], (DEPTH, DA_V_DIM), f32),
        'hg_lower': nrm(ks[5], (DEPTH, HG_HEADS * HG_DK), f32) * 0.5,
        'hg_norm': 1.0 + 0.02 * nrm(ks[6], (DEPTH, HG_DV), f32),
        'rw_mu': jax.random.uniform(ks[7], (DEPTH, RW_MIX), f32),
        'rw_w0': jax.random.uniform(ks[8], (DEPTH, MIX_WIDTH), f32, -6.0, -1.0),
        'rw_w2': nrm(ks[9], (DEPTH, RW_W_RANK, MIX_WIDTH), f32) * 0.1 * RW_W_RANK ** -0.5,
        'rw_a0': nrm(ks[10], (DEPTH, MIX_WIDTH), f32) * 0.1,
        'rw_a2': nrm(ks[11], (DEPTH, RW_A_RANK, MIX_WIDTH), f32) * 0.5 * RW_A_RANK ** -0.5,
        'rw_v1': nrm(ks[12], (L1, D_MODEL, RW_V_RANK), f32) * D_MODEL ** -0.5,
        'rw_v_mu': jax.random.uniform(ks[13], (L1, RW_V_RANK), f32),
        'rw_v0': 1.0 + 0.1 * nrm(ks[14], (L1, MIX_WIDTH), f32),
        'rw_v2': nrm(ks[15], (L1, RW_V_RANK, MIX_WIDTH), f32) * 0.5 * RW_V_RANK ** -0.5,
        'rw_kk': 0.85 + 0.05 * nrm(ks[16], (DEPTH, MIX_WIDTH), f32),
        'rw_ka': 1.0 + 0.05 * nrm(ks[17], (DEPTH, MIX_WIDTH), f32),
        'rw_rk': nrm(ks[18], (DEPTH, RW_HEADS, RW_HEAD), f32) * 0.1,
        'rw_lnx_g': 1.0 + 0.02 * nrm(ks[19], (DEPTH, MIX_WIDTH), f32),
        'rw_lnx_b': 0.02 * nrm(ks[20], (DEPTH, MIX_WIDTH), f32),
        'w_branch': nrm(ks[21], (DEPTH, N_BRANCH, MIX_WIDTH, D_MODEL), f32) * MIX_WIDTH ** -0.5,
        'w_out': nrm(ks[22], (DEPTH, D_MODEL, D_MODEL), f32) * D_MODEL ** -0.5 * DEEPNORM_BETA,
        'ln_g': 1.0 + 0.02 * nrm(ks[23], (DEPTH, D_MODEL), f32),
        'ln_b': 0.02 * nrm(ks[24], (DEPTH, D_MODEL), f32),
    }


def reference(x, w_in, rel_bias, da_lambda, da_subln, hg_lower, hg_norm, rw_mu, rw_w0, rw_w2, rw_a0,
              rw_a2, rw_v1, rw_v_mu, rw_v0, rw_v2, rw_kk, rw_ka, rw_rk, rw_lnx_g, rw_lnx_b,
              w_branch, w_out, ln_g, ln_b):
    B, S, _ = x.shape
    f32 = jnp.float32
    lbs = jnp.cumsum(jax.nn.softmax(hg_lower.astype(f32), axis=0), axis=0)
    lbs = lbs - lbs[0:1]
    h = x
    v_first = None
    for l in range(DEPTH):
        z = h @ w_in[l]
        (a_q, a_k, a_v, a_g, h_q, h_f, h_i, h_g, r_mix, r_g,
         s_q, s_k, s_v, s_g, m_g) = jnp.split(z, SPLIT_POINTS, axis=-1)

        y_a = diff_attention(a_q.reshape(B, S, DA_HEADS, 2, DA_QK_DIM), a_k.reshape(B, S, DA_HEADS, 2, DA_QK_DIM),
                             a_v.reshape(B, S, DA_HEADS, DA_V_DIM), rel_bias, da_lambda[l], da_subln[l], l)
        y_a = y_a * jax.nn.silu(a_g)

        lb = lbs[l]
        zf = h_f.astype(f32)
        log_f = jnp.logaddexp(jnp.log(lb), jnp.log1p(-lb) + jax.nn.log_sigmoid(zf))
        k_in = (1.0 - lb) * jax.nn.sigmoid(-zf)
        o_h = hgrn2_chunked(h_q.reshape(B, S, HG_HEADS, HG_DK), log_f.reshape(B, S, HG_HEADS, HG_DK),
                            k_in.reshape(B, S, HG_HEADS, HG_DK), h_i.reshape(B, S, HG_HEADS, HG_DV))
        y_b = rms_norm(o_h, hg_norm[l]).reshape(B, S, MIX_WIDTH).astype(h.dtype) * jax.nn.silu(h_g)

        if l == 0:
            v_gate_logit = None
        else:
            vd = h @ rw_v1[l - 1]
            vd = vd + (token_shift(vd) - vd) * rw_v_mu[l - 1]
            v_gate_logit = rw_v0[l - 1] + vd @ rw_v2[l - 1]
        y_c, v_first = rwkv7_branch(r_mix, r_g, v_gate_logit, v_first, rw_mu[l], rw_w0[l], rw_w2[l], rw_a0[l],
                                    rw_a2[l], rw_kk[l], rw_ka[l], rw_rk[l], rw_lnx_g[l], rw_lnx_b[l])

        y_d = stick_breaking_attention(s_q.reshape(B, S, SB_HEADS, SB_DIM), s_k.reshape(B, S, SB_HEADS, SB_DIM),
                                       s_v.reshape(B, S, SB_HEADS, SB_DIM)) * jax.nn.silu(s_g)

        gates = jnp.split(m_g, MERGE_SPLITS, axis=-1)
        branches = (y_a, y_b, y_c, y_d)
        merged = jax.nn.sigmoid(gates[0]) * (branches[0] @ w_branch[l, 0])
        for n in range(1, N_BRANCH):
            merged = merged + jax.nn.sigmoid(gates[n]) * (branches[n] @ w_branch[l, n])
        out = merged @ w_out[l]
        h = layer_norm(DEEPNORM_ALPHA * h + out, ln_g[l], ln_b[l])
    return h
```

```cpp
#ifdef EMU
#include "emu.h"
#else
#include <hip/hip_runtime.h>
#include <cstdio>
#include <cstdint>
#endif

#ifndef CFG_D_MODEL
#define CFG_D_MODEL 2048
#endif
#ifndef CFG_BATCH
#define CFG_BATCH 4
#endif
#ifndef CFG_SEQ
#define CFG_SEQ 4096
#endif
#ifndef CFG_DEPTH
#define CFG_DEPTH 4
#endif
constexpr int D = CFG_D_MODEL, NB = CFG_BATCH, S = CFG_SEQ, L = CFG_DEPTH, MIX = D / 2, M = NB * S;
constexpr int AH = MIX / 128, HH = MIX / 128, RH = MIX / 64, SH = MIX / 128;
constexpr int RW_MIX = 3 * MIX + 128;
constexpr int C_AQ = 0, C_AK = MIX, C_AV = 2 * MIX, C_AG = 3 * MIX, C_HQ = 4 * MIX, C_HF = 5 * MIX, C_HI = 6 * MIX, C_HG = 7 * MIX;
constexpr int C_RM = 8 * MIX, C_RG = C_RM + RW_MIX, C_SQ = C_RG + MIX, C_SK = C_SQ + MIX, C_SV = C_SK + MIX, C_SG = C_SV + MIX, C_MG = C_SG + MIX;
constexpr int IN_COLS = C_MG + 4 * D, C_VD = IN_COLS, NP = ((IN_COLS + 32 + 255) / 256) * 256;
constexpr float LN_EPS = 1e-5f, RMS_EPS = 1e-6f, RW_LN_EPS = 64e-5f;
constexpr float LOG2E = 1.4426950408889634f, LN2 = 0.6931471805599453f;

constexpr size_t al256(size_t x) { return (x + 255) & ~(size_t)255; }
constexpr size_t WS_CTL = 0, CTL_BYTES = 1u << 20;
constexpr size_t SM_LAM = CTL_BYTES;
constexpr size_t SM_LB = SM_LAM + 256;
constexpr size_t SM_BT = al256(SM_LB + (size_t)3 * L * MIX * 4);
constexpr size_t SM_W2T = al256(SM_BT + (size_t)AH * 132 * 4);
constexpr size_t SM_A2T = al256(SM_W2T + (size_t)L * MIX * 64 * 2);
constexpr size_t SM_V2T = al256(SM_A2T + (size_t)L * MIX * 64 * 2);
constexpr size_t WS_WIN = al256(SM_V2T + (size_t)L * MIX * 32 * 2);
constexpr size_t WS_WBR = al256(WS_WIN + (size_t)L * NP * D * 2);
constexpr size_t WS_WOUT = al256(WS_WBR + (size_t)L * D * 4 * MIX * 2);
constexpr size_t WS_XN = al256(WS_WOUT + (size_t)L * D * 4 * D * 2);
constexpr size_t WS_H = al256(WS_XN + (size_t)M * D * 2);
constexpr size_t WS_Z = al256(WS_H + (size_t)M * D * 4);
constexpr size_t WS_Y = al256(WS_Z + (size_t)M * NP * 2);
constexpr size_t WS_P = al256(WS_Y + (size_t)M * 4 * MIX * 2);
constexpr size_t WS_OUTF = al256(WS_P + (size_t)M * 4 * D * 2);
constexpr size_t WS_VF = al256(WS_OUTF + (size_t)M * D * 4);
constexpr size_t WS_SCI = al256(WS_VF + (size_t)M * MIX * 4);
constexpr size_t WS_SCO = al256(WS_SCI + (size_t)M * MIX * 6 * 4);
constexpr size_t WS_BON = al256(WS_SCO + (size_t)M * MIX * 4);
constexpr size_t WS_END = al256(WS_BON + (size_t)M * RH * 4);

typedef unsigned short bf16_t;
typedef short bf16x8 __attribute__((ext_vector_type(8)));
typedef short s16x4 __attribute__((ext_vector_type(4)));
typedef float f32x16 __attribute__((ext_vector_type(16)));
typedef float f32x4 __attribute__((ext_vector_type(4)));
typedef float f32x2 __attribute__((ext_vector_type(2)));
typedef unsigned u32x4 __attribute__((ext_vector_type(4)));
typedef unsigned u32x2 __attribute__((ext_vector_type(2)));
#ifdef EMU
#define DI static inline
#define DM inline
#define LAS
#define GAS
#define WAVE_SYNC() emu_wave_barrier()
#define MFMA32(a, b, c) emu_mfma32(a, b, c)
#define MFMA16(a, b, c) emu_mfma16(a, b, c)
#define TR_READ(p) emu_tr_read((const void*)(p))
#define ROW_ROR(x, n) emu_row_ror(x, n)
#define ANY(p) emu_any(p)
#define RFL(x) (x)
DI float ex2(float x) { return exp2f(x); }
DI float lg2(float x) { return log2f(x); }
DI float frcp(float x) { return 1.f / x; }
DI float frsq(float x) { return 1.f / sqrtf(x); }
DI float u2f(unsigned u) { float f; memcpy(&f, &u, 4); return f; }
DI unsigned f2u(float f) { unsigned u; memcpy(&u, &f, 4); return u; }
#else
#define DI __device__ __forceinline__
#define DM __device__ __forceinline__
#define LAS __attribute__((address_space(3)))
#define GAS __attribute__((address_space(1)))
#define WAVE_SYNC() do { __builtin_amdgcn_fence(__ATOMIC_RELEASE, "wavefront"); __builtin_amdgcn_wave_barrier(); __builtin_amdgcn_fence(__ATOMIC_ACQUIRE, "wavefront"); } while (0)
#define MFMA32(a, b, c) __builtin_amdgcn_mfma_f32_32x32x16_bf16((a), (b), (c), 0, 0, 0)
#define MFMA16(a, b, c) __builtin_amdgcn_mfma_f32_16x16x32_bf16((a), (b), (c), 0, 0, 0)
typedef short v4i16_t __attribute__((ext_vector_type(4)));
#define TR_READ(p) __builtin_bit_cast(s16x4, __builtin_amdgcn_ds_read_tr16_b64_v4i16((LAS v4i16_t*)(p)))
#define ROW_ROR(x, n) __builtin_bit_cast(float, __builtin_amdgcn_update_dpp(0, __builtin_bit_cast(int, (x)), 0x120 + (n), 0xf, 0xf, false))
#define ANY(p) __any(p)
#define RFL(x) __builtin_amdgcn_readfirstlane(x)
DI float ex2(float x) { return __builtin_amdgcn_exp2f(x); }
DI float lg2(float x) { return __builtin_amdgcn_logf(x); }
DI float frcp(float x) { return __builtin_amdgcn_rcpf(x); }
DI float frsq(float x) { return __builtin_amdgcn_rsqf(x); }
DI float u2f(unsigned u) { return __builtin_bit_cast(float, u); }
DI unsigned f2u(float f) { return __builtin_bit_cast(unsigned, f); }
#endif
typedef LAS char* lptr;
#ifdef EMU
DI int TID() { return (int)threadIdx.x; }
#else
DI int TID() { int t = (int)threadIdx.x; asm volatile("" : "+v"(t)); return t; }
#endif
DI float bf2f(bf16_t v) { return u2f(((unsigned)v) << 16); }
DI bf16_t f2bf(float f) { unsigned u = f2u(f); return (bf16_t)((u + 0x7fffu + ((u >> 16) & 1u)) >> 16); }
DI unsigned pk2(float lo, float hi) { return (unsigned)f2bf(lo) | ((unsigned)f2bf(hi) << 16); }
DI float bflo(unsigned w) { return u2f(w << 16); }
DI float bfhi(unsigned w) { return u2f(w & 0xffff0000u); }
DI float fexp(float x) { return ex2(x * LOG2E); }
DI float flog(float x) { return lg2(x) * LN2; }
DI float fsigmoid(float x) { return frcp(1.f + fexp(-x)); }
DI float fsilu(float x) { return x * fsigmoid(x); }
DI float fsoftplus(float x) { return fmaxf(x, 0.f) + flog(1.f + fexp(-fabsf(x))); }
DI int crow(int i, int h) { return (i & 3) + 8 * (i >> 2) + 4 * h; }
DI bf16x8 pack8(float a0, float a1, float a2, float a3, float a4, float a5, float a6, float a7) {
    u32x4 w; w.x = pk2(a0, a1); w.y = pk2(a2, a3); w.z = pk2(a4, a5); w.w = pk2(a6, a7); return __builtin_bit_cast(bf16x8, w);
}
DI bf16x8 cat4(s16x4 lo, s16x4 hi) { return __builtin_shufflevector(lo, hi, 0, 1, 2, 3, 4, 5, 6, 7); }

struct Params {
    const float* in[25];
    float* out;
    unsigned char* ws;
};
enum { I_X = 0, I_WIN, I_REL, I_LAM, I_SUBLN, I_HGLOW, I_HGNORM, I_MU, I_W0, I_W2, I_A0, I_A2, I_V1, I_VMU, I_V0, I_V2, I_KK, I_KA, I_RK, I_LNXG, I_LNXB, I_WBR, I_WOUT, I_LNG, I_LNB };
namespace pg8 {
#ifdef EMU
#define PG8_LAS
#else
#define PG8_LAS __attribute__((address_space(3)))
#endif
typedef unsigned short bf16_t;
typedef short bf16x8 __attribute__((ext_vector_type(8)));
typedef float f32x4 __attribute__((ext_vector_type(4)));
typedef unsigned u32x4 __attribute__((ext_vector_type(4)));
constexpr int BM = 256, BK = 64, HALF = 128, HTB = HALF * BK * 2  , STAGE_BYTES = 8 * HTB, NXCD = 8, WGM = 8;

__host__ __device__ __forceinline__ int lds_byte(int r, int c) { const int st = (r >> 4) * 2 + (c >> 5), rr = r & 15, cc = c & 31, ob = rr * 64 + cc * 2; return st * 1024 + (ob ^ (((ob >> 9) & 1) << 5)); }
__host__ __device__ __forceinline__ void stage_rc(int b, int& R, int& C) { const int st = b / 1024, sb = b % 1024, swz = sb ^ (((sb >> 9) & 1) << 5); R = (st >> 1) * 16 + swz / 64; C = (st & 1) * 32 + (swz % 64) / 2; }
__host__ __device__ __forceinline__ int perm32(int rho) { const int n = rho >> 4, i = rho & 15; return 8 * (i >> 2) + 4 * n + (i & 3); }

struct Unit { int pm, pn, ka; };
struct Gemm { const bf16_t* A; const bf16_t* Bt; int M, N, K, lda, ldb; };

struct StaticOrder {
    int nM, nN, nwg, G, c;
    __host__ __device__ void init(int M, int N, int G_, int c_) { nM = M / BM; nN = N / BM; nwg = nM * nN; G = G_; c = c_; }
    __host__ __device__ bool next(int i, Unit& u) const {
        const long L = (long)i * G + c; if (L >= nwg) return false;
        int wgid = (int)L; { const int q = nwg / NXCD, r = nwg % NXCD, xcd = wgid % NXCD, off = wgid / NXCD; wgid = (xcd < r ? xcd * (q + 1) : r * (q + 1) + (xcd - r) * q) + off; }
        const int nig = WGM * nN, gid = wgid / nig, fm = gid * WGM, gsz = (nM - fm) < WGM ? (nM - fm) : WGM;
        u.pm = fm + ((wgid % nig) % gsz); u.pn = (wgid % nig) / gsz; u.ka = 0; return true;
    }
    __device__ __forceinline__ void a_ready(const Unit&) const {}
    __device__ __forceinline__ void done(const Unit&) const {}
};
#ifndef EMU
template <class Epi, class Sched, bool ALIGN_EPI = false, bool SP2 = false>
__device__ __forceinline__ void gemm_phase(PG8_LAS unsigned char* lds, const Gemm g, const Sched& S, const Epi& E) {
    const int tid = TID(), wid = __builtin_amdgcn_readfirstlane(tid >> 6), lane = tid & 63, wr = wid >> 2, wc = wid & 3, fr = lane & 15, fq = lane >> 4;
    const int K = g.K, nt = K / BK;
    unsigned voffA[2], voffB[2];
#pragma unroll
    for (int i = 0; i < 2; ++i) { int R, C; stage_rc(tid * 16 + i * 8192, R, C); const int Rb = Epi::PERM ? ((R & ~31) + perm32(R & 31)) : R;
        voffA[i] = (unsigned)(R * g.lda + C) * 2u; voffB[i] = (unsigned)(Rb * g.ldb + C) * 2u; }
    const size_t kstep = (size_t)(BK * 2);
    const size_t hstepA = (size_t)HALF * g.lda * 2, hstepB = (size_t)HALF * g.ldb * 2;
    const size_t tstepA = 2 * hstepA, tstepB = 2 * hstepB;
    const unsigned ldsw = (unsigned)wid * 1024u;
    const int aoff = lds_byte(wr * 64 + fr, fq * 8), boff = lds_byte(wc * 32 + fr, fq * 8);
#define PG8_SA(b, h) (((b) * 2 + (h)) * HTB)
#define PG8_SB(b, h) ((4 + (b) * 2 + (h)) * HTB)
#define PG8_STAGE(bufoff, gbase, voff) do { _Pragma("unroll") for (int _i = 0; _i < 2; ++_i) \
        __builtin_amdgcn_global_load_lds((const unsigned*)((const char*)(gbase) + (voff)[_i]), (PG8_LAS unsigned*)(lds + (bufoff) + ldsw + _i * 8192), 16, 0, 0); } while (0)
#define PG8_LDA(dst, b, h) do { _Pragma("unroll") for (int m = 0; m < 4; ++m) _Pragma("unroll") for (int k = 0; k < 2; ++k) dst[m][k] = *(const PG8_LAS bf16x8*)(lds + PG8_SA(b, h) + aoff + m * 2048 + k * 1024); } while (0)
#define PG8_LDB(dst, b, h) do { _Pragma("unroll") for (int n = 0; n < 2; ++n) _Pragma("unroll") for (int k = 0; k < 2; ++k) dst[n][k] = *(const PG8_LAS bf16x8*)(lds + PG8_SB(b, h) + boff + n * 2048 + k * 1024); } while (0)
#define PG8_MMA(ai, bj, At, Bt) do { __builtin_amdgcn_s_setprio(1); _Pragma("unroll") for (int m = 0; m < 4; ++m) _Pragma("unroll") for (int n = 0; n < 2; ++n) _Pragma("unroll") for (int k = 0; k < 2; ++k) \
        acc[ai][bj][m][n] = __builtin_amdgcn_mfma_f32_16x16x32_bf16(Bt[n][k], At[m][k], acc[ai][bj][m][n], 0, 0, 0); __builtin_amdgcn_s_setprio(0); } while (0)
#define PG8_WAIT_V(n) asm volatile("s_waitcnt vmcnt(" #n ")" ::: "memory")
#define PG8_WAIT_L(n) asm volatile("s_waitcnt lgkmcnt(" #n ")" ::: "memory")
#define PG8_BAR __builtin_amdgcn_s_barrier()
#define PG8_SCHED __builtin_amdgcn_sched_barrier(0)
    Unit cur, nxt; int ui = 0;
    if (!S.next(0, cur)) return;
    f32x4 acc[2][2][4][2];
#pragma unroll
    for (int a = 0; a < 2; ++a)
#pragma unroll
        for (int b = 0; b < 2; ++b)
#pragma unroll
            for (int m = 0; m < 4; ++m)
#pragma unroll
                for (int n = 0; n < 2; ++n) acc[a][b][m][n] = (f32x4){0.f, 0.f, 0.f, 0.f};
    bf16x8 At[4][2], B0[2][2], B1[2][2];
    const char* cA = (const char*)g.A + (size_t)cur.pm * tstepA + (size_t)cur.ka * 2; const char* cB = (const char*)g.Bt + (size_t)cur.pn * tstepB;
    S.a_ready(cur);
    if constexpr (SP2) {
        PG8_STAGE(PG8_SB(0, 0), cB, voffB); PG8_STAGE(PG8_SB(0, 1), cB + hstepB, voffB); PG8_STAGE(PG8_SA(0, 0), cA, voffA); PG8_STAGE(PG8_SA(0, 1), cA + hstepA, voffA);
        if (wr == 1) PG8_BAR;
        PG8_WAIT_V(2); PG8_BAR;
        PG8_STAGE(PG8_SB(1, 0), cB + kstep, voffB); PG8_STAGE(PG8_SA(1, 0), cA + kstep, voffA); PG8_STAGE(PG8_SB(1, 1), cB + hstepB + kstep, voffB);
        PG8_WAIT_V(6); PG8_BAR;
    } else {
        PG8_STAGE(PG8_SB(0, 0), cB, voffB); PG8_STAGE(PG8_SA(0, 0), cA, voffA); PG8_STAGE(PG8_SB(0, 1), cB + hstepB, voffB); PG8_STAGE(PG8_SA(0, 1), cA + hstepA, voffA);
        if (wr == 1) PG8_BAR;
        PG8_WAIT_V(4); PG8_BAR;
        PG8_STAGE(PG8_SB(1, 0), cB + kstep, voffB); PG8_STAGE(PG8_SA(1, 0), cA + kstep, voffA); PG8_STAGE(PG8_SB(1, 1), cB + hstepB + kstep, voffB);
        PG8_WAIT_V(6); PG8_BAR;
    }
    for (;;) {
        const bool has_next = S.next(ui + 1, nxt);
        const char* nA = has_next ? (const char*)g.A + (size_t)nxt.pm * tstepA + (size_t)nxt.ka * 2 : cA; const char* nB = has_next ? (const char*)g.Bt + (size_t)nxt.pn * tstepB : cB;
        for (int t = 0; t < nt; t += 2) {
            const bool last = (t == nt - 2);
            const char* a1 = cA + (size_t)(t + 1) * kstep;
            const char* a2 = last ? nA : cA + (size_t)(t + 2) * kstep; const char* b2 = last ? nB : cB + (size_t)(t + 2) * kstep;
            const char* a3 = a2 + kstep; const char* b3 = b2 + kstep;
            if (last && has_next) S.a_ready(nxt);
            if constexpr (SP2) {
            PG8_LDB(B0, 0, 0); PG8_LDB(B1, 0, 1); PG8_SCHED; PG8_LDA(At, 0, 0); PG8_STAGE(PG8_SA(1, 1), a1 + hstepA, voffA);
            PG8_WAIT_V(8); PG8_WAIT_L(0); PG8_BAR; PG8_MMA(0, 0, At, B0); PG8_MMA(0, 1, At, B1); PG8_BAR; PG8_SCHED;
            PG8_LDA(At, 0, 1); PG8_STAGE(PG8_SB(0, 0), b2, voffB); PG8_STAGE(PG8_SB(0, 1), b2 + hstepB, voffB); PG8_STAGE(PG8_SA(0, 0), a2, voffA);
            PG8_WAIT_V(8); PG8_WAIT_L(0); PG8_BAR; PG8_MMA(1, 0, At, B0); PG8_MMA(1, 1, At, B1); PG8_BAR; PG8_SCHED;
            PG8_LDB(B0, 1, 0); PG8_LDB(B1, 1, 1); PG8_SCHED; PG8_LDA(At, 1, 0); PG8_STAGE(PG8_SA(0, 1), a2 + hstepA, voffA);
            PG8_WAIT_V(8); PG8_WAIT_L(0); PG8_BAR; PG8_MMA(0, 0, At, B0); PG8_MMA(0, 1, At, B1); PG8_BAR; PG8_SCHED;
            PG8_LDA(At, 1, 1); PG8_STAGE(PG8_SB(1, 0), b3, voffB); PG8_STAGE(PG8_SB(1, 1), b3 + hstepB, voffB); PG8_STAGE(PG8_SA(1, 0), a3, voffA);
            PG8_WAIT_V(8); PG8_WAIT_L(0); PG8_BAR; PG8_MMA(1, 0, At, B0); PG8_MMA(1, 1, At, B1); PG8_BAR; PG8_SCHED;
            } else {
            PG8_LDB(B0, 0, 0); PG8_SCHED; PG8_LDA(At, 0, 0); PG8_STAGE(PG8_SA(1, 1), a1 + hstepA, voffA);
            PG8_WAIT_L(8); PG8_BAR; PG8_WAIT_L(0); PG8_MMA(0, 0, At, B0); PG8_BAR; PG8_SCHED;
            PG8_LDB(B1, 0, 1); PG8_STAGE(PG8_SB(0, 0), b2, voffB);
            PG8_BAR; PG8_WAIT_L(0); PG8_MMA(0, 1, At, B1); PG8_BAR;
            PG8_LDA(At, 0, 1); PG8_STAGE(PG8_SA(0, 0), a2, voffA);
            PG8_BAR; PG8_WAIT_L(0); PG8_MMA(1, 0, At, B0); PG8_BAR; PG8_SCHED;
            PG8_STAGE(PG8_SB(0, 1), b2 + hstepB, voffB);
            PG8_WAIT_V(6); PG8_BAR; PG8_MMA(1, 1, At, B1); PG8_BAR;
            PG8_LDB(B0, 1, 0); PG8_SCHED; PG8_LDA(At, 1, 0); PG8_STAGE(PG8_SA(0, 1), a2 + hstepA, voffA);
            PG8_WAIT_L(8); PG8_BAR; PG8_WAIT_L(0); PG8_MMA(0, 0, At, B0); PG8_BAR; PG8_SCHED;
            PG8_LDB(B1, 1, 1); PG8_STAGE(PG8_SB(1, 0), b3, voffB);
            PG8_BAR; PG8_WAIT_L(0); PG8_MMA(0, 1, At, B1); PG8_BAR;
            PG8_LDA(At, 1, 1); PG8_STAGE(PG8_SA(1, 0), a3, voffA);
            PG8_BAR; PG8_WAIT_L(0); PG8_MMA(1, 0, At, B0); PG8_BAR; PG8_SCHED;
            PG8_STAGE(PG8_SB(1, 1), b3 + hstepB, voffB);
            PG8_WAIT_V(6); PG8_BAR; PG8_MMA(1, 1, At, B1); PG8_BAR;
            }
        }
        if constexpr (ALIGN_EPI) { if (wr == 0) PG8_BAR; }
        if constexpr (!Epi::AFTER_DRAIN) { E(acc, cur, wr, wc, fr, fq); S.done(cur); }
        if (!has_next) break;
#pragma unroll
        for (int a = 0; a < 2; ++a)
#pragma unroll
            for (int b = 0; b < 2; ++b)
#pragma unroll
                for (int m = 0; m < 4; ++m)
#pragma unroll
                    for (int n = 0; n < 2; ++n) acc[a][b][m][n] = (f32x4){0.f, 0.f, 0.f, 0.f};
        cur = nxt; cA = nA; cB = nB; ++ui;
        if constexpr (ALIGN_EPI) { if (wr == 1) PG8_BAR; }
    }
    PG8_WAIT_V(0);
    if constexpr (!ALIGN_EPI) { if (wr == 0) PG8_BAR; }
    PG8_BAR;
    if constexpr (Epi::AFTER_DRAIN) { E.fused(acc, cur, wr, wc, fr, fq, lds, wid, lane); S.done(cur); }
#undef PG8_SA
#undef PG8_SB
#undef PG8_STAGE
#undef PG8_LDA
#undef PG8_LDB
#undef PG8_MMA
#undef PG8_WAIT_V
#undef PG8_WAIT_L
#undef PG8_BAR
#undef PG8_SCHED
}
#endif
}
struct EpiPlain {
    static constexpr bool PERM = true, AFTER_DRAIN = false;
    bf16_t* O; int ldc;
    DM void operator()(const f32x4 (&acc)[2][2][4][2], const pg8::Unit& u, int wr, int wc, int fr, int fq) const {
        const int row0 = u.pm * 256 + wr * 64 + fr, col0 = u.pn * 256 + wc * 32 + 8 * fq;
#pragma unroll
        for (int ai = 0; ai < 2; ++ai)
#pragma unroll
            for (int m = 0; m < 4; ++m) { bf16_t* rowp = O + (size_t)(row0 + ai * 128 + m * 16) * ldc + col0;
#pragma unroll
                for (int bj = 0; bj < 2; ++bj) { const f32x4 v0 = acc[ai][bj][m][0], v1 = acc[ai][bj][m][1];
                    u32x4 w; w.x = pk2(v0[0], v0[1]); w.y = pk2(v0[2], v0[3]); w.z = pk2(v1[0], v1[1]); w.w = pk2(v1[2], v1[3]);
                    *(u32x4*)(rowp + bj * 128) = w; } }
    }
};
struct EpiGate {
    static constexpr bool PERM = true, AFTER_DRAIN = false;
    bf16_t* O; int ldc; const bf16_t* G; int ldg;
    DM void operator()(const f32x4 (&acc)[2][2][4][2], const pg8::Unit& u, int wr, int wc, int fr, int fq) const {
        const int row0 = u.pm * 256 + wr * 64 + fr, col0 = u.pn * 256 + wc * 32 + 8 * fq;
#pragma unroll
        for (int ai = 0; ai < 2; ++ai)
#pragma unroll
            for (int m = 0; m < 4; ++m) { const size_t row = (size_t)(row0 + ai * 128 + m * 16);
#pragma unroll
                for (int bj = 0; bj < 2; ++bj) { const f32x4 v0 = acc[ai][bj][m][0], v1 = acc[ai][bj][m][1];
                    const u32x4 g = *(const u32x4*)(G + row * ldg + col0 + bj * 128);
                    u32x4 w; w.x = pk2(v0[0] * fsigmoid(bflo(g.x)), v0[1] * fsigmoid(bfhi(g.x))); w.y = pk2(v0[2] * fsigmoid(bflo(g.y)), v0[3] * fsigmoid(bfhi(g.y)));
                    w.z = pk2(v1[0] * fsigmoid(bflo(g.z)), v1[1] * fsigmoid(bfhi(g.z))); w.w = pk2(v1[2] * fsigmoid(bflo(g.w)), v1[3] * fsigmoid(bfhi(g.w)));
                    *(u32x4*)(O + row * ldc + col0 + bj * 128) = w; } }
    }
};
struct EpiF32 {
    static constexpr bool PERM = false, AFTER_DRAIN = false;
    float* O; int ldc;
    DM void operator()(const f32x4 (&acc)[2][2][4][2], const pg8::Unit& u, int wr, int wc, int fr, int fq) const {
        const int row0 = u.pm * 256 + wr * 64 + fr, col0 = u.pn * 256 + wc * 32 + 4 * fq;
#pragma unroll
        for (int ai = 0; ai < 2; ++ai)
#pragma unroll
            for (int m = 0; m < 4; ++m) { float* rowp = O + (size_t)(row0 + ai * 128 + m * 16) * ldc + col0;
#pragma unroll
                for (int bj = 0; bj < 2; ++bj)
#pragma unroll
                    for (int n = 0; n < 2; ++n) *(f32x4*)(rowp + bj * 128 + n * 16) = acc[ai][bj][m][n]; }
    }
};

#ifdef EMU
template <class Epi> static void emu_gemm(const pg8::Gemm g, const Epi& E, int ka_div, int ka_mul) {
    if (g.M % 256 || g.N % 256) { printf("emu_gemm: M %d N %d not multiples of 256\n", g.M, g.N); exit(1); }
    std::vector<float> C((size_t)256 * 256);
    for (int pm = 0; pm < g.M / 256; ++pm) for (int pn = 0; pn < g.N / 256; ++pn) {
        for (int i = 0; i < 256; ++i) for (int j = 0; j < 256; ++j) { float a = 0.f; const bf16_t* ar = g.A + (size_t)(pm * 256 + i) * g.lda + (ka_div ? (pn / ka_div) * ka_mul : 0); const bf16_t* br = g.Bt + (size_t)(pn * 256 + j) * g.ldb;
            for (int k = 0; k < g.K; ++k) a += bf2f(ar[k]) * bf2f(br[k]); C[(size_t)i * 256 + j] = a; }
        pg8::Unit u{pm, pn, 0};
        for (int wid = 0; wid < 8; ++wid) for (int lane = 0; lane < 64; ++lane) { const int wr = wid >> 2, wc = wid & 3, fr = lane & 15, fq = lane >> 4;
            f32x4 acc[2][2][4][2];
            for (int ai = 0; ai < 2; ++ai) for (int bj = 0; bj < 2; ++bj) for (int m = 0; m < 4; ++m) for (int n = 0; n < 2; ++n) for (int e = 0; e < 4; ++e) {
                const int r = 128 * ai + 64 * wr + 16 * m + fr; const int c = Epi::PERM ? (128 * bj + 32 * wc + 8 * fq + 4 * n + e) : (128 * bj + 32 * wc + 16 * n + 4 * fq + e);
                acc[ai][bj][m][n][e] = C[(size_t)r * 256 + c]; }
            E(acc, u, wr, wc, fr, fq); }
    }
}
#endif
DI void transpose_item(const float* W, int N, bf16_t* dst, size_t ld_dst, int row_off, int col_off, int ncopy, size_t copy_stride, LAS float* scr, int kb, int nb, int lane) {
    const int k0 = 64 * kb, n0 = 32 * nb;
#pragma unroll 8
    for (int i = 0; i < 32; ++i) { const int kk = 2 * i + (lane >> 5); scr[kk * 33 + (lane & 31)] = W[(size_t)(k0 + kk) * N + n0 + (lane & 31)]; }
    WAVE_SYNC();
    const int c = lane & 7;
#pragma unroll
    for (int j = 0; j < 4; ++j) { const int n = (lane >> 3) + 8 * j; const LAS float* s = scr + (8 * c) * 33 + n;
        u32x4 o; o.x = pk2(s[0 * 33], s[1 * 33]); o.y = pk2(s[2 * 33], s[3 * 33]); o.z = pk2(s[4 * 33], s[5 * 33]); o.w = pk2(s[6 * 33], s[7 * 33]);
        for (int cp = 0; cp < ncopy; ++cp) *(u32x4*)(dst + (size_t)(row_off + n0 + n) * ld_dst + col_off + cp * copy_stride + k0 + 8 * c) = o; }
    WAVE_SYNC();
}
__device__ const unsigned char T5_THR[15] = {19, 21, 24, 27, 31, 35, 40, 46, 52, 59, 67, 77, 87, 99, 113};
DI int t5_bucket(int n) { if (n < 16) return n; int b = 16;
#pragma unroll
    for (int i = 0; i < 15; ++i) b += (n >= (int)T5_THR[i]) ? 1 : 0;
    return b; }

DI void phase_prologue(const Params& p, lptr lds) {
    const int tid = TID(), lane = tid & 63, wave = tid >> 6;
    const int gw = blockIdx.x * 8 + wave, NGW = gridDim.x * 8;
    const size_t gt = (size_t)blockIdx.x * 512 + tid, NGT = (size_t)gridDim.x * 512;
    LAS float* scr = (LAS float*)(lds + wave * 8704);
    bf16_t* WIN = (bf16_t*)(p.ws + WS_WIN); bf16_t* WBR = (bf16_t*)(p.ws + WS_WBR); bf16_t* WOUT = (bf16_t*)(p.ws + WS_WOUT);
    constexpr int NI_IN = (D / 64) * (IN_COLS / 32), NI_V1 = (D / 64) * 1, NI_BR = (MIX / 64) * (D / 32), NI_OUT = (D / 64) * (D / 32);
    constexpr int PER_L = NI_IN + NI_V1 + 4 * NI_BR + NI_OUT;
    for (int it = gw; it < L * PER_L; it += NGW) {
        const int l = it / PER_L; int r = it % PER_L;
        if (r < NI_IN) { const int nblk = IN_COLS / 32; transpose_item(p.in[I_WIN] + (size_t)l * D * IN_COLS, IN_COLS, WIN + (size_t)l * NP * D, D, 0, 0, 1, 0, scr, r / nblk, r % nblk, lane); continue; } r -= NI_IN;
        if (r < NI_V1) { if (l > 0) transpose_item(p.in[I_V1] + (size_t)(l - 1) * D * 32, 32, WIN + (size_t)l * NP * D, D, C_VD, 0, 1, 0, scr, r, 0, lane); continue; } r -= NI_V1;
        if (r < 4 * NI_BR) { const int n = r / NI_BR, rr = r % NI_BR, nblk = D / 32;
            transpose_item(p.in[I_WBR] + ((size_t)l * 4 + n) * MIX * D, D, WBR + (size_t)l * 4 * D * MIX, MIX, n * D, 0, 1, 0, scr, rr / nblk, rr % nblk, lane); continue; } r -= 4 * NI_BR;
        { const int nblk = D / 32; transpose_item(p.in[I_WOUT] + (size_t)l * D * D, D, WOUT + (size_t)l * D * 4 * D, 4 * D, 0, 0, 4, D, scr, r / nblk, r % nblk, lane); }
    }
    for (int l = 0; l < L; ++l) { const int r0 = (l == 0) ? IN_COLS : IN_COLS + 32; const size_t n8 = (size_t)(NP - r0) * D / 8; u32x4* dst = (u32x4*)(WIN + ((size_t)l * NP + r0) * D);
        for (size_t i = gt; i < n8; i += NGT) dst[i] = (u32x4){0u, 0u, 0u, 0u}; }
    { const f32x4* x4 = (const f32x4*)p.in[I_X]; u32x2* xn = (u32x2*)(p.ws + WS_XN);
      for (size_t i = gt; i < (size_t)M * D / 4; i += NGT) { const f32x4 v = x4[i]; u32x2 o; o.x = pk2(v[0], v[1]); o.y = pk2(v[2], v[3]); xn[i] = o; } }
    { bf16_t* W2T = (bf16_t*)(p.ws + SM_W2T); bf16_t* A2T = (bf16_t*)(p.ws + SM_A2T); bf16_t* V2T = (bf16_t*)(p.ws + SM_V2T);
      for (size_t i = gt; i < (size_t)L * MIX * 64; i += NGT) { const int j = (int)(i % 64); const int c = (int)((i / 64) % MIX); const int l = (int)(i / ((size_t)64 * MIX));
          W2T[i] = f2bf(p.in[I_W2][((size_t)l * 64 + j) * MIX + c]); A2T[i] = f2bf(p.in[I_A2][((size_t)l * 64 + j) * MIX + c]); }
      for (size_t i = gt; i < (size_t)L * MIX * 32; i += NGT) { const int j = (int)(i % 32); const int c = (int)((i / 32) % MIX); const int l = (int)(i / ((size_t)32 * MIX));
          V2T[i] = (l > 0) ? f2bf(p.in[I_V2][((size_t)(l - 1) * 32 + j) * MIX + c]) : (bf16_t)0; } }
    if (blockIdx.x == 0) {
        float* LAM = (float*)(p.ws + SM_LAM); float* LB = (float*)(p.ws + SM_LB); float* BT = (float*)(p.ws + SM_BT);
        if (tid < L) { const float* lm = p.in[I_LAM] + (size_t)tid * 256; float s1 = 0.f, s2 = 0.f;
            for (int i = 0; i < 64; ++i) { s1 += lm[i] * lm[64 + i]; s2 += lm[128 + i] * lm[192 + i]; }
            const float li = 0.8f - 0.6f * expf(-0.3f * (float)tid); LAM[tid] = expf(s1) - expf(s2) + li; LAM[L + tid] = li; }
        for (int c = tid; c < MIX; c += 512) { float mx = -1e30f; for (int l = 0; l < L; ++l) mx = fmaxf(mx, p.in[I_HGLOW][(size_t)l * MIX + c]);
            float den = 0.f; for (int l = 0; l < L; ++l) den += expf(p.in[I_HGLOW][(size_t)l * MIX + c] - mx);
            float cum = 0.f; for (int l = 0; l < L; ++l) { if (l > 0) cum += expf(p.in[I_HGLOW][(size_t)l * MIX + c] - mx) / den;
                LB[(size_t)l * MIX + c] = cum; LB[(size_t)(L + l) * MIX + c] = (l > 0) ? logf(cum) : -1e30f; LB[(size_t)(2 * L + l) * MIX + c] = log1pf(-cum); } }
        for (int i = tid; i < AH * 132; i += 512) { const int h = i / 132, d = i % 132; const int bk = (d >= 128) ? 31 : t5_bucket(d); BT[i] = p.in[I_REL][bk * AH + h] * LOG2E; }
    }
}
constexpr int ATT_KSTR = 272, ATT_VSTR = 320;
constexpr int ATT_K_OFF = 0, ATT_V_OFF = 64 * ATT_KSTR, ATT_BT_OFF = ATT_V_OFF + 64 * ATT_VSTR, ATT_X_OFF = 40960;
DI void stage_kv(const bf16_t* Z, size_t row0, int kcol, int vcol, lptr lds, int tid) {
#pragma unroll
    for (int i = 0; i < 2; ++i) { const int pc = tid + 512 * i, row = pc >> 4, c16 = pc & 15;
        const u32x4 kv = *(const u32x4*)(Z + (row0 + row) * NP + kcol + c16 * 8);
        const u32x4 vv = *(const u32x4*)(Z + (row0 + row) * NP + vcol + c16 * 8);
        *(LAS u32x4*)(lds + ATT_K_OFF + row * ATT_KSTR + c16 * 16) = kv;
        *(LAS u32x4*)(lds + ATT_V_OFF + row * ATT_VSTR + c16 * 16) = vv; }
}
DI void pv_acc(f32x16 (&o)[4], const f32x16& pt, lptr lds, int kh, int lane) {
    const int hh = lane >> 5, gsub = (lane >> 4) & 1, i16 = lane & 15, qq = i16 >> 2, pp = i16 & 3;
#pragma unroll
    for (int s = 0; s < 2; ++s) {
        const bf16x8 pb = pack8(pt[8 * s], pt[8 * s + 1], pt[8 * s + 2], pt[8 * s + 3], pt[8 * s + 4], pt[8 * s + 5], pt[8 * s + 6], pt[8 * s + 7]);
        const lptr vrow = lds + ATT_V_OFF + (32 * kh + 16 * s + 4 * hh + qq) * ATT_VSTR + gsub * 32 + pp * 8;
#pragma unroll
        for (int db = 0; db < 4; ++db) {
            const s16x4 lo = TR_READ(vrow + db * 64), hi = TR_READ(vrow + 8 * ATT_VSTR + db * 64);
            o[db] = MFMA32(cat4(lo, hi), pb, o[db]); }
    }
}
DI void phase_att_a(const Params& p, int layer, lptr lds, int unit) {
    const int tid = TID(), lane = tid & 63, wid = RFL(tid >> 6), r = lane & 31, hh = lane >> 5;
    constexpr int NQB = S / 128;
    const int qb = NQB - 1 - (unit % NQB), bh = unit / NQB, h = bh % AH, b = bh / AH;
    const int mp = wid & 1, qs = wid >> 1, q0 = qb * 128, qw0 = q0 + 32 * qs, q = qw0 + r;
    const bf16_t* Z = (const bf16_t*)(p.ws + WS_Z); const size_t rowb = (size_t)b * S;
    const float* LAM = (const float*)(p.ws + SM_LAM); const float lam_full = LAM[layer], lam_init = LAM[L + layer];
    LAS float* BT = (LAS float*)(lds + ATT_BT_OFF);
    __syncthreads();
    if (tid < 132) BT[tid] = ((const float*)(p.ws + SM_BT))[h * 132 + tid];
    bf16x8 qf[4];
    { const bf16_t* qp = Z + (rowb + q) * NP + C_AQ + h * 128 + mp * 64 + 8 * hh; const float qsc = 0.125f * LOG2E;
#pragma unroll
      for (int ds = 0; ds < 4; ++ds) { const u32x4 w = *(const u32x4*)(qp + 16 * ds);
          qf[ds] = pack8(bflo(w.x) * qsc, bfhi(w.x) * qsc, bflo(w.y) * qsc, bfhi(w.y) * qsc, bflo(w.z) * qsc, bfhi(w.z) * qsc, bflo(w.w) * qsc, bfhi(w.w) * qsc); } }
    f32x16 o[4];
#pragma unroll
    for (int db = 0; db < 4; ++db)
#pragma unroll
        for (int i = 0; i < 16; ++i) o[db][i] = 0.f;
    float mrun = -INFINITY, lrun = 0.f;
    const int nkt = (q0 + 128) / 64;
    for (int kt = 0; kt < nkt; ++kt) {
        const int k0 = kt * 64;
        __syncthreads();
        stage_kv(Z, rowb + k0, C_AK + h * 128, C_AV + h * 128, lds, tid);
        __syncthreads();
        if (k0 <= qw0 + 31) {
#pragma unroll 1
            for (int kh = 0; kh < 2; ++kh) {
                if (k0 + 32 * kh > qw0 + 31) break;
                f32x16 sc;
#pragma unroll
                for (int i = 0; i < 16; ++i) sc[i] = 0.f;
#pragma unroll
                for (int ds = 0; ds < 4; ++ds) { const bf16x8 a = *(const LAS bf16x8*)(lds + ATT_K_OFF + (32 * kh + r) * ATT_KSTR + mp * 128 + ds * 32 + hh * 16); sc = MFMA32(a, qf[ds], sc); }
                const int kbase = k0 + 32 * kh;
                if (qw0 - (kbase + 31) >= 128) { const float cb = BT[128];
#pragma unroll
                    for (int i = 0; i < 16; ++i) sc[i] += cb;
                } else {
#pragma unroll
                    for (int i = 0; i < 16; ++i) { const int dist = q - (kbase + crow(i, hh)); const int di = dist < 0 ? 0 : (dist > 128 ? 128 : dist);
                        sc[i] = (dist < 0) ? -INFINITY : sc[i] + BT[di]; }
                }
                float mx = sc[0];
#pragma unroll
                for (int i = 1; i < 16; ++i) mx = fmaxf(mx, sc[i]);
                mx = fmaxf(mx, __shfl_xor(mx, 32));
                const float mnew = fmaxf(mrun, mx), alpha = ex2(mrun - mnew);
                float sum = 0.f;
#pragma unroll
                for (int i = 0; i < 16; ++i) { const float e = ex2(sc[i] - mnew); sc[i] = e; sum += e; }
                sum += __shfl_xor(sum, 32);
                lrun = lrun * alpha + sum; mrun = mnew;
#pragma unroll
                for (int db = 0; db < 4; ++db)
#pragma unroll
                    for (int i = 0; i < 16; ++i) o[db][i] *= alpha;
                pv_acc(o, sc, lds, kh, lane);
            }
        }
    }
    __syncthreads();
    const float inv = 1.f / lrun;
    LAS float* X = (LAS float*)(lds + ATT_X_OFF) + (qs * 32 + r) * 132;
    if (mp == 1) {
#pragma unroll
        for (int db = 0; db < 4; ++db)
#pragma unroll
            for (int g = 0; g < 4; ++g) { f32x4 v; v[0] = o[db][4 * g] * inv * lam_full; v[1] = o[db][4 * g + 1] * inv * lam_full; v[2] = o[db][4 * g + 2] * inv * lam_full; v[3] = o[db][4 * g + 3] * inv * lam_full;
                *(LAS f32x4*)(X + 32 * db + 8 * g + 4 * hh) = v; }
    }
    __syncthreads();
    if (mp == 0) {
        float ss = 0.f;
#pragma unroll
        for (int db = 0; db < 4; ++db)
#pragma unroll
            for (int g = 0; g < 4; ++g) { const f32x4 x1 = *(const LAS f32x4*)(X + 32 * db + 8 * g + 4 * hh);
#pragma unroll
                for (int e = 0; e < 4; ++e) { const float x = o[db][4 * g + e] * inv - x1[e]; o[db][4 * g + e] = x; ss += x * x; } }
        ss += __shfl_xor(ss, 32);
        const float rinv = frsq(ss * (1.f / 128.f) + RMS_EPS) * (1.f - lam_init);
        const float* sg = p.in[I_SUBLN] + (size_t)layer * 128;
        const bf16_t* gp = Z + (rowb + q) * NP + C_AG + h * 128; bf16_t* yp = (bf16_t*)(p.ws + WS_Y) + (rowb + q) * (4 * MIX) + 0 * MIX + h * 128;
#pragma unroll
        for (int db = 0; db < 4; ++db)
#pragma unroll
            for (int g = 0; g < 4; ++g) { const int d = 32 * db + 8 * g + 4 * hh; const u32x2 gw = *(const u32x2*)(gp + d); const f32x4 sv = *(const f32x4*)(sg + d);
                u32x2 w; w.x = pk2(o[db][4 * g] * rinv * sv[0] * fsilu(bflo(gw.x)), o[db][4 * g + 1] * rinv * sv[1] * fsilu(bfhi(gw.x)));
                w.y = pk2(o[db][4 * g + 2] * rinv * sv[2] * fsilu(bflo(gw.y)), o[db][4 * g + 3] * rinv * sv[3] * fsilu(bfhi(gw.y)));
                *(u32x2*)(yp + d) = w; }
    }
}

constexpr float SB_CUT = -110.f;
DI void phase_att_d(const Params& p, int layer, lptr lds, int unit) {
    const int tid = TID(), lane = tid & 63, wid = RFL(tid >> 6), r = lane & 31, hh = lane >> 5;
    constexpr int NQB = S / 256;
    const int qb = NQB - 1 - (unit % NQB), bh = unit / NQB, h = bh % SH, b = bh / SH;
    const int q0 = qb * 256, qw0 = q0 + 32 * wid, q = qw0 + r;
    const bf16_t* Z = (const bf16_t*)(p.ws + WS_Z); const size_t rowb = (size_t)b * S;
    LAS int* FLG = (LAS int*)(lds + ATT_BT_OFF);
    bf16x8 qf[8];
    { const bf16_t* qp = Z + (rowb + q) * NP + C_SQ + h * 128 + 8 * hh; const float qsc = 0.08838834764831845f;
#pragma unroll
      for (int ds = 0; ds < 8; ++ds) { const u32x4 w = *(const u32x4*)(qp + 16 * ds);
          qf[ds] = pack8(bflo(w.x) * qsc, bfhi(w.x) * qsc, bflo(w.y) * qsc, bfhi(w.y) * qsc, bflo(w.z) * qsc, bfhi(w.z) * qsc, bflo(w.w) * qsc, bfhi(w.w) * qsc); } }
    f32x16 o[4];
#pragma unroll
    for (int db = 0; db < 4; ++db)
#pragma unroll
        for (int i = 0; i < 16; ++i) o[db][i] = 0.f;
    float carry = 0.f;
    for (int kt = (q0 + 255) / 64; kt >= 0; --kt) {
        const int k0 = kt * 64;
        __syncthreads();
        if (tid < 8) FLG[tid] = 0;
        stage_kv(Z, rowb + k0, C_SK + h * 128, C_SV + h * 128, lds, tid);
        __syncthreads();
        if (k0 < qw0 + 31) {
#pragma unroll 1
            for (int kh = 1; kh >= 0; --kh) {
                if (k0 + 32 * kh >= qw0 + 31) continue;
                f32x16 z;
#pragma unroll
                for (int i = 0; i < 16; ++i) z[i] = 0.f;
#pragma unroll
                for (int ds = 0; ds < 8; ++ds) { const bf16x8 a = *(const LAS bf16x8*)(lds + ATT_K_OFF + (32 * kh + r) * ATT_KSTR + ds * 32 + hh * 16); z = MFMA32(a, qf[ds], z); }
                f32x16 lk; float gsum[4];
#pragma unroll
                for (int g = 0; g < 4; ++g) { gsum[g] = 0.f;
#pragma unroll
                    for (int e = 0; e < 4; ++e) { const int i = 4 * g + e; const bool valid = (k0 + 32 * kh + crow(i, hh)) < q; const float sp = fsoftplus(z[i]);
                        lk[i] = valid ? -sp : 0.f; z[i] = valid ? (z[i] - sp) : -INFINITY; gsum[g] += lk[i]; } }
                float og[4];
#pragma unroll
                for (int g = 0; g < 4; ++g) og[g] = __shfl_xor(gsum[g], 32);
                float suf[4]; float run = 0.f;
#pragma unroll
                for (int g = 3; g >= 0; --g) {
                    if (hh == 1) { suf[g] = run; run += gsum[g] + og[g]; }
                    else { suf[g] = run + og[g]; run += gsum[g] + og[g]; }
                }
#pragma unroll
                for (int g = 0; g < 4; ++g) { float inner = 0.f;
#pragma unroll
                    for (int e = 3; e >= 0; --e) { const int i = 4 * g + e; const float between = carry + suf[g] + inner; inner += lk[i]; z[i] = ex2((z[i] + between) * LOG2E); } }
                carry += run;
                pv_acc(o, z, lds, kh, lane);
            }
        }
        const int active = ANY(carry > SB_CUT) ? 1 : 0;
        if (lane == 0) FLG[wid] = active;
        __syncthreads();
        int anyact = 0;
#pragma unroll
        for (int w = 0; w < 8; ++w) anyact |= FLG[w];
        if (!anyact) break;
    }
    const bf16_t* gp = Z + (rowb + q) * NP + C_SG + h * 128; bf16_t* yp = (bf16_t*)(p.ws + WS_Y) + (rowb + q) * (4 * MIX) + 3 * MIX + h * 128;
#pragma unroll
    for (int db = 0; db < 4; ++db)
#pragma unroll
        for (int g = 0; g < 4; ++g) { const int d = 32 * db + 8 * g + 4 * hh; const u32x2 gw = *(const u32x2*)(gp + d);
            u32x2 w; w.x = pk2(o[db][4 * g] * fsilu(bflo(gw.x)), o[db][4 * g + 1] * fsilu(bfhi(gw.x)));
            w.y = pk2(o[db][4 * g + 2] * fsilu(bflo(gw.y)), o[db][4 * g + 3] * fsilu(bfhi(gw.y)));
            *(u32x2*)(yp + d) = w; }
}
constexpr int HG_STR = 144;
constexpr int HG_QT = 0, HG_KT = 128 * HG_STR, HG_IT = 2 * 128 * HG_STR, HG_SC = 3 * 128 * HG_STR, HG_VEC = HG_SC + 64 * HG_STR;
DI bf16x8 hg_trfrag(lptr img, int col0, int dbase, int lane) {
    const int g = lane >> 4, i16 = lane & 15, qq = i16 >> 2, pp = i16 & 3;
    const lptr a = img + (dbase + 4 * g + qq) * HG_STR + (col0 + 4 * pp) * 2;
    return cat4(TR_READ(a), TR_READ(a + 16 * HG_STR));
}
DI void phase_hgrn(const Params& p, int layer, lptr lds, int unit) {
    const int tid = TID(), lane = tid & 63, wid = RFL(tid >> 6), g = lane >> 4, c16 = lane & 15;
    const int h = unit % HH, b = unit / HH;
    const bf16_t* Z = (const bf16_t*)(p.ws + WS_Z); const size_t rowb = (size_t)b * S;
    const float* LBp = (const float*)(p.ws + SM_LB);
    LAS float* EBR = (LAS float*)(lds + HG_VEC); LAS float* EBL = EBR + 128; LAS float* EBD = EBR + 256; LAS float* QTOT = EBR + 384; LAS float* PS = EBR + 896;
    const int ch = tid & 127, tq = tid >> 7;
    const float lb = LBp[(size_t)layer * MIX + h * 128 + ch], loglb = LBp[(size_t)(L + layer) * MIX + h * 128 + ch], log1m = LBp[(size_t)(2 * L + layer) * MIX + h * 128 + ch];
    const float gnorm = p.in[I_HGNORM][(size_t)layer * 128 + 16 * wid + c16];
    f32x4 st[8];
#pragma unroll
    for (int db = 0; db < 8; ++db) st[db] = (f32x4){0.f, 0.f, 0.f, 0.f};
    __syncthreads();
    for (int c = 0; c < S / 64; ++c) {
        const size_t row0 = rowb + (size_t)c * 64;
        float bl[16], qv[16], kv[16], iv[16];
        { const bf16_t* zp = Z + (row0 + 16 * tq) * NP + h * 128 + ch; float run = 0.f;
#pragma unroll
          for (int t = 0; t < 16; ++t) { const float zq = bf2f(zp[(size_t)t * NP + C_HQ]), zf = bf2f(zp[(size_t)t * NP + C_HF]); iv[t] = bf2f(zp[(size_t)t * NP + C_HI]);
              const float ls = -fsoftplus(-zf);
              float lf; if (lb > 0.f) { const float a_ = loglb, b_ = log1m + ls, mx = fmaxf(a_, b_); lf = mx + flog(fexp(a_ - mx) + fexp(b_ - mx)); } else lf = ls;
              run += lf; bl[t] = run; qv[t] = zq; kv[t] = (1.f - lb) * fexp(ls - zf); }
          QTOT[tq * 128 + ch] = run; }
        __syncthreads();
        { const float t0 = QTOT[ch], t1 = QTOT[128 + ch], t2 = QTOT[256 + ch], t3 = QTOT[384 + ch];
          const float pre = (tq > 0 ? t0 : 0.f) + (tq > 1 ? t1 : 0.f) + (tq > 2 ? t2 : 0.f), bref = t0 + t1, blast = bref + t2 + t3;
          unsigned qw[8], kw[8], iw[8];
#pragma unroll
          for (int t = 0; t < 16; t += 2) { const float b0 = pre + bl[t] - bref, b1 = pre + bl[t + 1] - bref;
              qw[t >> 1] = pk2(qv[t] * fexp(b0), qv[t + 1] * fexp(b1)); kw[t >> 1] = pk2(kv[t] * fexp(-b0), kv[t + 1] * fexp(-b1)); iw[t >> 1] = pk2(iv[t], iv[t + 1]); }
          LAS u32x4* dq = (LAS u32x4*)(lds + HG_QT + ch * HG_STR + tq * 32); dq[0] = (u32x4){qw[0], qw[1], qw[2], qw[3]}; dq[1] = (u32x4){qw[4], qw[5], qw[6], qw[7]};
          LAS u32x4* dk = (LAS u32x4*)(lds + HG_KT + ch * HG_STR + tq * 32); dk[0] = (u32x4){kw[0], kw[1], kw[2], kw[3]}; dk[1] = (u32x4){kw[4], kw[5], kw[6], kw[7]};
          LAS u32x4* di = (LAS u32x4*)(lds + HG_IT + ch * HG_STR + tq * 32); di[0] = (u32x4){iw[0], iw[1], iw[2], iw[3]}; di[1] = (u32x4){iw[4], iw[5], iw[6], iw[7]};
          if (tq == 0) { EBR[ch] = fexp(bref); EBL[ch] = fexp(blast); EBD[ch] = fexp(blast - bref); } }
        __syncthreads();
#pragma unroll
        for (int k2 = 0; k2 < 2; ++k2) { const int ti = 2 * wid + k2, tb = ti >> 2, sb = ti & 3;
            f32x4 acc = (f32x4){0.f, 0.f, 0.f, 0.f};
            if (sb <= tb) {
#pragma unroll
                for (int dp = 0; dp < 4; ++dp) acc = MFMA16(hg_trfrag(lds + HG_QT, 16 * tb, 32 * dp, lane), hg_trfrag(lds + HG_KT, 16 * sb, 32 * dp, lane), acc); }
            const int s = 16 * sb + c16;
#pragma unroll
            for (int e = 0; e < 4; ++e) { const int t = 16 * tb + 4 * g + e; *(LAS bf16_t*)(lds + HG_SC + t * HG_STR + s * 2) = f2bf((s <= t) ? acc[e] : 0.f); } }
        __syncthreads();
        bf16x8 ib[2], sf[4];
#pragma unroll
        for (int ks = 0; ks < 2; ++ks) ib[ks] = *(const LAS bf16x8*)(lds + HG_IT + (16 * wid + c16) * HG_STR + (8 * g + 32 * ks) * 2);
#pragma unroll
        for (int dp = 0; dp < 4; ++dp) { const f32x4 e0 = *(const LAS f32x4*)(EBR + 32 * dp + 4 * g), e1 = *(const LAS f32x4*)(EBR + 32 * dp + 16 + 4 * g);
            sf[dp] = pack8(st[2 * dp][0] * e0[0], st[2 * dp][1] * e0[1], st[2 * dp][2] * e0[2], st[2 * dp][3] * e0[3], st[2 * dp + 1][0] * e1[0], st[2 * dp + 1][1] * e1[1], st[2 * dp + 1][2] * e1[2], st[2 * dp + 1][3] * e1[3]); }
        f32x4 ot[4];
#pragma unroll
        for (int tb = 0; tb < 4; ++tb) { f32x4 acc = (f32x4){0.f, 0.f, 0.f, 0.f};
#pragma unroll
            for (int dp = 0; dp < 4; ++dp) acc = MFMA16(hg_trfrag(lds + HG_QT, 16 * tb, 32 * dp, lane), sf[dp], acc);
#pragma unroll
            for (int ks = 0; ks < 2; ++ks) acc = MFMA16(*(const LAS bf16x8*)(lds + HG_SC + (16 * tb + c16) * HG_STR + (8 * g + 32 * ks) * 2), ib[ks], acc);
            ot[tb] = acc;
#pragma unroll
            for (int e = 0; e < 4; ++e) { float v = acc[e] * acc[e]; v += __shfl_xor(v, 1); v += __shfl_xor(v, 2); v += __shfl_xor(v, 4); v += __shfl_xor(v, 8);
                if (c16 == 0) PS[wid * 64 + 16 * tb + 4 * g + e] = v; } }
#pragma unroll
        for (int db = 0; db < 8; ++db) { f32x4 tmp = (f32x4){0.f, 0.f, 0.f, 0.f};
#pragma unroll
            for (int ks = 0; ks < 2; ++ks) tmp = MFMA16(*(const LAS bf16x8*)(lds + HG_KT + (16 * db + c16) * HG_STR + (8 * g + 32 * ks) * 2), ib[ks], tmp);
            const f32x4 el = *(const LAS f32x4*)(EBL + 16 * db + 4 * g), ed = *(const LAS f32x4*)(EBD + 16 * db + 4 * g);
#pragma unroll
            for (int e = 0; e < 4; ++e) st[db][e] = el[e] * st[db][e] + ed[e] * tmp[e]; }
        __syncthreads();
        { const int e_col = h * 128 + 16 * wid + c16;
#pragma unroll
          for (int tb = 0; tb < 4; ++tb)
#pragma unroll
              for (int e = 0; e < 4; ++e) { const int t = 16 * tb + 4 * g + e; float ss = 0.f;
#pragma unroll
                  for (int w = 0; w < 8; ++w) ss += PS[w * 64 + t];
                  const float gate = bf2f(Z[(row0 + t) * NP + C_HG + e_col]);
                  ((bf16_t*)(p.ws + WS_Y))[(row0 + t) * (4 * MIX) + 1 * MIX + e_col] = f2bf(ot[tb][e] * frsq(ss * (1.f / 128.f) + RMS_EPS) * gnorm * fsilu(gate)); } }
    }
}
DI f32x4 lerp4(const bf16_t* zc, const bf16_t* zp, bool hp, const float* mu) {
    const u32x2 c = *(const u32x2*)zc; u32x2 pv = (u32x2){0u, 0u}; if (hp) pv = *(const u32x2*)zp; const f32x4 m4 = *(const f32x4*)mu;
    f32x4 o; const float c0 = bflo(c.x), c1 = bfhi(c.x), c2 = bflo(c.y), c3 = bfhi(c.y);
    o[0] = c0 + (bflo(pv.x) - c0) * m4[0]; o[1] = c1 + (bfhi(pv.x) - c1) * m4[1]; o[2] = c2 + (bflo(pv.y) - c2) * m4[2]; o[3] = c3 + (bfhi(pv.y) - c3) * m4[3]; return o; }
#ifdef EMU
#define SCHED_FENCE()
#else
#define SCHED_FENCE() __builtin_amdgcn_sched_barrier(0)
#endif
DI void rw_prep_item(const Params& p, int layer, int item, int lane) {
    const int r = lane & 31, hh = lane >> 5;
    const int hd = item % RH, tt = item / RH;
    const size_t m = (size_t)tt * 32 + r; const int t = (int)(m % S), b = (int)(m / S); const bool hp = t > 0;
    const bf16_t* Z = (const bf16_t*)(p.ws + WS_Z); const bf16_t* zc = Z + m * NP; const bf16_t* zp = hp ? zc - NP : zc;
    const float* mu = p.in[I_MU] + (size_t)layer * RW_MIX;
    bf16x8 xw[4], xa[4], xv[2];
#pragma unroll
    for (int s = 0; s < 4; ++s) { const int jj = 16 * s + 8 * hh;
        const f32x4 w0v = lerp4(zc + C_RM + 3 * MIX + jj, zp + C_RM + 3 * MIX + jj, hp, mu + 3 * MIX + jj), w1v = lerp4(zc + C_RM + 3 * MIX + jj + 4, zp + C_RM + 3 * MIX + jj + 4, hp, mu + 3 * MIX + jj + 4);
        xw[s] = pack8(tanhf(w0v[0]), tanhf(w0v[1]), tanhf(w0v[2]), tanhf(w0v[3]), tanhf(w1v[0]), tanhf(w1v[1]), tanhf(w1v[2]), tanhf(w1v[3]));
        const f32x4 a0v = lerp4(zc + C_RM + 3 * MIX + 64 + jj, zp + C_RM + 3 * MIX + 64 + jj, hp, mu + 3 * MIX + 64 + jj), a1v = lerp4(zc + C_RM + 3 * MIX + 64 + jj + 4, zp + C_RM + 3 * MIX + 64 + jj + 4, hp, mu + 3 * MIX + 64 + jj + 4);
        xa[s] = pack8(a0v[0], a0v[1], a0v[2], a0v[3], a1v[0], a1v[1], a1v[2], a1v[3]); SCHED_FENCE(); }
    if (layer > 0) { const float* vmu = p.in[I_VMU] + (size_t)(layer - 1) * 32;
#pragma unroll
        for (int s = 0; s < 2; ++s) { const int jj = 16 * s + 8 * hh;
            const f32x4 v0v = lerp4(zc + C_VD + jj, zp + C_VD + jj, hp, vmu + jj), v1v = lerp4(zc + C_VD + jj + 4, zp + C_VD + jj + 4, hp, vmu + jj + 4);
            xv[s] = pack8(v0v[0], v0v[1], v0v[2], v0v[3], v1v[0], v1v[1], v1v[2], v1v[3]); } }
    else { xv[0] = xw[0]; xv[1] = xw[0]; }
    const bf16_t* W2T = (const bf16_t*)(p.ws + SM_W2T) + (size_t)layer * MIX * 64; const bf16_t* A2T = (const bf16_t*)(p.ws + SM_A2T) + (size_t)layer * MIX * 64;
    const bf16_t* V2T = (const bf16_t*)(p.ws + SM_V2T) + (size_t)layer * MIX * 32;
    float* SCI = (float*)(p.ws + WS_SCI) + (((size_t)b * RH + hd) * S + t) * 384;
    float* VF = (float*)(p.ws + WS_VF) + m * MIX;
    const float* w0 = p.in[I_W0] + (size_t)layer * MIX; const float* a0 = p.in[I_A0] + (size_t)layer * MIX; const float* kkp = p.in[I_KK] + (size_t)layer * MIX;
    const float* kap = p.in[I_KA] + (size_t)layer * MIX; const float* rkp = p.in[I_RK] + (size_t)layer * MIX; const float* v0 = p.in[I_V0] + (size_t)(layer > 0 ? layer - 1 : 0) * MIX;
    float ssq = 0.f;
#pragma unroll 1
    for (int cg = 0; cg < 8; ++cg) {
        const int ch = hd * 64 + 32 * (cg >> 2) + 8 * (cg & 3) + 4 * hh;
        const f32x4 k4 = lerp4(zc + C_RM + MIX + ch, zp + C_RM + MIX + ch, hp, mu + MIX + ch), kq = *(const f32x4*)(kkp + ch);
        ssq += (k4[0] * kq[0] * k4[0] * kq[0] + k4[1] * kq[1] * k4[1] * kq[1]) + (k4[2] * kq[2] * k4[2] * kq[2] + k4[3] * kq[3] * k4[3] * kq[3]); }
    ssq += __shfl_xor(ssq, 32);
    const float kinv = 1.f / fmaxf(sqrtf(ssq), 1e-12f);
    float bon = 0.f;
#pragma unroll 1
    for (int cb = 0; cb < 2; ++cb) {
        const int chA = hd * 64 + 32 * cb + r;
        f32x16 lw, la, lv;
#pragma unroll
        for (int i = 0; i < 16; ++i) { lw[i] = 0.f; la[i] = 0.f; lv[i] = 0.f; }
#pragma unroll
        for (int s = 0; s < 4; ++s) { lw = MFMA32(*(const bf16x8*)(W2T + (size_t)chA * 64 + 16 * s + 8 * hh), xw[s], lw);
                                      la = MFMA32(*(const bf16x8*)(A2T + (size_t)chA * 64 + 16 * s + 8 * hh), xa[s], la); }
        if (layer > 0) {
#pragma unroll
            for (int s = 0; s < 2; ++s) lv = MFMA32(*(const bf16x8*)(V2T + (size_t)chA * 32 + 16 * s + 8 * hh), xv[s], lv); }
#pragma unroll
        for (int gq = 0; gq < 4; ++gq) { f32x4 o_w, o_k, o_a, o_b; const int cl = 32 * cb + 8 * gq + 4 * hh, ch = hd * 64 + cl;
            const f32x4 r4 = lerp4(zc + C_RM + ch, zp + C_RM + ch, hp, mu + ch), k4 = lerp4(zc + C_RM + MIX + ch, zp + C_RM + MIX + ch, hp, mu + MIX + ch);
            f32x4 v4 = lerp4(zc + C_RM + 2 * MIX + ch, zp + C_RM + 2 * MIX + ch, hp, mu + 2 * MIX + ch);
            const f32x4 w04 = *(const f32x4*)(w0 + ch), a04 = *(const f32x4*)(a0 + ch), kq = *(const f32x4*)(kkp + ch), ka4 = *(const f32x4*)(kap + ch), rk4 = *(const f32x4*)(rkp + ch);
            if (layer == 0) *(f32x4*)(VF + ch) = v4;
            else { const f32x4 vf = *(const f32x4*)(VF + ch), v04 = *(const f32x4*)(v0 + ch);
#pragma unroll
                for (int e = 0; e < 4; ++e) v4[e] = v4[e] + (vf[e] - v4[e]) * fsigmoid(v04[e] + lv[4 * gq + e]); }
#pragma unroll
            for (int e = 0; e < 4; ++e) { const int i = 4 * gq + e;
                const float wlog = -fsoftplus(-(w04[e] + lw[i])) - 0.5f; o_w[e] = fexp(-fexp(wlog));
                const float a = fsigmoid(a04[e] + la[i]);
                const float kk = k4[e] * kq[e] * kinv; const float k2 = k4[e] * (1.f + (a - 1.f) * ka4[e]);
                bon += r4[e] * k2 * rk4[e];
                o_k[e] = k2; o_a[e] = -kk; o_b[e] = kk * a; }
            *(f32x4*)(SCI + 0 * 64 + cl) = r4; *(f32x4*)(SCI + 1 * 64 + cl) = o_w; *(f32x4*)(SCI + 2 * 64 + cl) = o_k;
            *(f32x4*)(SCI + 3 * 64 + cl) = v4; *(f32x4*)(SCI + 4 * 64 + cl) = o_a; *(f32x4*)(SCI + 5 * 64 + cl) = o_b; SCHED_FENCE(); }
    }
    bon += __shfl_xor(bon, 32);
    if (hh == 0) ((float*)(p.ws + WS_BON))[m * RH + hd] = bon;
}
DI void phase_rw_prep(const Params& p, int layer) {
    const int tid = TID(), lane = tid & 63, wave = tid >> 6;
    constexpr int NITEM = (M / 32) * RH;
    for (int it = blockIdx.x * 8 + wave; it < NITEM; it += gridDim.x * 8) rw_prep_item(p, layer, it, lane);
}

constexpr int RS_TC = 64, RS_BUF = 0, RS_OB = RS_TC * 384 * 4;
DI void phase_rw_scan(const Params& p, lptr lds, int unit) {
    const int tid = TID(), kseg = tid & 15, rl = tid >> 4;
    const int half = unit & 1, bh = unit >> 1, hd = bh % RH, b = bh / RH;
    const float* SCI = (const float*)(p.ws + WS_SCI) + ((size_t)b * RH + hd) * S * 384;
    float* SCO = (float*)(p.ws + WS_SCO) + (size_t)b * S * MIX + hd * 64 + half * 32;
    LAS float* buf = (LAS float*)(lds + RS_BUF); LAS float* OB = (LAS float*)(lds + RS_OB);
    f32x4 st = (f32x4){0.f, 0.f, 0.f, 0.f};
    for (int c0 = 0; c0 < S; c0 += RS_TC) {
        __syncthreads();
        { const f32x4* src = (const f32x4*)(SCI + (size_t)c0 * 384);
#pragma unroll
          for (int i = 0; i < RS_TC * 96 / 512; ++i) ((LAS f32x4*)buf)[tid + 512 * i] = src[tid + 512 * i]; }
        __syncthreads();
        for (int t = 0; t < RS_TC; ++t) { const LAS float* sp = buf + t * 384 + 4 * kseg;
            const f32x4 r4 = *(const LAS f32x4*)(sp), w4 = *(const LAS f32x4*)(sp + 64), k4 = *(const LAS f32x4*)(sp + 128), a4 = *(const LAS f32x4*)(sp + 256), b4 = *(const LAS f32x4*)(sp + 320);
            const float vr = buf[t * 384 + 192 + half * 32 + rl];
            float sa = st[0] * a4[0] + st[1] * a4[1] + st[2] * a4[2] + st[3] * a4[3];
            sa += ROW_ROR(sa, 8); sa += ROW_ROR(sa, 4); sa += ROW_ROR(sa, 2); sa += ROW_ROR(sa, 1);
#pragma unroll
            for (int e = 0; e < 4; ++e) st[e] = st[e] * w4[e] + (sa * b4[e] + vr * k4[e]);
            float ov = st[0] * r4[0] + st[1] * r4[1] + st[2] * r4[2] + st[3] * r4[3];
            ov += ROW_ROR(ov, 8); ov += ROW_ROR(ov, 4); ov += ROW_ROR(ov, 2); ov += ROW_ROR(ov, 1);
            if (kseg == 0) OB[t * 32 + rl] = ov; }
        __syncthreads();
#pragma unroll
        for (int i = 0; i < RS_TC * 32 / 512; ++i) { const int idx = tid + 512 * i, t = idx >> 5, rr = idx & 31; SCO[(size_t)(c0 + t) * MIX + rr] = OB[idx]; }
    }
}

DI void phase_rw_post(const Params& p, int layer) {
    const size_t gt = (size_t)blockIdx.x * 512 + TID(), NGT = (size_t)gridDim.x * 512;
    const bf16_t* Z = (const bf16_t*)(p.ws + WS_Z); const float* SCO = (const float*)(p.ws + WS_SCO); const float* BON = (const float*)(p.ws + WS_BON);
    const float* lg = p.in[I_LNXG] + (size_t)layer * MIX; const float* lbv = p.in[I_LNXB] + (size_t)layer * MIX;
    for (size_t i = gt; i < (size_t)M * (MIX / 16); i += NGT) { const size_t m = i / (MIX / 16); const int c0 = (int)(i % (MIX / 16)) * 16, hd = c0 >> 6; const int t = (int)(m % S), b = (int)(m / S);
        float o[16]; float s1 = 0.f;
#pragma unroll
        for (int j = 0; j < 4; ++j) { const f32x4 v = *(const f32x4*)(SCO + m * MIX + c0 + 4 * j); o[4 * j] = v[0]; o[4 * j + 1] = v[1]; o[4 * j + 2] = v[2]; o[4 * j + 3] = v[3]; s1 += (v[0] + v[1]) + (v[2] + v[3]); }
        s1 += __shfl_xor(s1, 1); s1 += __shfl_xor(s1, 2); const float mean = s1 * (1.f / 64.f); float s2 = 0.f;
#pragma unroll
        for (int j = 0; j < 16; ++j) { o[j] -= mean; s2 += o[j] * o[j]; }
        s2 += __shfl_xor(s2, 1); s2 += __shfl_xor(s2, 2); const float rstd = frsq(s2 * (1.f / 64.f) + RW_LN_EPS);
        const float bon = BON[m * RH + hd]; const float* vsrc = (const float*)(p.ws + WS_SCI) + (((size_t)b * RH + hd) * S + t) * 384 + 192 + (c0 & 63);
        const bf16_t* gp = Z + m * NP + C_RG + c0; bf16_t* yp = (bf16_t*)(p.ws + WS_Y) + m * (4 * MIX) + 2 * MIX + c0;
        unsigned w[8];
#pragma unroll
        for (int j = 0; j < 16; j += 2) { const float y0 = (o[j] * rstd * lg[c0 + j] + lbv[c0 + j] + bon * vsrc[j]) * fsilu(bf2f(gp[j])), y1 = (o[j + 1] * rstd * lg[c0 + j + 1] + lbv[c0 + j + 1] + bon * vsrc[j + 1]) * fsilu(bf2f(gp[j + 1]));
            w[j >> 1] = pk2(y0, y1); }
        *(u32x4*)(yp) = (u32x4){w[0], w[1], w[2], w[3]}; *(u32x4*)(yp + 8) = (u32x4){w[4], w[5], w[6], w[7]}; }
}

DI void phase_ln(const Params& p, int layer) {
    const int tid = TID(), lane = tid & 63, wave = tid >> 6;
    const float alpha = sqrtf(sqrtf(2.f * (float)L));
    const float* hprev = (layer == 0) ? p.in[I_X] : (const float*)(p.ws + WS_H); const float* outf = (const float*)(p.ws + WS_OUTF);
    float* hnew = (layer == L - 1) ? p.out : (float*)(p.ws + WS_H); bf16_t* xn = (bf16_t*)(p.ws + WS_XN);
    const float* lg = p.in[I_LNG] + (size_t)layer * D; const float* lbv = p.in[I_LNB] + (size_t)layer * D;
    constexpr int NV = D / 256;
    for (size_t m = (size_t)blockIdx.x * 8 + wave; m < (size_t)M; m += (size_t)gridDim.x * 8) {
        f32x4 v[NV]; float s = 0.f;
#pragma unroll
        for (int j = 0; j < NV; ++j) { const f32x4 a = *(const f32x4*)(hprev + m * D + 256 * j + 4 * lane), o = *(const f32x4*)(outf + m * D + 256 * j + 4 * lane); v[j] = a * alpha + o; s += (v[j][0] + v[j][1]) + (v[j][2] + v[j][3]); }
#pragma unroll
        for (int o = 1; o < 64; o <<= 1) s += __shfl_xor(s, o);
        const float mean = s * (1.f / D); float s2 = 0.f;
#pragma unroll
        for (int j = 0; j < NV; ++j) { v[j] = v[j] - mean; s2 += (v[j][0] * v[j][0] + v[j][1] * v[j][1]) + (v[j][2] * v[j][2] + v[j][3] * v[j][3]); }
#pragma unroll
        for (int o = 1; o < 64; o <<= 1) s2 += __shfl_xor(s2, o);
        const float rstd = 1.f / sqrtf(s2 * (1.f / D) + LN_EPS);
#pragma unroll
        for (int j = 0; j < NV; ++j) { const f32x4 g4 = *(const f32x4*)(lg + 256 * j + 4 * lane), b4 = *(const f32x4*)(lbv + 256 * j + 4 * lane); const f32x4 y = v[j] * rstd * g4 + b4;
            *(f32x4*)(hnew + m * D + 256 * j + 4 * lane) = y; u32x2 w; w.x = pk2(y[0], y[1]); w.y = pk2(y[2], y[3]); *(u32x2*)(xn + m * D + 256 * j + 4 * lane) = w; }
    }
}
constexpr int NWAVES = 8, LDS_RING = 131072, MISC_OFF = LDS_RING + 320, LDS_BYTES = 147456;
constexpr int CW_BAR = 4096, CW_WQ = 16384;
enum { PH_INPROJ = 0, PH_RWPREP, PH_MIX, PH_RWPOST, PH_BRANCH, PH_OUT, PH_LN, PH_COUNT };
constexpr int U_SCAN = NB * RH * 2, U_HG = NB * HH, U_AA = NB * AH * (S / 128), U_AD = NB * SH * (S / 256), U_MIX = U_SCAN + U_HG + U_AA + U_AD;

struct Args { Params p; int do_pro, l_lo, l_hi, ph_lo, ph_hi, mega, pad0, pad1; };

#ifndef EMU
#define XB_TMO      128
#define XB_XCNT(j)  (256  + 64 * (j))
#define XB_XSUB(j)  (1280 + 64 * (j))
#define XB_XGEN(j)  (2304 + 64 * (j))
#define XB_TOP      3328
#define XB_TOPGEN   3392
#define XCD_BAR_WORDS 3456
#define XB_SPIN_CAP (1u << 18)
__device__ __forceinline__ unsigned xb_ld(unsigned* p)              { return __hip_atomic_load(p, __ATOMIC_RELAXED, __HIP_MEMORY_SCOPE_AGENT); }
__device__ __forceinline__ unsigned xb_add(unsigned* p, unsigned v) { return __hip_atomic_fetch_add(p, v, __ATOMIC_RELAXED, __HIP_MEMORY_SCOPE_AGENT); }
__device__ __forceinline__ unsigned xb_xcc_id() { return (unsigned)__builtin_amdgcn_s_getreg((3 << 11) | 20) & 0xFu; }
#define XB_SPIN(cond, bar) do { unsigned _sp = 0; while (cond) { __builtin_amdgcn_s_sleep(1); \
    if ((++_sp & 255u) == 0u) { if (xb_ld(&(bar)[XB_TMO])) break; if (_sp > XB_SPIN_CAP) { atomicAdd(&(bar)[XB_TMO], 1u); break; } } } } while (0)
struct XcdBarrier { unsigned* bar; unsigned x; volatile LAS unsigned* st; };
__device__ __forceinline__ XcdBarrier xcd_barrier_post(unsigned* bar, volatile LAS unsigned* st) {
    XcdBarrier b; b.bar = bar; b.x = xb_xcc_id(); b.st = st;
    if (threadIdx.x == 0) (void)xb_add(&bar[XB_XCNT(b.x)], 1u);
    return b;
}
__device__ __forceinline__ void xcd_barrier_complete(unsigned* bar, unsigned x, unsigned& nloc, unsigned& nx) {
    const unsigned G = gridDim.x * gridDim.y * gridDim.z;
    unsigned sum, cnt, mine, sp = 0u;
    for (;;) {
        sum = 0u; cnt = 0u; mine = 0u;
#pragma unroll
        for (unsigned j = 0; j < 16; ++j) { const unsigned c = xb_ld(&bar[XB_XCNT(j)]); sum += c; cnt += (c > 0u) ? 1u : 0u; mine = (j == x) ? c : mine; }
        if (sum == G) break;
        __builtin_amdgcn_s_sleep(1);
        if ((++sp & 255u) == 0u) { if (xb_ld(&bar[XB_TMO])) break; if (sp > XB_SPIN_CAP) { atomicAdd(&bar[XB_TMO], 1u); break; } }
    }
    nloc = mine > 0u ? mine : 1u; nx = cnt > 0u ? cnt : 1u;
}
__device__ __forceinline__ void xcd_barrier(const XcdBarrier& b) {
    asm volatile("s_waitcnt vmcnt(0)" ::: "memory");
    __syncthreads();
    if (threadIdx.x == 0) {
        unsigned* bar = b.bar;
        __builtin_amdgcn_s_waitcnt(0);
        unsigned nloc = b.st[0], nx = b.st[1];
        if (nloc == 0u) { xcd_barrier_complete(bar, b.x, nloc, nx); b.st[0] = nloc; b.st[1] = nx; }
        const unsigned old = xb_add(&bar[XB_XSUB(b.x)], 1u);
        const unsigned gen = old / nloc;
        if (old + 1u == (gen + 1u) * nloc) {
            __builtin_amdgcn_fence(__ATOMIC_RELEASE, "agent");
            asm volatile("s_waitcnt vmcnt(0)" ::: "memory");
            const unsigned og = xb_add(&bar[XB_TOP], 1u);
            const unsigned tg = og / nx;
            if (og + 1u == (tg + 1u) * nx) xb_add(&bar[XB_TOPGEN], 1u);
            else XB_SPIN(xb_ld(&bar[XB_TOPGEN]) == tg, bar);
            __builtin_amdgcn_fence(__ATOMIC_ACQUIRE, "agent");
            xb_add(&bar[XB_XGEN(b.x)], 1u);
            asm volatile("s_waitcnt vmcnt(0)" ::: "memory");
        } else {
            XB_SPIN(xb_ld(&bar[XB_XGEN(b.x)]) == gen, bar);
            __builtin_amdgcn_fence(__ATOMIC_ACQUIRE, "agent");
            asm volatile("s_waitcnt vmcnt(0)" ::: "memory");
        }
    }
    __syncthreads();
}
#endif

DI int next_unit(unsigned* head, lptr lds) {
    LAS int* slot = (LAS int*)(lds + MISC_OFF + 64);
    __syncthreads();
#ifdef EMU
    if (threadIdx.x == 0) { *slot = (int)(*head); *head += 1; }
#else
    if (threadIdx.x == 0) *slot = (int)__hip_atomic_fetch_add(head, 1u, __ATOMIC_RELAXED, __HIP_MEMORY_SCOPE_AGENT);
#endif
    __syncthreads();
    return *slot;
}

struct BranchOrder {
    pg8::StaticOrder so;
    DM bool next(int i, pg8::Unit& u) const { if (!so.next(i, u)) return false; u.ka = (u.pn / (D / 256)) * MIX; return true; }
    DM void a_ready(const pg8::Unit&) const {}
    DM void done(const pg8::Unit&) const {}
};

#ifndef DBG_PHMASK
#define DBG_PHMASK 0xffff
#endif
#ifndef DBG_MIXMASK
#define DBG_MIXMASK 15
#endif
DI void run_phase(const Args& a, int l, int ph, lptr lds) {
    const Params& p = a.p; unsigned char* ws = p.ws;
    if (!((DBG_PHMASK >> ph) & 1)) return;
    if (ph == PH_INPROJ) {
        pg8::Gemm g{(const bf16_t*)(ws + WS_XN), (const bf16_t*)(ws + WS_WIN) + (size_t)l * NP * D, M, NP, D, D, D};
        EpiPlain E{(bf16_t*)(ws + WS_Z), NP};
#ifndef EMU
        pg8::StaticOrder so; so.init(M, NP, gridDim.x, blockIdx.x);
        pg8::gemm_phase<EpiPlain, pg8::StaticOrder, true, true>((LAS unsigned char*)lds, g, so, E);
#endif
    } else if (ph == PH_RWPREP) {
        phase_rw_prep(p, l);
    } else if (ph == PH_MIX) {
        unsigned* head = (unsigned*)(ws + WS_CTL) + CW_WQ + 64 * l;
        for (;;) { int u = next_unit(head, lds); if (u >= U_MIX) break;
            if (u < U_SCAN) { if (DBG_MIXMASK & 1) phase_rw_scan(p, lds, u); continue; } u -= U_SCAN;
            if (u < U_HG) { if (DBG_MIXMASK & 2) phase_hgrn(p, l, lds, u); continue; } u -= U_HG;
            if (u < U_AA) { if (DBG_MIXMASK & 4) phase_att_a(p, l, lds, u); continue; } u -= U_AA;
            if (DBG_MIXMASK & 8) phase_att_d(p, l, lds, u); }
    } else if (ph == PH_RWPOST) {
        phase_rw_post(p, l);
    } else if (ph == PH_BRANCH) {
        pg8::Gemm g{(const bf16_t*)(ws + WS_Y), (const bf16_t*)(ws + WS_WBR) + (size_t)l * 4 * D * MIX, M, 4 * D, MIX, 4 * MIX, MIX};
        EpiGate E{(bf16_t*)(ws + WS_P), 4 * D, (const bf16_t*)(ws + WS_Z) + C_MG, NP};
#ifndef EMU
        BranchOrder bo; bo.so.init(M, 4 * D, gridDim.x, blockIdx.x);
        pg8::gemm_phase<EpiGate, BranchOrder, true, true>((LAS unsigned char*)lds, g, bo, E);
#endif
    } else if (ph == PH_OUT) {
        pg8::Gemm g{(const bf16_t*)(ws + WS_P), (const bf16_t*)(ws + WS_WOUT) + (size_t)l * D * 4 * D, M, D, 4 * D, 4 * D, 4 * D};
        EpiF32 E{(float*)(ws + WS_OUTF), D};
#ifndef EMU
        pg8::StaticOrder so; so.init(M, D, gridDim.x, blockIdx.x);
        pg8::gemm_phase<EpiF32, pg8::StaticOrder, true, true>((LAS unsigned char*)lds, g, so, E);
#endif
    } else if (ph == PH_LN) {
        phase_ln(p, l);
    }
}

#ifndef EMU
__global__ void __launch_bounds__(NWAVES * 64, 2) fwd(Args a) {
    extern __shared__ __attribute__((aligned(16))) unsigned char lds_raw[];
    lptr lds = (lptr)lds_raw;
    volatile LAS unsigned* MISC = (volatile LAS unsigned*)(lds + MISC_OFF);
    for (int u = threadIdx.x; u < (LDS_BYTES - LDS_RING) / 4; u += NWAVES * 64) ((LAS unsigned*)(lds + LDS_RING))[u] = 0u;
    __syncthreads();
    XcdBarrier bar; bar.bar = (unsigned*)(a.p.ws + WS_CTL) + CW_BAR; bar.x = 0; bar.st = nullptr;
    if (a.mega) bar = xcd_barrier_post((unsigned*)(a.p.ws + WS_CTL) + CW_BAR, MISC + 8);
#define SEAM() do { if (a.mega) xcd_barrier(bar); } while (0)
    if (a.do_pro != 0 && ((DBG_PHMASK >> 8) & 1) != 0) { phase_prologue(a.p, lds); SEAM(); }
    for (int l = a.l_lo; l < a.l_hi; ++l) {
        if (a.ph_lo <= PH_INPROJ && PH_INPROJ < a.ph_hi) { run_phase(a, l, PH_INPROJ, lds); SEAM(); }
        if (a.ph_lo <= PH_RWPREP && PH_RWPREP < a.ph_hi) { run_phase(a, l, PH_RWPREP, lds); SEAM(); }
        if (a.ph_lo <= PH_MIX && PH_MIX < a.ph_hi) { run_phase(a, l, PH_MIX, lds); SEAM(); }
        if (a.ph_lo <= PH_RWPOST && PH_RWPOST < a.ph_hi) { run_phase(a, l, PH_RWPOST, lds); SEAM(); }
        if (a.ph_lo <= PH_BRANCH && PH_BRANCH < a.ph_hi) { run_phase(a, l, PH_BRANCH, lds); SEAM(); }
        if (a.ph_lo <= PH_OUT && PH_OUT < a.ph_hi) { run_phase(a, l, PH_OUT, lds); SEAM(); }
        if (a.ph_lo <= PH_LN && PH_LN < a.ph_hi) { run_phase(a, l, PH_LN, lds); SEAM(); }
    }
#undef SEAM
}

#ifndef MK_MEGA
#define MK_MEGA 1
#endif
extern "C" void kernel_launch(void* const* d_in, const int* in_sizes, int n_in, void* d_out, int out_size, void* d_ws, size_t ws_size, hipStream_t stream) {
    static int grid = 0;
    if (grid == 0) {
        if (n_in != 25 || in_sizes[0] != M * D || out_size != M * D || ws_size < WS_END) { fprintf(stderr, "kernel_launch: shape/workspace mismatch (n_in %d, in0 %d, out %d, ws %zu need %zu)\n", n_in, n_in > 0 ? in_sizes[0] : -1, out_size, ws_size, (size_t)WS_END); grid = -1; return; }
        int dev = 0, cus = 0, per_cu = 0;
        if (hipGetDevice(&dev) != hipSuccess || hipDeviceGetAttribute(&cus, hipDeviceAttributeMultiprocessorCount, dev) != hipSuccess) { grid = -1; return; }
        if (hipFuncSetAttribute((const void*)fwd, hipFuncAttributeMaxDynamicSharedMemorySize, LDS_BYTES) != hipSuccess) { fprintf(stderr, "kernel_launch: hipFuncSetAttribute failed\n"); grid = -1; return; }
        if (hipOccupancyMaxActiveBlocksPerMultiprocessor(&per_cu, (const void*)fwd, NWAVES * 64, LDS_BYTES) != hipSuccess || per_cu < 1) fprintf(stderr, "kernel_launch: occupancy query says %d\n", per_cu);
        (void)hipGetLastError();
        grid = cus;
    }
    if (grid < 0) return;
    (void)hipMemsetAsync((char*)d_ws + WS_CTL, 0, CTL_BYTES, stream);
    Args a{};
    for (int i = 0; i < 25; ++i) a.p.in[i] = (const float*)d_in[i];
    a.p.out = (float*)d_out; a.p.ws = (unsigned char*)d_ws;
    if (MK_MEGA) {
        a.do_pro = 1; a.l_lo = 0; a.l_hi = L; a.ph_lo = 0; a.ph_hi = PH_COUNT; a.mega = 1;
        hipLaunchKernelGGL(fwd, dim3(grid), dim3(NWAVES * 64), LDS_BYTES, stream, a);
    } else {
        a.mega = 0; a.do_pro = 1; a.l_lo = 0; a.l_hi = 0; a.ph_lo = 0; a.ph_hi = 0;
        hipLaunchKernelGGL(fwd, dim3(grid), dim3(NWAVES * 64), LDS_BYTES, stream, a);
        a.do_pro = 0;
        for (int l = 0; l < L; ++l) for (int ph = 0; ph < PH_COUNT; ++ph) { a.l_lo = l; a.l_hi = l + 1; a.ph_lo = ph; a.ph_hi = ph + 1;
            hipLaunchKernelGGL(fwd, dim3(grid), dim3(NWAVES * 64), LDS_BYTES, stream, a); }
    }
}
#endif
```

```cpp
#ifdef EMU
#include "emu.h"
#else
#include <hip/hip_runtime.h>
#include <cstdio>
#include <cstdint>
#endif

#ifndef CFG_D_MODEL
#define CFG_D_MODEL 2048
#endif
#ifndef CFG_BATCH
#define CFG_BATCH 4
#endif
#ifndef CFG_SEQ
#define CFG_SEQ 4096
#endif
#ifndef CFG_DEPTH
#define CFG_DEPTH 4
#endif
constexpr int D = CFG_D_MODEL, NB = CFG_BATCH, S = CFG_SEQ, L = CFG_DEPTH, MIX = D / 2, M = NB * S;
constexpr int AH = MIX / 128, HH = MIX / 128, RH = MIX / 64, SH = MIX / 128;
constexpr int RW_MIX = 3 * MIX + 128;
constexpr int C_AQ = 0, C_AK = MIX, C_AV = 2 * MIX, C_AG = 3 * MIX, C_HQ = 4 * MIX, C_HF = 5 * MIX, C_HI = 6 * MIX, C_HG = 7 * MIX;
constexpr int C_RM = 8 * MIX, C_RG = C_RM + RW_MIX, C_SQ = C_RG + MIX, C_SK = C_SQ + MIX, C_SV = C_SK + MIX, C_SG = C_SV + MIX, C_MG = C_SG + MIX;
constexpr int IN_COLS = C_MG + 4 * D;
constexpr int C_VD = C_MG, CG0 = ((C_MG + 32 + 255) / 256) * 256, NP = CG0 + 4 * D, ZLD = CG0;
constexpr float LN_EPS = 1e-5f, RMS_EPS = 1e-6f, RW_LN_EPS = 64e-5f;
constexpr float LOG2E = 1.4426950408889634f, LN2 = 0.6931471805599453f;

constexpr size_t al256(size_t x) { return (x + 255) & ~(size_t)255; }
constexpr size_t WS_CTL = 0, CTL_BYTES = 1u << 20;
constexpr size_t SM_LAM = CTL_BYTES;
constexpr size_t SM_LB = SM_LAM + 256;
constexpr size_t SM_BT = al256(SM_LB + (size_t)3 * L * MIX * 4);
constexpr size_t SM_W2T = al256(SM_BT + (size_t)AH * 132 * 4);
constexpr size_t SM_A2T = al256(SM_W2T + (size_t)L * MIX * 64 * 2);
constexpr size_t SM_V2T = al256(SM_A2T + (size_t)L * MIX * 64 * 2);
constexpr size_t WS_WIN = al256(SM_V2T + (size_t)L * MIX * 32 * 2);
constexpr size_t WS_WBR = al256(WS_WIN + (size_t)L * NP * D * 2);
constexpr size_t WS_WOUT = al256(WS_WBR + (size_t)L * D * 4 * MIX * 2);
constexpr size_t WS_XN = al256(WS_WOUT + (size_t)L * D * D * 2);
constexpr size_t WS_H = al256(WS_XN + (size_t)M * D * 2);
constexpr size_t WS_Z = al256(WS_H + (size_t)M * D * 4);
constexpr size_t WS_Y = al256(WS_Z + (size_t)M * ZLD * 2);
constexpr size_t WS_RHO = al256(WS_Y + (size_t)M * 4 * MIX * 2);
constexpr size_t WS_P = al256(WS_RHO + (size_t)M * 4 * D * 2);
constexpr size_t WS_MG = al256(WS_P + (size_t)M * 4 * D * 2);
constexpr size_t WS_OUTF = al256(WS_MG + (size_t)M * D * 2);
constexpr size_t WS_VF = al256(WS_OUTF + (size_t)M * D * 4);
constexpr size_t WS_SCI = al256(WS_VF + (size_t)M * MIX * 4);
constexpr size_t WS_SCO = al256(WS_SCI + (size_t)M * MIX * 6 * 4);
constexpr size_t WS_BON = al256(WS_SCO + (size_t)M * MIX * 4);
constexpr size_t HG_CHUNKS = (size_t)NB * (MIX / 128) * (S / 64);
constexpr size_t WS_HGQF = al256(WS_BON + (size_t)M * RH * 4);
constexpr size_t WS_HGIN = al256(WS_HGQF + HG_CHUNKS * 16 * 64 * 16);
constexpr size_t WS_HGDS = al256(WS_HGIN + HG_CHUNKS * 8 * 4 * 64 * 16);
constexpr size_t WS_HGVE = al256(WS_HGDS + HG_CHUNKS * 8 * 8 * 64 * 16);
constexpr size_t WS_HGSF = al256(WS_HGVE + HG_CHUNKS * 256 * 4);
constexpr int FX_T = 4, FX_ROWS = NB * FX_T;
constexpr size_t WS_ZF = al256(WS_HGSF + HG_CHUNKS * 8 * 4 * 64 * 16);
constexpr size_t WS_OEX = al256(WS_ZF + (size_t)FX_ROWS * ZLD * 4);
constexpr size_t WS_END = al256(WS_OEX + (size_t)NB * (MIX / 128) * FX_T * 128 * 4);

typedef unsigned short bf16_t;
typedef short bf16x8 __attribute__((ext_vector_type(8)));
typedef short s16x4 __attribute__((ext_vector_type(4)));
typedef float f32x16 __attribute__((ext_vector_type(16)));
typedef float f32x4 __attribute__((ext_vector_type(4)));
typedef float f32x2 __attribute__((ext_vector_type(2)));
typedef unsigned u32x4 __attribute__((ext_vector_type(4)));
typedef unsigned u32x2 __attribute__((ext_vector_type(2)));
#ifdef EMU
#define DI static inline
#define DM inline
#define LAS
#define GAS
#define WAVE_SYNC() emu_wave_barrier()
#define MFMA32(a, b, c) emu_mfma32(a, b, c)
#define MFMA16(a, b, c) emu_mfma16(a, b, c)
#define TR_READ(p) emu_tr_read((const void*)(p))
#define ROW_ROR(x, n) emu_row_ror(x, n)
#define ANY(p) emu_any(p)
#define RFL(x) (x)
DI float ex2(float x) { return exp2f(x); }
DI float lg2(float x) { return log2f(x); }
DI float frcp(float x) { return 1.f / x; }
DI float frsq(float x) { return 1.f / sqrtf(x); }
DI float u2f(unsigned u) { float f; memcpy(&f, &u, 4); return f; }
DI unsigned f2u(float f) { unsigned u; memcpy(&u, &f, 4); return u; }
#else
#define DI __device__ __forceinline__
#define DM __device__ __forceinline__
#define LAS __attribute__((address_space(3)))
#define GAS __attribute__((address_space(1)))
#define WAVE_SYNC() do { __builtin_amdgcn_fence(__ATOMIC_RELEASE, "wavefront"); __builtin_amdgcn_wave_barrier(); __builtin_amdgcn_fence(__ATOMIC_ACQUIRE, "wavefront"); } while (0)
#define MFMA32(a, b, c) __builtin_amdgcn_mfma_f32_32x32x16_bf16((a), (b), (c), 0, 0, 0)
#define MFMA16(a, b, c) __builtin_amdgcn_mfma_f32_16x16x32_bf16((a), (b), (c), 0, 0, 0)
typedef short v4i16_t __attribute__((ext_vector_type(4)));
#define TR_READ(p) __builtin_bit_cast(s16x4, __builtin_amdgcn_ds_read_tr16_b64_v4i16((LAS v4i16_t*)(p)))
#define ROW_ROR(x, n) __builtin_bit_cast(float, __builtin_amdgcn_update_dpp(0, __builtin_bit_cast(int, (x)), 0x120 + (n), 0xf, 0xf, false))
#define ANY(p) __any(p)
#define RFL(x) __builtin_amdgcn_readfirstlane(x)
DI float ex2(float x) { return __builtin_amdgcn_exp2f(x); }
DI float lg2(float x) { return __builtin_amdgcn_logf(x); }
DI float frcp(float x) { return __builtin_amdgcn_rcpf(x); }
DI float frsq(float x) { return __builtin_amdgcn_rsqf(x); }
DI float u2f(unsigned u) { return __builtin_bit_cast(float, u); }
DI unsigned f2u(float f) { return __builtin_bit_cast(unsigned, f); }
#endif
#ifdef EMU
#define SCHED_FENCE()
#else
#define SCHED_FENCE() __builtin_amdgcn_sched_barrier(0)
#endif
typedef LAS char* lptr;
#ifdef EMU
DI int TID() { return (int)threadIdx.x; }
#else
DI int TID() { int t = (int)threadIdx.x; asm volatile("" : "+v"(t)); return t; }
#endif
DI float bf2f(bf16_t v) { return u2f(((unsigned)v) << 16); }
DI bf16_t f2bf(float f) { unsigned u = f2u(f); return (bf16_t)((u + 0x7fffu + ((u >> 16) & 1u)) >> 16); }
DI unsigned pk2(float lo, float hi) { return (unsigned)f2bf(lo) | ((unsigned)f2bf(hi) << 16); }
DI float bflo(unsigned w) { return u2f(w << 16); }
DI float bfhi(unsigned w) { return u2f(w & 0xffff0000u); }
DI float fexp(float x) { return ex2(x * LOG2E); }
DI float flog(float x) { return lg2(x) * LN2; }
DI float fsigmoid(float x) { return frcp(1.f + fexp(-x)); }
DI float fsilu(float x) { return x * fsigmoid(x); }
DI float fsoftplus(float x) { return fmaxf(x, 0.f) + flog(1.f + fexp(-fabsf(x))); }
DI int crow(int i, int h) { return (i & 3) + 8 * (i >> 2) + 4 * h; }
DI bf16x8 pack8(float a0, float a1, float a2, float a3, float a4, float a5, float a6, float a7) {
    u32x4 w; w.x = pk2(a0, a1); w.y = pk2(a2, a3); w.z = pk2(a4, a5); w.w = pk2(a6, a7); return __builtin_bit_cast(bf16x8, w);
}
DI bf16x8 cat4(s16x4 lo, s16x4 hi) { return __builtin_shufflevector(lo, hi, 0, 1, 2, 3, 4, 5, 6, 7); }

struct Params {
    const float* in[25];
    float* out;
    unsigned char* ws;
};
#ifdef EMU
typedef const Params* KP;
#else
typedef const __attribute__((address_space(4))) Params* KP;
#endif
enum { I_X = 0, I_WIN, I_REL, I_LAM, I_SUBLN, I_HGLOW, I_HGNORM, I_MU, I_W0, I_W2, I_A0, I_A2, I_V1, I_VMU, I_V0, I_V2, I_KK, I_KA, I_RK, I_LNXG, I_LNXB, I_WBR, I_WOUT, I_LNG, I_LNB };
namespace pg8 {
#ifdef EMU
#define PG8_LAS
#else
#define PG8_LAS __attribute__((address_space(3)))
#endif
typedef unsigned short bf16_t;
typedef short bf16x8 __attribute__((ext_vector_type(8)));
typedef float f32x4 __attribute__((ext_vector_type(4)));
typedef unsigned u32x4 __attribute__((ext_vector_type(4)));
constexpr int BM = 256, BK = 64, HALF = 128, HTB = HALF * BK * 2  , STAGE_BYTES = 8 * HTB, NXCD = 8, WGM = 8;

__host__ __device__ __forceinline__ int lds_byte(int r, int c) { const int st = (r >> 4) * 2 + (c >> 5), rr = r & 15, cc = c & 31, ob = rr * 64 + cc * 2; return st * 1024 + (ob ^ (((ob >> 9) & 1) << 5)); }
__host__ __device__ __forceinline__ void stage_rc(int b, int& R, int& C) { const int st = b / 1024, sb = b % 1024, swz = sb ^ (((sb >> 9) & 1) << 5); R = (st >> 1) * 16 + swz / 64; C = (st & 1) * 32 + (swz % 64) / 2; }
__host__ __device__ __forceinline__ int perm32(int rho) { const int n = rho >> 4, i = rho & 15; return 8 * (i >> 2) + 4 * n + (i & 3); }

struct Unit { int pm, pn, ka; };
struct Gemm { const bf16_t* A; const bf16_t* Bt; int M, N, K, lda, ldb; };

struct StaticOrder {
    int nM, nN, nwg, G, c;
    __host__ __device__ void init(int M, int N, int G_, int c_) { nM = M / BM; nN = N / BM; nwg = nM * nN; G = G_; c = c_; }
    __host__ __device__ bool next(int i, Unit& u) const {
        const long L = (long)i * G + c; if (L >= nwg) return false;
        int wgid = (int)L; { const int q = nwg / NXCD, r = nwg % NXCD, xcd = wgid % NXCD, off = wgid / NXCD; wgid = (xcd < r ? xcd * (q + 1) : r * (q + 1) + (xcd - r) * q) + off; }
        const int nig = WGM * nN, gid = wgid / nig, fm = gid * WGM, gsz = (nM - fm) < WGM ? (nM - fm) : WGM;
        u.pm = fm + ((wgid % nig) % gsz); u.pn = (wgid % nig) / gsz; u.ka = 0; return true;
    }
    __device__ __forceinline__ void a_ready(const Unit&) const {}
    __device__ __forceinline__ void done(const Unit&) const {}
};
#ifndef EMU
template <class Epi, class Sched, bool ALIGN_EPI, bool SP2, int LDA, int LDB, int KDIM>
__device__ __forceinline__ void gemm_phase(PG8_LAS unsigned char* lds, const Gemm g, const Sched& S, const Epi& E) {
    const int tid = TID(), wid = __builtin_amdgcn_readfirstlane(tid >> 6), lane = tid & 63, wr = wid >> 2, wc = wid & 3, fr = lane & 15, fq = lane >> 4;
    constexpr int K = KDIM, nt = K / BK;
    unsigned voffA, voffB;
    { int R, C; stage_rc(tid * 16, R, C); const int Rb = Epi::PERM ? ((R & ~31) + perm32(R & 31)) : R;
      voffA = (unsigned)(R * LDA + C) * 2u; voffB = (unsigned)(Rb * LDB + C) * 2u; }
    const size_t qA = (size_t)64 * LDA * 2, qB = (size_t)64 * LDB * 2;
    const size_t kstep = (size_t)(BK * 2);
    const size_t hstepA = (size_t)HALF * LDA * 2, hstepB = (size_t)HALF * LDB * 2;
    const size_t tstepA = 2 * hstepA, tstepB = 2 * hstepB;
    const unsigned ldsw = (unsigned)wid * 1024u;
    const int aoff = lds_byte(wr * 64 + fr, fq * 8), boff = lds_byte(wc * 32 + fr, fq * 8);
#define PG8_SA(b, h) (((b) * 2 + (h)) * HTB)
#define PG8_SB(b, h) ((4 + (b) * 2 + (h)) * HTB)
#define PG8_STAGE_X(bufoff, gbase, voff, q) do { _Pragma("unroll") for (int _i = 0; _i < 2; ++_i) \
        __builtin_amdgcn_global_load_lds((const unsigned*)((const char*)(gbase) + (size_t)_i * (q) + (voff)), (PG8_LAS unsigned*)(lds + (bufoff) + ldsw + _i * 8192), 16, 0, 0); } while (0)
#define PG8_STAGE_A(bufoff, gbase) PG8_STAGE_X(bufoff, gbase, voffA, qA)
#define PG8_STAGE_B(bufoff, gbase) PG8_STAGE_X(bufoff, gbase, voffB, qB)
#define PG8_LDA(dst, b, h) do { _Pragma("unroll") for (int m = 0; m < 4; ++m) _Pragma("unroll") for (int k = 0; k < 2; ++k) dst[m][k] = *(const PG8_LAS bf16x8*)(lds + PG8_SA(b, h) + aoff + m * 2048 + k * 1024); } while (0)
#define PG8_LDB(dst, b, h) do { _Pragma("unroll") for (int n = 0; n < 2; ++n) _Pragma("unroll") for (int k = 0; k < 2; ++k) dst[n][k] = *(const PG8_LAS bf16x8*)(lds + PG8_SB(b, h) + boff + n * 2048 + k * 1024); } while (0)
#define PG8_MMA(ai, bj, At, Bt) do { __builtin_amdgcn_s_setprio(1); _Pragma("unroll") for (int m = 0; m < 4; ++m) _Pragma("unroll") for (int n = 0; n < 2; ++n) _Pragma("unroll") for (int k = 0; k < 2; ++k) \
        acc[ai][bj][m][n] = __builtin_amdgcn_mfma_f32_16x16x32_bf16(Bt[n][k], At[m][k], acc[ai][bj][m][n], 0, 0, 0); __builtin_amdgcn_s_setprio(0); } while (0)
#define PG8_WAIT_V(n) asm volatile("s_waitcnt vmcnt(" #n ")" ::: "memory")
#define PG8_WAIT_L(n) asm volatile("s_waitcnt lgkmcnt(" #n ")" ::: "memory")
#define PG8_BAR __builtin_amdgcn_s_barrier()
#define PG8_SCHED __builtin_amdgcn_sched_barrier(0)
    Unit cur, nxt; int ui = 0;
    if (!S.next(0, cur)) return;
    f32x4 acc[2][2][4][2];
#pragma unroll
    for (int a = 0; a < 2; ++a)
#pragma unroll
        for (int b = 0; b < 2; ++b)
#pragma unroll
            for (int m = 0; m < 4; ++m)
#pragma unroll
                for (int n = 0; n < 2; ++n) acc[a][b][m][n] = (f32x4){0.f, 0.f, 0.f, 0.f};
    bf16x8 At[4][2], B0[2][2], B1[2][2];
    const char* cA = (const char*)g.A + (size_t)cur.pm * tstepA + (size_t)cur.ka * 2; const char* cB = (const char*)g.Bt + (size_t)cur.pn * tstepB;
    S.a_ready(cur);
    if constexpr (SP2) {
        PG8_STAGE_B(PG8_SB(0, 0), cB); PG8_STAGE_B(PG8_SB(0, 1), cB + hstepB); PG8_STAGE_A(PG8_SA(0, 0), cA); PG8_STAGE_A(PG8_SA(0, 1), cA + hstepA);
        if (wr == 1) PG8_BAR;
        PG8_WAIT_V(2); PG8_BAR;
        PG8_STAGE_B(PG8_SB(1, 0), cB + kstep); PG8_STAGE_A(PG8_SA(1, 0), cA + kstep); PG8_STAGE_B(PG8_SB(1, 1), cB + hstepB + kstep);
        PG8_WAIT_V(6); PG8_BAR;
    } else {
        PG8_STAGE_B(PG8_SB(0, 0), cB); PG8_STAGE_A(PG8_SA(0, 0), cA); PG8_STAGE_B(PG8_SB(0, 1), cB + hstepB); PG8_STAGE_A(PG8_SA(0, 1), cA + hstepA);
        if (wr == 1) PG8_BAR;
        PG8_WAIT_V(4); PG8_BAR;
        PG8_STAGE_B(PG8_SB(1, 0), cB + kstep); PG8_STAGE_A(PG8_SA(1, 0), cA + kstep); PG8_STAGE_B(PG8_SB(1, 1), cB + hstepB + kstep);
        PG8_WAIT_V(6); PG8_BAR;
    }
    for (;;) {
        const bool has_next = S.next(ui + 1, nxt);
        const char* nA = has_next ? (const char*)g.A + (size_t)nxt.pm * tstepA + (size_t)nxt.ka * 2 : cA; const char* nB = has_next ? (const char*)g.Bt + (size_t)nxt.pn * tstepB : cB;
        for (int t = 0; t < nt; t += 2) {
            if constexpr (Epi::MIDK > 0) { if (t > 0 && (t % Epi::MIDK) == 0) E.mid(acc, cur, t / Epi::MIDK - 1, wr, wc, fr, fq); }
            const bool last = (t == nt - 2);
            const char* a1 = cA + (size_t)(t + 1) * kstep;
            const char* a2 = last ? nA : cA + (size_t)(t + 2) * kstep; const char* b2 = last ? nB : cB + (size_t)(t + 2) * kstep;
            const char* a3 = a2 + kstep; const char* b3 = b2 + kstep;
            if (last && has_next) S.a_ready(nxt);
            if constexpr (SP2) {
            PG8_LDB(B0, 0, 0); PG8_LDB(B1, 0, 1); PG8_SCHED; PG8_LDA(At, 0, 0); PG8_STAGE_A(PG8_SA(1, 1), a1 + hstepA);
            PG8_WAIT_V(8); PG8_WAIT_L(0); PG8_BAR; PG8_MMA(0, 0, At, B0); PG8_MMA(0, 1, At, B1); PG8_BAR; PG8_SCHED;
            PG8_LDA(At, 0, 1); PG8_STAGE_B(PG8_SB(0, 0), b2); PG8_STAGE_B(PG8_SB(0, 1), b2 + hstepB); PG8_STAGE_A(PG8_SA(0, 0), a2);
            PG8_WAIT_V(8); PG8_WAIT_L(0); PG8_BAR; PG8_MMA(1, 0, At, B0); PG8_MMA(1, 1, At, B1); PG8_BAR; PG8_SCHED;
            PG8_LDB(B0, 1, 0); PG8_LDB(B1, 1, 1); PG8_SCHED; PG8_LDA(At, 1, 0); PG8_STAGE_A(PG8_SA(0, 1), a2 + hstepA);
            PG8_WAIT_V(8); PG8_WAIT_L(0); PG8_BAR; PG8_MMA(0, 0, At, B0); PG8_MMA(0, 1, At, B1); PG8_BAR; PG8_SCHED;
            PG8_LDA(At, 1, 1); PG8_STAGE_B(PG8_SB(1, 0), b3); PG8_STAGE_B(PG8_SB(1, 1), b3 + hstepB); PG8_STAGE_A(PG8_SA(1, 0), a3);
            PG8_WAIT_V(8); PG8_WAIT_L(0); PG8_BAR; PG8_MMA(1, 0, At, B0); PG8_MMA(1, 1, At, B1); PG8_BAR; PG8_SCHED;
            } else {
            PG8_LDB(B0, 0, 0); PG8_SCHED; PG8_LDA(At, 0, 0); PG8_STAGE_A(PG8_SA(1, 1), a1 + hstepA);
            PG8_WAIT_L(8); PG8_BAR; PG8_WAIT_L(0); PG8_MMA(0, 0, At, B0); PG8_BAR; PG8_SCHED;
            PG8_LDB(B1, 0, 1); PG8_STAGE_B(PG8_SB(0, 0), b2);
            PG8_BAR; PG8_WAIT_L(0); PG8_MMA(0, 1, At, B1); PG8_BAR;
            PG8_LDA(At, 0, 1); PG8_STAGE_A(PG8_SA(0, 0), a2);
            PG8_BAR; PG8_WAIT_L(0); PG8_MMA(1, 0, At, B0); PG8_BAR; PG8_SCHED;
            PG8_STAGE_B(PG8_SB(0, 1), b2 + hstepB);
            PG8_WAIT_V(6); PG8_BAR; PG8_MMA(1, 1, At, B1); PG8_BAR;
            PG8_LDB(B0, 1, 0); PG8_SCHED; PG8_LDA(At, 1, 0); PG8_STAGE_A(PG8_SA(0, 1), a2 + hstepA);
            PG8_WAIT_L(8); PG8_BAR; PG8_WAIT_L(0); PG8_MMA(0, 0, At, B0); PG8_BAR; PG8_SCHED;
            PG8_LDB(B1, 1, 1); PG8_STAGE_B(PG8_SB(1, 0), b3);
            PG8_BAR; PG8_WAIT_L(0); PG8_MMA(0, 1, At, B1); PG8_BAR;
            PG8_LDA(At, 1, 1); PG8_STAGE_A(PG8_SA(1, 0), a3);
            PG8_BAR; PG8_WAIT_L(0); PG8_MMA(1, 0, At, B0); PG8_BAR; PG8_SCHED;
            PG8_STAGE_B(PG8_SB(1, 1), b3 + hstepB);
            PG8_WAIT_V(6); PG8_BAR; PG8_MMA(1, 1, At, B1); PG8_BAR;
            }
        }
        if constexpr (ALIGN_EPI) { if (wr == 0) PG8_BAR; }
        if constexpr (!Epi::AFTER_DRAIN) { E(acc, cur, wr, wc, fr, fq); S.done(cur); }
        if (!has_next) break;
#pragma unroll
        for (int a = 0; a < 2; ++a)
#pragma unroll
            for (int b = 0; b < 2; ++b)
#pragma unroll
                for (int m = 0; m < 4; ++m)
#pragma unroll
                    for (int n = 0; n < 2; ++n) acc[a][b][m][n] = (f32x4){0.f, 0.f, 0.f, 0.f};
        cur = nxt; cA = nA; cB = nB; ++ui;
        if constexpr (ALIGN_EPI) { if (wr == 1) PG8_BAR; }
    }
    PG8_WAIT_V(0);
    if constexpr (!ALIGN_EPI) { if (wr == 0) PG8_BAR; }
    PG8_BAR;
    if constexpr (Epi::AFTER_DRAIN) { E.fused(acc, cur, wr, wc, fr, fq, lds, wid, lane); S.done(cur); }
#undef PG8_SA
#undef PG8_SB
#undef PG8_STAGE_X
#undef PG8_STAGE_A
#undef PG8_STAGE_B
#undef PG8_LDA
#undef PG8_LDB
#undef PG8_MMA
#undef PG8_WAIT_V
#undef PG8_WAIT_L
#undef PG8_BAR
#undef PG8_SCHED
}
#endif
}
#ifdef EMU
#define EPI_COORDS()
#else
#define EPI_COORDS() { const int t_ = TID(); const int w_ = RFL(t_ >> 6), l_ = t_ & 63; wr = w_ >> 2; wc = w_ & 3; fr = l_ & 15; fq = l_ >> 4; }
#endif
struct EpiInproj {
    static constexpr bool PERM = true, AFTER_DRAIN = false; static constexpr int MIDK = 0;
    bf16_t* O; int ldc; bf16_t* RHO; int gate_pn0;
    DM void operator()(const f32x4 (&acc)[2][2][4][2], const pg8::Unit& u, int wr, int wc, int fr, int fq) const {
        const int row0 = u.pm * 256 + wr * 64 + fr;
        if (u.pn < gate_pn0) { const int col0 = u.pn * 256 + wc * 32 + 8 * fq;
#pragma unroll
            for (int ai = 0; ai < 2; ++ai)
#pragma unroll
                for (int m = 0; m < 4; ++m) { bf16_t* rowp = O + (size_t)(row0 + ai * 128 + m * 16) * ldc + col0;
#pragma unroll
                    for (int bj = 0; bj < 2; ++bj) { const f32x4 v0 = acc[ai][bj][m][0], v1 = acc[ai][bj][m][1];
                        u32x4 w; w.x = pk2(v0[0], v0[1]); w.y = pk2(v0[2], v0[3]); w.z = pk2(v1[0], v1[1]); w.w = pk2(v1[2], v1[3]);
                        *(u32x4*)(rowp + bj * 128) = w; } }
        } else {
            const int T = u.pn - gate_pn0, pnc = T >> 2, bjc = (T & 3) >> 1, wcc = 2 * (T & 1) + (wc >> 1), fqc = fq, nc = wc & 1;
            bf16_t* base = RHO + ((((size_t)u.pm * (D / 256) + pnc) * 4) * 8 + (wr * 4 + wcc)) * (size_t)(16 * 64 * 8) + bjc * 512 + (fqc * 16 + fr) * 8 + nc * 4;
            constexpr size_t SEG_STRIDE = (size_t)8 * 16 * 64 * 8;
#pragma unroll
            for (int ai = 0; ai < 2; ++ai)
#pragma unroll
                for (int m = 0; m < 4; ++m) { bf16_t* rp = base + (ai * 4 + m) * 1024; float r0[4], r1[4], r2[4], r3[4];
#pragma unroll
                    for (int e = 0; e < 4; ++e) { const float d0 = 1.f + fexp(-acc[ai][0][m][0][e]), d1 = 1.f + fexp(-acc[ai][0][m][1][e]), d2 = 1.f + fexp(-acc[ai][1][m][0][e]), d3 = 1.f + fexp(-acc[ai][1][m][1][e]);
                        const float i0 = frcp(d0), i1 = frcp(d1), i2 = frcp(d2), i3 = frcp(d3);
                        r0[e] = i0; r1[e] = i1; r2[e] = i2; r3[e] = i3; }
                    u32x2 w; w.x = pk2(r0[0], r0[1]); w.y = pk2(r0[2], r0[3]); *(u32x2*)(rp) = w; w.x = pk2(r1[0], r1[1]); w.y = pk2(r1[2], r1[3]); *(u32x2*)(rp + SEG_STRIDE) = w;
                    w.x = pk2(r2[0], r2[1]); w.y = pk2(r2[2], r2[3]); *(u32x2*)(rp + 2 * SEG_STRIDE) = w; w.x = pk2(r3[0], r3[1]); w.y = pk2(r3[2], r3[3]); *(u32x2*)(rp + 3 * SEG_STRIDE) = w; } }
    }
};
struct EpiGateP {
    static constexpr bool PERM = false, AFTER_DRAIN = false; static constexpr int MIDK = 0;
    bf16_t* O; int ldc; const bf16_t* SG;
    DM void operator()(const f32x4 (&acc)[2][2][4][2], const pg8::Unit& u, int wr, int wc, int fr, int fq) const {
        const int n = u.pn / (D / 256), pnc = u.pn % (D / 256);
        const u32x4* base = (const u32x4*)(SG + ((((size_t)u.pm * (D / 256) + pnc) * 4 + n) * 8 + (wr * 4 + wc)) * (size_t)(16 * 64 * 8)) + (fq * 16 + fr);
        const int row0 = u.pm * 256 + wr * 64 + fr, col0 = u.pn * 256 + wc * 32 + 4 * fq;
#pragma unroll
        for (int ai = 0; ai < 2; ++ai)
#pragma unroll
            for (int m = 0; m < 4; ++m) { bf16_t* rowp = O + (size_t)(row0 + ai * 128 + m * 16) * ldc + col0;
#pragma unroll
                for (int bj = 0; bj < 2; ++bj) { const u32x4 g = base[((ai * 4 + m) * 2 + bj) * 64]; const f32x4 v0 = acc[ai][bj][m][0], v1 = acc[ai][bj][m][1];
                    u32x2 w0, w1; w0.x = pk2(v0[0] * bflo(g.x), v0[1] * bfhi(g.x)); w0.y = pk2(v0[2] * bflo(g.y), v0[3] * bfhi(g.y)); w1.x = pk2(v1[0] * bflo(g.z), v1[1] * bfhi(g.z)); w1.y = pk2(v1[2] * bflo(g.w), v1[3] * bfhi(g.w));
                    *(u32x2*)(rowp + bj * 128) = w0; *(u32x2*)(rowp + bj * 128 + 16) = w1; } }
    }
};
struct EpiF32 {
    static constexpr bool PERM = false, AFTER_DRAIN = false; static constexpr int MIDK = 0;
    float* O; int ldc;
    DM void operator()(const f32x4 (&acc)[2][2][4][2], const pg8::Unit& u, int wr, int wc, int fr, int fq) const {
        const int row0 = u.pm * 256 + wr * 64 + fr, col0 = u.pn * 256 + wc * 32 + 4 * fq;
#pragma unroll
        for (int ai = 0; ai < 2; ++ai)
#pragma unroll
            for (int m = 0; m < 4; ++m) { float* rowp = O + (size_t)(row0 + ai * 128 + m * 16) * ldc + col0;
#pragma unroll
                for (int bj = 0; bj < 2; ++bj)
#pragma unroll
                    for (int n = 0; n < 2; ++n) *(f32x4*)(rowp + bj * 128 + n * 16) = acc[ai][bj][m][n]; }
    }
};

#ifdef EMU
template <class Epi> static void emu_gemm(const pg8::Gemm g, const Epi& E, int ka_div = 0, int ka_mul = 0) {
    if (g.M % 256 || g.N % 256) { printf("emu_gemm: M %d N %d not multiples of 256\n", g.M, g.N); exit(1); }
    std::vector<float> C((size_t)256 * 256);
    const int seglen = (Epi::MIDK > 0) ? Epi::MIDK * 64 : g.K, nseg = g.K / seglen;
    for (int pm = 0; pm < g.M / 256; ++pm) for (int pn = 0; pn < g.N / 256; ++pn) {
        pg8::Unit u{pm, pn, 0};
        std::fill(C.begin(), C.end(), 0.f);
        for (int sg = 0; sg < nseg; ++sg) {
            for (int i = 0; i < 256; ++i) for (int j = 0; j < 256; ++j) { float a = 0.f; const bf16_t* ar = g.A + (size_t)(pm * 256 + i) * g.lda + sg * seglen + (ka_div ? (pn / ka_div) * ka_mul : 0); const bf16_t* br = g.Bt + (size_t)(pn * 256 + j) * g.ldb + sg * seglen;
                for (int k = 0; k < seglen; ++k) a += bf2f(ar[k]) * bf2f(br[k]); C[(size_t)i * 256 + j] += a; }
            const bool fin = (sg == nseg - 1);
            for (int wid = 0; wid < 8; ++wid) for (int lane = 0; lane < 64; ++lane) { const int wr = wid >> 2, wc = wid & 3, fr = lane & 15, fq = lane >> 4;
                f32x4 acc[2][2][4][2];
                for (int ai = 0; ai < 2; ++ai) for (int bj = 0; bj < 2; ++bj) for (int m = 0; m < 4; ++m) for (int n = 0; n < 2; ++n) for (int e = 0; e < 4; ++e) {
                    const int r = 128 * ai + 64 * wr + 16 * m + fr; const int c = Epi::PERM ? (128 * bj + 32 * wc + 8 * fq + 4 * n + e) : (128 * bj + 32 * wc + 16 * n + 4 * fq + e);
                    acc[ai][bj][m][n][e] = C[(size_t)r * 256 + c]; }
                if (fin) E(acc, u, wr, wc, fr, fq);
                else { if constexpr (Epi::MIDK > 0) E.mid(acc, u, sg, wr, wc, fr, fq);
                    for (int ai = 0; ai < 2; ++ai) for (int bj = 0; bj < 2; ++bj) for (int m = 0; m < 4; ++m) for (int n = 0; n < 2; ++n) for (int e = 0; e < 4; ++e) {
                        const int r = 128 * ai + 64 * wr + 16 * m + fr; const int c = Epi::PERM ? (128 * bj + 32 * wc + 8 * fq + 4 * n + e) : (128 * bj + 32 * wc + 16 * n + 4 * fq + e);
                        C[(size_t)r * 256 + c] = acc[ai][bj][m][n][e]; } } }
        }
    }
}
#endif
DI int gate_row(int sc) { const int n = sc / D, j = sc % D, jl = j & 63; return CG0 + 256 * (j >> 6) + 128 * (n >> 1) + 32 * (jl >> 4) + 8 * ((jl >> 2) & 3) + 4 * (n & 1) + (jl & 3); }
template <bool GATE> DI void transpose_item(const float* W, int N, bf16_t* dst, size_t ld_dst, int row_off, int col_off, LAS float* scr, int kb, int nb, int lane) {
    const int k0 = 64 * kb, n0 = 32 * nb;
#pragma unroll 8
    for (int i = 0; i < 32; ++i) { const int kk = 2 * i + (lane >> 5); scr[kk * 33 + (lane & 31)] = W[(size_t)(k0 + kk) * N + n0 + (lane & 31)]; }
    WAVE_SYNC();
    const int c = lane & 7;
#pragma unroll
    for (int j = 0; j < 4; ++j) { const int n = (lane >> 3) + 8 * j; const LAS float* s = scr + (8 * c) * 33 + n;
        u32x4 o; o.x = pk2(s[0 * 33], s[1 * 33]); o.y = pk2(s[2 * 33], s[3 * 33]); o.z = pk2(s[4 * 33], s[5 * 33]); o.w = pk2(s[6 * 33], s[7 * 33]);
        const int drow = GATE ? gate_row(n0 + n - C_MG) : (row_off + n0 + n);
        *(u32x4*)(dst + (size_t)drow * ld_dst + col_off + k0 + 8 * c) = o; }
    WAVE_SYNC();
}
__device__ const unsigned char T5_THR[15] = {19, 21, 24, 27, 31, 35, 40, 46, 52, 59, 67, 77, 87, 99, 113};
DI int t5_bucket(int n) { if (n < 16) return n; int b = 16;
#pragma unroll
    for (int i = 0; i < 15; ++i) b += (n >= (int)T5_THR[i]) ? 1 : 0;
    return b; }

DI void phase_prologue(KP p, lptr lds) {
    const int tid = TID(), lane = tid & 63, wave = tid >> 6;
    const int gw = blockIdx.x * 8 + wave, NGW = gridDim.x * 8;
    const size_t gt = (size_t)blockIdx.x * 512 + tid, NGT = (size_t)gridDim.x * 512;
    LAS float* scr = (LAS float*)(lds + wave * 8704);
    bf16_t* WIN = (bf16_t*)(p->ws + WS_WIN); bf16_t* WBR = (bf16_t*)(p->ws + WS_WBR); bf16_t* WOUT = (bf16_t*)(p->ws + WS_WOUT);
    constexpr int NI_IN = (D / 64) * (IN_COLS / 32), NI_V1 = (D / 64) * 1, NI_BR = (MIX / 64) * (D / 32), NI_OUT = (D / 64) * (D / 32);
    constexpr int PER_L = NI_IN + NI_V1 + 4 * NI_BR + NI_OUT;
    for (int it = gw; it < L * PER_L; it += NGW) {
        const int l = it / PER_L; int r = it % PER_L;
        if (r < NI_IN) { const int nblk = IN_COLS / 32, nb = r % nblk; const float* src = p->in[I_WIN] + (size_t)l * D * IN_COLS; bf16_t* dstw = WIN + (size_t)l * NP * D;
            if (32 * nb >= C_MG) transpose_item<true>(src, IN_COLS, dstw, D, 0, 0, scr, r / nblk, nb, lane); else transpose_item<false>(src, IN_COLS, dstw, D, 0, 0, scr, r / nblk, nb, lane); continue; } r -= NI_IN;
        if (r < NI_V1) { if (l > 0) transpose_item<false>(p->in[I_V1] + (size_t)(l - 1) * D * 32, 32, WIN + (size_t)l * NP * D, D, C_VD, 0, scr, r, 0, lane); continue; } r -= NI_V1;
        if (r < 4 * NI_BR) { const int n = r / NI_BR, rr = r % NI_BR, nblk = D / 32;
            transpose_item<false>(p->in[I_WBR] + ((size_t)l * 4 + n) * MIX * D, D, WBR + (size_t)l * 4 * D * MIX, MIX, n * D, 0, scr, rr / nblk, rr % nblk, lane); continue; } r -= 4 * NI_BR;
        { const int nblk = D / 32; transpose_item<false>(p->in[I_WOUT] + (size_t)l * D * D, D, WOUT + (size_t)l * D * D, D, 0, 0, scr, r / nblk, r % nblk, lane); }
    }
    for (int l = 0; l < L; ++l) { const int r0 = (l == 0) ? C_VD : C_VD + 32; const size_t n8 = (size_t)(CG0 - r0) * D / 8; u32x4* dst = (u32x4*)(WIN + ((size_t)l * NP + r0) * D);
        for (size_t i = gt; i < n8; i += NGT) dst[i] = (u32x4){0u, 0u, 0u, 0u}; }
    { const f32x4* x4 = (const f32x4*)p->in[I_X]; u32x2* xn = (u32x2*)(p->ws + WS_XN);
      for (size_t i = gt; i < (size_t)M * D / 4; i += NGT) { const f32x4 v = x4[i]; u32x2 o; o.x = pk2(v[0], v[1]); o.y = pk2(v[2], v[3]); xn[i] = o; } }
    { bf16_t* W2T = (bf16_t*)(p->ws + SM_W2T); bf16_t* A2T = (bf16_t*)(p->ws + SM_A2T); bf16_t* V2T = (bf16_t*)(p->ws + SM_V2T);
      for (size_t i = gt; i < (size_t)L * MIX * 64; i += NGT) { const int j = (int)(i % 64); const int c = (int)((i / 64) % MIX); const int l = (int)(i / ((size_t)64 * MIX));
          W2T[i] = f2bf(p->in[I_W2][((size_t)l * 64 + j) * MIX + c]); A2T[i] = f2bf(p->in[I_A2][((size_t)l * 64 + j) * MIX + c]); }
      for (size_t i = gt; i < (size_t)L * MIX * 32; i += NGT) { const int j = (int)(i % 32); const int c = (int)((i / 32) % MIX); const int l = (int)(i / ((size_t)32 * MIX));
          V2T[i] = (l > 0) ? f2bf(p->in[I_V2][((size_t)(l - 1) * 32 + j) * MIX + c]) : (bf16_t)0; } }
    if (blockIdx.x == 0) {
        float* LAM = (float*)(p->ws + SM_LAM); float* LB = (float*)(p->ws + SM_LB); float* BT = (float*)(p->ws + SM_BT);
        if (tid < L) { const float* lm = p->in[I_LAM] + (size_t)tid * 256; float s1 = 0.f, s2 = 0.f;
            for (int i = 0; i < 64; ++i) { s1 += lm[i] * lm[64 + i]; s2 += lm[128 + i] * lm[192 + i]; }
            const float li = 0.8f - 0.6f * expf(-0.3f * (float)tid); LAM[tid] = expf(s1) - expf(s2) + li; LAM[L + tid] = li; }
        for (int c = tid; c < MIX; c += 512) { float mx = -1e30f; for (int l = 0; l < L; ++l) mx = fmaxf(mx, p->in[I_HGLOW][(size_t)l * MIX + c]);
            float den = 0.f; for (int l = 0; l < L; ++l) den += expf(p->in[I_HGLOW][(size_t)l * MIX + c] - mx);
            float cum = 0.f; for (int l = 0; l < L; ++l) { if (l > 0) cum += expf(p->in[I_HGLOW][(size_t)l * MIX + c] - mx) / den;
                LB[(size_t)l * MIX + c] = cum; LB[(size_t)(L + l) * MIX + c] = (l > 0) ? logf(cum) : -1e30f; LB[(size_t)(2 * L + l) * MIX + c] = log1pf(-cum); } }
        for (int i = tid; i < AH * 132; i += 512) { const int h = i / 132, d = i % 132; const int bk = (d >= 128) ? 31 : t5_bucket(d); BT[i] = p->in[I_REL][bk * AH + h] * LOG2E; }
    }
}
constexpr int ATT_KSTR = 272, ATT_VSTR = 320;
constexpr int ATT_K_OFF = 0, ATT_V_OFF = 64 * ATT_KSTR, ATT_BT_OFF = ATT_V_OFF + 64 * ATT_VSTR, ATT_X_OFF = 40960;
struct KVRegs { u32x4 k[2], v[2]; };
DI void load_kv(KVRegs& rg, const bf16_t* Z, size_t row0, int kcol, int vcol, int tid) {
#pragma unroll
    for (int i = 0; i < 2; ++i) { const int pc = tid + 512 * i, row = pc >> 4, c16 = pc & 15;
        rg.k[i] = *(const u32x4*)(Z + (row0 + row) * ZLD + kcol + c16 * 8);
        rg.v[i] = *(const u32x4*)(Z + (row0 + row) * ZLD + vcol + c16 * 8); }
}
DI void store_kv(const KVRegs& rg, lptr lds, int tid) {
#pragma unroll
    for (int i = 0; i < 2; ++i) { const int pc = tid + 512 * i, row = pc >> 4, c16 = pc & 15;
        *(LAS u32x4*)(lds + ATT_K_OFF + row * ATT_KSTR + c16 * 16) = rg.k[i];
        *(LAS u32x4*)(lds + ATT_V_OFF + row * ATT_VSTR + c16 * 16) = rg.v[i]; }
}
DI void pv_acc(f32x16 (&o)[4], const f32x16& pt, lptr lds, int kh, int lane) {
    const int hh = lane >> 5, gsub = (lane >> 4) & 1, i16 = lane & 15, qq = i16 >> 2, pp = i16 & 3;
#pragma unroll
    for (int s = 0; s < 2; ++s) {
        const bf16x8 pb = pack8(pt[8 * s], pt[8 * s + 1], pt[8 * s + 2], pt[8 * s + 3], pt[8 * s + 4], pt[8 * s + 5], pt[8 * s + 6], pt[8 * s + 7]);
        const lptr vrow = lds + ATT_V_OFF + (32 * kh + 16 * s + 4 * hh + qq) * ATT_VSTR + gsub * 32 + pp * 8;
#pragma unroll
        for (int db = 0; db < 4; ++db) {
            const s16x4 lo = TR_READ(vrow + db * 64), hi = TR_READ(vrow + 8 * ATT_VSTR + db * 64);
            o[db] = MFMA32(cat4(lo, hi), pb, o[db]); }
    }
}
DI void phase_att_a(KP p, int layer, lptr lds, int unit) {
    const int tid = TID(), lane = tid & 63, wid = RFL(tid >> 6), r = lane & 31, hh = lane >> 5;
    constexpr int NQB = S / 128;
    const int qb = NQB - 1 - (unit % NQB), bh = unit / NQB, h = bh % AH, b = bh / AH;
    const int mp = wid & 1, qs = wid >> 1, q0 = qb * 128, qw0 = q0 + 32 * qs, q = qw0 + r;
    const bf16_t* Z = (const bf16_t*)(p->ws + WS_Z); const size_t rowb = (size_t)b * S;
    const float* LAM = (const float*)(p->ws + SM_LAM); const float lam_full = LAM[layer], lam_init = LAM[L + layer];
    LAS float* BT = (LAS float*)(lds + ATT_BT_OFF);
    __syncthreads();
    if (tid < 132) BT[tid] = ((const float*)(p->ws + SM_BT))[h * 132 + tid];
    bf16x8 qf[4];
    { const bf16_t* qp = Z + (rowb + q) * ZLD + C_AQ + h * 128 + mp * 64 + 8 * hh; const float qsc = 0.125f * LOG2E;
#pragma unroll
      for (int ds = 0; ds < 4; ++ds) { const u32x4 w = *(const u32x4*)(qp + 16 * ds);
          qf[ds] = pack8(bflo(w.x) * qsc, bfhi(w.x) * qsc, bflo(w.y) * qsc, bfhi(w.y) * qsc, bflo(w.z) * qsc, bfhi(w.z) * qsc, bflo(w.w) * qsc, bfhi(w.w) * qsc); } }
    f32x16 o[4];
#pragma unroll
    for (int db = 0; db < 4; ++db)
#pragma unroll
        for (int i = 0; i < 16; ++i) o[db][i] = 0.f;
    float mrun = -INFINITY, lrun = 0.f;
    const int nkt = (q0 + 128) / 64;
    KVRegs rg; load_kv(rg, Z, rowb, C_AK + h * 128, C_AV + h * 128, tid);
    for (int kt = 0; kt < nkt; ++kt) {
        const int k0 = kt * 64;
        __syncthreads();
        store_kv(rg, lds, tid);
        if (kt + 1 < nkt) load_kv(rg, Z, rowb + k0 + 64, C_AK + h * 128, C_AV + h * 128, tid);
        __syncthreads();
        if (k0 <= qw0 + 31) {
#pragma unroll 1
            for (int kh = 0; kh < 2; ++kh) {
                if (k0 + 32 * kh > qw0 + 31) break;
                f32x16 sc;
#pragma unroll
                for (int i = 0; i < 16; ++i) sc[i] = 0.f;
#pragma unroll
                for (int ds = 0; ds < 4; ++ds) { const bf16x8 a = *(const LAS bf16x8*)(lds + ATT_K_OFF + (32 * kh + r) * ATT_KSTR + mp * 128 + ds * 32 + hh * 16); sc = MFMA32(a, qf[ds], sc); }
                const int kbase = k0 + 32 * kh;
                if (qw0 - (kbase + 31) >= 128) { const float cb = BT[128];
#pragma unroll
                    for (int i = 0; i < 16; ++i) sc[i] += cb;
                } else {
#pragma unroll
                    for (int i = 0; i < 16; ++i) { const int dist = q - (kbase + crow(i, hh)); const int di = dist < 0 ? 0 : (dist > 128 ? 128 : dist);
                        sc[i] = (dist < 0) ? -INFINITY : sc[i] + BT[di]; }
                }
                float mx = sc[0];
#pragma unroll
                for (int i = 1; i < 16; ++i) mx = fmaxf(mx, sc[i]);
                mx = fmaxf(mx, __shfl_xor(mx, 32));
                const float mnew = fmaxf(mrun, mx), alpha = ex2(mrun - mnew);
                float sum = 0.f;
#pragma unroll
                for (int i = 0; i < 16; ++i) { const float e = ex2(sc[i] - mnew); sc[i] = e; sum += e; }
                sum += __shfl_xor(sum, 32);
                lrun = lrun * alpha + sum; mrun = mnew;
                if (ANY(alpha != 1.f)) {
#pragma unroll
                    for (int db = 0; db < 4; ++db)
#pragma unroll
                        for (int i = 0; i < 16; ++i) o[db][i] *= alpha; }
                pv_acc(o, sc, lds, kh, lane);
            }
        }
    }
    __syncthreads();
    const float inv = 1.f / lrun;
    LAS float* X = (LAS float*)(lds + ATT_X_OFF) + (qs * 32 + r) * 132;
    if (mp == 1) {
#pragma unroll
        for (int db = 0; db < 4; ++db)
#pragma unroll
            for (int g = 0; g < 4; ++g) { f32x4 v; v[0] = o[db][4 * g] * inv * lam_full; v[1] = o[db][4 * g + 1] * inv * lam_full; v[2] = o[db][4 * g + 2] * inv * lam_full; v[3] = o[db][4 * g + 3] * inv * lam_full;
                *(LAS f32x4*)(X + 32 * db + 8 * g + 4 * hh) = v; }
    }
    __syncthreads();
    if (mp == 0) {
        float ss = 0.f;
#pragma unroll
        for (int db = 0; db < 4; ++db)
#pragma unroll
            for (int g = 0; g < 4; ++g) { const f32x4 x1 = *(const LAS f32x4*)(X + 32 * db + 8 * g + 4 * hh);
#pragma unroll
                for (int e = 0; e < 4; ++e) { const float x = o[db][4 * g + e] * inv - x1[e]; o[db][4 * g + e] = x; ss += x * x; } }
        ss += __shfl_xor(ss, 32);
        const float rinv = frsq(ss * (1.f / 128.f) + RMS_EPS) * (1.f - lam_init);
        const float* sg = p->in[I_SUBLN] + (size_t)layer * 128;
        const bf16_t* gp = Z + (rowb + q) * ZLD + C_AG + h * 128; bf16_t* yp = (bf16_t*)(p->ws + WS_Y) + (rowb + q) * (4 * MIX) + 0 * MIX + h * 128;
#pragma unroll
        for (int db = 0; db < 4; ++db)
#pragma unroll
            for (int g = 0; g < 4; ++g) { const int d = 32 * db + 8 * g + 4 * hh; const u32x2 gw = *(const u32x2*)(gp + d); const f32x4 sv = *(const f32x4*)(sg + d);
                u32x2 w; w.x = pk2(o[db][4 * g] * rinv * sv[0] * fsilu(bflo(gw.x)), o[db][4 * g + 1] * rinv * sv[1] * fsilu(bfhi(gw.x)));
                w.y = pk2(o[db][4 * g + 2] * rinv * sv[2] * fsilu(bflo(gw.y)), o[db][4 * g + 3] * rinv * sv[3] * fsilu(bfhi(gw.y)));
                *(u32x2*)(yp + d) = w; }
    }
}

constexpr float SB_CUT = -110.f;
DI void phase_att_d(KP p, int layer, lptr lds, int unit) {
    const int tid = TID(), lane = tid & 63, wid = RFL(tid >> 6), r = lane & 31, hh = lane >> 5;
    constexpr int NQB = S / 256;
    const int qb = NQB - 1 - (unit % NQB), bh = unit / NQB, h = bh % SH, b = bh / SH;
    const int q0 = qb * 256, qw0 = q0 + 32 * wid, q = qw0 + r;
    const bf16_t* Z = (const bf16_t*)(p->ws + WS_Z); const size_t rowb = (size_t)b * S;
    LAS int* FLG = (LAS int*)(lds + ATT_BT_OFF);
    bf16x8 qf[8];
    { const bf16_t* qp = Z + (rowb + q) * ZLD + C_SQ + h * 128 + 8 * hh; const float qsc = 0.08838834764831845f;
#pragma unroll
      for (int ds = 0; ds < 8; ++ds) { const u32x4 w = *(const u32x4*)(qp + 16 * ds);
          qf[ds] = pack8(bflo(w.x) * qsc, bfhi(w.x) * qsc, bflo(w.y) * qsc, bfhi(w.y) * qsc, bflo(w.z) * qsc, bfhi(w.z) * qsc, bflo(w.w) * qsc, bfhi(w.w) * qsc); } }
    f32x16 o[4];
#pragma unroll
    for (int db = 0; db < 4; ++db)
#pragma unroll
        for (int i = 0; i < 16; ++i) o[db][i] = 0.f;
    float carry = 0.f;
    KVRegs rg; load_kv(rg, Z, rowb + (size_t)((q0 + 255) / 64) * 64, C_SK + h * 128, C_SV + h * 128, tid);
    for (int kt = (q0 + 255) / 64; kt >= 0; --kt) {
        const int k0 = kt * 64;
        __syncthreads();
        store_kv(rg, lds, tid);
        if (kt > 0) load_kv(rg, Z, rowb + k0 - 64, C_SK + h * 128, C_SV + h * 128, tid);
        __syncthreads();
        if (k0 < qw0 + 31) {
#pragma unroll 1
            for (int kh = 1; kh >= 0; --kh) {
                if (k0 + 32 * kh >= qw0 + 31) continue;
                f32x16 z;
#pragma unroll
                for (int i = 0; i < 16; ++i) z[i] = 0.f;
#pragma unroll
                for (int ds = 0; ds < 8; ++ds) { const bf16x8 a = *(const LAS bf16x8*)(lds + ATT_K_OFF + (32 * kh + r) * ATT_KSTR + ds * 32 + hh * 16); z = MFMA32(a, qf[ds], z); }
                f32x16 lk; float gsum[4];
#pragma unroll
                for (int g = 0; g < 4; ++g) { gsum[g] = 0.f;
#pragma unroll
                    for (int e = 0; e < 4; ++e) { const int i = 4 * g + e; const bool valid = (k0 + 32 * kh + crow(i, hh)) < q; const float sp = fsoftplus(z[i]);
                        lk[i] = valid ? -sp : 0.f; z[i] = valid ? (z[i] - sp) : -INFINITY; gsum[g] += lk[i]; } }
                float og[4];
#pragma unroll
                for (int g = 0; g < 4; ++g) og[g] = __shfl_xor(gsum[g], 32);
                float suf[4]; float run = 0.f;
#pragma unroll
                for (int g = 3; g >= 0; --g) {
                    if (hh == 1) { suf[g] = run; run += gsum[g] + og[g]; }
                    else { suf[g] = run + og[g]; run += gsum[g] + og[g]; }
                }
#pragma unroll
                for (int g = 0; g < 4; ++g) { float inner = 0.f;
#pragma unroll
                    for (int e = 3; e >= 0; --e) { const int i = 4 * g + e; const float between = carry + suf[g] + inner; inner += lk[i]; z[i] = ex2((z[i] + between) * LOG2E); } }
                carry += run;
                pv_acc(o, z, lds, kh, lane);
            }
        }
        const int active = ANY(carry > SB_CUT) ? 1 : 0;
        if (lane == 0) FLG[wid] = active;
        __syncthreads();
        int anyact = 0;
#pragma unroll
        for (int w = 0; w < 8; ++w) anyact |= FLG[w];
        if (!anyact) break;
    }
    const bf16_t* gp = Z + (rowb + q) * ZLD + C_SG + h * 128; bf16_t* yp = (bf16_t*)(p->ws + WS_Y) + (rowb + q) * (4 * MIX) + 3 * MIX + h * 128;
#pragma unroll
    for (int db = 0; db < 4; ++db)
#pragma unroll
        for (int g = 0; g < 4; ++g) { const int d = 32 * db + 8 * g + 4 * hh; const u32x2 gw = *(const u32x2*)(gp + d);
            u32x2 w; w.x = pk2(o[db][4 * g] * fsilu(bflo(gw.x)), o[db][4 * g + 1] * fsilu(bfhi(gw.x)));
            w.y = pk2(o[db][4 * g + 2] * fsilu(bflo(gw.y)), o[db][4 * g + 3] * fsilu(bfhi(gw.y)));
            *(u32x2*)(yp + d) = w; }
}
constexpr int HG_STR = 144;
constexpr int HG_QT = 0, HG_KT = 128 * HG_STR, HG_IT = 2 * 128 * HG_STR, HG_SC = 3 * 128 * HG_STR, HG_VEC = HG_SC + 64 * HG_STR;
DI bf16x8 hg_trfrag(lptr img, int col0, int dbase, int lane) {
    const int g = lane >> 4, i16 = lane & 15, qq = i16 >> 2, pp = i16 & 3;
    const lptr a = img + (dbase + 4 * g + qq) * HG_STR + (col0 + 4 * pp) * 2;
    return cat4(TR_READ(a), TR_READ(a + 16 * HG_STR));
}
constexpr int HG_NC = S / 64, HG_NCH = NB * HH * HG_NC;
DI void phase_hg_local(KP p, int layer, lptr lds, int unit) {
    const int tid = TID(), lane = tid & 63, wid = RFL(tid >> 6), g = lane >> 4, c16 = lane & 15;
    const int c = unit % HG_NC, bh = unit / HG_NC, h = bh % HH, b = bh / HH;
    const bf16_t* Z = (const bf16_t*)(p->ws + WS_Z); const size_t row0 = (size_t)b * S + (size_t)c * 64;
    const float* LBp = (const float*)(p->ws + SM_LB);
    LAS float* EBD = (LAS float*)(lds + HG_VEC); LAS float* QTOT = EBD + 128;
    const int ch = tid & 127, tq = tid >> 7;
    const float lb = LBp[(size_t)layer * MIX + h * 128 + ch], loglb = LBp[(size_t)(L + layer) * MIX + h * 128 + ch], log1m = LBp[(size_t)(2 * L + layer) * MIX + h * 128 + ch];
    __syncthreads();
    float bl[16], qv[16], kv[16], iv[16];
    { const bf16_t* zp = Z + (row0 + 16 * tq) * ZLD + h * 128 + ch; float run = 0.f;
#pragma unroll
      for (int t = 0; t < 16; ++t) { const float zq = bf2f(zp[(size_t)t * ZLD + C_HQ]), zf = bf2f(zp[(size_t)t * ZLD + C_HF]); iv[t] = bf2f(zp[(size_t)t * ZLD + C_HI]);
          const float ls = -fsoftplus(-zf);
          float lf; if (lb > 0.f) { const float a_ = loglb, b_ = log1m + ls, mx = fmaxf(a_, b_); lf = mx + flog(fexp(a_ - mx) + fexp(b_ - mx)); } else lf = ls;
          run += lf; bl[t] = run; qv[t] = zq; kv[t] = (1.f - lb) * fexp(ls - zf); }
      QTOT[tq * 128 + ch] = run; }
    __syncthreads();
    { const float t0 = QTOT[ch], t1 = QTOT[128 + ch], t2 = QTOT[256 + ch], t3 = QTOT[384 + ch];
      const float pre = (tq > 0 ? t0 : 0.f) + (tq > 1 ? t1 : 0.f) + (tq > 2 ? t2 : 0.f), bref = t0 + t1, blast = bref + t2 + t3;
      unsigned qw[8], kw[8], iw[8];
#pragma unroll
      for (int t = 0; t < 16; t += 2) { const float b0 = pre + bl[t] - bref, b1 = pre + bl[t + 1] - bref;
          qw[t >> 1] = pk2(qv[t] * fexp(b0), qv[t + 1] * fexp(b1)); kw[t >> 1] = pk2(kv[t] * fexp(-b0), kv[t + 1] * fexp(-b1)); iw[t >> 1] = pk2(iv[t], iv[t + 1]); }
      LAS u32x4* dq = (LAS u32x4*)(lds + HG_QT + ch * HG_STR + tq * 32); dq[0] = (u32x4){qw[0], qw[1], qw[2], qw[3]}; dq[1] = (u32x4){qw[4], qw[5], qw[6], qw[7]};
      LAS u32x4* dk = (LAS u32x4*)(lds + HG_KT + ch * HG_STR + tq * 32); dk[0] = (u32x4){kw[0], kw[1], kw[2], kw[3]}; dk[1] = (u32x4){kw[4], kw[5], kw[6], kw[7]};
      LAS u32x4* di = (LAS u32x4*)(lds + HG_IT + ch * HG_STR + tq * 32); di[0] = (u32x4){iw[0], iw[1], iw[2], iw[3]}; di[1] = (u32x4){iw[4], iw[5], iw[6], iw[7]};
      if (tq == 0) { float* VE = (float*)(p->ws + WS_HGVE) + (size_t)unit * 256; VE[ch] = fexp(bref); VE[128 + ch] = fexp(blast); EBD[ch] = fexp(blast - bref); } }
    __syncthreads();
#pragma unroll
    for (int k2 = 0; k2 < 2; ++k2) { const int ti = 2 * wid + k2, tb = ti >> 2, sb = ti & 3;
        f32x4 acc = (f32x4){0.f, 0.f, 0.f, 0.f};
        if (sb <= tb) {
#pragma unroll
            for (int dp = 0; dp < 4; ++dp) acc = MFMA16(hg_trfrag(lds + HG_QT, 16 * tb, 32 * dp, lane), hg_trfrag(lds + HG_KT, 16 * sb, 32 * dp, lane), acc); }
        const int s = 16 * sb + c16;
#pragma unroll
        for (int e = 0; e < 4; ++e) { const int t = 16 * tb + 4 * g + e; *(LAS bf16_t*)(lds + HG_SC + t * HG_STR + s * 2) = f2bf((s <= t) ? acc[e] : 0.f); }
        ((bf16x8*)(p->ws + WS_HGQF))[((size_t)unit * 16 + ti) * 64 + lane] = hg_trfrag(lds + HG_QT, 16 * (ti >> 2), 32 * (ti & 3), lane); }
    __syncthreads();
    bf16x8 ib[2];
#pragma unroll
    for (int ks = 0; ks < 2; ++ks) ib[ks] = *(const LAS bf16x8*)(lds + HG_IT + (16 * wid + c16) * HG_STR + (8 * g + 32 * ks) * 2);
    f32x4* IN = (f32x4*)(p->ws + WS_HGIN) + ((size_t)unit * 8 + wid) * 4 * 64;
#pragma unroll
    for (int tb = 0; tb < 4; ++tb) { f32x4 acc = (f32x4){0.f, 0.f, 0.f, 0.f};
#pragma unroll
        for (int ks = 0; ks < 2; ++ks) acc = MFMA16(*(const LAS bf16x8*)(lds + HG_SC + (16 * tb + c16) * HG_STR + (8 * g + 32 * ks) * 2), ib[ks], acc);
        IN[tb * 64 + lane] = acc; }
    f32x4* DS = (f32x4*)(p->ws + WS_HGDS) + ((size_t)unit * 8 + wid) * 8 * 64;
#pragma unroll
    for (int db = 0; db < 8; ++db) { f32x4 tmp = (f32x4){0.f, 0.f, 0.f, 0.f};
#pragma unroll
        for (int ks = 0; ks < 2; ++ks) tmp = MFMA16(*(const LAS bf16x8*)(lds + HG_KT + (16 * db + c16) * HG_STR + (8 * g + 32 * ks) * 2), ib[ks], tmp);
        const f32x4 ed = *(const LAS f32x4*)(EBD + 16 * db + 4 * g);
        DS[db * 64 + lane] = tmp * ed; }
}
DI void phase_hg_scan(KP p, int unit) {
    const int tid = TID(), lane = tid & 63, wid = RFL(tid >> 6), g = lane >> 4;
    f32x4 st[8];
#pragma unroll
    for (int db = 0; db < 8; ++db) st[db] = (f32x4){0.f, 0.f, 0.f, 0.f};
    const float* VE0 = (const float*)(p->ws + WS_HGVE) + (size_t)unit * HG_NC * 256;
    const f32x4* DS0 = (const f32x4*)(p->ws + WS_HGDS) + ((size_t)unit * HG_NC * 8 + wid) * 8 * 64 + lane;
    bf16x8* SF0 = (bf16x8*)(p->ws + WS_HGSF) + ((size_t)unit * HG_NC * 8 + wid) * 4 * 64 + lane;
    f32x4 ds[8], el[8], er[8];
#pragma unroll
    for (int db = 0; db < 8; ++db) { ds[db] = DS0[db * 64]; el[db] = *(const f32x4*)(VE0 + 128 + 16 * db + 4 * g); er[db] = *(const f32x4*)(VE0 + 16 * db + 4 * g); }
    for (int c = 0; c < HG_NC; ++c) {
        const int cn = (c + 1 < HG_NC) ? c + 1 : c;
        f32x4 dsn[8], eln[8], ern[8];
#pragma unroll
        for (int db = 0; db < 8; ++db) { dsn[db] = DS0[((size_t)cn * 8 * 8 + db) * 64]; eln[db] = *(const f32x4*)(VE0 + (size_t)cn * 256 + 128 + 16 * db + 4 * g); ern[db] = *(const f32x4*)(VE0 + (size_t)cn * 256 + 16 * db + 4 * g); }
#pragma unroll
        for (int dp = 0; dp < 4; ++dp) { const f32x4 a0 = st[2 * dp] * er[2 * dp], a1 = st[2 * dp + 1] * er[2 * dp + 1];
            SF0[((size_t)c * 8 * 4 + dp) * 64] = pack8(a0[0], a0[1], a0[2], a0[3], a1[0], a1[1], a1[2], a1[3]); }
#pragma unroll
        for (int db = 0; db < 8; ++db) { st[db] = el[db] * st[db] + ds[db]; ds[db] = dsn[db]; el[db] = eln[db]; er[db] = ern[db]; }
    }
}
DI void phase_hg_out(KP p, int layer, lptr lds, int unit) {
    const int tid = TID(), lane = tid & 63, wid = RFL(tid >> 6), g = lane >> 4, c16 = lane & 15;
    const int c = unit % HG_NC, bh = unit / HG_NC, h = bh % HH, b = bh / HH;
    const bf16_t* Z = (const bf16_t*)(p->ws + WS_Z); const size_t row0 = (size_t)b * S + (size_t)c * 64;
    LAS float* PS = (LAS float*)(lds + HG_VEC);
    const float gnorm = p->in[I_HGNORM][(size_t)layer * 128 + 16 * wid + c16];
    const bf16x8* QF = (const bf16x8*)(p->ws + WS_HGQF) + (size_t)unit * 16 * 64 + lane;
    const bf16x8* SF = (const bf16x8*)(p->ws + WS_HGSF) + ((size_t)unit * 8 + wid) * 4 * 64 + lane;
    const f32x4* IN = (const f32x4*)(p->ws + WS_HGIN) + ((size_t)unit * 8 + wid) * 4 * 64 + lane;
    bf16x8 sf[4];
#pragma unroll
    for (int dp = 0; dp < 4; ++dp) sf[dp] = SF[dp * 64];
    f32x4 ot[4];
#pragma unroll
    for (int tb = 0; tb < 4; ++tb) { f32x4 acc = IN[tb * 64];
#pragma unroll
        for (int dp = 0; dp < 4; ++dp) acc = MFMA16(QF[(tb * 4 + dp) * 64], sf[dp], acc);
        ot[tb] = acc; }
    if (c == 0 && g == 0) { const float* OEX = (const float*)(p->ws + WS_OEX) + (size_t)bh * FX_T * 128 + 16 * wid + c16;
#pragma unroll
        for (int e = 0; e < FX_T; ++e) ot[0][e] = OEX[e * 128]; }
    __syncthreads();
#pragma unroll
    for (int tb = 0; tb < 4; ++tb)
#pragma unroll
        for (int e = 0; e < 4; ++e) { float v = ot[tb][e] * ot[tb][e]; v += __shfl_xor(v, 1); v += __shfl_xor(v, 2); v += __shfl_xor(v, 4); v += __shfl_xor(v, 8);
            if (c16 == 0) PS[wid * 64 + 16 * tb + 4 * g + e] = v; }
    __syncthreads();
    const int e_col = h * 128 + 16 * wid + c16;
#pragma unroll
    for (int tb = 0; tb < 4; ++tb)
#pragma unroll
        for (int e = 0; e < 4; ++e) { const int t = 16 * tb + 4 * g + e; float ss = 0.f;
#pragma unroll
            for (int w = 0; w < 8; ++w) ss += PS[w * 64 + t];
            const float gate = bf2f(Z[(row0 + t) * ZLD + C_HG + e_col]);
            ((bf16_t*)(p->ws + WS_Y))[(row0 + t) * (4 * MIX) + 1 * MIX + e_col] = f2bf(ot[tb][e] * frsq(ss * (1.f / 128.f) + RMS_EPS) * gnorm * fsilu(gate)); }
}
DI f32x4 lerp4(const bf16_t* zc, const bf16_t* zp, bool hp, const float* mu) {
    const u32x2 c = *(const u32x2*)zc; u32x2 pv = (u32x2){0u, 0u}; if (hp) pv = *(const u32x2*)zp; const f32x4 m4 = *(const f32x4*)mu;
    f32x4 o; const float c0 = bflo(c.x), c1 = bfhi(c.x), c2 = bflo(c.y), c3 = bfhi(c.y);
    o[0] = c0 + (bflo(pv.x) - c0) * m4[0]; o[1] = c1 + (bfhi(pv.x) - c1) * m4[1]; o[2] = c2 + (bflo(pv.y) - c2) * m4[2]; o[3] = c3 + (bfhi(pv.y) - c3) * m4[3]; return o; }
DI void rw_prep_item(KP p, int layer, int item, int lane) {
    const int r = lane & 31, hh = lane >> 5;
    const int hd = item % RH, tt = item / RH;
    const size_t m = (size_t)tt * 32 + r; const int t = (int)(m % S), b = (int)(m / S); const bool hp = t > 0;
    const bf16_t* Z = (const bf16_t*)(p->ws + WS_Z); const bf16_t* zc = Z + m * ZLD; const bf16_t* zp = hp ? zc - ZLD : zc;
    const float* mu = p->in[I_MU] + (size_t)layer * RW_MIX;
    bf16x8 xw[4], xa[4], xv[2];
#pragma unroll
    for (int s = 0; s < 4; ++s) { const int jj = 16 * s + 8 * hh;
        const f32x4 w0v = lerp4(zc + C_RM + 3 * MIX + jj, zp + C_RM + 3 * MIX + jj, hp, mu + 3 * MIX + jj), w1v = lerp4(zc + C_RM + 3 * MIX + jj + 4, zp + C_RM + 3 * MIX + jj + 4, hp, mu + 3 * MIX + jj + 4);
        xw[s] = pack8(tanhf(w0v[0]), tanhf(w0v[1]), tanhf(w0v[2]), tanhf(w0v[3]), tanhf(w1v[0]), tanhf(w1v[1]), tanhf(w1v[2]), tanhf(w1v[3]));
        const f32x4 a0v = lerp4(zc + C_RM + 3 * MIX + 64 + jj, zp + C_RM + 3 * MIX + 64 + jj, hp, mu + 3 * MIX + 64 + jj), a1v = lerp4(zc + C_RM + 3 * MIX + 64 + jj + 4, zp + C_RM + 3 * MIX + 64 + jj + 4, hp, mu + 3 * MIX + 64 + jj + 4);
        xa[s] = pack8(a0v[0], a0v[1], a0v[2], a0v[3], a1v[0], a1v[1], a1v[2], a1v[3]); SCHED_FENCE(); }
    if (layer > 0) { const float* vmu = p->in[I_VMU] + (size_t)(layer - 1) * 32;
#pragma unroll
        for (int s = 0; s < 2; ++s) { const int jj = 16 * s + 8 * hh;
            const f32x4 v0v = lerp4(zc + C_VD + jj, zp + C_VD + jj, hp, vmu + jj), v1v = lerp4(zc + C_VD + jj + 4, zp + C_VD + jj + 4, hp, vmu + jj + 4);
            xv[s] = pack8(v0v[0], v0v[1], v0v[2], v0v[3], v1v[0], v1v[1], v1v[2], v1v[3]); } }
    else { xv[0] = xw[0]; xv[1] = xw[0]; }
    const bf16_t* W2T = (const bf16_t*)(p->ws + SM_W2T) + (size_t)layer * MIX * 64; const bf16_t* A2T = (const bf16_t*)(p->ws + SM_A2T) + (size_t)layer * MIX * 64;
    const bf16_t* V2T = (const bf16_t*)(p->ws + SM_V2T) + (size_t)layer * MIX * 32;
    float* SCI = (float*)(p->ws + WS_SCI) + (((size_t)b * RH + hd) * S + t) * 384;
    float* VF = (float*)(p->ws + WS_VF) + m * MIX;
    const float* w0 = p->in[I_W0] + (size_t)layer * MIX; const float* a0 = p->in[I_A0] + (size_t)layer * MIX; const float* kkp = p->in[I_KK] + (size_t)layer * MIX;
    const float* kap = p->in[I_KA] + (size_t)layer * MIX; const float* rkp = p->in[I_RK] + (size_t)layer * MIX; const float* v0 = p->in[I_V0] + (size_t)(layer > 0 ? layer - 1 : 0) * MIX;
    float ssq = 0.f;
#pragma unroll 1
    for (int cg = 0; cg < 8; ++cg) {
        const int ch = hd * 64 + 32 * (cg >> 2) + 8 * (cg & 3) + 4 * hh;
        const f32x4 k4 = lerp4(zc + C_RM + MIX + ch, zp + C_RM + MIX + ch, hp, mu + MIX + ch), kq = *(const f32x4*)(kkp + ch);
        ssq += (k4[0] * kq[0] * k4[0] * kq[0] + k4[1] * kq[1] * k4[1] * kq[1]) + (k4[2] * kq[2] * k4[2] * kq[2] + k4[3] * kq[3] * k4[3] * kq[3]); }
    ssq += __shfl_xor(ssq, 32);
    const float kinv = 1.f / fmaxf(sqrtf(ssq), 1e-12f);
    float bon = 0.f;
#pragma unroll 1
    for (int cb = 0; cb < 2; ++cb) {
        const int chA = hd * 64 + 32 * cb + r;
        f32x16 lw, la, lv;
#pragma unroll
        for (int i = 0; i < 16; ++i) { lw[i] = 0.f; la[i] = 0.f; lv[i] = 0.f; }
#pragma unroll
        for (int s = 0; s < 4; ++s) { lw = MFMA32(*(const bf16x8*)(W2T + (size_t)chA * 64 + 16 * s + 8 * hh), xw[s], lw);
                                      la = MFMA32(*(const bf16x8*)(A2T + (size_t)chA * 64 + 16 * s + 8 * hh), xa[s], la); }
        if (layer > 0) {
#pragma unroll
            for (int s = 0; s < 2; ++s) lv = MFMA32(*(const bf16x8*)(V2T + (size_t)chA * 32 + 16 * s + 8 * hh), xv[s], lv); }
#pragma unroll
        for (int gq = 0; gq < 4; ++gq) { f32x4 o_w, o_k, o_a, o_b; const int cl = 32 * cb + 8 * gq + 4 * hh, ch = hd * 64 + cl;
            const f32x4 r4 = lerp4(zc + C_RM + ch, zp + C_RM + ch, hp, mu + ch), k4 = lerp4(zc + C_RM + MIX + ch, zp + C_RM + MIX + ch, hp, mu + MIX + ch);
            f32x4 v4 = lerp4(zc + C_RM + 2 * MIX + ch, zp + C_RM + 2 * MIX + ch, hp, mu + 2 * MIX + ch);
            const f32x4 w04 = *(const f32x4*)(w0 + ch), a04 = *(const f32x4*)(a0 + ch), kq = *(const f32x4*)(kkp + ch), ka4 = *(const f32x4*)(kap + ch), rk4 = *(const f32x4*)(rkp + ch);
            if (layer == 0) { if (t >= FX_T) *(f32x4*)(VF + ch) = v4; }
            else { const f32x4 vf = *(const f32x4*)(VF + ch), v04 = *(const f32x4*)(v0 + ch);
#pragma unroll
                for (int e = 0; e < 4; ++e) v4[e] = v4[e] + (vf[e] - v4[e]) * fsigmoid(v04[e] + lv[4 * gq + e]); }
#pragma unroll
            for (int e = 0; e < 4; ++e) { const int i = 4 * gq + e;
                const float wlog = -fsoftplus(-(w04[e] + lw[i])) - 0.5f; o_w[e] = fexp(-fexp(wlog));
                const float a = fsigmoid(a04[e] + la[i]);
                const float kk = k4[e] * kq[e] * kinv; const float k2 = k4[e] * (1.f + (a - 1.f) * ka4[e]);
                bon += r4[e] * k2 * rk4[e];
                o_k[e] = k2; o_a[e] = -kk; o_b[e] = kk * a; }
            if (t >= FX_T) {
            *(f32x4*)(SCI + 0 * 64 + cl) = r4; *(f32x4*)(SCI + 1 * 64 + cl) = o_w; *(f32x4*)(SCI + 2 * 64 + cl) = o_k;
            *(f32x4*)(SCI + 3 * 64 + cl) = v4; *(f32x4*)(SCI + 4 * 64 + cl) = o_a; *(f32x4*)(SCI + 5 * 64 + cl) = o_b; } SCHED_FENCE(); }
    }
    bon += __shfl_xor(bon, 32);
    if (hh == 0 && t >= FX_T) ((float*)(p->ws + WS_BON))[m * RH + hd] = bon;
}
DI void phase_rw_prep(KP p, int layer) {
    const int tid = TID(), lane = tid & 63, wave = tid >> 6;
    constexpr int NITEM = (M / 32) * RH;
    for (int it = blockIdx.x * 8 + wave; it < NITEM; it += gridDim.x * 8) rw_prep_item(p, layer, it, lane);
}

constexpr int RS_TC = 64, RS_BUF = 0, RS_OB = RS_TC * 384 * 4;
DI void phase_rw_scan(KP p, lptr lds, int unit) {
    const int tid = TID(), kseg = tid & 15, rl = tid >> 4;
    const int half = unit & 1, bh = unit >> 1, hd = bh % RH, b = bh / RH;
    const float* SCI = (const float*)(p->ws + WS_SCI) + ((size_t)b * RH + hd) * S * 384;
    float* SCO = (float*)(p->ws + WS_SCO) + (size_t)b * S * MIX + hd * 64 + half * 32;
    LAS float* buf = (LAS float*)(lds + RS_BUF); LAS float* OB = (LAS float*)(lds + RS_OB);
    f32x4 st = (f32x4){0.f, 0.f, 0.f, 0.f};
    for (int c0 = 0; c0 < S; c0 += RS_TC) {
        __syncthreads();
        { const f32x4* src = (const f32x4*)(SCI + (size_t)c0 * 384);
#pragma unroll
          for (int i = 0; i < RS_TC * 96 / 512; ++i) ((LAS f32x4*)buf)[tid + 512 * i] = src[tid + 512 * i]; }
        __syncthreads();
        { const LAS float* sp = buf + 4 * kseg; const LAS float* vp = buf + 192 + half * 32 + rl;
          f32x4 r4 = *(const LAS f32x4*)(sp), w4 = *(const LAS f32x4*)(sp + 64), k4 = *(const LAS f32x4*)(sp + 128), a4 = *(const LAS f32x4*)(sp + 256), b4 = *(const LAS f32x4*)(sp + 320); float vr = *vp;
#pragma unroll 2
          for (int t = 0; t < RS_TC; ++t) {
              const int tn = (t + 1 < RS_TC) ? (t + 1) : t;
              const f32x4 r4n = *(const LAS f32x4*)(sp + tn * 384), w4n = *(const LAS f32x4*)(sp + tn * 384 + 64), k4n = *(const LAS f32x4*)(sp + tn * 384 + 128), a4n = *(const LAS f32x4*)(sp + tn * 384 + 256), b4n = *(const LAS f32x4*)(sp + tn * 384 + 320);
              const float vrn = vp[tn * 384];
              float sa = (st[0] * a4[0] + st[1] * a4[1]) + (st[2] * a4[2] + st[3] * a4[3]);
              sa += ROW_ROR(sa, 8); sa += ROW_ROR(sa, 4); sa += ROW_ROR(sa, 2); sa += ROW_ROR(sa, 1);
#pragma unroll
              for (int e = 0; e < 4; ++e) st[e] = st[e] * w4[e] + (sa * b4[e] + vr * k4[e]);
              float ov = (st[0] * r4[0] + st[1] * r4[1]) + (st[2] * r4[2] + st[3] * r4[3]);
              ov += ROW_ROR(ov, 8); ov += ROW_ROR(ov, 4); ov += ROW_ROR(ov, 2); ov += ROW_ROR(ov, 1);
              if (kseg == 0) OB[t * 32 + rl] = ov;
              r4 = r4n; w4 = w4n; k4 = k4n; a4 = a4n; b4 = b4n; vr = vrn; } }
        __syncthreads();
#pragma unroll
        for (int i = 0; i < RS_TC * 32 / 512; ++i) { const int idx = tid + 512 * i, t = idx >> 5, rr = idx & 31; SCO[(size_t)(c0 + t) * MIX + rr] = OB[idx]; }
    }
}

DI void phase_rw_post(KP p, int layer) {
    const size_t gt = (size_t)blockIdx.x * 512 + TID(), NGT = (size_t)gridDim.x * 512;
    const bf16_t* Z = (const bf16_t*)(p->ws + WS_Z); const float* SCO = (const float*)(p->ws + WS_SCO); const float* BON = (const float*)(p->ws + WS_BON);
    const float* lg = p->in[I_LNXG] + (size_t)layer * MIX; const float* lbv = p->in[I_LNXB] + (size_t)layer * MIX;
    for (size_t i = gt; i < (size_t)M * (MIX / 16); i += NGT) { const size_t m = i / (MIX / 16); const int c0 = (int)(i % (MIX / 16)) * 16, hd = c0 >> 6; const int t = (int)(m % S), b = (int)(m / S);
        float o[16]; float s1 = 0.f;
#pragma unroll
        for (int j = 0; j < 4; ++j) { const f32x4 v = *(const f32x4*)(SCO + m * MIX + c0 + 4 * j); o[4 * j] = v[0]; o[4 * j + 1] = v[1]; o[4 * j + 2] = v[2]; o[4 * j + 3] = v[3]; s1 += (v[0] + v[1]) + (v[2] + v[3]); }
        s1 += __shfl_xor(s1, 1); s1 += __shfl_xor(s1, 2); const float mean = s1 * (1.f / 64.f); float s2 = 0.f;
#pragma unroll
        for (int j = 0; j < 16; ++j) { o[j] -= mean; s2 += o[j] * o[j]; }
        s2 += __shfl_xor(s2, 1); s2 += __shfl_xor(s2, 2); const float rstd = frsq(s2 * (1.f / 64.f) + RW_LN_EPS);
        const float bon = BON[m * RH + hd]; const float* vsrc = (const float*)(p->ws + WS_SCI) + (((size_t)b * RH + hd) * S + t) * 384 + 192 + (c0 & 63);
        const bf16_t* gp = Z + m * ZLD + C_RG + c0; bf16_t* yp = (bf16_t*)(p->ws + WS_Y) + m * (4 * MIX) + 2 * MIX + c0;
        unsigned w[8];
#pragma unroll
        for (int j = 0; j < 16; j += 2) { const float y0 = (o[j] * rstd * lg[c0 + j] + lbv[c0 + j] + bon * vsrc[j]) * fsilu(bf2f(gp[j])), y1 = (o[j + 1] * rstd * lg[c0 + j + 1] + lbv[c0 + j + 1] + bon * vsrc[j + 1]) * fsilu(bf2f(gp[j + 1]));
            w[j >> 1] = pk2(y0, y1); }
        *(u32x4*)(yp) = (u32x4){w[0], w[1], w[2], w[3]}; *(u32x4*)(yp + 8) = (u32x4){w[4], w[5], w[6], w[7]}; }
}

DI void phase_ln(KP p, int layer) {
    const int tid = TID(), lane = tid & 63, wave = tid >> 6;
    const float alpha = sqrtf(sqrtf(2.f * (float)L));
    const float* hprev = (layer == 0) ? p->in[I_X] : (const float*)(p->ws + WS_H); const float* outf = (const float*)(p->ws + WS_OUTF);
    float* hnew = (layer == L - 1) ? p->out : (float*)(p->ws + WS_H); bf16_t* xn = (bf16_t*)(p->ws + WS_XN);
    const float* lg = p->in[I_LNG] + (size_t)layer * D; const float* lbv = p->in[I_LNB] + (size_t)layer * D;
    constexpr int NV = D / 256;
    for (size_t m = (size_t)blockIdx.x * 8 + wave; m < (size_t)M; m += (size_t)gridDim.x * 8) {
        f32x4 v[NV]; float s = 0.f;
#pragma unroll
        for (int j = 0; j < NV; ++j) { const f32x4 a = *(const f32x4*)(hprev + m * D + 256 * j + 4 * lane), o = *(const f32x4*)(outf + m * D + 256 * j + 4 * lane); v[j] = a * alpha + o; s += (v[j][0] + v[j][1]) + (v[j][2] + v[j][3]); }
#pragma unroll
        for (int o = 1; o < 64; o <<= 1) s += __shfl_xor(s, o);
        const float mean = s * (1.f / D); float s2 = 0.f;
#pragma unroll
        for (int j = 0; j < NV; ++j) { v[j] = v[j] - mean; s2 += (v[j][0] * v[j][0] + v[j][1] * v[j][1]) + (v[j][2] * v[j][2] + v[j][3] * v[j][3]); }
#pragma unroll
        for (int o = 1; o < 64; o <<= 1) s2 += __shfl_xor(s2, o);
        const float rstd = 1.f / sqrtf(s2 * (1.f / D) + LN_EPS);
#pragma unroll
        for (int j = 0; j < NV; ++j) { const f32x4 g4 = *(const f32x4*)(lg + 256 * j + 4 * lane), b4 = *(const f32x4*)(lbv + 256 * j + 4 * lane); const f32x4 y = v[j] * rstd * g4 + b4;
            *(f32x4*)(hnew + m * D + 256 * j + 4 * lane) = y; u32x2 w; w.x = pk2(y[0], y[1]); w.y = pk2(y[2], y[3]); *(u32x2*)(xn + m * D + 256 * j + 4 * lane) = w; }
    }
}
constexpr int FX_NS_HG = 3 * MIX / 64, FX_NS_RW = RW_MIX / 64, FX_NSTRIP = FX_NS_HG + FX_NS_RW + 1;
DI void phase_fx_project(KP p, int layer, lptr lds, int strip) {
    const int tid = TID(), c = tid & 63, kg = tid >> 6;
    const float* hsrc = (layer == 0) ? p->in[I_X] : (const float*)(p->ws + WS_H);
    LAS float* HR = (LAS float*)lds;
    __syncthreads();
    for (int i = tid; i < FX_ROWS * D / 4; i += 512) { const int r = i / (D / 4), k4 = i % (D / 4); const size_t m = (size_t)(r / FX_T) * S + (r % FX_T);
        *(LAS f32x4*)(HR + r * D + 4 * k4) = *(const f32x4*)(hsrc + m * D + 4 * k4); }
    __syncthreads();
    int col0, ncol, ldw; const float* W;
    if (strip < FX_NS_HG) { col0 = C_HQ + 64 * strip; ncol = 64; ldw = IN_COLS; W = p->in[I_WIN] + (size_t)layer * D * IN_COLS + col0; }
    else if (strip < FX_NS_HG + FX_NS_RW) { col0 = C_RM + 64 * (strip - FX_NS_HG); ncol = 64; ldw = IN_COLS; W = p->in[I_WIN] + (size_t)layer * D * IN_COLS + col0; }
    else { col0 = C_VD; ncol = 32; ldw = 32; W = p->in[I_V1] + (size_t)(layer > 0 ? layer - 1 : 0) * D * 32; if (layer == 0) ncol = 0; }
    float acc[FX_ROWS];
#pragma unroll
    for (int r = 0; r < FX_ROWS; ++r) acc[r] = 0.f;
    if (c < ncol) {
        for (int k = kg * (D / 8); k < (kg + 1) * (D / 8); ++k) { const float w = W[(size_t)k * ldw + c];
#pragma unroll
            for (int r = 0; r < FX_ROWS; ++r) acc[r] += HR[r * D + k] * w; } }
    __syncthreads();
    LAS float* RED = (LAS float*)lds;
#pragma unroll
    for (int r = 0; r < FX_ROWS; ++r) RED[(kg * FX_ROWS + r) * 64 + c] = acc[r];
    __syncthreads();
    for (int i = tid; i < FX_ROWS * 64; i += 512) { const int r = i >> 6, cc = i & 63; float s = 0.f;
#pragma unroll
        for (int g = 0; g < 8; ++g) s += RED[(g * FX_ROWS + r) * 64 + cc];
        if (cc < ncol) ((float*)(p->ws + WS_ZF))[(size_t)r * ZLD + col0 + cc] = s; }
}
DI float wave_sum64(float v) {
#pragma unroll
    for (int o = 1; o < 64; o <<= 1) v += __shfl_xor(v, o);
    return v; }
DI void fx_rwkv(KP p, int layer, int item, int lane) {
    const int hd = item % RH, b = item / RH, ch = hd * 64 + lane;
    const float* ZF = (const float*)(p->ws + WS_ZF) + (size_t)b * FX_T * ZLD;
    const float* mu = p->in[I_MU] + (size_t)layer * RW_MIX;
    const float mur = mu[ch], muk = mu[MIX + ch], muv = mu[2 * MIX + ch], muw = mu[3 * MIX + lane], mua = mu[3 * MIX + 64 + lane];
    const float muvd = (layer > 0 && lane < 32) ? p->in[I_VMU][(size_t)(layer - 1) * 32 + lane] : 0.f;
    const float* w2 = p->in[I_W2] + (size_t)layer * 64 * MIX + ch; const float* a2 = p->in[I_A2] + (size_t)layer * 64 * MIX + ch;
    const float* v2 = p->in[I_V2] + (size_t)(layer > 0 ? layer - 1 : 0) * 32 * MIX + ch;
    const float w0 = p->in[I_W0][(size_t)layer * MIX + ch], a0 = p->in[I_A0][(size_t)layer * MIX + ch], kq = p->in[I_KK][(size_t)layer * MIX + ch], ka = p->in[I_KA][(size_t)layer * MIX + ch], rk = p->in[I_RK][(size_t)layer * MIX + ch];
    const float v0 = p->in[I_V0][(size_t)(layer > 0 ? layer - 1 : 0) * MIX + ch];
    float pr = 0.f, pk = 0.f, pv = 0.f, pw = 0.f, pa = 0.f, pvd = 0.f;
    for (int t = 0; t < FX_T; ++t) { const float* z = ZF + (size_t)t * ZLD;
        const float cr = z[C_RM + ch], ck = z[C_RM + MIX + ch], cv = z[C_RM + 2 * MIX + ch], cw = z[C_RM + 3 * MIX + lane], ca = z[C_RM + 3 * MIX + 64 + lane], cvd = (layer > 0 && lane < 32) ? z[C_VD + lane] : 0.f;
        const float r = cr + (pr - cr) * mur, k = ck + (pk - ck) * muk; float v = cv + (pv - cv) * muv;
        const float tw = tanhf(cw + (pw - cw) * muw), ad = ca + (pa - ca) * mua, vd = cvd + (pvd - cvd) * muvd;
        pr = cr; pk = ck; pv = cv; pw = cw; pa = ca; pvd = cvd;
        float lw = 0.f, la = 0.f, lv = 0.f;
        for (int j = 0; j < 64; ++j) { lw += __shfl(tw, j) * w2[(size_t)j * MIX]; la += __shfl(ad, j) * a2[(size_t)j * MIX]; }
        if (layer > 0) for (int j = 0; j < 32; ++j) lv += __shfl(vd, j) * v2[(size_t)j * MIX];
        const float wlog = -(fmaxf(-(w0 + lw), 0.f) + log1pf(expf(-fabsf(w0 + lw)))) - 0.5f, decay = expf(-expf(wlog));
        const float a = 1.f / (1.f + expf(-(a0 + la)));
        const size_t m = (size_t)b * S + t; float* VF = (float*)(p->ws + WS_VF) + m * MIX;
        if (layer == 0) VF[ch] = v; else { const float vf = VF[ch]; v = v + (vf - v) / (1.f + expf(-(v0 + lv))); }
        float kk = k * kq; const float nrm = sqrtf(wave_sum64(kk * kk)); kk = kk / fmaxf(nrm, 1e-12f);
        const float k2 = k * (1.f + (a - 1.f) * ka);
        const float bon = wave_sum64(r * k2 * rk);
        float* SCI = (float*)(p->ws + WS_SCI) + (((size_t)b * RH + hd) * S + t) * 384;
        SCI[lane] = r; SCI[64 + lane] = decay; SCI[128 + lane] = k2; SCI[192 + lane] = v; SCI[256 + lane] = -kk; SCI[320 + lane] = kk * a;
        if (lane == 0) ((float*)(p->ws + WS_BON))[m * RH + hd] = bon; }
}
DI void fx_hgrn(KP p, int layer, int item, int lane) {
    const int h = item % HH, b = item / HH;
    const float* ZF = (const float*)(p->ws + WS_ZF) + (size_t)b * FX_T * ZLD; const float* LBp = (const float*)(p->ws + SM_LB);
    float q[FX_T][2], kx[FX_T][2], Bc[FX_T][2], iv[FX_T][2];
#pragma unroll
    for (int u = 0; u < 2; ++u) { const int d = h * 128 + lane + 64 * u; const float lb = LBp[(size_t)layer * MIX + d]; float run = 0.f;
#pragma unroll
        for (int t = 0; t < FX_T; ++t) { const float* z = ZF + (size_t)t * ZLD; const float zf = z[C_HF + d]; q[t][u] = z[C_HQ + d]; iv[t][u] = z[C_HI + d];
            const float sg = 1.f / (1.f + expf(-zf)); run += logf(lb + (1.f - lb) * sg); Bc[t][u] = run; kx[t][u] = (1.f - lb) * (1.f - sg); } }
    float* OEX = (float*)(p->ws + WS_OEX) + (size_t)item * FX_T * 128;
#pragma unroll
    for (int t = 0; t < FX_T; ++t) { float o0 = 0.f, o1 = 0.f;
#pragma unroll
        for (int s = 0; s <= t; ++s) { const float c = wave_sum64(q[t][0] * kx[s][0] * expf(Bc[t][0] - Bc[s][0]) + q[t][1] * kx[s][1] * expf(Bc[t][1] - Bc[s][1])); o0 += c * iv[s][0]; o1 += c * iv[s][1]; }
        OEX[t * 128 + lane] = o0; OEX[t * 128 + 64 + lane] = o1; }
}
DI void phase_fx_fix(KP p, int layer) {
    const int tid = TID(), lane = tid & 63, gw = blockIdx.x * 8 + (tid >> 6), NGW = gridDim.x * 8;
    for (int it = gw; it < NB * RH + NB * HH; it += NGW) { if (it < NB * RH) fx_rwkv(p, layer, it, lane); else fx_hgrn(p, layer, it - NB * RH, lane); }
}
constexpr int NWAVES = 8, LDS_RING = 131072, MISC_OFF = LDS_RING + 320, LDS_BYTES = 147456;
constexpr int CW_BAR = 4096, CW_WQ = 16384;
enum { PH_INPROJ = 0, PH_RWPREP, PH_MIX, PH_RWPOST, PH_BRANCH, PH_SUM, PH_OUT, PH_LN, PH_COUNT };
constexpr int U_SCAN = NB * RH * 2, U_HG = NB * HH, U_HGC = NB * HH * (S / 64), U_AA = NB * AH * (S / 128), U_AD = NB * SH * (S / 256), U_MIX = U_SCAN + U_HG + U_AA + U_AD;

struct Args { Params p; int do_pro, l_lo, l_hi, ph_lo, ph_hi, mega, pad0, pad1; };

#ifndef EMU
#define XB_TMO      128
#define XB_XCNT(j)  (256  + 64 * (j))
#define XB_XSUB(j)  (1280 + 64 * (j))
#define XB_XGEN(j)  (2304 + 64 * (j))
#define XB_TOP      3328
#define XB_TOPGEN   3392
#define XCD_BAR_WORDS 3456
#define XB_SPIN_CAP (1u << 18)
__device__ __forceinline__ unsigned xb_ld(unsigned* p)              { return __hip_atomic_load(p, __ATOMIC_RELAXED, __HIP_MEMORY_SCOPE_AGENT); }
__device__ __forceinline__ unsigned xb_add(unsigned* p, unsigned v) { return __hip_atomic_fetch_add(p, v, __ATOMIC_RELAXED, __HIP_MEMORY_SCOPE_AGENT); }
__device__ __forceinline__ unsigned xb_xcc_id() { return (unsigned)__builtin_amdgcn_s_getreg((3 << 11) | 20) & 0xFu; }
#define XB_SPIN(cond, bar) do { unsigned _sp = 0; while (cond) { __builtin_amdgcn_s_sleep(1); \
    if ((++_sp & 255u) == 0u) { if (xb_ld(&(bar)[XB_TMO])) break; if (_sp > XB_SPIN_CAP) { atomicAdd(&(bar)[XB_TMO], 1u); break; } } } } while (0)
struct XcdBarrier { unsigned* bar; unsigned x; volatile LAS unsigned* st; };
__device__ __forceinline__ XcdBarrier xcd_barrier_post(unsigned* bar, volatile LAS unsigned* st) {
    XcdBarrier b; b.bar = bar; b.x = xb_xcc_id(); b.st = st;
    if (threadIdx.x == 0) (void)xb_add(&bar[XB_XCNT(b.x)], 1u);
    return b;
}
__device__ __forceinline__ void xcd_barrier_complete(unsigned* bar, unsigned x, unsigned& nloc, unsigned& nx) {
    const unsigned G = gridDim.x * gridDim.y * gridDim.z;
    unsigned sum, cnt, mine, sp = 0u;
    for (;;) {
        sum = 0u; cnt = 0u; mine = 0u;
#pragma unroll
        for (unsigned j = 0; j < 16; ++j) { const unsigned c = xb_ld(&bar[XB_XCNT(j)]); sum += c; cnt += (c > 0u) ? 1u : 0u; mine = (j == x) ? c : mine; }
        if (sum == G) break;
        __builtin_amdgcn_s_sleep(1);
        if ((++sp & 255u) == 0u) { if (xb_ld(&bar[XB_TMO])) break; if (sp > XB_SPIN_CAP) { atomicAdd(&bar[XB_TMO], 1u); break; } }
    }
    nloc = mine > 0u ? mine : 1u; nx = cnt > 0u ? cnt : 1u;
}
__device__ __forceinline__ void xcd_barrier(const XcdBarrier& b) {
    asm volatile("s_waitcnt vmcnt(0)" ::: "memory");
    __syncthreads();
    if (threadIdx.x == 0) {
        unsigned* bar = b.bar;
        __builtin_amdgcn_s_waitcnt(0);
        unsigned nloc = b.st[0], nx = b.st[1];
        if (nloc == 0u) { xcd_barrier_complete(bar, b.x, nloc, nx); b.st[0] = nloc; b.st[1] = nx; }
        const unsigned old = xb_add(&bar[XB_XSUB(b.x)], 1u);
        const unsigned gen = old / nloc;
        if (old + 1u == (gen + 1u) * nloc) {
            __builtin_amdgcn_fence(__ATOMIC_RELEASE, "agent");
            asm volatile("s_waitcnt vmcnt(0)" ::: "memory");
            const unsigned og = xb_add(&bar[XB_TOP], 1u);
            const unsigned tg = og / nx;
            if (og + 1u == (tg + 1u) * nx) xb_add(&bar[XB_TOPGEN], 1u);
            else XB_SPIN(xb_ld(&bar[XB_TOPGEN]) == tg, bar);
            __builtin_amdgcn_fence(__ATOMIC_ACQUIRE, "agent");
            xb_add(&bar[XB_XGEN(b.x)], 1u);
            asm volatile("s_waitcnt vmcnt(0)" ::: "memory");
        } else {
            XB_SPIN(xb_ld(&bar[XB_XGEN(b.x)]) == gen, bar);
            __builtin_amdgcn_fence(__ATOMIC_ACQUIRE, "agent");
            asm volatile("s_waitcnt vmcnt(0)" ::: "memory");
        }
    }
    __syncthreads();
}
#endif

DI int next_unit(unsigned* head, lptr lds) {
    LAS int* slot = (LAS int*)(lds + MISC_OFF + 64);
    __syncthreads();
#ifdef EMU
    if (threadIdx.x == 0) { *slot = (int)(*head); *head += 1; }
#else
    if (threadIdx.x == 0) *slot = (int)__hip_atomic_fetch_add(head, 1u, __ATOMIC_RELAXED, __HIP_MEMORY_SCOPE_AGENT);
#endif
    __syncthreads();
    return *slot;
}

#ifndef DBG_PHMASK
#define DBG_PHMASK 0xffff
#endif
struct BranchOrder {
    pg8::StaticOrder so;
    DM bool next(int i, pg8::Unit& u) const { if (!so.next(i, u)) return false; u.ka = (u.pn / (D / 256)) * MIX; return true; }
    DM void a_ready(const pg8::Unit&) const {}
    DM void done(const pg8::Unit&) const {}
};
#ifndef PROBE_REP
#define PROBE_REP 0
#endif
#ifndef PROBE_MIXREP
#define PROBE_MIXREP 15
#endif
#ifndef DBG_MIXMASK
#define DBG_MIXMASK 15
#endif
DI void run_phase(KP p, int rep, int l, int ph, lptr lds) {
    unsigned char* ws = p->ws;
    if (!((DBG_PHMASK >> ph) & 1)) return;
    if (ph == PH_INPROJ) {
        pg8::Gemm g{(const bf16_t*)(ws + WS_XN), (const bf16_t*)(ws + WS_WIN) + (size_t)l * NP * D, M, NP, D, D, D};
        EpiInproj E{(bf16_t*)(ws + WS_Z), ZLD, (bf16_t*)(ws + WS_RHO), CG0 / 256};
#ifndef EMU
        pg8::StaticOrder so; so.init(M, NP, gridDim.x, blockIdx.x);
        pg8::gemm_phase<EpiInproj, pg8::StaticOrder, true, true, D, D, D>((LAS unsigned char*)lds, g, so, E);
#endif
        for (int s = blockIdx.x; s < FX_NSTRIP; s += gridDim.x) phase_fx_project(p, l, lds, s);
    } else if (ph == PH_RWPREP) {
        phase_rw_prep(p, l);
        phase_fx_fix(p, l);
        for (int u = blockIdx.x; u < U_HGC; u += gridDim.x) phase_hg_local(p, l, lds, u);
    } else if (ph == PH_MIX) {
        unsigned* head = (unsigned*)(ws + WS_CTL) + CW_WQ + 64 * l + (rep ? 32 * 64 : 0);
        for (;;) { int u = next_unit(head, lds); if (u >= U_MIX) break;
            const int mm = rep ? PROBE_MIXREP : DBG_MIXMASK;
            if (u < U_SCAN) { if (mm & 1) phase_rw_scan(p, lds, u); continue; } u -= U_SCAN;
            if (u < U_HG) { if (mm & 2) phase_hg_scan(p, u); continue; } u -= U_HG;
            if (u < U_AA) { if (mm & 4) phase_att_a(p, l, lds, u); continue; } u -= U_AA;
            if (mm & 8) phase_att_d(p, l, lds, u); }
    } else if (ph == PH_RWPOST) {
        phase_rw_post(p, l);
        for (int u = blockIdx.x; u < U_HGC; u += gridDim.x) phase_hg_out(p, l, lds, u);
    } else if (ph == PH_BRANCH) {
        pg8::Gemm g{(const bf16_t*)(ws + WS_Y), (const bf16_t*)(ws + WS_WBR) + (size_t)l * 4 * D * MIX, M, 4 * D, MIX, 4 * MIX, MIX};
        EpiGateP E{(bf16_t*)(ws + WS_P), 4 * D, (const bf16_t*)(ws + WS_RHO)};
#ifndef EMU
        BranchOrder bo; bo.so.init(M, 4 * D, gridDim.x, blockIdx.x);
        pg8::gemm_phase<EpiGateP, BranchOrder, true, true, 4 * MIX, MIX, MIX>((LAS unsigned char*)lds, g, bo, E);
#endif
    } else if (ph == PH_SUM) {
        const size_t gt = (size_t)blockIdx.x * 512 + TID(), NGT = (size_t)gridDim.x * 512; const u32x4* P4 = (const u32x4*)(ws + WS_P); u32x4* MG4 = (u32x4*)(ws + WS_MG);
        for (size_t i = gt; i < (size_t)M * D / 8; i += NGT) { const size_t m = i / (D / 8), c = i % (D / 8); const u32x4* src = P4 + m * (4 * D / 8) + c;
            const u32x4 a0 = src[0], a1 = src[D / 8], a2 = src[2 * (D / 8)], a3 = src[3 * (D / 8)]; u32x4 o;
            o.x = pk2((bflo(a0.x) + bflo(a1.x)) + (bflo(a2.x) + bflo(a3.x)), (bfhi(a0.x) + bfhi(a1.x)) + (bfhi(a2.x) + bfhi(a3.x))); o.y = pk2((bflo(a0.y) + bflo(a1.y)) + (bflo(a2.y) + bflo(a3.y)), (bfhi(a0.y) + bfhi(a1.y)) + (bfhi(a2.y) + bfhi(a3.y)));
            o.z = pk2((bflo(a0.z) + bflo(a1.z)) + (bflo(a2.z) + bflo(a3.z)), (bfhi(a0.z) + bfhi(a1.z)) + (bfhi(a2.z) + bfhi(a3.z))); o.w = pk2((bflo(a0.w) + bflo(a1.w)) + (bflo(a2.w) + bflo(a3.w)), (bfhi(a0.w) + bfhi(a1.w)) + (bfhi(a2.w) + bfhi(a3.w)));
            MG4[i] = o; }
    } else if (ph == PH_OUT) {
        pg8::Gemm g{(const bf16_t*)(ws + WS_MG), (const bf16_t*)(ws + WS_WOUT) + (size_t)l * D * D, M, D, D, D, D};
        EpiF32 E{(float*)(ws + WS_OUTF), D};
#ifndef EMU
        pg8::StaticOrder so; so.init(M, D, gridDim.x, blockIdx.x);
        pg8::gemm_phase<EpiF32, pg8::StaticOrder, true, true, D, D, D>((LAS unsigned char*)lds, g, so, E);
#endif
    } else if (ph == PH_LN) {
        phase_ln(p, l);
    }
}

#ifndef EMU
__global__ void __launch_bounds__(NWAVES * 64, 2) fwd(Args a) {
    extern __shared__ __attribute__((aligned(16))) unsigned char lds_raw[];
    lptr lds = (lptr)lds_raw;
    volatile LAS unsigned* MISC = (volatile LAS unsigned*)(lds + MISC_OFF);
    for (int u = threadIdx.x; u < (LDS_BYTES - LDS_RING) / 4; u += NWAVES * 64) ((LAS unsigned*)(lds + LDS_RING))[u] = 0u;
    __syncthreads();
    typedef const __attribute__((address_space(4))) Args* KA;
    KA ka = (KA)__builtin_amdgcn_kernarg_segment_ptr();
    const int mega = ka->mega, do_pro = ka->do_pro, l_lo = ka->l_lo, l_hi = ka->l_hi, ph_lo = ka->ph_lo, ph_hi = ka->ph_hi;
    auto kp = [&]() -> KP { KA k2 = ka; asm volatile("" : "+s"(k2)); return &k2->p; };
    XcdBarrier bar; bar.bar = (unsigned*)(ka->p.ws + WS_CTL) + CW_BAR; bar.x = 0; bar.st = nullptr;
    if (mega) bar = xcd_barrier_post((unsigned*)(ka->p.ws + WS_CTL) + CW_BAR, MISC + 8);
#define SEAM() do { if (mega) xcd_barrier(bar); } while (0)
    if (do_pro != 0 && ((DBG_PHMASK >> 8) & 1) != 0) { phase_prologue(kp(), lds); SEAM(); }
    for (int l = l_lo; l < l_hi; ++l) {
        if (ph_lo <= PH_INPROJ && PH_INPROJ < ph_hi) { run_phase(kp(), 0, l, PH_INPROJ, lds); SEAM(); if ((PROBE_REP >> PH_INPROJ) & 1) { run_phase(kp(), 1, l, PH_INPROJ, lds); SEAM(); } }
        if (ph_lo <= PH_RWPREP && PH_RWPREP < ph_hi) { run_phase(kp(), 0, l, PH_RWPREP, lds); SEAM(); if ((PROBE_REP >> PH_RWPREP) & 1) { run_phase(kp(), 1, l, PH_RWPREP, lds); SEAM(); } }
        if (ph_lo <= PH_MIX && PH_MIX < ph_hi) { run_phase(kp(), 0, l, PH_MIX, lds); SEAM(); if ((PROBE_REP >> PH_MIX) & 1) { run_phase(kp(), 1, l, PH_MIX, lds); SEAM(); } }
        if (ph_lo <= PH_RWPOST && PH_RWPOST < ph_hi) { run_phase(kp(), 0, l, PH_RWPOST, lds); SEAM(); if ((PROBE_REP >> PH_RWPOST) & 1) { run_phase(kp(), 1, l, PH_RWPOST, lds); SEAM(); } }
        if (ph_lo <= PH_BRANCH && PH_BRANCH < ph_hi) { run_phase(kp(), 0, l, PH_BRANCH, lds); SEAM(); if ((PROBE_REP >> PH_BRANCH) & 1) { run_phase(kp(), 1, l, PH_BRANCH, lds); SEAM(); } }
        if (ph_lo <= PH_SUM && PH_SUM < ph_hi) { run_phase(kp(), 0, l, PH_SUM, lds); SEAM(); }
        if (ph_lo <= PH_OUT && PH_OUT < ph_hi) { run_phase(kp(), 0, l, PH_OUT, lds); SEAM(); if ((PROBE_REP >> PH_OUT) & 1) { run_phase(kp(), 1, l, PH_OUT, lds); SEAM(); } }
        if (ph_lo <= PH_LN && PH_LN < ph_hi) { run_phase(kp(), 0, l, PH_LN, lds); SEAM(); }
    }
#undef SEAM
}

#ifndef MK_MEGA
#define MK_MEGA 1
#endif
extern "C" void kernel_launch(void* const* d_in, const int* in_sizes, int n_in, void* d_out, int out_size, void* d_ws, size_t ws_size, hipStream_t stream) {
    static int grid = 0;
    if (grid == 0) {
        if (n_in != 25 || in_sizes[0] != M * D || out_size != M * D || ws_size < WS_END) { fprintf(stderr, "kernel_launch: shape/workspace mismatch (n_in %d, in0 %d, out %d, ws %zu need %zu)\n", n_in, n_in > 0 ? in_sizes[0] : -1, out_size, ws_size, (size_t)WS_END); grid = -1; return; }
        int dev = 0, cus = 0, per_cu = 0;
        if (hipGetDevice(&dev) != hipSuccess || hipDeviceGetAttribute(&cus, hipDeviceAttributeMultiprocessorCount, dev) != hipSuccess) { grid = -1; return; }
        if (hipFuncSetAttribute((const void*)fwd, hipFuncAttributeMaxDynamicSharedMemorySize, LDS_BYTES) != hipSuccess) { fprintf(stderr, "kernel_launch: hipFuncSetAttribute failed\n"); grid = -1; return; }
        if (hipOccupancyMaxActiveBlocksPerMultiprocessor(&per_cu, (const void*)fwd, NWAVES * 64, LDS_BYTES) != hipSuccess || per_cu < 1) fprintf(stderr, "kernel_launch: occupancy query says %d\n", per_cu);
        (void)hipGetLastError();
        grid = cus;
    }
    if (grid < 0) return;
    (void)hipMemsetAsync((char*)d_ws + WS_CTL, 0, CTL_BYTES, stream);
    Args a{};
    for (int i = 0; i < 25; ++i) a.p.in[i] = (const float*)d_in[i];
    a.p.out = (float*)d_out; a.p.ws = (unsigned char*)d_ws;
    if (MK_MEGA) {
        a.do_pro = 1; a.l_lo = 0; a.l_hi = L; a.ph_lo = 0; a.ph_hi = PH_COUNT; a.mega = 1;
        hipLaunchKernelGGL(fwd, dim3(grid), dim3(NWAVES * 64), LDS_BYTES, stream, a);
    } else {
        a.mega = 0; a.do_pro = 1; a.l_lo = 0; a.l_hi = 0; a.ph_lo = 0; a.ph_hi = 0;
        hipLaunchKernelGGL(fwd, dim3(grid), dim3(NWAVES * 64), LDS_BYTES, stream, a);
        a.do_pro = 0;
        for (int l = 0; l < L; ++l) for (int ph = 0; ph < PH_COUNT; ++ph) { a.l_lo = l; a.l_hi = l + 1; a.ph_lo = ph; a.ph_hi = ph + 1;
            hipLaunchKernelGGL(fwd, dim3(grid), dim3(NWAVES * 64), LDS_BYTES, stream, a); }
    }
}
#endif
```

```cpp
#ifdef EMU
#include "emu.h"
#else
#include <hip/hip_runtime.h>
#include <cstdio>
#include <cstdint>
#endif

#ifndef CFG_D_MODEL
#define CFG_D_MODEL 2048
#endif
#ifndef CFG_BATCH
#define CFG_BATCH 4
#endif
#ifndef CFG_SEQ
#define CFG_SEQ 4096
#endif
#ifndef CFG_DEPTH
#define CFG_DEPTH 4
#endif
constexpr int D = CFG_D_MODEL, NB = CFG_BATCH, S = CFG_SEQ, L = CFG_DEPTH, MIX = D / 2, M = NB * S;
constexpr int AH = MIX / 128, HH = MIX / 128, RH = MIX / 64, SH = MIX / 128;
constexpr int RW_MIX = 3 * MIX + 128;
constexpr int C_AQ = 0, C_AK = MIX, C_AV = 2 * MIX, C_AG = 3 * MIX, C_HQ = 4 * MIX, C_HF = 5 * MIX, C_HI = 6 * MIX, C_HG = 7 * MIX;
constexpr int C_RM = 8 * MIX, C_RG = C_RM + RW_MIX, C_SQ = C_RG + MIX, C_SK = C_SQ + MIX, C_SV = C_SK + MIX, C_SG = C_SV + MIX, C_MG = C_SG + MIX;
constexpr int IN_COLS = C_MG + 4 * D;
constexpr int C_VD = C_MG, CG0 = ((C_MG + 32 + 255) / 256) * 256, NP = CG0 + 4 * D, ZLD = CG0;
constexpr float LN_EPS = 1e-5f, RMS_EPS = 1e-6f, RW_LN_EPS = 64e-5f;
constexpr float LOG2E = 1.4426950408889634f, LN2 = 0.6931471805599453f;

constexpr size_t al256(size_t x) { return (x + 255) & ~(size_t)255; }
constexpr size_t WS_CTL = 0, CTL_BYTES = 1u << 20;
constexpr size_t SM_LAM = CTL_BYTES;
constexpr size_t SM_LB = SM_LAM + 256;
constexpr size_t SM_BT = al256(SM_LB + (size_t)3 * L * MIX * 4);
constexpr size_t SM_W2T = al256(SM_BT + (size_t)AH * 132 * 4);
constexpr size_t SM_A2T = al256(SM_W2T + (size_t)L * MIX * 64 * 2);
constexpr size_t SM_V2T = al256(SM_A2T + (size_t)L * MIX * 64 * 2);
constexpr size_t WS_WIN = al256(SM_V2T + (size_t)L * MIX * 32 * 2);
constexpr size_t WS_WBR = al256(WS_WIN + (size_t)L * NP * D * 2);
constexpr size_t WS_WOUT = al256(WS_WBR + (size_t)L * D * 4 * MIX * 2);
constexpr size_t WS_XN = al256(WS_WOUT + (size_t)L * D * D * 2);
constexpr size_t WS_H = al256(WS_XN + (size_t)M * D * 2);
constexpr size_t WS_Z = al256(WS_H + (size_t)M * D * 4);
constexpr size_t WS_Y = al256(WS_Z + (size_t)M * ZLD * 2);
constexpr size_t WS_RHO = al256(WS_Y + (size_t)M * 4 * MIX * 2);
constexpr size_t WS_P = al256(WS_RHO + (size_t)M * 4 * D * 2);
constexpr size_t WS_MG = al256(WS_P + (size_t)M * 4 * D * 2);
constexpr size_t WS_OUTF = al256(WS_MG + (size_t)M * D * 2);
constexpr size_t WS_VF = al256(WS_OUTF + (size_t)M * D * 4);
constexpr size_t WS_SCI = al256(WS_VF + (size_t)M * MIX * 4);
constexpr size_t WS_SCO = al256(WS_SCI + (size_t)M * MIX * 6 * 4);
constexpr size_t WS_BON = al256(WS_SCO + (size_t)M * MIX * 4);
constexpr size_t HG_CHUNKS = (size_t)NB * (MIX / 128) * (S / 64);
constexpr size_t WS_HGQF = al256(WS_BON + (size_t)M * RH * 4);
constexpr size_t WS_HGIN = al256(WS_HGQF + HG_CHUNKS * 16 * 64 * 16);
constexpr size_t WS_HGDS = al256(WS_HGIN + HG_CHUNKS * 8 * 4 * 64 * 16);
constexpr size_t WS_HGVE = al256(WS_HGDS + HG_CHUNKS * 8 * 8 * 64 * 16);
constexpr size_t WS_HGSF = al256(WS_HGVE + HG_CHUNKS * 256 * 4);
constexpr int FX_T = 4, FX_ROWS = NB * FX_T;
constexpr size_t WS_ZF = al256(WS_HGSF + HG_CHUNKS * 8 * 4 * 64 * 16);
constexpr size_t WS_OEX = al256(WS_ZF + (size_t)FX_ROWS * ZLD * 4);
constexpr size_t WS_OEXC = al256(WS_OEX + (size_t)NB * (MIX / 128) * FX_T * 128 * 4);
constexpr size_t WS_END = al256(WS_OEXC + (size_t)NB * FX_T * MIX * 4);
constexpr size_t WS_RC = WS_P;
static_assert((size_t)NB * (MIX / 64) * (S / 16) * 22784 <= WS_VF - WS_P, "RWKV records fit the aliased region");

typedef unsigned short bf16_t;
typedef short bf16x8 __attribute__((ext_vector_type(8)));
typedef short s16x4 __attribute__((ext_vector_type(4)));
typedef float f32x16 __attribute__((ext_vector_type(16)));
typedef float f32x4 __attribute__((ext_vector_type(4)));
typedef float f32x2 __attribute__((ext_vector_type(2)));
typedef unsigned u32x4 __attribute__((ext_vector_type(4)));
typedef unsigned u32x2 __attribute__((ext_vector_type(2)));
#ifdef EMU
#define DI static inline
#define DM inline
#define LAS
#define GAS
#define WAVE_SYNC() emu_wave_barrier()
#define MFMA32(a, b, c) emu_mfma32(a, b, c)
#define MFMA16(a, b, c) emu_mfma16(a, b, c)
#define TR_READ(p) emu_tr_read((const void*)(p))
#define ROW_ROR(x, n) emu_row_ror(x, n)
#define ANY(p) emu_any(p)
#define RFL(x) (x)
DI float ex2(float x) { return exp2f(x); }
DI float lg2(float x) { return log2f(x); }
DI float frcp(float x) { return 1.f / x; }
DI float frsq(float x) { return 1.f / sqrtf(x); }
DI float u2f(unsigned u) { float f; memcpy(&f, &u, 4); return f; }
DI unsigned f2u(float f) { unsigned u; memcpy(&u, &f, 4); return u; }
#else
#define DI __device__ __forceinline__
#define DM __device__ __forceinline__
#define LAS __attribute__((address_space(3)))
#define GAS __attribute__((address_space(1)))
#define WAVE_SYNC() do { __builtin_amdgcn_fence(__ATOMIC_RELEASE, "wavefront"); __builtin_amdgcn_wave_barrier(); __builtin_amdgcn_fence(__ATOMIC_ACQUIRE, "wavefront"); } while (0)
#define MFMA32(a, b, c) __builtin_amdgcn_mfma_f32_32x32x16_bf16((a), (b), (c), 0, 0, 0)
#define MFMA16(a, b, c) __builtin_amdgcn_mfma_f32_16x16x32_bf16((a), (b), (c), 0, 0, 0)
typedef short v4i16_t __attribute__((ext_vector_type(4)));
#define TR_READ(p) __builtin_bit_cast(s16x4, __builtin_amdgcn_ds_read_tr16_b64_v4i16((LAS v4i16_t*)(p)))
#define ROW_ROR(x, n) __builtin_bit_cast(float, __builtin_amdgcn_update_dpp(0, __builtin_bit_cast(int, (x)), 0x120 + (n), 0xf, 0xf, false))
#define ANY(p) __any(p)
#define RFL(x) __builtin_amdgcn_readfirstlane(x)
DI float ex2(float x) { return __builtin_amdgcn_exp2f(x); }
DI float lg2(float x) { return __builtin_amdgcn_logf(x); }
DI float frcp(float x) { return __builtin_amdgcn_rcpf(x); }
DI float frsq(float x) { return __builtin_amdgcn_rsqf(x); }
DI float u2f(unsigned u) { return __builtin_bit_cast(float, u); }
DI unsigned f2u(float f) { return __builtin_bit_cast(unsigned, f); }
#endif
#ifdef EMU
#define SCHED_FENCE()
#else
#define SCHED_FENCE() __builtin_amdgcn_sched_barrier(0)
#endif
typedef LAS char* lptr;
#ifdef EMU
DI int TID() { return (int)threadIdx.x; }
#else
DI int TID() { int t = (int)threadIdx.x; asm volatile("" : "+v"(t)); return t; }
#endif
DI float bf2f(bf16_t v) { return u2f(((unsigned)v) << 16); }
DI bf16_t f2bf(float f) { unsigned u = f2u(f); return (bf16_t)((u + 0x7fffu + ((u >> 16) & 1u)) >> 16); }
DI unsigned pk2(float lo, float hi) { return (unsigned)f2bf(lo) | ((unsigned)f2bf(hi) << 16); }
DI float bflo(unsigned w) { return u2f(w << 16); }
DI float bfhi(unsigned w) { return u2f(w & 0xffff0000u); }
DI float fexp(float x) { return ex2(x * LOG2E); }
DI float flog(float x) { return lg2(x) * LN2; }
DI float fsigmoid(float x) { return frcp(1.f + fexp(-x)); }
DI float fsilu(float x) { return x * fsigmoid(x); }
DI float fsoftplus(float x) { return fmaxf(x, 0.f) + flog(1.f + fexp(-fabsf(x))); }
DI int crow(int i, int h) { return (i & 3) + 8 * (i >> 2) + 4 * h; }
DI bf16x8 pack8(float a0, float a1, float a2, float a3, float a4, float a5, float a6, float a7) {
    u32x4 w; w.x = pk2(a0, a1); w.y = pk2(a2, a3); w.z = pk2(a4, a5); w.w = pk2(a6, a7); return __builtin_bit_cast(bf16x8, w);
}
DI bf16x8 cat4(s16x4 lo, s16x4 hi) { return __builtin_shufflevector(lo, hi, 0, 1, 2, 3, 4, 5, 6, 7); }

struct Params {
    const float* in[25];
    float* out;
    unsigned char* ws;
};
#ifdef EMU
typedef const Params* KP;
#else
typedef const __attribute__((address_space(4))) Params* KP;
#endif
enum { I_X = 0, I_WIN, I_REL, I_LAM, I_SUBLN, I_HGLOW, I_HGNORM, I_MU, I_W0, I_W2, I_A0, I_A2, I_V1, I_VMU, I_V0, I_V2, I_KK, I_KA, I_RK, I_LNXG, I_LNXB, I_WBR, I_WOUT, I_LNG, I_LNB };
namespace pg8 {
#ifdef EMU
#define PG8_LAS
#else
#define PG8_LAS __attribute__((address_space(3)))
#endif
typedef unsigned short bf16_t;
typedef short bf16x8 __attribute__((ext_vector_type(8)));
typedef float f32x4 __attribute__((ext_vector_type(4)));
typedef unsigned u32x4 __attribute__((ext_vector_type(4)));
constexpr int BM = 256, BK = 64, HALF = 128, HTB = HALF * BK * 2  , STAGE_BYTES = 8 * HTB, NXCD = 8, WGM = 8;

__host__ __device__ __forceinline__ int lds_byte(int r, int c) { const int st = (r >> 4) * 2 + (c >> 5), rr = r & 15, cc = c & 31, ob = rr * 64 + cc * 2; return st * 1024 + (ob ^ (((ob >> 9) & 1) << 5)); }
__host__ __device__ __forceinline__ void stage_rc(int b, int& R, int& C) { const int st = b / 1024, sb = b % 1024, swz = sb ^ (((sb >> 9) & 1) << 5); R = (st >> 1) * 16 + swz / 64; C = (st & 1) * 32 + (swz % 64) / 2; }
__host__ __device__ __forceinline__ int perm32(int rho) { const int n = rho >> 4, i = rho & 15; return 8 * (i >> 2) + 4 * n + (i & 3); }

struct Unit { int pm, pn, ka; };
struct Gemm { const bf16_t* A; const bf16_t* Bt; int M, N, K, lda, ldb; };

struct StaticOrder {
    int nM, nN, nwg, G, c;
    __host__ __device__ void init(int M, int N, int G_, int c_) { nM = M / BM; nN = N / BM; nwg = nM * nN; G = G_; c = c_; }
    __host__ __device__ bool next(int i, Unit& u) const {
        const long L = (long)i * G + c; if (L >= nwg) return false;
        int wgid = (int)L; { const int q = nwg / NXCD, r = nwg % NXCD, xcd = wgid % NXCD, off = wgid / NXCD; wgid = (xcd < r ? xcd * (q + 1) : r * (q + 1) + (xcd - r) * q) + off; }
        const int nig = WGM * nN, gid = wgid / nig, fm = gid * WGM, gsz = (nM - fm) < WGM ? (nM - fm) : WGM;
        u.pm = fm + ((wgid % nig) % gsz); u.pn = (wgid % nig) / gsz; u.ka = 0; return true;
    }
    __device__ __forceinline__ void a_ready(const Unit&) const {}
    __device__ __forceinline__ void done(const Unit&) const {}
};
#ifndef EMU
template <class Epi, class Sched, bool ALIGN_EPI, bool SP2, int LDA, int LDB, int KDIM>
__device__ __forceinline__ void gemm_phase(PG8_LAS unsigned char* lds, const Gemm g, const Sched& S, const Epi& E) {
    const int tid = TID(), wid = __builtin_amdgcn_readfirstlane(tid >> 6), lane = tid & 63, wr = wid >> 2, wc = wid & 3, fr = lane & 15, fq = lane >> 4;
    constexpr int K = KDIM, nt = K / BK;
    unsigned voffA, voffB;
    { int R, C; stage_rc(tid * 16, R, C); const int Rb = Epi::PERM ? ((R & ~31) + perm32(R & 31)) : R;
      voffA = (unsigned)(R * LDA + C) * 2u; voffB = (unsigned)(Rb * LDB + C) * 2u; }
    const size_t qA = (size_t)64 * LDA * 2, qB = (size_t)64 * LDB * 2;
    const size_t kstep = (size_t)(BK * 2);
    const size_t hstepA = (size_t)HALF * LDA * 2, hstepB = (size_t)HALF * LDB * 2;
    const size_t tstepA = 2 * hstepA, tstepB = 2 * hstepB;
    const unsigned ldsw = (unsigned)wid * 1024u;
    const int aoff = lds_byte(wr * 64 + fr, fq * 8), boff = lds_byte(wc * 32 + fr, fq * 8);
#define PG8_SA(b, h) (((b) * 2 + (h)) * HTB)
#define PG8_SB(b, h) ((4 + (b) * 2 + (h)) * HTB)
#define PG8_STAGE_X(bufoff, gbase, voff, q) do { _Pragma("unroll") for (int _i = 0; _i < 2; ++_i) \
        __builtin_amdgcn_global_load_lds((const unsigned*)((const char*)(gbase) + (size_t)_i * (q) + (voff)), (PG8_LAS unsigned*)(lds + (bufoff) + ldsw + _i * 8192), 16, 0, 0); } while (0)
#define PG8_STAGE_A(bufoff, gbase) PG8_STAGE_X(bufoff, gbase, voffA, qA)
#define PG8_STAGE_B(bufoff, gbase) PG8_STAGE_X(bufoff, gbase, voffB, qB)
#define PG8_LDA(dst, b, h) do { _Pragma("unroll") for (int m = 0; m < 4; ++m) _Pragma("unroll") for (int k = 0; k < 2; ++k) dst[m][k] = *(const PG8_LAS bf16x8*)(lds + PG8_SA(b, h) + aoff + m * 2048 + k * 1024); } while (0)
#define PG8_LDB(dst, b, h) do { _Pragma("unroll") for (int n = 0; n < 2; ++n) _Pragma("unroll") for (int k = 0; k < 2; ++k) dst[n][k] = *(const PG8_LAS bf16x8*)(lds + PG8_SB(b, h) + boff + n * 2048 + k * 1024); } while (0)
#define PG8_MMA(ai, bj, At, Bt) do { __builtin_amdgcn_s_setprio(1); _Pragma("unroll") for (int m = 0; m < 4; ++m) _Pragma("unroll") for (int n = 0; n < 2; ++n) _Pragma("unroll") for (int k = 0; k < 2; ++k) \
        acc[ai][bj][m][n] = __builtin_amdgcn_mfma_f32_16x16x32_bf16(Bt[n][k], At[m][k], acc[ai][bj][m][n], 0, 0, 0); __builtin_amdgcn_s_setprio(0); } while (0)
#define PG8_WAIT_V(n) asm volatile("s_waitcnt vmcnt(" #n ")" ::: "memory")
#define PG8_WAIT_L(n) asm volatile("s_waitcnt lgkmcnt(" #n ")" ::: "memory")
#define PG8_BAR __builtin_amdgcn_s_barrier()
#define PG8_SCHED __builtin_amdgcn_sched_barrier(0)
    Unit cur, nxt; int ui = 0;
    if (!S.next(0, cur)) return;
    f32x4 acc[2][2][4][2];
#pragma unroll
    for (int a = 0; a < 2; ++a)
#pragma unroll
        for (int b = 0; b < 2; ++b)
#pragma unroll
            for (int m = 0; m < 4; ++m)
#pragma unroll
                for (int n = 0; n < 2; ++n) acc[a][b][m][n] = (f32x4){0.f, 0.f, 0.f, 0.f};
    bf16x8 At[4][2], B0[2][2], B1[2][2];
    const char* cA = (const char*)g.A + (size_t)cur.pm * tstepA + (size_t)cur.ka * 2; const char* cB = (const char*)g.Bt + (size_t)cur.pn * tstepB;
    S.a_ready(cur);
    if constexpr (SP2) {
        PG8_STAGE_B(PG8_SB(0, 0), cB); PG8_STAGE_B(PG8_SB(0, 1), cB + hstepB); PG8_STAGE_A(PG8_SA(0, 0), cA); PG8_STAGE_A(PG8_SA(0, 1), cA + hstepA);
        if (wr == 1) PG8_BAR;
        PG8_WAIT_V(2); PG8_BAR;
        PG8_STAGE_B(PG8_SB(1, 0), cB + kstep); PG8_STAGE_A(PG8_SA(1, 0), cA + kstep); PG8_STAGE_B(PG8_SB(1, 1), cB + hstepB + kstep);
        PG8_WAIT_V(6); PG8_BAR;
    } else {
        PG8_STAGE_B(PG8_SB(0, 0), cB); PG8_STAGE_A(PG8_SA(0, 0), cA); PG8_STAGE_B(PG8_SB(0, 1), cB + hstepB); PG8_STAGE_A(PG8_SA(0, 1), cA + hstepA);
        if (wr == 1) PG8_BAR;
        PG8_WAIT_V(4); PG8_BAR;
        PG8_STAGE_B(PG8_SB(1, 0), cB + kstep); PG8_STAGE_A(PG8_SA(1, 0), cA + kstep); PG8_STAGE_B(PG8_SB(1, 1), cB + hstepB + kstep);
        PG8_WAIT_V(6); PG8_BAR;
    }
    for (;;) {
        const bool has_next = S.next(ui + 1, nxt);
        const char* nA = has_next ? (const char*)g.A + (size_t)nxt.pm * tstepA + (size_t)nxt.ka * 2 : cA; const char* nB = has_next ? (const char*)g.Bt + (size_t)nxt.pn * tstepB : cB;
        for (int t = 0; t < nt; t += 2) {
            if constexpr (Epi::MIDK > 0) { if (t > 0 && (t % Epi::MIDK) == 0) E.mid(acc, cur, t / Epi::MIDK - 1, wr, wc, fr, fq); }
            const bool last = (t == nt - 2);
            const char* a1 = cA + (size_t)(t + 1) * kstep;
            const char* a2 = last ? nA : cA + (size_t)(t + 2) * kstep; const char* b2 = last ? nB : cB + (size_t)(t + 2) * kstep;
            const char* a3 = a2 + kstep; const char* b3 = b2 + kstep;
            if (last && has_next) S.a_ready(nxt);
            if constexpr (SP2) {
            PG8_LDB(B0, 0, 0); PG8_LDB(B1, 0, 1); PG8_SCHED; PG8_LDA(At, 0, 0); PG8_STAGE_A(PG8_SA(1, 1), a1 + hstepA);
            PG8_WAIT_V(8); PG8_WAIT_L(0); PG8_BAR; PG8_MMA(0, 0, At, B0); PG8_MMA(0, 1, At, B1); PG8_BAR; PG8_SCHED;
            PG8_LDA(At, 0, 1); PG8_STAGE_B(PG8_SB(0, 0), b2); PG8_STAGE_B(PG8_SB(0, 1), b2 + hstepB); PG8_STAGE_A(PG8_SA(0, 0), a2);
            PG8_WAIT_V(8); PG8_WAIT_L(0); PG8_BAR; PG8_MMA(1, 0, At, B0); PG8_MMA(1, 1, At, B1); PG8_BAR; PG8_SCHED;
            PG8_LDB(B0, 1, 0); PG8_LDB(B1, 1, 1); PG8_SCHED; PG8_LDA(At, 1, 0); PG8_STAGE_A(PG8_SA(0, 1), a2 + hstepA);
            PG8_WAIT_V(8); PG8_WAIT_L(0); PG8_BAR; PG8_MMA(0, 0, At, B0); PG8_MMA(0, 1, At, B1); PG8_BAR; PG8_SCHED;
            PG8_LDA(At, 1, 1); PG8_STAGE_B(PG8_SB(1, 0), b3); PG8_STAGE_B(PG8_SB(1, 1), b3 + hstepB); PG8_STAGE_A(PG8_SA(1, 0), a3);
            PG8_WAIT_V(8); PG8_WAIT_L(0); PG8_BAR; PG8_MMA(1, 0, At, B0); PG8_MMA(1, 1, At, B1); PG8_BAR; PG8_SCHED;
            } else {
            PG8_LDB(B0, 0, 0); PG8_SCHED; PG8_LDA(At, 0, 0); PG8_STAGE_A(PG8_SA(1, 1), a1 + hstepA);
            PG8_WAIT_L(8); PG8_BAR; PG8_WAIT_L(0); PG8_MMA(0, 0, At, B0); PG8_BAR; PG8_SCHED;
            PG8_LDB(B1, 0, 1); PG8_STAGE_B(PG8_SB(0, 0), b2);
            PG8_BAR; PG8_WAIT_L(0); PG8_MMA(0, 1, At, B1); PG8_BAR;
            PG8_LDA(At, 0, 1); PG8_STAGE_A(PG8_SA(0, 0), a2);
            PG8_BAR; PG8_WAIT_L(0); PG8_MMA(1, 0, At, B0); PG8_BAR; PG8_SCHED;
            PG8_STAGE_B(PG8_SB(0, 1), b2 + hstepB);
            PG8_WAIT_V(6); PG8_BAR; PG8_MMA(1, 1, At, B1); PG8_BAR;
            PG8_LDB(B0, 1, 0); PG8_SCHED; PG8_LDA(At, 1, 0); PG8_STAGE_A(PG8_SA(0, 1), a2 + hstepA);
            PG8_WAIT_L(8); PG8_BAR; PG8_WAIT_L(0); PG8_MMA(0, 0, At, B0); PG8_BAR; PG8_SCHED;
            PG8_LDB(B1, 1, 1); PG8_STAGE_B(PG8_SB(1, 0), b3);
            PG8_BAR; PG8_WAIT_L(0); PG8_MMA(0, 1, At, B1); PG8_BAR;
            PG8_LDA(At, 1, 1); PG8_STAGE_A(PG8_SA(1, 0), a3);
            PG8_BAR; PG8_WAIT_L(0); PG8_MMA(1, 0, At, B0); PG8_BAR; PG8_SCHED;
            PG8_STAGE_B(PG8_SB(1, 1), b3 + hstepB);
            PG8_WAIT_V(6); PG8_BAR; PG8_MMA(1, 1, At, B1); PG8_BAR;
            }
        }
        if constexpr (ALIGN_EPI) { if (wr == 0) PG8_BAR; }
        if constexpr (!Epi::AFTER_DRAIN) { E(acc, cur, wr, wc, fr, fq); S.done(cur); }
        if (!has_next) break;
#pragma unroll
        for (int a = 0; a < 2; ++a)
#pragma unroll
            for (int b = 0; b < 2; ++b)
#pragma unroll
                for (int m = 0; m < 4; ++m)
#pragma unroll
                    for (int n = 0; n < 2; ++n) acc[a][b][m][n] = (f32x4){0.f, 0.f, 0.f, 0.f};
        cur = nxt; cA = nA; cB = nB; ++ui;
        if constexpr (ALIGN_EPI) { if (wr == 1) PG8_BAR; }
    }
    PG8_WAIT_V(0);
    if constexpr (!ALIGN_EPI) { if (wr == 0) PG8_BAR; }
    PG8_BAR;
    if constexpr (Epi::AFTER_DRAIN) { E.fused(acc, cur, wr, wc, fr, fq, lds, wid, lane); S.done(cur); }
#undef PG8_SA
#undef PG8_SB
#undef PG8_STAGE_X
#undef PG8_STAGE_A
#undef PG8_STAGE_B
#undef PG8_LDA
#undef PG8_LDB
#undef PG8_MMA
#undef PG8_WAIT_V
#undef PG8_WAIT_L
#undef PG8_BAR
#undef PG8_SCHED
}
#endif
}
#ifdef EMU
#define EPI_COORDS()
#else
#define EPI_COORDS() { const int t_ = TID(); const int w_ = RFL(t_ >> 6), l_ = t_ & 63; wr = w_ >> 2; wc = w_ & 3; fr = l_ & 15; fq = l_ >> 4; }
#endif
struct EpiInproj {
    static constexpr bool PERM = true, AFTER_DRAIN = false; static constexpr int MIDK = 0;
    bf16_t* O; int ldc; bf16_t* RHO; int gate_pn0;
    DM void operator()(const f32x4 (&acc)[2][2][4][2], const pg8::Unit& u, int wr, int wc, int fr, int fq) const {
        const int row0 = u.pm * 256 + wr * 64 + fr;
        if (u.pn < gate_pn0) { const int col0 = u.pn * 256 + wc * 32 + 8 * fq;
#pragma unroll
            for (int ai = 0; ai < 2; ++ai)
#pragma unroll
                for (int m = 0; m < 4; ++m) { bf16_t* rowp = O + (size_t)(row0 + ai * 128 + m * 16) * ldc + col0;
#pragma unroll
                    for (int bj = 0; bj < 2; ++bj) { const f32x4 v0 = acc[ai][bj][m][0], v1 = acc[ai][bj][m][1];
                        u32x4 w; w.x = pk2(v0[0], v0[1]); w.y = pk2(v0[2], v0[3]); w.z = pk2(v1[0], v1[1]); w.w = pk2(v1[2], v1[3]);
                        *(u32x4*)(rowp + bj * 128) = w; } }
        } else {
            const int T = u.pn - gate_pn0, pnc = T >> 2, bjc = (T & 3) >> 1, wcc = 2 * (T & 1) + (wc >> 1), fqc = fq, nc = wc & 1;
            bf16_t* base = RHO + ((((size_t)u.pm * (D / 256) + pnc) * 4) * 8 + (wr * 4 + wcc)) * (size_t)(16 * 64 * 8) + bjc * 512 + (fqc * 16 + fr) * 8 + nc * 4;
            constexpr size_t SEG_STRIDE = (size_t)8 * 16 * 64 * 8;
#pragma unroll
            for (int ai = 0; ai < 2; ++ai)
#pragma unroll
                for (int m = 0; m < 4; ++m) { bf16_t* rp = base + (ai * 4 + m) * 1024; float r0[4], r1[4], r2[4], r3[4];
#pragma unroll
                    for (int e = 0; e < 4; ++e) { const float d0 = 1.f + fexp(-acc[ai][0][m][0][e]), d1 = 1.f + fexp(-acc[ai][0][m][1][e]), d2 = 1.f + fexp(-acc[ai][1][m][0][e]), d3 = 1.f + fexp(-acc[ai][1][m][1][e]);
                        const float i0 = frcp(d0), i1 = frcp(d1), i2 = frcp(d2), i3 = frcp(d3);
                        r0[e] = i0; r1[e] = i1; r2[e] = i2; r3[e] = i3; }
                    u32x2 w; w.x = pk2(r0[0], r0[1]); w.y = pk2(r0[2], r0[3]); *(u32x2*)(rp) = w; w.x = pk2(r1[0], r1[1]); w.y = pk2(r1[2], r1[3]); *(u32x2*)(rp + SEG_STRIDE) = w;
                    w.x = pk2(r2[0], r2[1]); w.y = pk2(r2[2], r2[3]); *(u32x2*)(rp + 2 * SEG_STRIDE) = w; w.x = pk2(r3[0], r3[1]); w.y = pk2(r3[2], r3[3]); *(u32x2*)(rp + 3 * SEG_STRIDE) = w; } }
    }
};
struct EpiGateP {
    static constexpr bool PERM = false, AFTER_DRAIN = false; static constexpr int MIDK = 0;
    bf16_t* O; int ldc; const bf16_t* SG;
    DM void operator()(const f32x4 (&acc)[2][2][4][2], const pg8::Unit& u, int wr, int wc, int fr, int fq) const {
        const int n = u.pn / (D / 256), pnc = u.pn % (D / 256);
        const u32x4* base = (const u32x4*)(SG + ((((size_t)u.pm * (D / 256) + pnc) * 4 + n) * 8 + (wr * 4 + wc)) * (size_t)(16 * 64 * 8)) + (fq * 16 + fr);
        const int row0 = u.pm * 256 + wr * 64 + fr, col0 = u.pn * 256 + wc * 32 + 4 * fq;
#pragma unroll
        for (int ai = 0; ai < 2; ++ai)
#pragma unroll
            for (int m = 0; m < 4; ++m) { bf16_t* rowp = O + (size_t)(row0 + ai * 128 + m * 16) * ldc + col0;
#pragma unroll
                for (int bj = 0; bj < 2; ++bj) { const u32x4 g = base[((ai * 4 + m) * 2 + bj) * 64]; const f32x4 v0 = acc[ai][bj][m][0], v1 = acc[ai][bj][m][1];
                    u32x2 w0, w1; w0.x = pk2(v0[0] * bflo(g.x), v0[1] * bfhi(g.x)); w0.y = pk2(v0[2] * bflo(g.y), v0[3] * bfhi(g.y)); w1.x = pk2(v1[0] * bflo(g.z), v1[1] * bfhi(g.z)); w1.y = pk2(v1[2] * bflo(g.w), v1[3] * bfhi(g.w));
                    *(u32x2*)(rowp + bj * 128) = w0; *(u32x2*)(rowp + bj * 128 + 16) = w1; } }
    }
};
struct EpiF32 {
    static constexpr bool PERM = false, AFTER_DRAIN = false; static constexpr int MIDK = 0;
    float* O; int ldc;
    DM void operator()(const f32x4 (&acc)[2][2][4][2], const pg8::Unit& u, int wr, int wc, int fr, int fq) const {
        const int row0 = u.pm * 256 + wr * 64 + fr, col0 = u.pn * 256 + wc * 32 + 4 * fq;
#pragma unroll
        for (int ai = 0; ai < 2; ++ai)
#pragma unroll
            for (int m = 0; m < 4; ++m) { float* rowp = O + (size_t)(row0 + ai * 128 + m * 16) * ldc + col0;
#pragma unroll
                for (int bj = 0; bj < 2; ++bj)
#pragma unroll
                    for (int n = 0; n < 2; ++n) *(f32x4*)(rowp + bj * 128 + n * 16) = acc[ai][bj][m][n]; }
    }
};

#ifdef EMU
template <class Epi> static void emu_gemm(const pg8::Gemm g, const Epi& E, int ka_div = 0, int ka_mul = 0) {
    if (g.M % 256 || g.N % 256) { printf("emu_gemm: M %d N %d not multiples of 256\n", g.M, g.N); exit(1); }
    std::vector<float> C((size_t)256 * 256);
    const int seglen = (Epi::MIDK > 0) ? Epi::MIDK * 64 : g.K, nseg = g.K / seglen;
    for (int pm = 0; pm < g.M / 256; ++pm) for (int pn = 0; pn < g.N / 256; ++pn) {
        pg8::Unit u{pm, pn, 0};
        std::fill(C.begin(), C.end(), 0.f);
        for (int sg = 0; sg < nseg; ++sg) {
            for (int i = 0; i < 256; ++i) for (int j = 0; j < 256; ++j) { float a = 0.f; const bf16_t* ar = g.A + (size_t)(pm * 256 + i) * g.lda + sg * seglen + (ka_div ? (pn / ka_div) * ka_mul : 0); const bf16_t* br = g.Bt + (size_t)(pn * 256 + j) * g.ldb + sg * seglen;
                for (int k = 0; k < seglen; ++k) a += bf2f(ar[k]) * bf2f(br[k]); C[(size_t)i * 256 + j] += a; }
            const bool fin = (sg == nseg - 1);
            for (int wid = 0; wid < 8; ++wid) for (int lane = 0; lane < 64; ++lane) { const int wr = wid >> 2, wc = wid & 3, fr = lane & 15, fq = lane >> 4;
                f32x4 acc[2][2][4][2];
                for (int ai = 0; ai < 2; ++ai) for (int bj = 0; bj < 2; ++bj) for (int m = 0; m < 4; ++m) for (int n = 0; n < 2; ++n) for (int e = 0; e < 4; ++e) {
                    const int r = 128 * ai + 64 * wr + 16 * m + fr; const int c = Epi::PERM ? (128 * bj + 32 * wc + 8 * fq + 4 * n + e) : (128 * bj + 32 * wc + 16 * n + 4 * fq + e);
                    acc[ai][bj][m][n][e] = C[(size_t)r * 256 + c]; }
                if (fin) E(acc, u, wr, wc, fr, fq);
                else { if constexpr (Epi::MIDK > 0) E.mid(acc, u, sg, wr, wc, fr, fq);
                    for (int ai = 0; ai < 2; ++ai) for (int bj = 0; bj < 2; ++bj) for (int m = 0; m < 4; ++m) for (int n = 0; n < 2; ++n) for (int e = 0; e < 4; ++e) {
                        const int r = 128 * ai + 64 * wr + 16 * m + fr; const int c = Epi::PERM ? (128 * bj + 32 * wc + 8 * fq + 4 * n + e) : (128 * bj + 32 * wc + 16 * n + 4 * fq + e);
                        C[(size_t)r * 256 + c] = acc[ai][bj][m][n][e]; } } }
        }
    }
}
#endif
DI int gate_row(int sc) { const int n = sc / D, j = sc % D, jl = j & 63; return CG0 + 256 * (j >> 6) + 128 * (n >> 1) + 32 * (jl >> 4) + 8 * ((jl >> 2) & 3) + 4 * (n & 1) + (jl & 3); }
template <bool GATE> DI void transpose_item(const float* W, int N, bf16_t* dst, size_t ld_dst, int row_off, int col_off, LAS float* scr, int kb, int nb, int lane) {
    const int k0 = 64 * kb, n0 = 32 * nb;
#pragma unroll 8
    for (int i = 0; i < 32; ++i) { const int kk = 2 * i + (lane >> 5); scr[kk * 33 + (lane & 31)] = W[(size_t)(k0 + kk) * N + n0 + (lane & 31)]; }
    WAVE_SYNC();
    const int c = lane & 7;
#pragma unroll
    for (int j = 0; j < 4; ++j) { const int n = (lane >> 3) + 8 * j; const LAS float* s = scr + (8 * c) * 33 + n;
        u32x4 o; o.x = pk2(s[0 * 33], s[1 * 33]); o.y = pk2(s[2 * 33], s[3 * 33]); o.z = pk2(s[4 * 33], s[5 * 33]); o.w = pk2(s[6 * 33], s[7 * 33]);
        const int drow = GATE ? gate_row(n0 + n - C_MG) : (row_off + n0 + n);
        *(u32x4*)(dst + (size_t)drow * ld_dst + col_off + k0 + 8 * c) = o; }
    WAVE_SYNC();
}
__device__ const unsigned char T5_THR[15] = {19, 21, 24, 27, 31, 35, 40, 46, 52, 59, 67, 77, 87, 99, 113};
DI int t5_bucket(int n) { if (n < 16) return n; int b = 16;
#pragma unroll
    for (int i = 0; i < 15; ++i) b += (n >= (int)T5_THR[i]) ? 1 : 0;
    return b; }

DI void phase_prologue(KP p, lptr lds) {
    const int tid = TID(), lane = tid & 63, wave = tid >> 6;
    const int gw = blockIdx.x * 8 + wave, NGW = gridDim.x * 8;
    const size_t gt = (size_t)blockIdx.x * 512 + tid, NGT = (size_t)gridDim.x * 512;
    LAS float* scr = (LAS float*)(lds + wave * 8704);
    bf16_t* WIN = (bf16_t*)(p->ws + WS_WIN); bf16_t* WBR = (bf16_t*)(p->ws + WS_WBR); bf16_t* WOUT = (bf16_t*)(p->ws + WS_WOUT);
    constexpr int NI_IN = (D / 64) * (IN_COLS / 32), NI_V1 = (D / 64) * 1, NI_BR = (MIX / 64) * (D / 32), NI_OUT = (D / 64) * (D / 32);
    constexpr int PER_L = NI_IN + NI_V1 + 4 * NI_BR + NI_OUT;
    for (int it = gw; it < L * PER_L; it += NGW) {
        const int l = it / PER_L; int r = it % PER_L;
        if (r < NI_IN) { const int nblk = IN_COLS / 32, nb = r % nblk; const float* src = p->in[I_WIN] + (size_t)l * D * IN_COLS; bf16_t* dstw = WIN + (size_t)l * NP * D;
            if (32 * nb >= C_MG) transpose_item<true>(src, IN_COLS, dstw, D, 0, 0, scr, r / nblk, nb, lane); else transpose_item<false>(src, IN_COLS, dstw, D, 0, 0, scr, r / nblk, nb, lane); continue; } r -= NI_IN;
        if (r < NI_V1) { if (l > 0) transpose_item<false>(p->in[I_V1] + (size_t)(l - 1) * D * 32, 32, WIN + (size_t)l * NP * D, D, C_VD, 0, scr, r, 0, lane); continue; } r -= NI_V1;
        if (r < 4 * NI_BR) { const int n = r / NI_BR, rr = r % NI_BR, nblk = D / 32;
            transpose_item<false>(p->in[I_WBR] + ((size_t)l * 4 + n) * MIX * D, D, WBR + (size_t)l * 4 * D * MIX, MIX, n * D, 0, scr, rr / nblk, rr % nblk, lane); continue; } r -= 4 * NI_BR;
        { const int nblk = D / 32; transpose_item<false>(p->in[I_WOUT] + (size_t)l * D * D, D, WOUT + (size_t)l * D * D, D, 0, 0, scr, r / nblk, r % nblk, lane); }
    }
    for (int l = 0; l < L; ++l) { const int r0 = (l == 0) ? C_VD : C_VD + 32; const size_t n8 = (size_t)(CG0 - r0) * D / 8; u32x4* dst = (u32x4*)(WIN + ((size_t)l * NP + r0) * D);
        for (size_t i = gt; i < n8; i += NGT) dst[i] = (u32x4){0u, 0u, 0u, 0u}; }
    { const f32x4* x4 = (const f32x4*)p->in[I_X]; u32x2* xn = (u32x2*)(p->ws + WS_XN);
      for (size_t i = gt; i < (size_t)M * D / 4; i += NGT) { const f32x4 v = x4[i]; u32x2 o; o.x = pk2(v[0], v[1]); o.y = pk2(v[2], v[3]); xn[i] = o; } }
    { bf16_t* W2T = (bf16_t*)(p->ws + SM_W2T); bf16_t* A2T = (bf16_t*)(p->ws + SM_A2T); bf16_t* V2T = (bf16_t*)(p->ws + SM_V2T);
      for (size_t i = gt; i < (size_t)L * MIX * 64; i += NGT) { const int j = (int)(i % 64); const int c = (int)((i / 64) % MIX); const int l = (int)(i / ((size_t)64 * MIX));
          W2T[i] = f2bf(p->in[I_W2][((size_t)l * 64 + j) * MIX + c]); A2T[i] = f2bf(p->in[I_A2][((size_t)l * 64 + j) * MIX + c]); }
      for (size_t i = gt; i < (size_t)L * MIX * 32; i += NGT) { const int j = (int)(i % 32); const int c = (int)((i / 32) % MIX); const int l = (int)(i / ((size_t)32 * MIX));
          V2T[i] = (l > 0) ? f2bf(p->in[I_V2][((size_t)(l - 1) * 32 + j) * MIX + c]) : (bf16_t)0; } }
    if (blockIdx.x == 0) {
        float* LAM = (float*)(p->ws + SM_LAM); float* LB = (float*)(p->ws + SM_LB); float* BT = (float*)(p->ws + SM_BT);
        if (tid < L) { const float* lm = p->in[I_LAM] + (size_t)tid * 256; float s1 = 0.f, s2 = 0.f;
            for (int i = 0; i < 64; ++i) { s1 += lm[i] * lm[64 + i]; s2 += lm[128 + i] * lm[192 + i]; }
            const float li = 0.8f - 0.6f * expf(-0.3f * (float)tid); LAM[tid] = expf(s1) - expf(s2) + li; LAM[L + tid] = li; }
        for (int c = tid; c < MIX; c += 512) { float mx = -1e30f; for (int l = 0; l < L; ++l) mx = fmaxf(mx, p->in[I_HGLOW][(size_t)l * MIX + c]);
            float den = 0.f; for (int l = 0; l < L; ++l) den += expf(p->in[I_HGLOW][(size_t)l * MIX + c] - mx);
            float cum = 0.f; for (int l = 0; l < L; ++l) { if (l > 0) cum += expf(p->in[I_HGLOW][(size_t)l * MIX + c] - mx) / den;
                LB[(size_t)l * MIX + c] = cum; LB[(size_t)(L + l) * MIX + c] = (l > 0) ? logf(cum) : -1e30f; LB[(size_t)(2 * L + l) * MIX + c] = log1pf(-cum); } }
        for (int i = tid; i < AH * 132; i += 512) { const int h = i / 132, d = i % 132; const int bk = (d >= 128) ? 31 : t5_bucket(d); BT[i] = p->in[I_REL][bk * AH + h] * LOG2E; }
    }
}
constexpr int ATT_KSTR = 272, ATT_VSTR = 320;
constexpr int ATT_K_OFF = 0, ATT_V_OFF = 64 * ATT_KSTR, ATT_BT_OFF = ATT_V_OFF + 64 * ATT_VSTR, ATT_X_OFF = 40960;
struct KVRegs { u32x4 k[2], v[2]; };
DI void load_kv(KVRegs& rg, const bf16_t* Z, size_t row0, int kcol, int vcol, int tid) {
#pragma unroll
    for (int i = 0; i < 2; ++i) { const int pc = tid + 512 * i, row = pc >> 4, c16 = pc & 15;
        rg.k[i] = *(const u32x4*)(Z + (row0 + row) * ZLD + kcol + c16 * 8);
        rg.v[i] = *(const u32x4*)(Z + (row0 + row) * ZLD + vcol + c16 * 8); }
}
DI void store_kv(const KVRegs& rg, lptr lds, int tid) {
#pragma unroll
    for (int i = 0; i < 2; ++i) { const int pc = tid + 512 * i, row = pc >> 4, c16 = pc & 15;
        *(LAS u32x4*)(lds + ATT_K_OFF + row * ATT_KSTR + c16 * 16) = rg.k[i];
        *(LAS u32x4*)(lds + ATT_V_OFF + row * ATT_VSTR + c16 * 16) = rg.v[i]; }
}
DI void pv_acc(f32x16 (&o)[4], const f32x16& pt, lptr lds, int kh, int lane) {
    const int hh = lane >> 5, gsub = (lane >> 4) & 1, i16 = lane & 15, qq = i16 >> 2, pp = i16 & 3;
#pragma unroll
    for (int s = 0; s < 2; ++s) {
        const bf16x8 pb = pack8(pt[8 * s], pt[8 * s + 1], pt[8 * s + 2], pt[8 * s + 3], pt[8 * s + 4], pt[8 * s + 5], pt[8 * s + 6], pt[8 * s + 7]);
        const lptr vrow = lds + ATT_V_OFF + (32 * kh + 16 * s + 4 * hh + qq) * ATT_VSTR + gsub * 32 + pp * 8;
#pragma unroll
        for (int db = 0; db < 4; ++db) {
            const s16x4 lo = TR_READ(vrow + db * 64), hi = TR_READ(vrow + 8 * ATT_VSTR + db * 64);
            o[db] = MFMA32(cat4(lo, hi), pb, o[db]); }
    }
}
DI void phase_att_a(KP p, int layer, lptr lds, int unit) {
    const int tid = TID(), lane = tid & 63, wid = RFL(tid >> 6), r = lane & 31, hh = lane >> 5;
    constexpr int NQB = S / 128;
    const int qb = NQB - 1 - (unit % NQB), bh = unit / NQB, h = bh % AH, b = bh / AH;
    const int mp = wid & 1, qs = wid >> 1, q0 = qb * 128, qw0 = q0 + 32 * qs, q = qw0 + r;
    const bf16_t* Z = (const bf16_t*)(p->ws + WS_Z); const size_t rowb = (size_t)b * S;
    const float* LAM = (const float*)(p->ws + SM_LAM); const float lam_full = LAM[layer], lam_init = LAM[L + layer];
    LAS float* BT = (LAS float*)(lds + ATT_BT_OFF);
    __syncthreads();
    if (tid < 132) BT[tid] = ((const float*)(p->ws + SM_BT))[h * 132 + tid];
    bf16x8 qf[4];
    { const bf16_t* qp = Z + (rowb + q) * ZLD + C_AQ + h * 128 + mp * 64 + 8 * hh; const float qsc = 0.125f * LOG2E;
#pragma unroll
      for (int ds = 0; ds < 4; ++ds) { const u32x4 w = *(const u32x4*)(qp + 16 * ds);
          qf[ds] = pack8(bflo(w.x) * qsc, bfhi(w.x) * qsc, bflo(w.y) * qsc, bfhi(w.y) * qsc, bflo(w.z) * qsc, bfhi(w.z) * qsc, bflo(w.w) * qsc, bfhi(w.w) * qsc); } }
    f32x16 o[4];
#pragma unroll
    for (int db = 0; db < 4; ++db)
#pragma unroll
        for (int i = 0; i < 16; ++i) o[db][i] = 0.f;
    float mrun = -INFINITY, lrun = 0.f;
    const int nkt = (q0 + 128) / 64;
    KVRegs rg; load_kv(rg, Z, rowb, C_AK + h * 128, C_AV + h * 128, tid);
    for (int kt = 0; kt < nkt; ++kt) {
        const int k0 = kt * 64;
        __syncthreads();
        store_kv(rg, lds, tid);
        if (kt + 1 < nkt) load_kv(rg, Z, rowb + k0 + 64, C_AK + h * 128, C_AV + h * 128, tid);
        __syncthreads();
        if (k0 <= qw0 + 31) {
#pragma unroll 1
            for (int kh = 0; kh < 2; ++kh) {
                if (k0 + 32 * kh > qw0 + 31) break;
                f32x16 sc;
#pragma unroll
                for (int i = 0; i < 16; ++i) sc[i] = 0.f;
#pragma unroll
                for (int ds = 0; ds < 4; ++ds) { const bf16x8 a = *(const LAS bf16x8*)(lds + ATT_K_OFF + (32 * kh + r) * ATT_KSTR + mp * 128 + ds * 32 + hh * 16); sc = MFMA32(a, qf[ds], sc); }
                const int kbase = k0 + 32 * kh;
                if (qw0 - (kbase + 31) >= 128) { const float cb = BT[128];
#pragma unroll
                    for (int i = 0; i < 16; ++i) sc[i] += cb;
                } else {
#pragma unroll
                    for (int i = 0; i < 16; ++i) { const int dist = q - (kbase + crow(i, hh)); const int di = dist < 0 ? 0 : (dist > 128 ? 128 : dist);
                        sc[i] = (dist < 0) ? -INFINITY : sc[i] + BT[di]; }
                }
                float mx = sc[0];
#pragma unroll
                for (int i = 1; i < 16; ++i) mx = fmaxf(mx, sc[i]);
                mx = fmaxf(mx, __shfl_xor(mx, 32));
                const float mnew = fmaxf(mrun, mx), alpha = ex2(mrun - mnew);
                float sum = 0.f;
#pragma unroll
                for (int i = 0; i < 16; ++i) { const float e = ex2(sc[i] - mnew); sc[i] = e; sum += e; }
                sum += __shfl_xor(sum, 32);
                lrun = lrun * alpha + sum; mrun = mnew;
                if (ANY(alpha != 1.f)) {
#pragma unroll
                    for (int db = 0; db < 4; ++db)
#pragma unroll
                        for (int i = 0; i < 16; ++i) o[db][i] *= alpha; }
                pv_acc(o, sc, lds, kh, lane);
            }
        }
    }
    __syncthreads();
    const float inv = 1.f / lrun;
    LAS float* X = (LAS float*)(lds + ATT_X_OFF) + (qs * 32 + r) * 132;
    if (mp == 1) {
#pragma unroll
        for (int db = 0; db < 4; ++db)
#pragma unroll
            for (int g = 0; g < 4; ++g) { f32x4 v; v[0] = o[db][4 * g] * inv * lam_full; v[1] = o[db][4 * g + 1] * inv * lam_full; v[2] = o[db][4 * g + 2] * inv * lam_full; v[3] = o[db][4 * g + 3] * inv * lam_full;
                *(LAS f32x4*)(X + 32 * db + 8 * g + 4 * hh) = v; }
    }
    __syncthreads();
    if (mp == 0) {
        float ss = 0.f;
#pragma unroll
        for (int db = 0; db < 4; ++db)
#pragma unroll
            for (int g = 0; g < 4; ++g) { const f32x4 x1 = *(const LAS f32x4*)(X + 32 * db + 8 * g + 4 * hh);
#pragma unroll
                for (int e = 0; e < 4; ++e) { const float x = o[db][4 * g + e] * inv - x1[e]; o[db][4 * g + e] = x; ss += x * x; } }
        ss += __shfl_xor(ss, 32);
        const float rinv = frsq(ss * (1.f / 128.f) + RMS_EPS) * (1.f - lam_init);
        const float* sg = p->in[I_SUBLN] + (size_t)layer * 128;
        const bf16_t* gp = Z + (rowb + q) * ZLD + C_AG + h * 128; bf16_t* yp = (bf16_t*)(p->ws + WS_Y) + (rowb + q) * (4 * MIX) + 0 * MIX + h * 128;
#pragma unroll
        for (int db = 0; db < 4; ++db)
#pragma unroll
            for (int g = 0; g < 4; ++g) { const int d = 32 * db + 8 * g + 4 * hh; const u32x2 gw = *(const u32x2*)(gp + d); const f32x4 sv = *(const f32x4*)(sg + d);
                u32x2 w; w.x = pk2(o[db][4 * g] * rinv * sv[0] * fsilu(bflo(gw.x)), o[db][4 * g + 1] * rinv * sv[1] * fsilu(bfhi(gw.x)));
                w.y = pk2(o[db][4 * g + 2] * rinv * sv[2] * fsilu(bflo(gw.y)), o[db][4 * g + 3] * rinv * sv[3] * fsilu(bfhi(gw.y)));
                *(u32x2*)(yp + d) = w; }
    }
}

constexpr float SB_CUT = -110.f;
DI void phase_att_d(KP p, int layer, lptr lds, int unit) {
    const int tid = TID(), lane = tid & 63, wid = RFL(tid >> 6), r = lane & 31, hh = lane >> 5;
    constexpr int NQB = S / 256;
    const int qb = NQB - 1 - (unit % NQB), bh = unit / NQB, h = bh % SH, b = bh / SH;
    const int q0 = qb * 256, qw0 = q0 + 32 * wid, q = qw0 + r;
    const bf16_t* Z = (const bf16_t*)(p->ws + WS_Z); const size_t rowb = (size_t)b * S;
    LAS int* FLG = (LAS int*)(lds + ATT_BT_OFF);
    bf16x8 qf[8];
    { const bf16_t* qp = Z + (rowb + q) * ZLD + C_SQ + h * 128 + 8 * hh; const float qsc = 0.08838834764831845f;
#pragma unroll
      for (int ds = 0; ds < 8; ++ds) { const u32x4 w = *(const u32x4*)(qp + 16 * ds);
          qf[ds] = pack8(bflo(w.x) * qsc, bfhi(w.x) * qsc, bflo(w.y) * qsc, bfhi(w.y) * qsc, bflo(w.z) * qsc, bfhi(w.z) * qsc, bflo(w.w) * qsc, bfhi(w.w) * qsc); } }
    f32x16 o[4];
#pragma unroll
    for (int db = 0; db < 4; ++db)
#pragma unroll
        for (int i = 0; i < 16; ++i) o[db][i] = 0.f;
    float carry = 0.f;
    KVRegs rg; load_kv(rg, Z, rowb + (size_t)((q0 + 255) / 64) * 64, C_SK + h * 128, C_SV + h * 128, tid);
    for (int kt = (q0 + 255) / 64; kt >= 0; --kt) {
        const int k0 = kt * 64;
        __syncthreads();
        store_kv(rg, lds, tid);
        if (kt > 0) load_kv(rg, Z, rowb + k0 - 64, C_SK + h * 128, C_SV + h * 128, tid);
        __syncthreads();
        if (k0 < qw0 + 31) {
#pragma unroll 1
            for (int kh = 1; kh >= 0; --kh) {
                if (k0 + 32 * kh >= qw0 + 31) continue;
                f32x16 z;
#pragma unroll
                for (int i = 0; i < 16; ++i) z[i] = 0.f;
#pragma unroll
                for (int ds = 0; ds < 8; ++ds) { const bf16x8 a = *(const LAS bf16x8*)(lds + ATT_K_OFF + (32 * kh + r) * ATT_KSTR + ds * 32 + hh * 16); z = MFMA32(a, qf[ds], z); }
                f32x16 lk; float gsum[4];
#pragma unroll
                for (int g = 0; g < 4; ++g) { gsum[g] = 0.f;
#pragma unroll
                    for (int e = 0; e < 4; ++e) { const int i = 4 * g + e; const bool valid = (k0 + 32 * kh + crow(i, hh)) < q; const float sp = fsoftplus(z[i]);
                        lk[i] = valid ? -sp : 0.f; z[i] = valid ? (z[i] - sp) : -INFINITY; gsum[g] += lk[i]; } }
                float og[4];
#pragma unroll
                for (int g = 0; g < 4; ++g) og[g] = __shfl_xor(gsum[g], 32);
                float suf[4]; float run = 0.f;
#pragma unroll
                for (int g = 3; g >= 0; --g) {
                    if (hh == 1) { suf[g] = run; run += gsum[g] + og[g]; }
                    else { suf[g] = run + og[g]; run += gsum[g] + og[g]; }
                }
#pragma unroll
                for (int g = 0; g < 4; ++g) { float inner = 0.f;
#pragma unroll
                    for (int e = 3; e >= 0; --e) { const int i = 4 * g + e; const float between = carry + suf[g] + inner; inner += lk[i]; z[i] = ex2((z[i] + between) * LOG2E); } }
                carry += run;
                pv_acc(o, z, lds, kh, lane);
            }
        }
        const int active = ANY(carry > SB_CUT) ? 1 : 0;
        if (lane == 0) FLG[wid] = active;
        __syncthreads();
        int anyact = 0;
#pragma unroll
        for (int w = 0; w < 8; ++w) anyact |= FLG[w];
        if (!anyact) break;
    }
    const bf16_t* gp = Z + (rowb + q) * ZLD + C_SG + h * 128; bf16_t* yp = (bf16_t*)(p->ws + WS_Y) + (rowb + q) * (4 * MIX) + 3 * MIX + h * 128;
#pragma unroll
    for (int db = 0; db < 4; ++db)
#pragma unroll
        for (int g = 0; g < 4; ++g) { const int d = 32 * db + 8 * g + 4 * hh; const u32x2 gw = *(const u32x2*)(gp + d);
            u32x2 w; w.x = pk2(o[db][4 * g] * fsilu(bflo(gw.x)), o[db][4 * g + 1] * fsilu(bfhi(gw.x)));
            w.y = pk2(o[db][4 * g + 2] * fsilu(bflo(gw.y)), o[db][4 * g + 3] * fsilu(bfhi(gw.y)));
            *(u32x2*)(yp + d) = w; }
}
constexpr int HG_STR = 144;
constexpr int HG_QT = 0, HG_KT = 128 * HG_STR, HG_IT = 2 * 128 * HG_STR, HG_SC = 3 * 128 * HG_STR, HG_VEC = HG_SC + 64 * HG_STR;
DI bf16x8 hg_trfrag(lptr img, int col0, int dbase, int lane) {
    const int g = lane >> 4, i16 = lane & 15, qq = i16 >> 2, pp = i16 & 3;
    const lptr a = img + (dbase + 4 * g + qq) * HG_STR + (col0 + 4 * pp) * 2;
    return cat4(TR_READ(a), TR_READ(a + 16 * HG_STR));
}
constexpr int HG_NC = S / 64, HG_NCH = NB * HH * HG_NC;
DI void phase_hg_local(KP p, int layer, lptr lds, int unit) {
    const int tid = TID(), lane = tid & 63, wid = RFL(tid >> 6), g = lane >> 4, c16 = lane & 15;
    const int c = unit % HG_NC, bh = unit / HG_NC, h = bh % HH, b = bh / HH;
    const bf16_t* Z = (const bf16_t*)(p->ws + WS_Z); const size_t row0 = (size_t)b * S + (size_t)c * 64;
    const float* LBp = (const float*)(p->ws + SM_LB);
    LAS float* EBD = (LAS float*)(lds + HG_VEC); LAS float* QTOT = EBD + 128;
    const int ch = tid & 127, tq = tid >> 7;
    const float lb = LBp[(size_t)layer * MIX + h * 128 + ch], loglb = LBp[(size_t)(L + layer) * MIX + h * 128 + ch], log1m = LBp[(size_t)(2 * L + layer) * MIX + h * 128 + ch];
    __syncthreads();
    float bl[16], qv[16], kv[16], iv[16];
    { const bf16_t* zp = Z + (row0 + 16 * tq) * ZLD + h * 128 + ch; float run = 0.f;
#pragma unroll
      for (int t = 0; t < 16; ++t) { const float zq = bf2f(zp[(size_t)t * ZLD + C_HQ]), zf = bf2f(zp[(size_t)t * ZLD + C_HF]); iv[t] = bf2f(zp[(size_t)t * ZLD + C_HI]);
          const float ls = -fsoftplus(-zf);
          float lf; if (lb > 0.f) { const float a_ = loglb, b_ = log1m + ls, mx = fmaxf(a_, b_); lf = mx + flog(fexp(a_ - mx) + fexp(b_ - mx)); } else lf = ls;
          run += lf; bl[t] = run; qv[t] = zq; kv[t] = (1.f - lb) * fexp(ls - zf); }
      QTOT[tq * 128 + ch] = run; }
    __syncthreads();
    { const float t0 = QTOT[ch], t1 = QTOT[128 + ch], t2 = QTOT[256 + ch], t3 = QTOT[384 + ch];
      const float pre = (tq > 0 ? t0 : 0.f) + (tq > 1 ? t1 : 0.f) + (tq > 2 ? t2 : 0.f), bref = t0 + t1, blast = bref + t2 + t3;
      unsigned qw[8], kw[8], iw[8];
#pragma unroll
      for (int t = 0; t < 16; t += 2) { const float b0 = pre + bl[t] - bref, b1 = pre + bl[t + 1] - bref;
          qw[t >> 1] = pk2(qv[t] * fexp(b0), qv[t + 1] * fexp(b1)); kw[t >> 1] = pk2(kv[t] * fexp(-b0), kv[t + 1] * fexp(-b1)); iw[t >> 1] = pk2(iv[t], iv[t + 1]); }
      LAS u32x4* dq = (LAS u32x4*)(lds + HG_QT + ch * HG_STR + tq * 32); dq[0] = (u32x4){qw[0], qw[1], qw[2], qw[3]}; dq[1] = (u32x4){qw[4], qw[5], qw[6], qw[7]};
      LAS u32x4* dk = (LAS u32x4*)(lds + HG_KT + ch * HG_STR + tq * 32); dk[0] = (u32x4){kw[0], kw[1], kw[2], kw[3]}; dk[1] = (u32x4){kw[4], kw[5], kw[6], kw[7]};
      LAS u32x4* di = (LAS u32x4*)(lds + HG_IT + ch * HG_STR + tq * 32); di[0] = (u32x4){iw[0], iw[1], iw[2], iw[3]}; di[1] = (u32x4){iw[4], iw[5], iw[6], iw[7]};
      if (tq == 0) { float* VE = (float*)(p->ws + WS_HGVE) + (size_t)unit * 256; VE[ch] = fexp(bref); VE[128 + ch] = fexp(blast); EBD[ch] = fexp(blast - bref); } }
    __syncthreads();
#pragma unroll
    for (int k2 = 0; k2 < 2; ++k2) { const int ti = 2 * wid + k2, tb = ti >> 2, sb = ti & 3;
        f32x4 acc = (f32x4){0.f, 0.f, 0.f, 0.f};
        if (sb <= tb) {
#pragma unroll
            for (int dp = 0; dp < 4; ++dp) acc = MFMA16(hg_trfrag(lds + HG_QT, 16 * tb, 32 * dp, lane), hg_trfrag(lds + HG_KT, 16 * sb, 32 * dp, lane), acc); }
        const int s = 16 * sb + c16;
#pragma unroll
        for (int e = 0; e < 4; ++e) { const int t = 16 * tb + 4 * g + e; *(LAS bf16_t*)(lds + HG_SC + t * HG_STR + s * 2) = f2bf((s <= t) ? acc[e] : 0.f); }
        ((bf16x8*)(p->ws + WS_HGQF))[((size_t)unit * 16 + ti) * 64 + lane] = hg_trfrag(lds + HG_QT, 16 * (ti >> 2), 32 * (ti & 3), lane); }
    __syncthreads();
    bf16x8 ib[2];
#pragma unroll
    for (int ks = 0; ks < 2; ++ks) ib[ks] = *(const LAS bf16x8*)(lds + HG_IT + (16 * wid + c16) * HG_STR + (8 * g + 32 * ks) * 2);
    f32x4* IN = (f32x4*)(p->ws + WS_HGIN) + ((size_t)unit * 8 + wid) * 4 * 64;
#pragma unroll
    for (int tb = 0; tb < 4; ++tb) { f32x4 acc = (f32x4){0.f, 0.f, 0.f, 0.f};
#pragma unroll
        for (int ks = 0; ks < 2; ++ks) acc = MFMA16(*(const LAS bf16x8*)(lds + HG_SC + (16 * tb + c16) * HG_STR + (8 * g + 32 * ks) * 2), ib[ks], acc);
        IN[tb * 64 + lane] = acc; }
    f32x4* DS = (f32x4*)(p->ws + WS_HGDS) + ((size_t)unit * 8 + wid) * 8 * 64;
#pragma unroll
    for (int db = 0; db < 8; ++db) { f32x4 tmp = (f32x4){0.f, 0.f, 0.f, 0.f};
#pragma unroll
        for (int ks = 0; ks < 2; ++ks) tmp = MFMA16(*(const LAS bf16x8*)(lds + HG_KT + (16 * db + c16) * HG_STR + (8 * g + 32 * ks) * 2), ib[ks], tmp);
        const f32x4 ed = *(const LAS f32x4*)(EBD + 16 * db + 4 * g);
        DS[db * 64 + lane] = tmp * ed; }
}
DI void phase_hg_scan(KP p, int unit) {
    const int tid = TID(), lane = tid & 63, wid = RFL(tid >> 6), g = lane >> 4;
    f32x4 st[8];
#pragma unroll
    for (int db = 0; db < 8; ++db) st[db] = (f32x4){0.f, 0.f, 0.f, 0.f};
    const float* VE0 = (const float*)(p->ws + WS_HGVE) + (size_t)unit * HG_NC * 256;
    const f32x4* DS0 = (const f32x4*)(p->ws + WS_HGDS) + ((size_t)unit * HG_NC * 8 + wid) * 8 * 64 + lane;
    bf16x8* SF0 = (bf16x8*)(p->ws + WS_HGSF) + ((size_t)unit * HG_NC * 8 + wid) * 4 * 64 + lane;
    f32x4 ds[8], el[8], er[8];
#pragma unroll
    for (int db = 0; db < 8; ++db) { ds[db] = DS0[db * 64]; el[db] = *(const f32x4*)(VE0 + 128 + 16 * db + 4 * g); er[db] = *(const f32x4*)(VE0 + 16 * db + 4 * g); }
    for (int c = 0; c < HG_NC; ++c) {
        const int cn = (c + 1 < HG_NC) ? c + 1 : c;
        f32x4 dsn[8], eln[8], ern[8];
#pragma unroll
        for (int db = 0; db < 8; ++db) { dsn[db] = DS0[((size_t)cn * 8 * 8 + db) * 64]; eln[db] = *(const f32x4*)(VE0 + (size_t)cn * 256 + 128 + 16 * db + 4 * g); ern[db] = *(const f32x4*)(VE0 + (size_t)cn * 256 + 16 * db + 4 * g); }
#pragma unroll
        for (int dp = 0; dp < 4; ++dp) { const f32x4 a0 = st[2 * dp] * er[2 * dp], a1 = st[2 * dp + 1] * er[2 * dp + 1];
            SF0[((size_t)c * 8 * 4 + dp) * 64] = pack8(a0[0], a0[1], a0[2], a0[3], a1[0], a1[1], a1[2], a1[3]); }
#pragma unroll
        for (int db = 0; db < 8; ++db) { st[db] = el[db] * st[db] + ds[db]; ds[db] = dsn[db]; el[db] = eln[db]; er[db] = ern[db]; }
    }
}
DI void phase_hg_out(KP p, int layer, lptr lds, int unit) {
    const int tid = TID(), lane = tid & 63, wid = RFL(tid >> 6), g = lane >> 4, c16 = lane & 15;
    const int c = unit % HG_NC, bh = unit / HG_NC, h = bh % HH, b = bh / HH;
    const bf16_t* Z = (const bf16_t*)(p->ws + WS_Z); const size_t row0 = (size_t)b * S + (size_t)c * 64;
    LAS float* PS = (LAS float*)(lds + HG_VEC);
    const float gnorm = p->in[I_HGNORM][(size_t)layer * 128 + 16 * wid + c16];
    const bf16x8* QF = (const bf16x8*)(p->ws + WS_HGQF) + (size_t)unit * 16 * 64 + lane;
    const bf16x8* SF = (const bf16x8*)(p->ws + WS_HGSF) + ((size_t)unit * 8 + wid) * 4 * 64 + lane;
    const f32x4* IN = (const f32x4*)(p->ws + WS_HGIN) + ((size_t)unit * 8 + wid) * 4 * 64 + lane;
    bf16x8 sf[4];
#pragma unroll
    for (int dp = 0; dp < 4; ++dp) sf[dp] = SF[dp * 64];
    f32x4 ot[4];
#pragma unroll
    for (int tb = 0; tb < 4; ++tb) { f32x4 acc = IN[tb * 64];
#pragma unroll
        for (int dp = 0; dp < 4; ++dp) acc = MFMA16(QF[(tb * 4 + dp) * 64], sf[dp], acc);
        ot[tb] = acc; }
    if (c == 0 && g == 0) { const float* OEX = (const float*)(p->ws + WS_OEX) + (size_t)bh * FX_T * 128 + 16 * wid + c16;
#pragma unroll
        for (int e = 0; e < FX_T; ++e) ot[0][e] = OEX[e * 128]; }
    __syncthreads();
#pragma unroll
    for (int tb = 0; tb < 4; ++tb)
#pragma unroll
        for (int e = 0; e < 4; ++e) { float v = ot[tb][e] * ot[tb][e]; v += __shfl_xor(v, 1); v += __shfl_xor(v, 2); v += __shfl_xor(v, 4); v += __shfl_xor(v, 8);
            if (c16 == 0) PS[wid * 64 + 16 * tb + 4 * g + e] = v; }
    __syncthreads();
    const int e_col = h * 128 + 16 * wid + c16;
#pragma unroll
    for (int tb = 0; tb < 4; ++tb)
#pragma unroll
        for (int e = 0; e < 4; ++e) { const int t = 16 * tb + 4 * g + e; float ss = 0.f;
#pragma unroll
            for (int w = 0; w < 8; ++w) ss += PS[w * 64 + t];
            const float gate = bf2f(Z[(row0 + t) * ZLD + C_HG + e_col]);
            ((bf16_t*)(p->ws + WS_Y))[(row0 + t) * (4 * MIX) + 1 * MIX + e_col] = f2bf(ot[tb][e] * frsq(ss * (1.f / 128.f) + RMS_EPS) * gnorm * fsilu(gate)); }
}
DI f32x4 lerp4(const bf16_t* zc, const bf16_t* zp, bool hp, const float* mu) {
    const u32x2 c = *(const u32x2*)zc; u32x2 pv = (u32x2){0u, 0u}; if (hp) pv = *(const u32x2*)zp; const f32x4 m4 = *(const f32x4*)mu;
    f32x4 o; const float c0 = bflo(c.x), c1 = bfhi(c.x), c2 = bflo(c.y), c3 = bfhi(c.y);
    o[0] = c0 + (bflo(pv.x) - c0) * m4[0]; o[1] = c1 + (bfhi(pv.x) - c1) * m4[1]; o[2] = c2 + (bflo(pv.y) - c2) * m4[2]; o[3] = c3 + (bfhi(pv.y) - c3) * m4[3]; return o; }
DI void rw_prep_item(KP p, int layer, int item, int lane) {
    const int r = lane & 31, hh = lane >> 5;
    const int hd = item % RH, tt = item / RH;
    const size_t m = (size_t)tt * 32 + r; const int t = (int)(m % S), b = (int)(m / S); const bool hp = t > 0;
    const bf16_t* Z = (const bf16_t*)(p->ws + WS_Z); const bf16_t* zc = Z + m * ZLD; const bf16_t* zp = hp ? zc - ZLD : zc;
    const float* mu = p->in[I_MU] + (size_t)layer * RW_MIX;
    bf16x8 xw[4], xa[4], xv[2];
#pragma unroll
    for (int s = 0; s < 4; ++s) { const int jj = 16 * s + 8 * hh;
        const f32x4 w0v = lerp4(zc + C_RM + 3 * MIX + jj, zp + C_RM + 3 * MIX + jj, hp, mu + 3 * MIX + jj), w1v = lerp4(zc + C_RM + 3 * MIX + jj + 4, zp + C_RM + 3 * MIX + jj + 4, hp, mu + 3 * MIX + jj + 4);
        xw[s] = pack8(tanhf(w0v[0]), tanhf(w0v[1]), tanhf(w0v[2]), tanhf(w0v[3]), tanhf(w1v[0]), tanhf(w1v[1]), tanhf(w1v[2]), tanhf(w1v[3]));
        const f32x4 a0v = lerp4(zc + C_RM + 3 * MIX + 64 + jj, zp + C_RM + 3 * MIX + 64 + jj, hp, mu + 3 * MIX + 64 + jj), a1v = lerp4(zc + C_RM + 3 * MIX + 64 + jj + 4, zp + C_RM + 3 * MIX + 64 + jj + 4, hp, mu + 3 * MIX + 64 + jj + 4);
        xa[s] = pack8(a0v[0], a0v[1], a0v[2], a0v[3], a1v[0], a1v[1], a1v[2], a1v[3]); SCHED_FENCE(); }
    if (layer > 0) { const float* vmu = p->in[I_VMU] + (size_t)(layer - 1) * 32;
#pragma unroll
        for (int s = 0; s < 2; ++s) { const int jj = 16 * s + 8 * hh;
            const f32x4 v0v = lerp4(zc + C_VD + jj, zp + C_VD + jj, hp, vmu + jj), v1v = lerp4(zc + C_VD + jj + 4, zp + C_VD + jj + 4, hp, vmu + jj + 4);
            xv[s] = pack8(v0v[0], v0v[1], v0v[2], v0v[3], v1v[0], v1v[1], v1v[2], v1v[3]); } }
    else { xv[0] = xw[0]; xv[1] = xw[0]; }
    const bf16_t* W2T = (const bf16_t*)(p->ws + SM_W2T) + (size_t)layer * MIX * 64; const bf16_t* A2T = (const bf16_t*)(p->ws + SM_A2T) + (size_t)layer * MIX * 64;
    const bf16_t* V2T = (const bf16_t*)(p->ws + SM_V2T) + (size_t)layer * MIX * 32;
    float* SCI = (float*)(p->ws + WS_SCI) + (((size_t)b * RH + hd) * S + t) * 384;
    float* VF = (float*)(p->ws + WS_VF) + m * MIX;
    const float* w0 = p->in[I_W0] + (size_t)layer * MIX; const float* a0 = p->in[I_A0] + (size_t)layer * MIX; const float* kkp = p->in[I_KK] + (size_t)layer * MIX;
    const float* kap = p->in[I_KA] + (size_t)layer * MIX; const float* rkp = p->in[I_RK] + (size_t)layer * MIX; const float* v0 = p->in[I_V0] + (size_t)(layer > 0 ? layer - 1 : 0) * MIX;
    float ssq = 0.f;
#pragma unroll 1
    for (int cg = 0; cg < 8; ++cg) {
        const int ch = hd * 64 + 32 * (cg >> 2) + 8 * (cg & 3) + 4 * hh;
        const f32x4 k4 = lerp4(zc + C_RM + MIX + ch, zp + C_RM + MIX + ch, hp, mu + MIX + ch), kq = *(const f32x4*)(kkp + ch);
        ssq += (k4[0] * kq[0] * k4[0] * kq[0] + k4[1] * kq[1] * k4[1] * kq[1]) + (k4[2] * kq[2] * k4[2] * kq[2] + k4[3] * kq[3] * k4[3] * kq[3]); }
    ssq += __shfl_xor(ssq, 32);
    const float kinv = 1.f / fmaxf(sqrtf(ssq), 1e-12f);
    float bon = 0.f;
#pragma unroll 1
    for (int cb = 0; cb < 2; ++cb) {
        const int chA = hd * 64 + 32 * cb + r;
        f32x16 lw, la, lv;
#pragma unroll
        for (int i = 0; i < 16; ++i) { lw[i] = 0.f; la[i] = 0.f; lv[i] = 0.f; }
#pragma unroll
        for (int s = 0; s < 4; ++s) { lw = MFMA32(*(const bf16x8*)(W2T + (size_t)chA * 64 + 16 * s + 8 * hh), xw[s], lw);
                                      la = MFMA32(*(const bf16x8*)(A2T + (size_t)chA * 64 + 16 * s + 8 * hh), xa[s], la); }
        if (layer > 0) {
#pragma unroll
            for (int s = 0; s < 2; ++s) lv = MFMA32(*(const bf16x8*)(V2T + (size_t)chA * 32 + 16 * s + 8 * hh), xv[s], lv); }
#pragma unroll
        for (int gq = 0; gq < 4; ++gq) { f32x4 o_w, o_k, o_a, o_b; const int cl = 32 * cb + 8 * gq + 4 * hh, ch = hd * 64 + cl;
            const f32x4 r4 = lerp4(zc + C_RM + ch, zp + C_RM + ch, hp, mu + ch), k4 = lerp4(zc + C_RM + MIX + ch, zp + C_RM + MIX + ch, hp, mu + MIX + ch);
            f32x4 v4 = lerp4(zc + C_RM + 2 * MIX + ch, zp + C_RM + 2 * MIX + ch, hp, mu + 2 * MIX + ch);
            const f32x4 w04 = *(const f32x4*)(w0 + ch), a04 = *(const f32x4*)(a0 + ch), kq = *(const f32x4*)(kkp + ch), ka4 = *(const f32x4*)(kap + ch), rk4 = *(const f32x4*)(rkp + ch);
            if (layer == 0) { if (t >= FX_T) *(f32x4*)(VF + ch) = v4; }
            else { const f32x4 vf = *(const f32x4*)(VF + ch), v04 = *(const f32x4*)(v0 + ch);
#pragma unroll
                for (int e = 0; e < 4; ++e) v4[e] = v4[e] + (vf[e] - v4[e]) * fsigmoid(v04[e] + lv[4 * gq + e]); }
#pragma unroll
            for (int e = 0; e < 4; ++e) { const int i = 4 * gq + e;
                const float wlog = -fsoftplus(-(w04[e] + lw[i])) - 0.5f; o_w[e] = fexp(-fexp(wlog));
                const float a = fsigmoid(a04[e] + la[i]);
                const float kk = k4[e] * kq[e] * kinv; const float k2 = k4[e] * (1.f + (a - 1.f) * ka4[e]);
                bon += r4[e] * k2 * rk4[e];
                o_k[e] = k2; o_a[e] = -kk; o_b[e] = kk * a; }
            if (t >= FX_T) {
            *(f32x4*)(SCI + 0 * 64 + cl) = r4; *(f32x4*)(SCI + 1 * 64 + cl) = o_w; *(f32x4*)(SCI + 2 * 64 + cl) = o_k;
            *(f32x4*)(SCI + 3 * 64 + cl) = v4; *(f32x4*)(SCI + 4 * 64 + cl) = o_a; *(f32x4*)(SCI + 5 * 64 + cl) = o_b; } SCHED_FENCE(); }
    }
    bon += __shfl_xor(bon, 32);
    if (hh == 0 && t >= FX_T) ((float*)(p->ws + WS_BON))[m * RH + hd] = bon;
}
DI void phase_rw_prep(KP p, int layer) {
    const int tid = TID(), lane = tid & 63, wave = tid >> 6;
    constexpr int NITEM = (M / 32) * RH;
    for (int it = blockIdx.x * 8 + wave; it < NITEM; it += gridDim.x * 8) rw_prep_item(p, layer, it, lane);
}

constexpr int RC_GT = 0, RC_SL = 8192, RC_RH = 16384, RC_OL = 18432, RC_GAM = 22528, RC_BYTES = 22784;
constexpr int RC_NSUB = S / 16;
DI bf16x8 frag4_lds(lptr p) { const u32x2 w = *(const LAS u32x2*)p; u32x4 o; o.x = w.x; o.y = w.y; o.z = 0u; o.w = 0u; return __builtin_bit_cast(bf16x8, o); }
DI bf16x8 frag4_acc(const f32x4& x) { u32x4 o; o.x = pk2(x[0], x[1]); o.y = pk2(x[2], x[3]); o.z = 0u; o.w = 0u; return __builtin_bit_cast(bf16x8, o); }
DI void rw_local_item(KP p, lptr wl, int item, int lane) {
    const int j = item % RC_NSUB, bh = item / RC_NSUB, g = lane >> 4, c16 = lane & 15;
    const float* SCI = (const float*)(p->ws + WS_SCI) + ((size_t)bh * S + (size_t)j * 16) * 384;
    unsigned char* rec = p->ws + WS_RC + (size_t)item * RC_BYTES;
    { float at[16], vt[16], bt[16], kt[16]; float lw = 0.f, gp = 1.f;
#pragma unroll
      for (int t = 0; t < 16; ++t) { const float* s = SCI + t * 384 + lane; const float rr = s[0], w = s[64], k = s[128], v = s[192], a = s[256], b = s[320];
          lw += flog(w); const float gt = fexp(lw), gi = fexp(-lw);
          at[t] = a * gp; vt[t] = v; bt[t] = b * gi; kt[t] = k * gi; gp = gt;
          *(LAS bf16_t*)(wl + t * 128 + lane * 2) = f2bf(at[t]); *(LAS bf16_t*)(wl + 2048 + t * 128 + lane * 2) = f2bf(rr * gt);
          *(LAS bf16_t*)(wl + 4096 + t * 128 + lane * 2) = f2bf(bt[t]); *(LAS bf16_t*)(wl + 6144 + t * 128 + lane * 2) = f2bf(kt[t]); }
      ((float*)(rec + RC_GAM))[lane] = gp;
#pragma unroll
      for (int hfl = 0; hfl < 2; ++hfl) { u32x4 w0, w1, w2, w3; const int t0 = 8 * hfl;
          w0.x = pk2(at[t0], at[t0 + 1]); w0.y = pk2(at[t0 + 2], at[t0 + 3]); w0.z = pk2(at[t0 + 4], at[t0 + 5]); w0.w = pk2(at[t0 + 6], at[t0 + 7]);
          w1.x = pk2(vt[t0], vt[t0 + 1]); w1.y = pk2(vt[t0 + 2], vt[t0 + 3]); w1.z = pk2(vt[t0 + 4], vt[t0 + 5]); w1.w = pk2(vt[t0 + 6], vt[t0 + 7]);
          w2.x = pk2(bt[t0] * gp, bt[t0 + 1] * gp); w2.y = pk2(bt[t0 + 2] * gp, bt[t0 + 3] * gp); w2.z = pk2(bt[t0 + 4] * gp, bt[t0 + 5] * gp); w2.w = pk2(bt[t0 + 6] * gp, bt[t0 + 7] * gp);
          w3.x = pk2(kt[t0] * gp, kt[t0 + 1] * gp); w3.y = pk2(kt[t0 + 2] * gp, kt[t0 + 3] * gp); w3.z = pk2(kt[t0 + 4] * gp, kt[t0 + 5] * gp); w3.w = pk2(kt[t0 + 6] * gp, kt[t0 + 7] * gp);
          *(LAS u32x4*)(wl + 8192 + lane * 32 + 16 * hfl) = w0; *(LAS u32x4*)(wl + 10240 + lane * 32 + 16 * hfl) = w1;
          *(LAS u32x4*)(wl + 12288 + lane * 32 + 16 * hfl) = w2; *(LAS u32x4*)(wl + 14336 + lane * 32 + 16 * hfl) = w3; } }
    WAVE_SYNC();
    f32x4 nab = (f32x4){0.f, 0.f, 0.f, 0.f}, nak = nab, mrb = nab, mrk = nab;
#pragma unroll
    for (int ks = 0; ks < 2; ++ks) { const int off = c16 * 128 + (32 * ks + 8 * g) * 2;
        const bf16x8 fa = *(const LAS bf16x8*)(wl + off), fr = *(const LAS bf16x8*)(wl + 2048 + off), fb = *(const LAS bf16x8*)(wl + 4096 + off), fk = *(const LAS bf16x8*)(wl + 6144 + off);
        nab = MFMA16(fa, fb, nab); nak = MFMA16(fa, fk, nak); mrb = MFMA16(fr, fb, mrb); mrk = MFMA16(fr, fk, mrk); }
    f32x4 rt[4];
#pragma unroll
    for (int cb = 0; cb < 4; ++cb)
#pragma unroll
        for (int e = 0; e < 4; ++e) rt[cb][e] = bf2f(*(const LAS bf16_t*)(wl + 2048 + (4 * g + e) * 128 + (16 * cb + c16) * 2));
    WAVE_SYNC();
#pragma unroll
    for (int e = 0; e < 4; ++e) { const int t = 4 * g + e, i = c16;
        *(LAS float*)(wl + (t * 16 + i) * 4) = (i < t) ? nab[e] : 0.f;
        *(LAS bf16_t*)(wl + 1024 + (t * 16 + i) * 2) = f2bf((i < t) ? nak[e] : 0.f);
        *(LAS bf16_t*)(wl + 1536 + (t * 16 + i) * 2) = f2bf((i <= t) ? mrb[e] : 0.f);
        *(LAS bf16_t*)(wl + 2048 + (t * 16 + i) * 2) = f2bf((i <= t) ? mrk[e] : 0.f); }
    WAVE_SYNC();
    { float tr[16];
#pragma unroll
      for (int t = 0; t < 16; ++t) { float acc = (c16 == t) ? 1.f : 0.f;
#pragma unroll
          for (int s = 0; s < t; ++s) acc += *(const LAS float*)(wl + (t * 16 + s) * 4) * tr[s];
          tr[t] = acc; if (g == 0) *(LAS bf16_t*)(wl + 2560 + (t * 16 + c16) * 2) = f2bf(acc); } }
    WAVE_SYNC();
    const bf16x8 tf = frag4_lds(wl + 2560 + c16 * 32 + 8 * g), nakf = frag4_lds(wl + 1024 + c16 * 32 + 8 * g), mrbf = frag4_lds(wl + 1536 + c16 * 32 + 8 * g), mrkf = frag4_lds(wl + 2048 + c16 * 32 + 8 * g);
    const f32x4 z4 = (f32x4){0.f, 0.f, 0.f, 0.f};
    bf16x8 ahf[4], plf[4];
#pragma unroll
    for (int cb = 0; cb < 4; ++cb) { const f32x4 ah = MFMA16(tf, frag4_lds(wl + 8192 + (16 * cb + c16) * 32 + 8 * g), z4); ahf[cb] = frag4_acc(ah);
        const f32x4 rh = MFMA16(mrbf, ahf[cb], rt[cb]);
#pragma unroll
        for (int e = 0; e < 4; ++e) ((bf16_t*)(rec + RC_RH))[(4 * g + e) * 64 + 16 * cb + c16] = f2bf(rh[e]); }
#pragma unroll
    for (int vb = 0; vb < 4; ++vb) { const bf16x8 vf = frag4_lds(wl + 10240 + (16 * vb + c16) * 32 + 8 * g);
        const f32x4 q = MFMA16(nakf, vf, z4); const f32x4 pl = MFMA16(tf, frag4_acc(q), z4); plf[vb] = frag4_acc(pl);
        f32x4 ol = MFMA16(mrbf, plf[vb], z4); ol = MFMA16(mrkf, vf, ol);
        ((f32x4*)(rec + RC_OL))[vb * 64 + lane] = ol; }
#pragma unroll
    for (int kb2 = 0; kb2 < 4; ++kb2) { const bf16x8 bbf = frag4_lds(wl + 12288 + (16 * kb2 + c16) * 32 + 8 * g), kkf = frag4_lds(wl + 14336 + (16 * kb2 + c16) * 32 + 8 * g);
#pragma unroll
        for (int kb = 0; kb < 4; ++kb) { const f32x4 gp4 = MFMA16(ahf[kb], bbf, z4);
            u32x2 w; w.x = pk2(gp4[0], gp4[1]); w.y = pk2(gp4[2], gp4[3]); *(u32x2*)((bf16_t*)(rec + RC_GT) + (16 * kb2 + c16) * 64 + 16 * kb + 4 * g) = w; }
#pragma unroll
        for (int vb = 0; vb < 4; ++vb) { f32x4 sl = MFMA16(plf[vb], bbf, z4); sl = MFMA16(frag4_lds(wl + 10240 + (16 * vb + c16) * 32 + 8 * g), kkf, sl);
            u32x2 w; w.x = pk2(sl[0], sl[1]); w.y = pk2(sl[2], sl[3]); ((u32x2*)(rec + RC_SL))[(vb * 4 + kb2) * 64 + lane] = w; } }
    WAVE_SYNC();
}
DI void phase_rw_local(KP p, lptr lds) {
    const int tid = TID(), lane = tid & 63, wave = RFL(tid >> 6);
    constexpr int NITEM = NB * RH * RC_NSUB;
    for (int it = blockIdx.x * 8 + wave; it < NITEM; it += gridDim.x * 8) rw_local_item(p, lds + wave * 16384, it, lane);
}
constexpr int RS_STR = 144;
DI void phase_rw_scan(KP p, lptr lds, int unit) {
    const int tid = TID(), lane = tid & 63, wid = RFL(tid >> 6), g = lane >> 4, c16 = lane & 15;
    const int vb = wid >> 1, kb0 = 2 * (wid & 1), hd = unit % RH, b = unit / RH;
    const unsigned char* rec0 = p->ws + WS_RC + (size_t)unit * RC_NSUB * RC_BYTES;
    float* SCO = (float*)(p->ws + WS_SCO) + (size_t)b * S * MIX + hd * 64;
    f32x4 st[2]; st[0] = (f32x4){0.f, 0.f, 0.f, 0.f}; st[1] = st[0];
    __syncthreads();
    for (int j = 0; j < RC_NSUB; ++j) { const unsigned char* rec = rec0 + (size_t)j * RC_BYTES; const lptr img = lds + (j & 1) * (64 * RS_STR);
        bf16x8 gt[2][2]; u32x2 slw[2]; float gam[2];
#pragma unroll
        for (int tl = 0; tl < 2; ++tl) { const int kcol = 16 * (kb0 + tl) + c16;
#pragma unroll
            for (int ks = 0; ks < 2; ++ks) gt[tl][ks] = *(const bf16x8*)((const bf16_t*)(rec + RC_GT) + kcol * 64 + 32 * ks + 8 * g);
            slw[tl] = ((const u32x2*)(rec + RC_SL))[(vb * 4 + kb0 + tl) * 64 + lane]; gam[tl] = ((const float*)(rec + RC_GAM))[kcol]; }
        bf16x8 rh[2]; f32x4 ol = (f32x4){0.f, 0.f, 0.f, 0.f};
        if (wid < 4) {
#pragma unroll
            for (int ks = 0; ks < 2; ++ks) rh[ks] = *(const bf16x8*)((const bf16_t*)(rec + RC_RH) + c16 * 64 + 32 * ks + 8 * g);
            ol = ((const f32x4*)(rec + RC_OL))[wid * 64 + lane]; }
#pragma unroll
        for (int tl = 0; tl < 2; ++tl)
#pragma unroll
            for (int e = 0; e < 4; ++e) *(LAS bf16_t*)(img + (16 * vb + 4 * g + e) * RS_STR + (16 * (kb0 + tl) + c16) * 2) = f2bf(st[tl][e]);
        __syncthreads();
        bf16x8 af[2];
#pragma unroll
        for (int ks = 0; ks < 2; ++ks) af[ks] = *(const LAS bf16x8*)(img + (16 * vb + c16) * RS_STR + (32 * ks + 8 * g) * 2);
        if (wid < 4) {
            f32x4 o = ol;
#pragma unroll
            for (int ks = 0; ks < 2; ++ks) o = MFMA16(rh[ks], *(const LAS bf16x8*)(img + (16 * wid + c16) * RS_STR + (32 * ks + 8 * g) * 2), o);
#pragma unroll
            for (int e = 0; e < 4; ++e) SCO[(size_t)(16 * j + 4 * g + e) * MIX + 16 * wid + c16] = o[e]; }
#pragma unroll
        for (int tl = 0; tl < 2; ++tl) { f32x4 nw = (f32x4){0.f, 0.f, 0.f, 0.f};
#pragma unroll
            for (int ks = 0; ks < 2; ++ks) nw = MFMA16(af[ks], gt[tl][ks], nw);
            st[tl][0] = st[tl][0] * gam[tl] + nw[0] + bflo(slw[tl].x); st[tl][1] = st[tl][1] * gam[tl] + nw[1] + bfhi(slw[tl].x);
            st[tl][2] = st[tl][2] * gam[tl] + nw[2] + bflo(slw[tl].y); st[tl][3] = st[tl][3] * gam[tl] + nw[3] + bfhi(slw[tl].y); }
    }
}

DI void phase_rw_post(KP p, int layer) {
    const size_t gt = (size_t)blockIdx.x * 512 + TID(), NGT = (size_t)gridDim.x * 512;
    const bf16_t* Z = (const bf16_t*)(p->ws + WS_Z); const float* SCO = (const float*)(p->ws + WS_SCO); const float* BON = (const float*)(p->ws + WS_BON);
    const float* lg = p->in[I_LNXG] + (size_t)layer * MIX; const float* lbv = p->in[I_LNXB] + (size_t)layer * MIX;
    for (size_t i = gt; i < (size_t)M * (MIX / 16); i += NGT) { const size_t m = i / (MIX / 16); const int c0 = (int)(i % (MIX / 16)) * 16, hd = c0 >> 6; const int t = (int)(m % S), b = (int)(m / S);
        float o[16]; float s1 = 0.f; const float* osrc = (t < FX_T) ? (const float*)(p->ws + WS_OEXC) + ((size_t)b * FX_T + t) * MIX + c0 : SCO + m * MIX + c0;
#pragma unroll
        for (int j = 0; j < 4; ++j) { const f32x4 v = *(const f32x4*)(osrc + 4 * j); o[4 * j] = v[0]; o[4 * j + 1] = v[1]; o[4 * j + 2] = v[2]; o[4 * j + 3] = v[3]; s1 += (v[0] + v[1]) + (v[2] + v[3]); }
        s1 += __shfl_xor(s1, 1); s1 += __shfl_xor(s1, 2); const float mean = s1 * (1.f / 64.f); float s2 = 0.f;
#pragma unroll
        for (int j = 0; j < 16; ++j) { o[j] -= mean; s2 += o[j] * o[j]; }
        s2 += __shfl_xor(s2, 1); s2 += __shfl_xor(s2, 2); const float rstd = frsq(s2 * (1.f / 64.f) + RW_LN_EPS);
        const float bon = BON[m * RH + hd]; const float* vsrc = (const float*)(p->ws + WS_SCI) + (((size_t)b * RH + hd) * S + t) * 384 + 192 + (c0 & 63);
        const bf16_t* gp = Z + m * ZLD + C_RG + c0; bf16_t* yp = (bf16_t*)(p->ws + WS_Y) + m * (4 * MIX) + 2 * MIX + c0;
        unsigned w[8];
#pragma unroll
        for (int j = 0; j < 16; j += 2) { const float y0 = (o[j] * rstd * lg[c0 + j] + lbv[c0 + j] + bon * vsrc[j]) * fsilu(bf2f(gp[j])), y1 = (o[j + 1] * rstd * lg[c0 + j + 1] + lbv[c0 + j + 1] + bon * vsrc[j + 1]) * fsilu(bf2f(gp[j + 1]));
            w[j >> 1] = pk2(y0, y1); }
        *(u32x4*)(yp) = (u32x4){w[0], w[1], w[2], w[3]}; *(u32x4*)(yp + 8) = (u32x4){w[4], w[5], w[6], w[7]}; }
}

DI void phase_ln(KP p, int layer) {
    const int tid = TID(), lane = tid & 63, wave = tid >> 6;
    const float alpha = sqrtf(sqrtf(2.f * (float)L));
    const float* hprev = (layer == 0) ? p->in[I_X] : (const float*)(p->ws + WS_H); const float* outf = (const float*)(p->ws + WS_OUTF);
    float* hnew = (layer == L - 1) ? p->out : (float*)(p->ws + WS_H); bf16_t* xn = (bf16_t*)(p->ws + WS_XN);
    const float* lg = p->in[I_LNG] + (size_t)layer * D; const float* lbv = p->in[I_LNB] + (size_t)layer * D;
    constexpr int NV = D / 256;
    for (size_t m = (size_t)blockIdx.x * 8 + wave; m < (size_t)M; m += (size_t)gridDim.x * 8) {
        f32x4 v[NV]; float s = 0.f;
#pragma unroll
        for (int j = 0; j < NV; ++j) { const f32x4 a = *(const f32x4*)(hprev + m * D + 256 * j + 4 * lane), o = *(const f32x4*)(outf + m * D + 256 * j + 4 * lane); v[j] = a * alpha + o; s += (v[j][0] + v[j][1]) + (v[j][2] + v[j][3]); }
#pragma unroll
        for (int o = 1; o < 64; o <<= 1) s += __shfl_xor(s, o);
        const float mean = s * (1.f / D); float s2 = 0.f;
#pragma unroll
        for (int j = 0; j < NV; ++j) { v[j] = v[j] - mean; s2 += (v[j][0] * v[j][0] + v[j][1] * v[j][1]) + (v[j][2] * v[j][2] + v[j][3] * v[j][3]); }
#pragma unroll
        for (int o = 1; o < 64; o <<= 1) s2 += __shfl_xor(s2, o);
        const float rstd = 1.f / sqrtf(s2 * (1.f / D) + LN_EPS);
#pragma unroll
        for (int j = 0; j < NV; ++j) { const f32x4 g4 = *(const f32x4*)(lg + 256 * j + 4 * lane), b4 = *(const f32x4*)(lbv + 256 * j + 4 * lane); const f32x4 y = v[j] * rstd * g4 + b4;
            *(f32x4*)(hnew + m * D + 256 * j + 4 * lane) = y; u32x2 w; w.x = pk2(y[0], y[1]); w.y = pk2(y[2], y[3]); *(u32x2*)(xn + m * D + 256 * j + 4 * lane) = w; }
    }
}
constexpr int FX_NS_HG = 3 * MIX / 64, FX_NS_RW = RW_MIX / 64, FX_NSTRIP = FX_NS_HG + FX_NS_RW + 1;
DI void phase_fx_project(KP p, int layer, lptr lds, int strip) {
    const int tid = TID(), c = tid & 63, kg = tid >> 6;
    const float* hsrc = (layer == 0) ? p->in[I_X] : (const float*)(p->ws + WS_H);
    LAS float* HR = (LAS float*)lds;
    __syncthreads();
    for (int i = tid; i < FX_ROWS * D / 4; i += 512) { const int r = i / (D / 4), k4 = i % (D / 4); const size_t m = (size_t)(r / FX_T) * S + (r % FX_T);
        *(LAS f32x4*)(HR + r * D + 4 * k4) = *(const f32x4*)(hsrc + m * D + 4 * k4); }
    __syncthreads();
    int col0, ncol, ldw; const float* W;
    if (strip < FX_NS_HG) { col0 = C_HQ + 64 * strip; ncol = 64; ldw = IN_COLS; W = p->in[I_WIN] + (size_t)layer * D * IN_COLS + col0; }
    else if (strip < FX_NS_HG + FX_NS_RW) { col0 = C_RM + 64 * (strip - FX_NS_HG); ncol = 64; ldw = IN_COLS; W = p->in[I_WIN] + (size_t)layer * D * IN_COLS + col0; }
    else { col0 = C_VD; ncol = 32; ldw = 32; W = p->in[I_V1] + (size_t)(layer > 0 ? layer - 1 : 0) * D * 32; if (layer == 0) ncol = 0; }
    float acc[FX_ROWS];
#pragma unroll
    for (int r = 0; r < FX_ROWS; ++r) acc[r] = 0.f;
    if (c < ncol) {
        for (int k = kg * (D / 8); k < (kg + 1) * (D / 8); ++k) { const float w = W[(size_t)k * ldw + c];
#pragma unroll
            for (int r = 0; r < FX_ROWS; ++r) acc[r] += HR[r * D + k] * w; } }
    __syncthreads();
    LAS float* RED = (LAS float*)lds;
#pragma unroll
    for (int r = 0; r < FX_ROWS; ++r) RED[(kg * FX_ROWS + r) * 64 + c] = acc[r];
    __syncthreads();
    for (int i = tid; i < FX_ROWS * 64; i += 512) { const int r = i >> 6, cc = i & 63; float s = 0.f;
#pragma unroll
        for (int g = 0; g < 8; ++g) s += RED[(g * FX_ROWS + r) * 64 + cc];
        if (cc < ncol) ((float*)(p->ws + WS_ZF))[(size_t)r * ZLD + col0 + cc] = s; }
}
DI float wave_sum64(float v) {
#pragma unroll
    for (int o = 1; o < 64; o <<= 1) v += __shfl_xor(v, o);
    return v; }
DI void fx_rwkv(KP p, int layer, int item, int lane) {
    const int hd = item % RH, b = item / RH, ch = hd * 64 + lane;
    const float* ZF = (const float*)(p->ws + WS_ZF) + (size_t)b * FX_T * ZLD;
    const float* mu = p->in[I_MU] + (size_t)layer * RW_MIX;
    const float mur = mu[ch], muk = mu[MIX + ch], muv = mu[2 * MIX + ch], muw = mu[3 * MIX + lane], mua = mu[3 * MIX + 64 + lane];
    const float muvd = (layer > 0 && lane < 32) ? p->in[I_VMU][(size_t)(layer - 1) * 32 + lane] : 0.f;
    const float* w2 = p->in[I_W2] + (size_t)layer * 64 * MIX + ch; const float* a2 = p->in[I_A2] + (size_t)layer * 64 * MIX + ch;
    const float* v2 = p->in[I_V2] + (size_t)(layer > 0 ? layer - 1 : 0) * 32 * MIX + ch;
    const float w0 = p->in[I_W0][(size_t)layer * MIX + ch], a0 = p->in[I_A0][(size_t)layer * MIX + ch], kq = p->in[I_KK][(size_t)layer * MIX + ch], ka = p->in[I_KA][(size_t)layer * MIX + ch], rk = p->in[I_RK][(size_t)layer * MIX + ch];
    const float v0 = p->in[I_V0][(size_t)(layer > 0 ? layer - 1 : 0) * MIX + ch];
    float pr = 0.f, pk = 0.f, pv = 0.f, pw = 0.f, pa = 0.f, pvd = 0.f;
    float xs[2 * FX_T - 1], ys[2 * FX_T - 1];
#pragma unroll
    for (int t = 0; t < FX_T; ++t) { const float* z = ZF + (size_t)t * ZLD;
        const float cr = z[C_RM + ch], ck = z[C_RM + MIX + ch], cv = z[C_RM + 2 * MIX + ch], cw = z[C_RM + 3 * MIX + lane], ca = z[C_RM + 3 * MIX + 64 + lane], cvd = (layer > 0 && lane < 32) ? z[C_VD + lane] : 0.f;
        const float r = cr + (pr - cr) * mur, k = ck + (pk - ck) * muk; float v = cv + (pv - cv) * muv;
        const float tw = tanhf(cw + (pw - cw) * muw), ad = ca + (pa - ca) * mua, vd = cvd + (pvd - cvd) * muvd;
        pr = cr; pk = ck; pv = cv; pw = cw; pa = ca; pvd = cvd;
        float lw = 0.f, la = 0.f, lv = 0.f;
        for (int j = 0; j < 64; ++j) { lw += __shfl(tw, j) * w2[(size_t)j * MIX]; la += __shfl(ad, j) * a2[(size_t)j * MIX]; }
        if (layer > 0) for (int j = 0; j < 32; ++j) lv += __shfl(vd, j) * v2[(size_t)j * MIX];
        const float wlog = -(fmaxf(-(w0 + lw), 0.f) + log1pf(expf(-fabsf(w0 + lw)))) - 0.5f, decay = expf(-expf(wlog));
        const float a = 1.f / (1.f + expf(-(a0 + la)));
        const size_t m = (size_t)b * S + t; float* VF = (float*)(p->ws + WS_VF) + m * MIX;
        if (layer == 0) VF[ch] = v; else { const float vf = VF[ch]; v = v + (vf - v) / (1.f + expf(-(v0 + lv))); }
        float kk = k * kq; const float nrm = sqrtf(wave_sum64(kk * kk)); kk = kk / fmaxf(nrm, 1e-12f);
        const float k2 = k * (1.f + (a - 1.f) * ka);
        const float bon = wave_sum64(r * k2 * rk);
        float* SCI = (float*)(p->ws + WS_SCI) + (((size_t)b * RH + hd) * S + t) * 384;
        SCI[lane] = r; SCI[64 + lane] = decay; SCI[128 + lane] = k2; SCI[192 + lane] = v; SCI[256 + lane] = -kk; SCI[320 + lane] = kk * a;
        if (lane == 0) ((float*)(p->ws + WS_BON))[m * RH + hd] = bon;
        { const float an = -kk, bn = kk * a; float sa = 0.f, ov = 0.f;
          const int nt = (t == 0) ? 0 : 2 * t - 1;
#pragma unroll
          for (int i = 0; i < 2 * FX_T - 1; ++i) if (i < nt) { sa += xs[i] * wave_sum64(ys[i] * an); ys[i] *= decay; ov += xs[i] * wave_sum64(ys[i] * r); }
          if (t > 0) { ov += sa * wave_sum64(bn * r); }
          ov += v * wave_sum64(k2 * r);
#pragma unroll
          for (int i = 0; i < 2 * FX_T - 1; ++i) { if (t > 0 && i == nt) { xs[i] = sa; ys[i] = bn; } if (i == ((t == 0) ? 0 : nt + 1)) { xs[i] = v; ys[i] = k2; } }
          ((float*)(p->ws + WS_OEXC))[((size_t)b * FX_T + t) * MIX + ch] = ov; } }
}
DI void fx_hgrn(KP p, int layer, int item, int lane) {
    const int h = item % HH, b = item / HH;
    const float* ZF = (const float*)(p->ws + WS_ZF) + (size_t)b * FX_T * ZLD; const float* LBp = (const float*)(p->ws + SM_LB);
    float q[FX_T][2], kx[FX_T][2], Bc[FX_T][2], iv[FX_T][2];
#pragma unroll
    for (int u = 0; u < 2; ++u) { const int d = h * 128 + lane + 64 * u; const float lb = LBp[(size_t)layer * MIX + d]; float run = 0.f;
#pragma unroll
        for (int t = 0; t < FX_T; ++t) { const float* z = ZF + (size_t)t * ZLD; const float zf = z[C_HF + d]; q[t][u] = z[C_HQ + d]; iv[t][u] = z[C_HI + d];
            const float sg = 1.f / (1.f + expf(-zf)); run += logf(lb + (1.f - lb) * sg); Bc[t][u] = run; kx[t][u] = (1.f - lb) * (1.f - sg); } }
    float* OEX = (float*)(p->ws + WS_OEX) + (size_t)item * FX_T * 128;
#pragma unroll
    for (int t = 0; t < FX_T; ++t) { float o0 = 0.f, o1 = 0.f;
#pragma unroll
        for (int s = 0; s <= t; ++s) { const float c = wave_sum64(q[t][0] * kx[s][0] * expf(Bc[t][0] - Bc[s][0]) + q[t][1] * kx[s][1] * expf(Bc[t][1] - Bc[s][1])); o0 += c * iv[s][0]; o1 += c * iv[s][1]; }
        OEX[t * 128 + lane] = o0; OEX[t * 128 + 64 + lane] = o1; }
}
DI void phase_fx_fix(KP p, int layer) {
    const int tid = TID(), lane = tid & 63, gw = blockIdx.x * 8 + (tid >> 6), NGW = gridDim.x * 8;
    for (int it = gw; it < NB * RH + NB * HH; it += NGW) { if (it < NB * RH) fx_rwkv(p, layer, it, lane); else fx_hgrn(p, layer, it - NB * RH, lane); }
}
constexpr int NWAVES = 8, LDS_RING = 131072, MISC_OFF = LDS_RING + 320, LDS_BYTES = 147456;
constexpr int CW_BAR = 4096, CW_WQ = 16384;
enum { PH_INPROJ = 0, PH_RWPREP, PH_RWLOC, PH_MIX, PH_RWPOST, PH_BRANCH, PH_SUM, PH_OUT, PH_LN, PH_COUNT };
constexpr int U_SCAN = NB * RH, U_HG = NB * HH, U_HGC = NB * HH * (S / 64), U_AA = NB * AH * (S / 128), U_AD = NB * SH * (S / 256), U_MIX = U_SCAN + U_HG + U_AA + U_AD;

struct Args { Params p; int do_pro, l_lo, l_hi, ph_lo, ph_hi, mega, pad0, pad1; };

#ifndef EMU
#define XB_TMO      128
#define XB_XCNT(j)  (256  + 64 * (j))
#define XB_XSUB(j)  (1280 + 64 * (j))
#define XB_XGEN(j)  (2304 + 64 * (j))
#define XB_TOP      3328
#define XB_TOPGEN   3392
#define XCD_BAR_WORDS 3456
#define XB_SPIN_CAP (1u << 18)
__device__ __forceinline__ unsigned xb_ld(unsigned* p)              { return __hip_atomic_load(p, __ATOMIC_RELAXED, __HIP_MEMORY_SCOPE_AGENT); }
__device__ __forceinline__ unsigned xb_add(unsigned* p, unsigned v) { return __hip_atomic_fetch_add(p, v, __ATOMIC_RELAXED, __HIP_MEMORY_SCOPE_AGENT); }
__device__ __forceinline__ unsigned xb_xcc_id() { return (unsigned)__builtin_amdgcn_s_getreg((3 << 11) | 20) & 0xFu; }
#define XB_SPIN(cond, bar) do { unsigned _sp = 0; while (cond) { __builtin_amdgcn_s_sleep(1); \
    if ((++_sp & 255u) == 0u) { if (xb_ld(&(bar)[XB_TMO])) break; if (_sp > XB_SPIN_CAP) { atomicAdd(&(bar)[XB_TMO], 1u); break; } } } } while (0)
struct XcdBarrier { unsigned* bar; unsigned x; volatile LAS unsigned* st; };
__device__ __forceinline__ XcdBarrier xcd_barrier_post(unsigned* bar, volatile LAS unsigned* st) {
    XcdBarrier b; b.bar = bar; b.x = xb_xcc_id(); b.st = st;
    if (threadIdx.x == 0) (void)xb_add(&bar[XB_XCNT(b.x)], 1u);
    return b;
}
__device__ __forceinline__ void xcd_barrier_complete(unsigned* bar, unsigned x, unsigned& nloc, unsigned& nx) {
    const unsigned G = gridDim.x * gridDim.y * gridDim.z;
    unsigned sum, cnt, mine, sp = 0u;
    for (;;) {
        sum = 0u; cnt = 0u; mine = 0u;
#pragma unroll
        for (unsigned j = 0; j < 16; ++j) { const unsigned c = xb_ld(&bar[XB_XCNT(j)]); sum += c; cnt += (c > 0u) ? 1u : 0u; mine = (j == x) ? c : mine; }
        if (sum == G) break;
        __builtin_amdgcn_s_sleep(1);
        if ((++sp & 255u) == 0u) { if (xb_ld(&bar[XB_TMO])) break; if (sp > XB_SPIN_CAP) { atomicAdd(&bar[XB_TMO], 1u); break; } }
    }
    nloc = mine > 0u ? mine : 1u; nx = cnt > 0u ? cnt : 1u;
}
__device__ __forceinline__ void xcd_barrier(const XcdBarrier& b) {
    asm volatile("s_waitcnt vmcnt(0)" ::: "memory");
    __syncthreads();
    if (threadIdx.x == 0) {
        unsigned* bar = b.bar;
        __builtin_amdgcn_s_waitcnt(0);
        unsigned nloc = b.st[0], nx = b.st[1];
        if (nloc == 0u) { xcd_barrier_complete(bar, b.x, nloc, nx); b.st[0] = nloc; b.st[1] = nx; }
        const unsigned old = xb_add(&bar[XB_XSUB(b.x)], 1u);
        const unsigned gen = old / nloc;
        if (old + 1u == (gen + 1u) * nloc) {
            __builtin_amdgcn_fence(__ATOMIC_RELEASE, "agent");
            asm volatile("s_waitcnt vmcnt(0)" ::: "memory");
            const unsigned og = xb_add(&bar[XB_TOP], 1u);
            const unsigned tg = og / nx;
            if (og + 1u == (tg + 1u) * nx) xb_add(&bar[XB_TOPGEN], 1u);
            else XB_SPIN(xb_ld(&bar[XB_TOPGEN]) == tg, bar);
            __builtin_amdgcn_fence(__ATOMIC_ACQUIRE, "agent");
            xb_add(&bar[XB_XGEN(b.x)], 1u);
            asm volatile("s_waitcnt vmcnt(0)" ::: "memory");
        } else {
            XB_SPIN(xb_ld(&bar[XB_XGEN(b.x)]) == gen, bar);
            __builtin_amdgcn_fence(__ATOMIC_ACQUIRE, "agent");
            asm volatile("s_waitcnt vmcnt(0)" ::: "memory");
        }
    }
    __syncthreads();
}
#endif

DI int next_unit(unsigned* head, lptr lds) {
    LAS int* slot = (LAS int*)(lds + MISC_OFF + 64);
    __syncthreads();
#ifdef EMU
    if (threadIdx.x == 0) { *slot = (int)(*head); *head += 1; }
#else
    if (threadIdx.x == 0) *slot = (int)__hip_atomic_fetch_add(head, 1u, __ATOMIC_RELAXED, __HIP_MEMORY_SCOPE_AGENT);
#endif
    __syncthreads();
    return *slot;
}

#ifndef DBG_PHMASK
#define DBG_PHMASK 0xffff
#endif
struct BranchOrder {
    pg8::StaticOrder so;
    DM bool next(int i, pg8::Unit& u) const { if (!so.next(i, u)) return false; u.ka = (u.pn / (D / 256)) * MIX; return true; }
    DM void a_ready(const pg8::Unit&) const {}
    DM void done(const pg8::Unit&) const {}
};
#ifndef PROBE_REP
#define PROBE_REP 0
#endif
#ifndef PROBE_MIXREP
#define PROBE_MIXREP 15
#endif
#ifndef DBG_MIXMASK
#define DBG_MIXMASK 15
#endif
DI void run_phase(KP p, int rep, int l, int ph, lptr lds) {
    unsigned char* ws = p->ws;
    if (!((DBG_PHMASK >> ph) & 1)) return;
    if (ph == PH_INPROJ) {
        pg8::Gemm g{(const bf16_t*)(ws + WS_XN), (const bf16_t*)(ws + WS_WIN) + (size_t)l * NP * D, M, NP, D, D, D};
        EpiInproj E{(bf16_t*)(ws + WS_Z), ZLD, (bf16_t*)(ws + WS_RHO), CG0 / 256};
#ifndef EMU
        pg8::StaticOrder so; so.init(M, NP, gridDim.x, blockIdx.x);
        pg8::gemm_phase<EpiInproj, pg8::StaticOrder, true, true, D, D, D>((LAS unsigned char*)lds, g, so, E);
#endif
        for (int s = blockIdx.x; s < FX_NSTRIP; s += gridDim.x) phase_fx_project(p, l, lds, s);
    } else if (ph == PH_RWPREP) {
        phase_rw_prep(p, l);
        phase_fx_fix(p, l);
        for (int u = blockIdx.x; u < U_HGC; u += gridDim.x) phase_hg_local(p, l, lds, u);
    } else if (ph == PH_RWLOC) {
        phase_rw_local(p, lds);
    } else if (ph == PH_MIX) {
        unsigned* head = (unsigned*)(ws + WS_CTL) + CW_WQ + 64 * l + (rep ? 32 * 64 : 0);
        for (;;) { int u = next_unit(head, lds); if (u >= U_MIX) break;
            const int mm = rep ? PROBE_MIXREP : DBG_MIXMASK;
            if (u < U_SCAN) { if (mm & 1) phase_rw_scan(p, lds, u); continue; } u -= U_SCAN;
            if (u < U_HG) { if (mm & 2) phase_hg_scan(p, u); continue; } u -= U_HG;
            if (u < U_AA) { if (mm & 4) phase_att_a(p, l, lds, u); continue; } u -= U_AA;
            if (mm & 8) phase_att_d(p, l, lds, u); }
    } else if (ph == PH_RWPOST) {
        phase_rw_post(p, l);
        for (int u = blockIdx.x; u < U_HGC; u += gridDim.x) phase_hg_out(p, l, lds, u);
    } else if (ph == PH_BRANCH) {
        pg8::Gemm g{(const bf16_t*)(ws + WS_Y), (const bf16_t*)(ws + WS_WBR) + (size_t)l * 4 * D * MIX, M, 4 * D, MIX, 4 * MIX, MIX};
        EpiGateP E{(bf16_t*)(ws + WS_P), 4 * D, (const bf16_t*)(ws + WS_RHO)};
#ifndef EMU
        BranchOrder bo; bo.so.init(M, 4 * D, gridDim.x, blockIdx.x);
        pg8::gemm_phase<EpiGateP, BranchOrder, true, true, 4 * MIX, MIX, MIX>((LAS unsigned char*)lds, g, bo, E);
#endif
    } else if (ph == PH_SUM) {
        const size_t gt = (size_t)blockIdx.x * 512 + TID(), NGT = (size_t)gridDim.x * 512; const u32x4* P4 = (const u32x4*)(ws + WS_P); u32x4* MG4 = (u32x4*)(ws + WS_MG);
        for (size_t i = gt; i < (size_t)M * D / 8; i += NGT) { const size_t m = i / (D / 8), c = i % (D / 8); const u32x4* src = P4 + m * (4 * D / 8) + c;
            const u32x4 a0 = src[0], a1 = src[D / 8], a2 = src[2 * (D / 8)], a3 = src[3 * (D / 8)]; u32x4 o;
            o.x = pk2((bflo(a0.x) + bflo(a1.x)) + (bflo(a2.x) + bflo(a3.x)), (bfhi(a0.x) + bfhi(a1.x)) + (bfhi(a2.x) + bfhi(a3.x))); o.y = pk2((bflo(a0.y) + bflo(a1.y)) + (bflo(a2.y) + bflo(a3.y)), (bfhi(a0.y) + bfhi(a1.y)) + (bfhi(a2.y) + bfhi(a3.y)));
            o.z = pk2((bflo(a0.z) + bflo(a1.z)) + (bflo(a2.z) + bflo(a3.z)), (bfhi(a0.z) + bfhi(a1.z)) + (bfhi(a2.z) + bfhi(a3.z))); o.w = pk2((bflo(a0.w) + bflo(a1.w)) + (bflo(a2.w) + bflo(a3.w)), (bfhi(a0.w) + bfhi(a1.w)) + (bfhi(a2.w) + bfhi(a3.w)));
            MG4[i] = o; }
    } else if (ph == PH_OUT) {
        pg8::Gemm g{(const bf16_t*)(ws + WS_MG), (const bf16_t*)(ws + WS_WOUT) + (size_t)l * D * D, M, D, D, D, D};
        EpiF32 E{(float*)(ws + WS_OUTF), D};
#ifndef EMU
        pg8::StaticOrder so; so.init(M, D, gridDim.x, blockIdx.x);
        pg8::gemm_phase<EpiF32, pg8::StaticOrder, true, true, D, D, D>((LAS unsigned char*)lds, g, so, E);
#endif
    } else if (ph == PH_LN) {
        phase_ln(p, l);
    }
}

#ifndef EMU
__global__ void __launch_bounds__(NWAVES * 64, 2) fwd(Args a) {
    extern __shared__ __attribute__((aligned(16))) unsigned char lds_raw[];
    lptr lds = (lptr)lds_raw;
    volatile LAS unsigned* MISC = (volatile LAS unsigned*)(lds + MISC_OFF);
    for (int u = threadIdx.x; u < (LDS_BYTES - LDS_RING) / 4; u += NWAVES * 64) ((LAS unsigned*)(lds + LDS_RING))[u] = 0u;
    __syncthreads();
    typedef const __attribute__((address_space(4))) Args* KA;
    KA ka = (KA)__builtin_amdgcn_kernarg_segment_ptr();
    const int mega = ka->mega, do_pro = ka->do_pro, l_lo = ka->l_lo, l_hi = ka->l_hi, ph_lo = ka->ph_lo, ph_hi = ka->ph_hi;
    auto kp = [&]() -> KP { KA k2 = ka; asm volatile("" : "+s"(k2)); return &k2->p; };
    XcdBarrier bar; bar.bar = (unsigned*)(ka->p.ws + WS_CTL) + CW_BAR; bar.x = 0; bar.st = nullptr;
    if (mega) bar = xcd_barrier_post((unsigned*)(ka->p.ws + WS_CTL) + CW_BAR, MISC + 8);
#define SEAM() do { if (mega) xcd_barrier(bar); } while (0)
    if (do_pro != 0 && ((DBG_PHMASK >> 8) & 1) != 0) { phase_prologue(kp(), lds); SEAM(); }
    for (int l = l_lo; l < l_hi; ++l) {
        if (ph_lo <= PH_INPROJ && PH_INPROJ < ph_hi) { run_phase(kp(), 0, l, PH_INPROJ, lds); SEAM(); if ((PROBE_REP >> PH_INPROJ) & 1) { run_phase(kp(), 1, l, PH_INPROJ, lds); SEAM(); } }
        if (ph_lo <= PH_RWPREP && PH_RWPREP < ph_hi) { run_phase(kp(), 0, l, PH_RWPREP, lds); SEAM(); if ((PROBE_REP >> PH_RWPREP) & 1) { run_phase(kp(), 1, l, PH_RWPREP, lds); SEAM(); } }
        if (ph_lo <= PH_RWLOC && PH_RWLOC < ph_hi) { run_phase(kp(), 0, l, PH_RWLOC, lds); SEAM(); }
        if (ph_lo <= PH_MIX && PH_MIX < ph_hi) { run_phase(kp(), 0, l, PH_MIX, lds); SEAM(); if ((PROBE_REP >> PH_MIX) & 1) { run_phase(kp(), 1, l, PH_MIX, lds); SEAM(); } }
        if (ph_lo <= PH_RWPOST && PH_RWPOST < ph_hi) { run_phase(kp(), 0, l, PH_RWPOST, lds); SEAM(); if ((PROBE_REP >> PH_RWPOST) & 1) { run_phase(kp(), 1, l, PH_RWPOST, lds); SEAM(); } }
        if (ph_lo <= PH_BRANCH && PH_BRANCH < ph_hi) { run_phase(kp(), 0, l, PH_BRANCH, lds); SEAM(); if ((PROBE_REP >> PH_BRANCH) & 1) { run_phase(kp(), 1, l, PH_BRANCH, lds); SEAM(); } }
        if (ph_lo <= PH_SUM && PH_SUM < ph_hi) { run_phase(kp(), 0, l, PH_SUM, lds); SEAM(); }
        if (ph_lo <= PH_OUT && PH_OUT < ph_hi) { run_phase(kp(), 0, l, PH_OUT, lds); SEAM(); if ((PROBE_REP >> PH_OUT) & 1) { run_phase(kp(), 1, l, PH_OUT, lds); SEAM(); } }
        if (ph_lo <= PH_LN && PH_LN < ph_hi) { run_phase(kp(), 0, l, PH_LN, lds); SEAM(); }
    }
#undef SEAM
}

#ifndef MK_MEGA
#define MK_MEGA 1
#endif
extern "C" void kernel_launch(void* const* d_in, const int* in_sizes, int n_in, void* d_out, int out_size, void* d_ws, size_t ws_size, hipStream_t stream) {
    static int grid = 0;
    if (grid == 0) {
        if (n_in != 25 || in_sizes[0] != M * D || out_size != M * D || ws_size < WS_END) { fprintf(stderr, "kernel_launch: shape/workspace mismatch (n_in %d, in0 %d, out %d, ws %zu need %zu)\n", n_in, n_in > 0 ? in_sizes[0] : -1, out_size, ws_size, (size_t)WS_END); grid = -1; return; }
        int dev = 0, cus = 0, per_cu = 0;
        if (hipGetDevice(&dev) != hipSuccess || hipDeviceGetAttribute(&cus, hipDeviceAttributeMultiprocessorCount, dev) != hipSuccess) { grid = -1; return; }
        if (hipFuncSetAttribute((const void*)fwd, hipFuncAttributeMaxDynamicSharedMemorySize, LDS_BYTES) != hipSuccess) { fprintf(stderr, "kernel_launch: hipFuncSetAttribute failed\n"); grid = -1; return; }
        if (hipOccupancyMaxActiveBlocksPerMultiprocessor(&per_cu, (const void*)fwd, NWAVES * 64, LDS_BYTES) != hipSuccess || per_cu < 1) fprintf(stderr, "kernel_launch: occupancy query says %d\n", per_cu);
        (void)hipGetLastError();
        grid = cus;
    }
    if (grid < 0) return;
    (void)hipMemsetAsync((char*)d_ws + WS_CTL, 0, CTL_BYTES, stream);
    Args a{};
    for (int i = 0; i < 25; ++i) a.p.in[i] = (const float*)d_in[i];
    a.p.out = (float*)d_out; a.p.ws = (unsigned char*)d_ws;
    if (MK_MEGA) {
        a.do_pro = 1; a.l_lo = 0; a.l_hi = L; a.ph_lo = 0; a.ph_hi = PH_COUNT; a.mega = 1;
        hipLaunchKernelGGL(fwd, dim3(grid), dim3(NWAVES * 64), LDS_BYTES, stream, a);
    } else {
        a.mega = 0; a.do_pro = 1; a.l_lo = 0; a.l_hi = 0; a.ph_lo = 0; a.ph_hi = 0;
        hipLaunchKernelGGL(fwd, dim3(grid), dim3(NWAVES * 64), LDS_BYTES, stream, a);
        a.do_pro = 0;
        for (int l = 0; l < L; ++l) for (int ph = 0; ph < PH_COUNT; ++ph) { a.l_lo = l; a.l_hi = l + 1; a.ph_lo = ph; a.ph_hi = ph + 1;
            hipLaunchKernelGGL(fwd, dim3(grid), dim3(NWAVES * 64), LDS_BYTES, stream, a); }
    }
}
#endif
```

```cpp
#ifdef EMU
#include "emu.h"
#else
#include <hip/hip_runtime.h>
#include <cstdio>
#include <cstdint>
#endif

#ifndef CFG_D_MODEL
#define CFG_D_MODEL 2048
#endif
#ifndef CFG_BATCH
#define CFG_BATCH 4
#endif
#ifndef CFG_SEQ
#define CFG_SEQ 4096
#endif
#ifndef CFG_DEPTH
#define CFG_DEPTH 4
#endif
constexpr int D = CFG_D_MODEL, NB = CFG_BATCH, S = CFG_SEQ, L = CFG_DEPTH, MIX = D / 2, M = NB * S;
constexpr int AH = MIX / 128, HH = MIX / 128, RH = MIX / 64, SH = MIX / 128;
constexpr int RW_MIX = 3 * MIX + 128;
constexpr int C_AQ = 0, C_AK = MIX, C_AV = 2 * MIX, C_AG = 3 * MIX, C_HQ = 4 * MIX, C_HF = 5 * MIX, C_HI = 6 * MIX, C_HG = 7 * MIX;
constexpr int C_RM = 8 * MIX, C_RG = C_RM + RW_MIX, C_SQ = C_RG + MIX, C_SK = C_SQ + MIX, C_SV = C_SK + MIX, C_SG = C_SV + MIX, C_MG = C_SG + MIX;
constexpr int IN_COLS = C_MG + 4 * D;
constexpr int C_VD = C_MG, CG0 = ((C_MG + 32 + 255) / 256) * 256, NP = CG0 + 4 * D, ZLD = CG0;
constexpr float LN_EPS = 1e-5f, RMS_EPS = 1e-6f, RW_LN_EPS = 64e-5f;
constexpr float LOG2E = 1.4426950408889634f, LN2 = 0.6931471805599453f;

constexpr size_t al256(size_t x) { return (x + 255) & ~(size_t)255; }
constexpr size_t WS_CTL = 0, CTL_BYTES = 1u << 20;
constexpr size_t SM_LAM = CTL_BYTES;
constexpr size_t SM_LB = SM_LAM + 256;
constexpr size_t SM_BT = al256(SM_LB + (size_t)3 * L * MIX * 4);
constexpr size_t SM_W2T = al256(SM_BT + (size_t)AH * 132 * 4);
constexpr size_t SM_A2T = al256(SM_W2T + (size_t)L * MIX * 64 * 2);
constexpr size_t SM_V2T = al256(SM_A2T + (size_t)L * MIX * 64 * 2);
constexpr size_t WS_WIN = al256(SM_V2T + (size_t)L * MIX * 32 * 2);
constexpr size_t WS_WBR = al256(WS_WIN + (size_t)L * NP * D * 2);
constexpr size_t WS_WOUT = al256(WS_WBR + (size_t)L * D * 4 * MIX * 2);
constexpr size_t WS_XN = al256(WS_WOUT + (size_t)L * D * D * 2);
constexpr size_t WS_H = al256(WS_XN + (size_t)M * D * 2);
constexpr size_t WS_Z = al256(WS_H + (size_t)M * D * 4);
constexpr size_t WS_Y = al256(WS_Z + (size_t)M * ZLD * 2);
constexpr size_t WS_RHO = al256(WS_Y + (size_t)M * 4 * MIX * 2);
constexpr size_t WS_P = al256(WS_RHO + (size_t)M * 4 * D * 2);
constexpr size_t WS_MG = al256(WS_P + (size_t)M * 4 * D * 2);
constexpr size_t WS_OUTF = al256(WS_MG + (size_t)M * D * 2);
constexpr size_t WS_VF = al256(WS_OUTF + (size_t)M * D * 4);
constexpr size_t WS_SCI = al256(WS_VF + (size_t)M * MIX * 4);
constexpr size_t WS_SCO = al256(WS_SCI + (size_t)M * MIX * 6 * 4);
constexpr size_t WS_BON = al256(WS_SCO + (size_t)M * MIX * 4);
constexpr size_t HG_CHUNKS = (size_t)NB * (MIX / 128) * (S / 64);
constexpr size_t WS_HGQF = al256(WS_BON + (size_t)M * RH * 4);
constexpr size_t WS_HGIN = al256(WS_HGQF + HG_CHUNKS * 16 * 64 * 16);
constexpr size_t WS_HGDS = al256(WS_HGIN + HG_CHUNKS * 8 * 4 * 64 * 16);
constexpr size_t WS_HGVE = al256(WS_HGDS + HG_CHUNKS * 8 * 8 * 64 * 16);
constexpr size_t WS_HGSF = al256(WS_HGVE + HG_CHUNKS * 256 * 4);
constexpr int FX_T = 4, FX_ROWS = NB * FX_T;
constexpr size_t WS_ZF = al256(WS_HGSF + HG_CHUNKS * 8 * 4 * 64 * 16);
constexpr size_t WS_OEX = al256(WS_ZF + (size_t)FX_ROWS * ZLD * 4);
constexpr size_t WS_OEXC = al256(WS_OEX + (size_t)NB * (MIX / 128) * FX_T * 128 * 4);
constexpr size_t WS_END = al256(WS_OEXC + (size_t)NB * FX_T * MIX * 4);
constexpr size_t WS_RC = WS_P;
static_assert((size_t)NB * (MIX / 64) * (S / 16) * 22784 <= WS_VF - WS_P, "RWKV records fit the aliased region");

typedef unsigned short bf16_t;
typedef short bf16x8 __attribute__((ext_vector_type(8)));
typedef short s16x4 __attribute__((ext_vector_type(4)));
typedef float f32x16 __attribute__((ext_vector_type(16)));
typedef float f32x4 __attribute__((ext_vector_type(4)));
typedef float f32x2 __attribute__((ext_vector_type(2)));
typedef unsigned u32x4 __attribute__((ext_vector_type(4)));
typedef unsigned u32x2 __attribute__((ext_vector_type(2)));
#ifdef EMU
#define DI static inline
#define DM inline
#define LAS
#define GAS
#define WAVE_SYNC() emu_wave_barrier()
#define MFMA32(a, b, c) emu_mfma32(a, b, c)
#define MFMA16(a, b, c) emu_mfma16(a, b, c)
#define TR_READ(p) emu_tr_read((const void*)(p))
#define ROW_ROR(x, n) emu_row_ror(x, n)
#define ANY(p) emu_any(p)
#define RFL(x) (x)
DI float ex2(float x) { return exp2f(x); }
DI float lg2(float x) { return log2f(x); }
DI float frcp(float x) { return 1.f / x; }
DI float frsq(float x) { return 1.f / sqrtf(x); }
DI float u2f(unsigned u) { float f; memcpy(&f, &u, 4); return f; }
DI unsigned f2u(float f) { unsigned u; memcpy(&u, &f, 4); return u; }
#else
#define DI __device__ __forceinline__
#define DM __device__ __forceinline__
#define LAS __attribute__((address_space(3)))
#define GAS __attribute__((address_space(1)))
#define WAVE_SYNC() do { __builtin_amdgcn_fence(__ATOMIC_RELEASE, "wavefront"); __builtin_amdgcn_wave_barrier(); __builtin_amdgcn_fence(__ATOMIC_ACQUIRE, "wavefront"); } while (0)
#define MFMA32(a, b, c) __builtin_amdgcn_mfma_f32_32x32x16_bf16((a), (b), (c), 0, 0, 0)
#define MFMA16(a, b, c) __builtin_amdgcn_mfma_f32_16x16x32_bf16((a), (b), (c), 0, 0, 0)
typedef short v4i16_t __attribute__((ext_vector_type(4)));
#define TR_READ(p) __builtin_bit_cast(s16x4, __builtin_amdgcn_ds_read_tr16_b64_v4i16((LAS v4i16_t*)(p)))
#define ROW_ROR(x, n) __builtin_bit_cast(float, __builtin_amdgcn_update_dpp(0, __builtin_bit_cast(int, (x)), 0x120 + (n), 0xf, 0xf, false))
#define ANY(p) __any(p)
#define RFL(x) __builtin_amdgcn_readfirstlane(x)
DI float ex2(float x) { return __builtin_amdgcn_exp2f(x); }
DI float lg2(float x) { return __builtin_amdgcn_logf(x); }
DI float frcp(float x) { return __builtin_amdgcn_rcpf(x); }
DI float frsq(float x) { return __builtin_amdgcn_rsqf(x); }
DI float u2f(unsigned u) { return __builtin_bit_cast(float, u); }
DI unsigned f2u(float f) { return __builtin_bit_cast(unsigned, f); }
#endif
#ifdef EMU
#define SCHED_FENCE()
#else
#define SCHED_FENCE() __builtin_amdgcn_sched_barrier(0)
#endif
typedef LAS char* lptr;
#ifdef EMU
DI int TID() { return (int)threadIdx.x; }
#else
DI int TID() { int t = (int)threadIdx.x; asm volatile("" : "+v"(t)); return t; }
#endif
DI float bf2f(bf16_t v) { return u2f(((unsigned)v) << 16); }
DI bf16_t f2bf(float f) { unsigned u = f2u(f); return (bf16_t)((u + 0x7fffu + ((u >> 16) & 1u)) >> 16); }
#ifdef EMU
DI unsigned pk2(float lo, float hi) { return (unsigned)f2bf(lo) | ((unsigned)f2bf(hi) << 16); }
#else
typedef __bf16 bf16x2_hw __attribute__((ext_vector_type(2)));
DI unsigned pk2(float lo, float hi) { const f32x2 v = {lo, hi}; return __builtin_bit_cast(unsigned, __builtin_convertvector(v, bf16x2_hw)); }
#endif
DI float bflo(unsigned w) { return u2f(w << 16); }
DI float bfhi(unsigned w) { return u2f(w & 0xffff0000u); }
DI float fexp(float x) { return ex2(x * LOG2E); }
DI float flog(float x) { return lg2(x) * LN2; }
DI float fsigmoid(float x) { return frcp(1.f + fexp(-x)); }
DI float fsilu(float x) { return x * fsigmoid(x); }
DI float fsoftplus(float x) { return fmaxf(x, 0.f) + flog(1.f + fexp(-fabsf(x))); }
DI int crow(int i, int h) { return (i & 3) + 8 * (i >> 2) + 4 * h; }
DI bf16x8 pack8(float a0, float a1, float a2, float a3, float a4, float a5, float a6, float a7) {
    u32x4 w; w.x = pk2(a0, a1); w.y = pk2(a2, a3); w.z = pk2(a4, a5); w.w = pk2(a6, a7); return __builtin_bit_cast(bf16x8, w);
}
DI bf16x8 cat4(s16x4 lo, s16x4 hi) { return __builtin_shufflevector(lo, hi, 0, 1, 2, 3, 4, 5, 6, 7); }

struct Params {
    const float* in[25];
    float* out;
    unsigned char* ws;
};
#ifdef EMU
typedef const Params* KP;
#else
typedef const __attribute__((address_space(4))) Params* KP;
#endif
enum { I_X = 0, I_WIN, I_REL, I_LAM, I_SUBLN, I_HGLOW, I_HGNORM, I_MU, I_W0, I_W2, I_A0, I_A2, I_V1, I_VMU, I_V0, I_V2, I_KK, I_KA, I_RK, I_LNXG, I_LNXB, I_WBR, I_WOUT, I_LNG, I_LNB };
namespace pg8 {
#ifdef EMU
#define PG8_LAS
#else
#define PG8_LAS __attribute__((address_space(3)))
#endif
typedef unsigned short bf16_t;
typedef short bf16x8 __attribute__((ext_vector_type(8)));
typedef float f32x4 __attribute__((ext_vector_type(4)));
typedef unsigned u32x4 __attribute__((ext_vector_type(4)));
constexpr int BM = 256, BK = 64, HALF = 128, HTB = HALF * BK * 2  , STAGE_BYTES = 8 * HTB, NXCD = 8, WGM = 8;

__host__ __device__ __forceinline__ int lds_byte(int r, int c) { const int st = (r >> 4) * 2 + (c >> 5), rr = r & 15, cc = c & 31, ob = rr * 64 + cc * 2; return st * 1024 + (ob ^ (((ob >> 9) & 1) << 5)); }
__host__ __device__ __forceinline__ void stage_rc(int b, int& R, int& C) { const int st = b / 1024, sb = b % 1024, swz = sb ^ (((sb >> 9) & 1) << 5); R = (st >> 1) * 16 + swz / 64; C = (st & 1) * 32 + (swz % 64) / 2; }
__host__ __device__ __forceinline__ int perm32(int rho) { const int n = rho >> 4, i = rho & 15; return 8 * (i >> 2) + 4 * n + (i & 3); }

struct Unit { int pm, pn, ka; };
struct Gemm { const bf16_t* A; const bf16_t* Bt; int M, N, K, lda, ldb; };

struct StaticOrder {
    int nM, nN, nwg, G, c;
    __host__ __device__ void init(int M, int N, int G_, int c_) { nM = M / BM; nN = N / BM; nwg = nM * nN; G = G_; c = c_; }
    __host__ __device__ bool next(int i, Unit& u) const {
        const long L = (long)i * G + c; if (L >= nwg) return false;
        int wgid = (int)L; { const int q = nwg / NXCD, r = nwg % NXCD, xcd = wgid % NXCD, off = wgid / NXCD; wgid = (xcd < r ? xcd * (q + 1) : r * (q + 1) + (xcd - r) * q) + off; }
        const int nig = WGM * nN, gid = wgid / nig, fm = gid * WGM, gsz = (nM - fm) < WGM ? (nM - fm) : WGM;
        u.pm = fm + ((wgid % nig) % gsz); u.pn = (wgid % nig) / gsz; u.ka = 0; return true;
    }
    __device__ __forceinline__ void a_ready(const Unit&) const {}
    __device__ __forceinline__ void done(const Unit&) const {}
};
#ifndef EMU
template <class Epi, class Sched, bool ALIGN_EPI, bool SP2, int LDA, int LDB, int KDIM>
__device__ __forceinline__ void gemm_phase(PG8_LAS unsigned char* lds, const Gemm g, const Sched& S, const Epi& E) {
    const int tid = TID(), wid = __builtin_amdgcn_readfirstlane(tid >> 6), lane = tid & 63, wr = wid >> 2, wc = wid & 3, fr = lane & 15, fq = lane >> 4;
    constexpr int K = KDIM, nt = K / BK;
    unsigned voffA, voffB;
    { int R, C; stage_rc(tid * 16, R, C); const int Rb = Epi::PERM ? ((R & ~31) + perm32(R & 31)) : R;
      voffA = (unsigned)(R * LDA + C) * 2u; voffB = (unsigned)(Rb * LDB + C) * 2u; }
    const size_t qA = (size_t)64 * LDA * 2, qB = (size_t)64 * LDB * 2;
    const size_t kstep = (size_t)(BK * 2);
    const size_t hstepA = (size_t)HALF * LDA * 2, hstepB = (size_t)HALF * LDB * 2;
    const size_t tstepA = 2 * hstepA, tstepB = 2 * hstepB;
    const unsigned ldsw = (unsigned)wid * 1024u;
    const int aoff = lds_byte(wr * 64 + fr, fq * 8), boff = lds_byte(wc * 32 + fr, fq * 8);
#define PG8_SA(b, h) (((b) * 2 + (h)) * HTB)
#define PG8_SB(b, h) ((4 + (b) * 2 + (h)) * HTB)
#define PG8_STAGE_X(bufoff, gbase, voff, q) do { _Pragma("unroll") for (int _i = 0; _i < 2; ++_i) \
        __builtin_amdgcn_global_load_lds((const unsigned*)((const char*)(gbase) + (size_t)_i * (q) + (voff)), (PG8_LAS unsigned*)(lds + (bufoff) + ldsw + _i * 8192), 16, 0, 0); } while (0)
#define PG8_STAGE_A(bufoff, gbase) PG8_STAGE_X(bufoff, gbase, voffA, qA)
#define PG8_STAGE_B(bufoff, gbase) PG8_STAGE_X(bufoff, gbase, voffB, qB)
#define PG8_LDA(dst, b, h) do { _Pragma("unroll") for (int m = 0; m < 4; ++m) _Pragma("unroll") for (int k = 0; k < 2; ++k) dst[m][k] = *(const PG8_LAS bf16x8*)(lds + PG8_SA(b, h) + aoff + m * 2048 + k * 1024); } while (0)
#define PG8_LDB(dst, b, h) do { _Pragma("unroll") for (int n = 0; n < 2; ++n) _Pragma("unroll") for (int k = 0; k < 2; ++k) dst[n][k] = *(const PG8_LAS bf16x8*)(lds + PG8_SB(b, h) + boff + n * 2048 + k * 1024); } while (0)
#define PG8_MMA(ai, bj, At, Bt) do { __builtin_amdgcn_s_setprio(1); _Pragma("unroll") for (int m = 0; m < 4; ++m) _Pragma("unroll") for (int n = 0; n < 2; ++n) _Pragma("unroll") for (int k = 0; k < 2; ++k) \
        acc[ai][bj][m][n] = __builtin_amdgcn_mfma_f32_16x16x32_bf16(Bt[n][k], At[m][k], acc[ai][bj][m][n], 0, 0, 0); __builtin_amdgcn_s_setprio(0); } while (0)
#define PG8_WAIT_V(n) asm volatile("s_waitcnt vmcnt(" #n ")" ::: "memory")
#define PG8_WAIT_L(n) asm volatile("s_waitcnt lgkmcnt(" #n ")" ::: "memory")
#define PG8_BAR __builtin_amdgcn_s_barrier()
#define PG8_SCHED __builtin_amdgcn_sched_barrier(0)
    Unit cur, nxt; int ui = 0;
    if (!S.next(0, cur)) return;
    f32x4 acc[2][2][4][2];
#pragma unroll
    for (int a = 0; a < 2; ++a)
#pragma unroll
        for (int b = 0; b < 2; ++b)
#pragma unroll
            for (int m = 0; m < 4; ++m)
#pragma unroll
                for (int n = 0; n < 2; ++n) acc[a][b][m][n] = (f32x4){0.f, 0.f, 0.f, 0.f};
    bf16x8 At[4][2], B0[2][2], B1[2][2];
    const char* cA = (const char*)g.A + (size_t)cur.pm * tstepA + (size_t)cur.ka * 2; const char* cB = (const char*)g.Bt + (size_t)cur.pn * tstepB;
    S.a_ready(cur);
    if constexpr (SP2) {
        PG8_STAGE_B(PG8_SB(0, 0), cB); PG8_STAGE_B(PG8_SB(0, 1), cB + hstepB); PG8_STAGE_A(PG8_SA(0, 0), cA); PG8_STAGE_A(PG8_SA(0, 1), cA + hstepA);
        if (wr == 1) PG8_BAR;
        PG8_WAIT_V(2); PG8_BAR;
        PG8_STAGE_B(PG8_SB(1, 0), cB + kstep); PG8_STAGE_A(PG8_SA(1, 0), cA + kstep); PG8_STAGE_B(PG8_SB(1, 1), cB + hstepB + kstep);
        PG8_WAIT_V(6); PG8_BAR;
    } else {
        PG8_STAGE_B(PG8_SB(0, 0), cB); PG8_STAGE_A(PG8_SA(0, 0), cA); PG8_STAGE_B(PG8_SB(0, 1), cB + hstepB); PG8_STAGE_A(PG8_SA(0, 1), cA + hstepA);
        if (wr == 1) PG8_BAR;
        PG8_WAIT_V(4); PG8_BAR;
        PG8_STAGE_B(PG8_SB(1, 0), cB + kstep); PG8_STAGE_A(PG8_SA(1, 0), cA + kstep); PG8_STAGE_B(PG8_SB(1, 1), cB + hstepB + kstep);
        PG8_WAIT_V(6); PG8_BAR;
    }
    for (;;) {
        const bool has_next = S.next(ui + 1, nxt);
        const char* nA = has_next ? (const char*)g.A + (size_t)nxt.pm * tstepA + (size_t)nxt.ka * 2 : cA; const char* nB = has_next ? (const char*)g.Bt + (size_t)nxt.pn * tstepB : cB;
        for (int t = 0; t < nt; t += 2) {
            if constexpr (Epi::MIDK > 0) { if (t > 0 && (t % Epi::MIDK) == 0) E.mid(acc, cur, t / Epi::MIDK - 1, wr, wc, fr, fq); }
            const bool last = (t == nt - 2);
            const char* a1 = cA + (size_t)(t + 1) * kstep;
            const char* a2 = last ? nA : cA + (size_t)(t + 2) * kstep; const char* b2 = last ? nB : cB + (size_t)(t + 2) * kstep;
            const char* a3 = a2 + kstep; const char* b3 = b2 + kstep;
            if (last && has_next) S.a_ready(nxt);
            if constexpr (SP2) {
            PG8_LDB(B0, 0, 0); PG8_LDB(B1, 0, 1); PG8_SCHED; PG8_LDA(At, 0, 0); PG8_STAGE_A(PG8_SA(1, 1), a1 + hstepA);
            PG8_WAIT_V(8); PG8_WAIT_L(0); PG8_BAR; PG8_MMA(0, 0, At, B0); PG8_MMA(0, 1, At, B1); PG8_BAR; PG8_SCHED;
            PG8_LDA(At, 0, 1); PG8_STAGE_B(PG8_SB(0, 0), b2); PG8_STAGE_B(PG8_SB(0, 1), b2 + hstepB); PG8_STAGE_A(PG8_SA(0, 0), a2);
            PG8_WAIT_V(8); PG8_WAIT_L(0); PG8_BAR; PG8_MMA(1, 0, At, B0); PG8_MMA(1, 1, At, B1); PG8_BAR; PG8_SCHED;
            PG8_LDB(B0, 1, 0); PG8_LDB(B1, 1, 1); PG8_SCHED; PG8_LDA(At, 1, 0); PG8_STAGE_A(PG8_SA(0, 1), a2 + hstepA);
            PG8_WAIT_V(8); PG8_WAIT_L(0); PG8_BAR; PG8_MMA(0, 0, At, B0); PG8_MMA(0, 1, At, B1); PG8_BAR; PG8_SCHED;
            PG8_LDA(At, 1, 1); PG8_STAGE_B(PG8_SB(1, 0), b3); PG8_STAGE_B(PG8_SB(1, 1), b3 + hstepB); PG8_STAGE_A(PG8_SA(1, 0), a3);
            PG8_WAIT_V(8); PG8_WAIT_L(0); PG8_BAR; PG8_MMA(1, 0, At, B0); PG8_MMA(1, 1, At, B1); PG8_BAR; PG8_SCHED;
            } else {
            PG8_LDB(B0, 0, 0); PG8_SCHED; PG8_LDA(At, 0, 0); PG8_STAGE_A(PG8_SA(1, 1), a1 + hstepA);
            PG8_WAIT_L(8); PG8_BAR; PG8_WAIT_L(0); PG8_MMA(0, 0, At, B0); PG8_BAR; PG8_SCHED;
            PG8_LDB(B1, 0, 1); PG8_STAGE_B(PG8_SB(0, 0), b2);
            PG8_BAR; PG8_WAIT_L(0); PG8_MMA(0, 1, At, B1); PG8_BAR;
            PG8_LDA(At, 0, 1); PG8_STAGE_A(PG8_SA(0, 0), a2);
            PG8_BAR; PG8_WAIT_L(0); PG8_MMA(1, 0, At, B0); PG8_BAR; PG8_SCHED;
            PG8_STAGE_B(PG8_SB(0, 1), b2 + hstepB);
            PG8_WAIT_V(6); PG8_BAR; PG8_MMA(1, 1, At, B1); PG8_BAR;
            PG8_LDB(B0, 1, 0); PG8_SCHED; PG8_LDA(At, 1, 0); PG8_STAGE_A(PG8_SA(0, 1), a2 + hstepA);
            PG8_WAIT_L(8); PG8_BAR; PG8_WAIT_L(0); PG8_MMA(0, 0, At, B0); PG8_BAR; PG8_SCHED;
            PG8_LDB(B1, 1, 1); PG8_STAGE_B(PG8_SB(1, 0), b3);
            PG8_BAR; PG8_WAIT_L(0); PG8_MMA(0, 1, At, B1); PG8_BAR;
            PG8_LDA(At, 1, 1); PG8_STAGE_A(PG8_SA(1, 0), a3);
            PG8_BAR; PG8_WAIT_L(0); PG8_MMA(1, 0, At, B0); PG8_BAR; PG8_SCHED;
            PG8_STAGE_B(PG8_SB(1, 1), b3 + hstepB);
            PG8_WAIT_V(6); PG8_BAR; PG8_MMA(1, 1, At, B1); PG8_BAR;
            }
        }
        if constexpr (ALIGN_EPI) { if (wr == 0) PG8_BAR; }
        if constexpr (!Epi::AFTER_DRAIN) { E(acc, cur, wr, wc, fr, fq); S.done(cur); }
        if (!has_next) break;
#pragma unroll
        for (int a = 0; a < 2; ++a)
#pragma unroll
            for (int b = 0; b < 2; ++b)
#pragma unroll
                for (int m = 0; m < 4; ++m)
#pragma unroll
                    for (int n = 0; n < 2; ++n) acc[a][b][m][n] = (f32x4){0.f, 0.f, 0.f, 0.f};
        cur = nxt; cA = nA; cB = nB; ++ui;
        if constexpr (ALIGN_EPI) { if (wr == 1) PG8_BAR; }
    }
    PG8_WAIT_V(0);
    if constexpr (!ALIGN_EPI) { if (wr == 0) PG8_BAR; }
    PG8_BAR;
    if constexpr (Epi::AFTER_DRAIN) { E.fused(acc, cur, wr, wc, fr, fq, lds, wid, lane); S.done(cur); }
#undef PG8_SA
#undef PG8_SB
#undef PG8_STAGE_X
#undef PG8_STAGE_A
#undef PG8_STAGE_B
#undef PG8_LDA
#undef PG8_LDB
#undef PG8_MMA
#undef PG8_WAIT_V
#undef PG8_WAIT_L
#undef PG8_BAR
#undef PG8_SCHED
}
#endif
}
#ifdef EMU
#define EPI_COORDS()
#else
#define EPI_COORDS() { const int t_ = TID(); const int w_ = RFL(t_ >> 6), l_ = t_ & 63; wr = w_ >> 2; wc = w_ & 3; fr = l_ & 15; fq = l_ >> 4; }
#endif
struct EpiInproj {
    static constexpr bool PERM = true, AFTER_DRAIN = false; static constexpr int MIDK = 0;
    bf16_t* O; int ldc; bf16_t* RHO; int gate_pn0;
    DM void operator()(const f32x4 (&acc)[2][2][4][2], const pg8::Unit& u, int wr, int wc, int fr, int fq) const {
        const int row0 = u.pm * 256 + wr * 64 + fr;
        if (u.pn < gate_pn0) { const int col0 = u.pn * 256 + wc * 32 + 8 * fq;
#pragma unroll
            for (int ai = 0; ai < 2; ++ai)
#pragma unroll
                for (int m = 0; m < 4; ++m) { bf16_t* rowp = O + (size_t)(row0 + ai * 128 + m * 16) * ldc + col0;
#pragma unroll
                    for (int bj = 0; bj < 2; ++bj) { const f32x4 v0 = acc[ai][bj][m][0], v1 = acc[ai][bj][m][1];
                        u32x4 w; w.x = pk2(v0[0], v0[1]); w.y = pk2(v0[2], v0[3]); w.z = pk2(v1[0], v1[1]); w.w = pk2(v1[2], v1[3]);
                        *(u32x4*)(rowp + bj * 128) = w; } }
        } else {
            const int T = u.pn - gate_pn0, pnc = T >> 2, bjc = (T & 3) >> 1, wcc = 2 * (T & 1) + (wc >> 1), fqc = fq, nc = wc & 1;
            bf16_t* base = RHO + ((((size_t)u.pm * (D / 256) + pnc) * 4) * 8 + (wr * 4 + wcc)) * (size_t)(16 * 64 * 8) + bjc * 512 + (fqc * 16 + fr) * 8 + nc * 4;
            constexpr size_t SEG_STRIDE = (size_t)8 * 16 * 64 * 8;
#pragma unroll
            for (int ai = 0; ai < 2; ++ai)
#pragma unroll
                for (int m = 0; m < 4; ++m) { bf16_t* rp = base + (ai * 4 + m) * 1024; float r0[4], r1[4], r2[4], r3[4];
#pragma unroll
                    for (int e = 0; e < 4; ++e) { const float d0 = 1.f + fexp(-acc[ai][0][m][0][e]), d1 = 1.f + fexp(-acc[ai][0][m][1][e]), d2 = 1.f + fexp(-acc[ai][1][m][0][e]), d3 = 1.f + fexp(-acc[ai][1][m][1][e]);
                        const float i0 = frcp(d0), i1 = frcp(d1), i2 = frcp(d2), i3 = frcp(d3);
                        r0[e] = i0; r1[e] = i1; r2[e] = i2; r3[e] = i3; }
                    u32x2 w; w.x = pk2(r0[0], r0[1]); w.y = pk2(r0[2], r0[3]); *(u32x2*)(rp) = w; w.x = pk2(r1[0], r1[1]); w.y = pk2(r1[2], r1[3]); *(u32x2*)(rp + SEG_STRIDE) = w;
                    w.x = pk2(r2[0], r2[1]); w.y = pk2(r2[2], r2[3]); *(u32x2*)(rp + 2 * SEG_STRIDE) = w; w.x = pk2(r3[0], r3[1]); w.y = pk2(r3[2], r3[3]); *(u32x2*)(rp + 3 * SEG_STRIDE) = w; } }
    }
};
struct EpiGateP {
    static constexpr bool PERM = false, AFTER_DRAIN = false; static constexpr int MIDK = 0;
    bf16_t* O; int ldc; const bf16_t* SG;
    DM void operator()(const f32x4 (&acc)[2][2][4][2], const pg8::Unit& u, int wr, int wc, int fr, int fq) const {
        const int n = u.pn / (D / 256), pnc = u.pn % (D / 256);
        const u32x4* base = (const u32x4*)(SG + ((((size_t)u.pm * (D / 256) + pnc) * 4 + n) * 8 + (wr * 4 + wc)) * (size_t)(16 * 64 * 8)) + (fq * 16 + fr);
        const int row0 = u.pm * 256 + wr * 64 + fr, col0 = u.pn * 256 + wc * 32 + 4 * fq;
#pragma unroll
        for (int ai = 0; ai < 2; ++ai)
#pragma unroll
            for (int m = 0; m < 4; ++m) { bf16_t* rowp = O + (size_t)(row0 + ai * 128 + m * 16) * ldc + col0;
#pragma unroll
                for (int bj = 0; bj < 2; ++bj) { const u32x4 g = base[((ai * 4 + m) * 2 + bj) * 64]; const f32x4 v0 = acc[ai][bj][m][0], v1 = acc[ai][bj][m][1];
                    u32x2 w0, w1; w0.x = pk2(v0[0] * bflo(g.x), v0[1] * bfhi(g.x)); w0.y = pk2(v0[2] * bflo(g.y), v0[3] * bfhi(g.y)); w1.x = pk2(v1[0] * bflo(g.z), v1[1] * bfhi(g.z)); w1.y = pk2(v1[2] * bflo(g.w), v1[3] * bfhi(g.w));
                    *(u32x2*)(rowp + bj * 128) = w0; *(u32x2*)(rowp + bj * 128 + 16) = w1; } }
    }
};
struct EpiF32 {
    static constexpr bool PERM = false, AFTER_DRAIN = false; static constexpr int MIDK = 0;
    float* O; int ldc;
    DM void operator()(const f32x4 (&acc)[2][2][4][2], const pg8::Unit& u, int wr, int wc, int fr, int fq) const {
        const int row0 = u.pm * 256 + wr * 64 + fr, col0 = u.pn * 256 + wc * 32 + 4 * fq;
#pragma unroll
        for (int ai = 0; ai < 2; ++ai)
#pragma unroll
            for (int m = 0; m < 4; ++m) { float* rowp = O + (size_t)(row0 + ai * 128 + m * 16) * ldc + col0;
#pragma unroll
                for (int bj = 0; bj < 2; ++bj)
#pragma unroll
                    for (int n = 0; n < 2; ++n) *(f32x4*)(rowp + bj * 128 + n * 16) = acc[ai][bj][m][n]; }
    }
};

#ifdef EMU
template <class Epi> static void emu_gemm(const pg8::Gemm g, const Epi& E, int ka_div = 0, int ka_mul = 0) {
    if (g.M % 256 || g.N % 256) { printf("emu_gemm: M %d N %d not multiples of 256\n", g.M, g.N); exit(1); }
    std::vector<float> C((size_t)256 * 256);
    const int seglen = (Epi::MIDK > 0) ? Epi::MIDK * 64 : g.K, nseg = g.K / seglen;
    for (int pm = 0; pm < g.M / 256; ++pm) for (int pn = 0; pn < g.N / 256; ++pn) {
        pg8::Unit u{pm, pn, 0};
        std::fill(C.begin(), C.end(), 0.f);
        for (int sg = 0; sg < nseg; ++sg) {
            for (int i = 0; i < 256; ++i) for (int j = 0; j < 256; ++j) { float a = 0.f; const bf16_t* ar = g.A + (size_t)(pm * 256 + i) * g.lda + sg * seglen + (ka_div ? (pn / ka_div) * ka_mul : 0); const bf16_t* br = g.Bt + (size_t)(pn * 256 + j) * g.ldb + sg * seglen;
                for (int k = 0; k < seglen; ++k) a += bf2f(ar[k]) * bf2f(br[k]); C[(size_t)i * 256 + j] += a; }
            const bool fin = (sg == nseg - 1);
            for (int wid = 0; wid < 8; ++wid) for (int lane = 0; lane < 64; ++lane) { const int wr = wid >> 2, wc = wid & 3, fr = lane & 15, fq = lane >> 4;
                f32x4 acc[2][2][4][2];
                for (int ai = 0; ai < 2; ++ai) for (int bj = 0; bj < 2; ++bj) for (int m = 0; m < 4; ++m) for (int n = 0; n < 2; ++n) for (int e = 0; e < 4; ++e) {
                    const int r = 128 * ai + 64 * wr + 16 * m + fr; const int c = Epi::PERM ? (128 * bj + 32 * wc + 8 * fq + 4 * n + e) : (128 * bj + 32 * wc + 16 * n + 4 * fq + e);
                    acc[ai][bj][m][n][e] = C[(size_t)r * 256 + c]; }
                if (fin) E(acc, u, wr, wc, fr, fq);
                else { if constexpr (Epi::MIDK > 0) E.mid(acc, u, sg, wr, wc, fr, fq);
                    for (int ai = 0; ai < 2; ++ai) for (int bj = 0; bj < 2; ++bj) for (int m = 0; m < 4; ++m) for (int n = 0; n < 2; ++n) for (int e = 0; e < 4; ++e) {
                        const int r = 128 * ai + 64 * wr + 16 * m + fr; const int c = Epi::PERM ? (128 * bj + 32 * wc + 8 * fq + 4 * n + e) : (128 * bj + 32 * wc + 16 * n + 4 * fq + e);
                        C[(size_t)r * 256 + c] = acc[ai][bj][m][n][e]; } } }
        }
    }
}
#endif
DI int gate_row(int sc) { const int n = sc / D, j = sc % D, jl = j & 63; return CG0 + 256 * (j >> 6) + 128 * (n >> 1) + 32 * (jl >> 4) + 8 * ((jl >> 2) & 3) + 4 * (n & 1) + (jl & 3); }
template <bool GATE> DI void transpose_item(const float* W, int N, bf16_t* dst, size_t ld_dst, int row_off, int col_off, LAS float* scr, int kb, int nb, int lane) {
    const int k0 = 64 * kb, n0 = 32 * nb;
#pragma unroll 8
    for (int i = 0; i < 32; ++i) { const int kk = 2 * i + (lane >> 5); scr[kk * 33 + (lane & 31)] = W[(size_t)(k0 + kk) * N + n0 + (lane & 31)]; }
    WAVE_SYNC();
    const int c = lane & 7;
#pragma unroll
    for (int j = 0; j < 4; ++j) { const int n = (lane >> 3) + 8 * j; const LAS float* s = scr + (8 * c) * 33 + n;
        u32x4 o; o.x = pk2(s[0 * 33], s[1 * 33]); o.y = pk2(s[2 * 33], s[3 * 33]); o.z = pk2(s[4 * 33], s[5 * 33]); o.w = pk2(s[6 * 33], s[7 * 33]);
        const int drow = GATE ? gate_row(n0 + n - C_MG) : (row_off + n0 + n);
        *(u32x4*)(dst + (size_t)drow * ld_dst + col_off + k0 + 8 * c) = o; }
    WAVE_SYNC();
}
__device__ const unsigned char T5_THR[15] = {19, 21, 24, 27, 31, 35, 40, 46, 52, 59, 67, 77, 87, 99, 113};
DI int t5_bucket(int n) { if (n < 16) return n; int b = 16;
#pragma unroll
    for (int i = 0; i < 15; ++i) b += (n >= (int)T5_THR[i]) ? 1 : 0;
    return b; }

DI void phase_prologue(KP p, lptr lds) {
    const int tid = TID(), lane = tid & 63, wave = tid >> 6;
    const int gw = blockIdx.x * 8 + wave, NGW = gridDim.x * 8;
    const size_t gt = (size_t)blockIdx.x * 512 + tid, NGT = (size_t)gridDim.x * 512;
    LAS float* scr = (LAS float*)(lds + wave * 8704);
    bf16_t* WIN = (bf16_t*)(p->ws + WS_WIN); bf16_t* WBR = (bf16_t*)(p->ws + WS_WBR); bf16_t* WOUT = (bf16_t*)(p->ws + WS_WOUT);
    constexpr int NI_IN = (D / 64) * (IN_COLS / 32), NI_V1 = (D / 64) * 1, NI_BR = (MIX / 64) * (D / 32), NI_OUT = (D / 64) * (D / 32);
    constexpr int PER_L = NI_IN + NI_V1 + 4 * NI_BR + NI_OUT;
    for (int it = gw; it < L * PER_L; it += NGW) {
        const int l = it / PER_L; int r = it % PER_L;
        if (r < NI_IN) { const int nblk = IN_COLS / 32, nb = r % nblk; const float* src = p->in[I_WIN] + (size_t)l * D * IN_COLS; bf16_t* dstw = WIN + (size_t)l * NP * D;
            if (32 * nb >= C_MG) transpose_item<true>(src, IN_COLS, dstw, D, 0, 0, scr, r / nblk, nb, lane); else transpose_item<false>(src, IN_COLS, dstw, D, 0, 0, scr, r / nblk, nb, lane); continue; } r -= NI_IN;
        if (r < NI_V1) { if (l > 0) transpose_item<false>(p->in[I_V1] + (size_t)(l - 1) * D * 32, 32, WIN + (size_t)l * NP * D, D, C_VD, 0, scr, r, 0, lane); continue; } r -= NI_V1;
        if (r < 4 * NI_BR) { const int n = r / NI_BR, rr = r % NI_BR, nblk = D / 32;
            transpose_item<false>(p->in[I_WBR] + ((size_t)l * 4 + n) * MIX * D, D, WBR + (size_t)l * 4 * D * MIX, MIX, n * D, 0, scr, rr / nblk, rr % nblk, lane); continue; } r -= 4 * NI_BR;
        { const int nblk = D / 32; transpose_item<false>(p->in[I_WOUT] + (size_t)l * D * D, D, WOUT + (size_t)l * D * D, D, 0, 0, scr, r / nblk, r % nblk, lane); }
    }
    for (int l = 0; l < L; ++l) { const int r0 = (l == 0) ? C_VD : C_VD + 32; const size_t n8 = (size_t)(CG0 - r0) * D / 8; u32x4* dst = (u32x4*)(WIN + ((size_t)l * NP + r0) * D);
        for (size_t i = gt; i < n8; i += NGT) dst[i] = (u32x4){0u, 0u, 0u, 0u}; }
    { const f32x4* x4 = (const f32x4*)p->in[I_X]; u32x2* xn = (u32x2*)(p->ws + WS_XN);
      for (size_t i = gt; i < (size_t)M * D / 4; i += NGT) { const f32x4 v = x4[i]; u32x2 o; o.x = pk2(v[0], v[1]); o.y = pk2(v[2], v[3]); xn[i] = o; } }
    { bf16_t* W2T = (bf16_t*)(p->ws + SM_W2T); bf16_t* A2T = (bf16_t*)(p->ws + SM_A2T); bf16_t* V2T = (bf16_t*)(p->ws + SM_V2T);
      for (size_t i = gt; i < (size_t)L * MIX * 64; i += NGT) { const int j = (int)(i % 64); const int c = (int)((i / 64) % MIX); const int l = (int)(i / ((size_t)64 * MIX));
          W2T[i] = f2bf(p->in[I_W2][((size_t)l * 64 + j) * MIX + c]); A2T[i] = f2bf(p->in[I_A2][((size_t)l * 64 + j) * MIX + c]); }
      for (size_t i = gt; i < (size_t)L * MIX * 32; i += NGT) { const int j = (int)(i % 32); const int c = (int)((i / 32) % MIX); const int l = (int)(i / ((size_t)32 * MIX));
          V2T[i] = (l > 0) ? f2bf(p->in[I_V2][((size_t)(l - 1) * 32 + j) * MIX + c]) : (bf16_t)0; } }
    if (blockIdx.x == 0) {
        float* LAM = (float*)(p->ws + SM_LAM); float* LB = (float*)(p->ws + SM_LB); float* BT = (float*)(p->ws + SM_BT);
        if (tid < L) { const float* lm = p->in[I_LAM] + (size_t)tid * 256; float s1 = 0.f, s2 = 0.f;
            for (int i = 0; i < 64; ++i) { s1 += lm[i] * lm[64 + i]; s2 += lm[128 + i] * lm[192 + i]; }
            const float li = 0.8f - 0.6f * expf(-0.3f * (float)tid); LAM[tid] = expf(s1) - expf(s2) + li; LAM[L + tid] = li; }
        for (int c = tid; c < MIX; c += 512) { float mx = -1e30f; for (int l = 0; l < L; ++l) mx = fmaxf(mx, p->in[I_HGLOW][(size_t)l * MIX + c]);
            float den = 0.f; for (int l = 0; l < L; ++l) den += expf(p->in[I_HGLOW][(size_t)l * MIX + c] - mx);
            float cum = 0.f; for (int l = 0; l < L; ++l) { if (l > 0) cum += expf(p->in[I_HGLOW][(size_t)l * MIX + c] - mx) / den;
                LB[(size_t)l * MIX + c] = cum; LB[(size_t)(L + l) * MIX + c] = (l > 0) ? logf(cum) : -1e30f; LB[(size_t)(2 * L + l) * MIX + c] = log1pf(-cum); } }
        for (int i = tid; i < AH * 132; i += 512) { const int h = i / 132, d = i % 132; const int bk = (d >= 128) ? 31 : t5_bucket(d); BT[i] = p->in[I_REL][bk * AH + h] * LOG2E; }
    }
}
constexpr int ATT_KSTR = 272, ATT_VSTR = 320;
constexpr int ATT_K_OFF = 0, ATT_V_OFF = 64 * ATT_KSTR, ATT_BUF = ATT_V_OFF + 64 * ATT_VSTR, ATT_BT_OFF = 2 * ATT_BUF, ATT_X_OFF = 0;
struct KVRegs { u32x4 k[2], v[2]; };
DI void load_kv(KVRegs& rg, const bf16_t* Z, size_t row0, int kcol, int vcol, int tid) {
#pragma unroll
    for (int i = 0; i < 2; ++i) { const int pc = tid + 512 * i, row = pc >> 4, c16 = pc & 15;
        rg.k[i] = *(const u32x4*)(Z + (row0 + row) * ZLD + kcol + c16 * 8);
        rg.v[i] = *(const u32x4*)(Z + (row0 + row) * ZLD + vcol + c16 * 8); }
}
DI void store_kv(const KVRegs& rg, lptr lds, int tid) {
#pragma unroll
    for (int i = 0; i < 2; ++i) { const int pc = tid + 512 * i, row = pc >> 4, c16 = pc & 15;
        *(LAS u32x4*)(lds + ATT_K_OFF + row * ATT_KSTR + c16 * 16) = rg.k[i];
        *(LAS u32x4*)(lds + ATT_V_OFF + row * ATT_VSTR + c16 * 16) = rg.v[i]; }
}
DI void pv_acc(f32x16 (&o)[4], const f32x16& pt, lptr lds, int kh, int lane) {
    const int hh = lane >> 5, gsub = (lane >> 4) & 1, i16 = lane & 15, qq = i16 >> 2, pp = i16 & 3;
#pragma unroll
    for (int s = 0; s < 2; ++s) {
        const bf16x8 pb = pack8(pt[8 * s], pt[8 * s + 1], pt[8 * s + 2], pt[8 * s + 3], pt[8 * s + 4], pt[8 * s + 5], pt[8 * s + 6], pt[8 * s + 7]);
        const lptr vrow = lds + ATT_V_OFF + (32 * kh + 16 * s + 4 * hh + qq) * ATT_VSTR + gsub * 32 + pp * 8;
#pragma unroll
        for (int db = 0; db < 4; ++db) {
            const s16x4 lo = TR_READ(vrow + db * 64), hi = TR_READ(vrow + 8 * ATT_VSTR + db * 64);
            o[db] = MFMA32(cat4(lo, hi), pb, o[db]); }
    }
}
DI void phase_att_a(KP p, int layer, lptr lds, int unit) {
    const int tid = TID(), lane = tid & 63, wid = RFL(tid >> 6), r = lane & 31, hh = lane >> 5;
    constexpr int NQB = S / 128;
    const int qb = NQB - 1 - (unit / (NB * AH)), bh = unit % (NB * AH), h = bh % AH, b = bh / AH;
    const int mp = wid & 1, qs = wid >> 1, q0 = qb * 128, qw0 = q0 + 32 * qs, q = qw0 + r;
    const bf16_t* Z = (const bf16_t*)(p->ws + WS_Z); const size_t rowb = (size_t)b * S;
    const float* LAM = (const float*)(p->ws + SM_LAM); const float lam_full = LAM[layer], lam_init = LAM[L + layer];
    LAS float* BT = (LAS float*)(lds + ATT_BT_OFF);
    __syncthreads();
    if (tid < 132) BT[tid] = ((const float*)(p->ws + SM_BT))[h * 132 + tid];
    bf16x8 qf[4];
    { const bf16_t* qp = Z + (rowb + q) * ZLD + C_AQ + h * 128 + mp * 64 + 8 * hh; const float qsc = 0.125f * LOG2E;
#pragma unroll
      for (int ds = 0; ds < 4; ++ds) { const u32x4 w = *(const u32x4*)(qp + 16 * ds);
          qf[ds] = pack8(bflo(w.x) * qsc, bfhi(w.x) * qsc, bflo(w.y) * qsc, bfhi(w.y) * qsc, bflo(w.z) * qsc, bfhi(w.z) * qsc, bflo(w.w) * qsc, bfhi(w.w) * qsc); } }
    f32x16 o[4];
#pragma unroll
    for (int db = 0; db < 4; ++db)
#pragma unroll
        for (int i = 0; i < 16; ++i) o[db][i] = 0.f;
    float mrun = -INFINITY, lrun = 0.f;
    const int nkt = (q0 + 128) / 64;
    KVRegs rg; load_kv(rg, Z, rowb, C_AK + h * 128, C_AV + h * 128, tid);
    store_kv(rg, lds, tid);
    if (nkt > 1) load_kv(rg, Z, rowb + 64, C_AK + h * 128, C_AV + h * 128, tid);
    __syncthreads();
    for (int kt = 0; kt < nkt; ++kt) {
        const int k0 = kt * 64; const lptr buf = lds + (kt & 1) * ATT_BUF;
        if (kt + 1 < nkt) store_kv(rg, lds + ((kt + 1) & 1) * ATT_BUF, tid);
        if (kt + 2 < nkt) load_kv(rg, Z, rowb + k0 + 128, C_AK + h * 128, C_AV + h * 128, tid);
        if (k0 <= qw0 + 31) {
            const bool two = (k0 + 32 <= qw0 + 31);
            const bool far = (qw0 - (k0 + 63) >= 128);
            const float cinit = far ? BT[128] : 0.f;
            f32x16 sc0, sc1;
#pragma unroll
            for (int i = 0; i < 16; ++i) { sc0[i] = cinit; sc1[i] = cinit; }
#pragma unroll
            for (int ds = 0; ds < 4; ++ds) { sc0 = MFMA32(*(const LAS bf16x8*)(buf + ATT_K_OFF + r * ATT_KSTR + mp * 128 + ds * 32 + hh * 16), qf[ds], sc0);
                if (two) sc1 = MFMA32(*(const LAS bf16x8*)(buf + ATT_K_OFF + (32 + r) * ATT_KSTR + mp * 128 + ds * 32 + hh * 16), qf[ds], sc1); }
            if (!far) {
#pragma unroll
                for (int i = 0; i < 16; ++i) { const int d0 = q - (k0 + crow(i, hh)), d1 = d0 - 32; const int i0 = d0 < 0 ? 0 : (d0 > 128 ? 128 : d0), i1 = d1 < 0 ? 0 : (d1 > 128 ? 128 : d1);
                    sc0[i] = (d0 < 0) ? -INFINITY : sc0[i] + BT[i0]; sc1[i] = (d1 < 0 || !two) ? -INFINITY : sc1[i] + BT[i1]; }
            }
            float mx = fmaxf(sc0[0], sc1[0]);
#pragma unroll
            for (int i = 1; i < 16; ++i) mx = fmaxf(mx, fmaxf(sc0[i], sc1[i]));
            mx = fmaxf(mx, __shfl_xor(mx, 32));
            const float mnew = fmaxf(mrun, mx), alpha = ex2(mrun - mnew);
            float sum = 0.f;
#pragma unroll
            for (int i = 0; i < 16; ++i) { const float e0 = ex2(sc0[i] - mnew), e1 = ex2(sc1[i] - mnew); sc0[i] = e0; sc1[i] = e1; sum += e0 + e1; }
            sum += __shfl_xor(sum, 32);
            lrun = lrun * alpha + sum; mrun = mnew;
            if (ANY(alpha != 1.f)) {
#pragma unroll
                for (int db = 0; db < 4; ++db)
#pragma unroll
                    for (int i = 0; i < 16; ++i) o[db][i] *= alpha; }
            pv_acc(o, sc0, buf, 0, lane); if (two) pv_acc(o, sc1, buf, 1, lane);
        }
        __syncthreads();
    }
    __syncthreads();
    const float inv = 1.f / lrun;
    LAS float* X = (LAS float*)(lds + ATT_X_OFF) + (qs * 32 + r) * 132;
    if (mp == 1) {
#pragma unroll
        for (int db = 0; db < 4; ++db)
#pragma unroll
            for (int g = 0; g < 4; ++g) { f32x4 v; v[0] = o[db][4 * g] * inv * lam_full; v[1] = o[db][4 * g + 1] * inv * lam_full; v[2] = o[db][4 * g + 2] * inv * lam_full; v[3] = o[db][4 * g + 3] * inv * lam_full;
                *(LAS f32x4*)(X + 32 * db + 8 * g + 4 * hh) = v; }
    }
    __syncthreads();
    if (mp == 0) {
        float ss = 0.f;
#pragma unroll
        for (int db = 0; db < 4; ++db)
#pragma unroll
            for (int g = 0; g < 4; ++g) { const f32x4 x1 = *(const LAS f32x4*)(X + 32 * db + 8 * g + 4 * hh);
#pragma unroll
                for (int e = 0; e < 4; ++e) { const float x = o[db][4 * g + e] * inv - x1[e]; o[db][4 * g + e] = x; ss += x * x; } }
        ss += __shfl_xor(ss, 32);
        const float rinv = frsq(ss * (1.f / 128.f) + RMS_EPS) * (1.f - lam_init);
        const float* sg = p->in[I_SUBLN] + (size_t)layer * 128;
        const bf16_t* gp = Z + (rowb + q) * ZLD + C_AG + h * 128; bf16_t* yp = (bf16_t*)(p->ws + WS_Y) + (rowb + q) * (4 * MIX) + 0 * MIX + h * 128;
#pragma unroll
        for (int db = 0; db < 4; ++db)
#pragma unroll
            for (int g = 0; g < 4; ++g) { const int d = 32 * db + 8 * g + 4 * hh; const u32x2 gw = *(const u32x2*)(gp + d); const f32x4 sv = *(const f32x4*)(sg + d);
                u32x2 w; w.x = pk2(o[db][4 * g] * rinv * sv[0] * fsilu(bflo(gw.x)), o[db][4 * g + 1] * rinv * sv[1] * fsilu(bfhi(gw.x)));
                w.y = pk2(o[db][4 * g + 2] * rinv * sv[2] * fsilu(bflo(gw.y)), o[db][4 * g + 3] * rinv * sv[3] * fsilu(bfhi(gw.y)));
                *(u32x2*)(yp + d) = w; }
    }
}

constexpr float SB_CUT = -110.f;
DI void phase_att_d(KP p, int layer, lptr lds, int unit) {
    const int tid = TID(), lane = tid & 63, wid = RFL(tid >> 6), r = lane & 31, hh = lane >> 5;
    constexpr int NQB = S / 256;
    const int qb = NQB - 1 - (unit / (NB * SH)), bh = unit % (NB * SH), h = bh % SH, b = bh / SH;
    const int q0 = qb * 256, qw0 = q0 + 32 * wid, q = qw0 + r;
    const bf16_t* Z = (const bf16_t*)(p->ws + WS_Z); const size_t rowb = (size_t)b * S;
    LAS int* FLG = (LAS int*)(lds + ATT_BT_OFF);
    bf16x8 qf[8];
    { const bf16_t* qp = Z + (rowb + q) * ZLD + C_SQ + h * 128 + 8 * hh; const float qsc = 0.08838834764831845f;
#pragma unroll
      for (int ds = 0; ds < 8; ++ds) { const u32x4 w = *(const u32x4*)(qp + 16 * ds);
          qf[ds] = pack8(bflo(w.x) * qsc, bfhi(w.x) * qsc, bflo(w.y) * qsc, bfhi(w.y) * qsc, bflo(w.z) * qsc, bfhi(w.z) * qsc, bflo(w.w) * qsc, bfhi(w.w) * qsc); } }
    f32x16 o[4];
#pragma unroll
    for (int db = 0; db < 4; ++db)
#pragma unroll
        for (int i = 0; i < 16; ++i) o[db][i] = 0.f;
    float carry = 0.f;
    const int kt_hi = (q0 + 255) / 64;
    __syncthreads();
    KVRegs rg; load_kv(rg, Z, rowb + (size_t)kt_hi * 64, C_SK + h * 128, C_SV + h * 128, tid);
    store_kv(rg, lds + (kt_hi & 1) * ATT_BUF, tid);
    if (kt_hi > 0) load_kv(rg, Z, rowb + (size_t)(kt_hi - 1) * 64, C_SK + h * 128, C_SV + h * 128, tid);
    __syncthreads();
    for (int kt = kt_hi; kt >= 0; --kt) {
        const int k0 = kt * 64; const lptr buf = lds + (kt & 1) * ATT_BUF;
        if (kt > 0) store_kv(rg, lds + ((kt - 1) & 1) * ATT_BUF, tid);
        if (kt > 1) load_kv(rg, Z, rowb + k0 - 128, C_SK + h * 128, C_SV + h * 128, tid);
        if (k0 < qw0 + 31) {
#pragma unroll 1
            for (int kh = 1; kh >= 0; --kh) {
                if (k0 + 32 * kh >= qw0 + 31) continue;
                f32x16 z;
#pragma unroll
                for (int i = 0; i < 16; ++i) z[i] = 0.f;
#pragma unroll
                for (int ds = 0; ds < 8; ++ds) { const bf16x8 a = *(const LAS bf16x8*)(buf + ATT_K_OFF + (32 * kh + r) * ATT_KSTR + ds * 32 + hh * 16); z = MFMA32(a, qf[ds], z); }
                f32x16 lk; float gsum[4];
#pragma unroll
                for (int g = 0; g < 4; ++g) { gsum[g] = 0.f;
#pragma unroll
                    for (int e = 0; e < 4; ++e) { const int i = 4 * g + e; const bool valid = (k0 + 32 * kh + crow(i, hh)) < q; const float sp = fsoftplus(z[i]);
                        lk[i] = valid ? -sp : 0.f; z[i] = valid ? (z[i] - sp) : -INFINITY; gsum[g] += lk[i]; } }
                float og[4];
#pragma unroll
                for (int g = 0; g < 4; ++g) og[g] = __shfl_xor(gsum[g], 32);
                float suf[4]; float run = 0.f;
#pragma unroll
                for (int g = 3; g >= 0; --g) {
                    if (hh == 1) { suf[g] = run; run += gsum[g] + og[g]; }
                    else { suf[g] = run + og[g]; run += gsum[g] + og[g]; }
                }
#pragma unroll
                for (int g = 0; g < 4; ++g) { float inner = 0.f;
#pragma unroll
                    for (int e = 3; e >= 0; --e) { const int i = 4 * g + e; const float between = carry + suf[g] + inner; inner += lk[i]; z[i] = ex2((z[i] + between) * LOG2E); } }
                carry += run;
                pv_acc(o, z, buf, kh, lane);
            }
        }
        const int active = ANY(carry > SB_CUT) ? 1 : 0;
        if (lane == 0) FLG[(kt & 1) * 8 + wid] = active;
        __syncthreads();
        int anyact = 0;
#pragma unroll
        for (int w = 0; w < 8; ++w) anyact |= FLG[(kt & 1) * 8 + w];
        if (!anyact) break;
    }
    const bf16_t* gp = Z + (rowb + q) * ZLD + C_SG + h * 128; bf16_t* yp = (bf16_t*)(p->ws + WS_Y) + (rowb + q) * (4 * MIX) + 3 * MIX + h * 128;
#pragma unroll
    for (int db = 0; db < 4; ++db)
#pragma unroll
        for (int g = 0; g < 4; ++g) { const int d = 32 * db + 8 * g + 4 * hh; const u32x2 gw = *(const u32x2*)(gp + d);
            u32x2 w; w.x = pk2(o[db][4 * g] * fsilu(bflo(gw.x)), o[db][4 * g + 1] * fsilu(bfhi(gw.x)));
            w.y = pk2(o[db][4 * g + 2] * fsilu(bflo(gw.y)), o[db][4 * g + 3] * fsilu(bfhi(gw.y)));
            *(u32x2*)(yp + d) = w; }
}
constexpr int HG_STR = 144;
constexpr int HG_QT = 0, HG_KT = 128 * HG_STR, HG_IT = 2 * 128 * HG_STR, HG_SC = 3 * 128 * HG_STR, HG_VEC = HG_SC + 64 * HG_STR;
DI bf16x8 hg_trfrag(lptr img, int col0, int dbase, int lane) {
    const int g = lane >> 4, i16 = lane & 15, qq = i16 >> 2, pp = i16 & 3;
    const lptr a = img + (dbase + 4 * g + qq) * HG_STR + (col0 + 4 * pp) * 2;
    return cat4(TR_READ(a), TR_READ(a + 16 * HG_STR));
}
constexpr int HG_NC = S / 64, HG_NCH = NB * HH * HG_NC;
DI void phase_hg_local(KP p, int layer, lptr lds, int unit) {
    const int tid = TID(), lane = tid & 63, wid = RFL(tid >> 6), g = lane >> 4, c16 = lane & 15;
    const int c = unit % HG_NC, bh = unit / HG_NC, h = bh % HH, b = bh / HH;
    const bf16_t* Z = (const bf16_t*)(p->ws + WS_Z); const size_t row0 = (size_t)b * S + (size_t)c * 64;
    const float* LBp = (const float*)(p->ws + SM_LB);
    LAS float* EBD = (LAS float*)(lds + HG_VEC); LAS float* QTOT = EBD + 128;
    const int ch = tid & 127, tq = tid >> 7;
    const float lb = LBp[(size_t)layer * MIX + h * 128 + ch], loglb = LBp[(size_t)(L + layer) * MIX + h * 128 + ch], log1m = LBp[(size_t)(2 * L + layer) * MIX + h * 128 + ch];
    __syncthreads();
    float bl[16], qv[16], kv[16], iv[16];
    { const bf16_t* zp = Z + (row0 + 16 * tq) * ZLD + h * 128 + ch; float run = 0.f;
#pragma unroll
      for (int t = 0; t < 16; ++t) { const float zq = bf2f(zp[(size_t)t * ZLD + C_HQ]), zf = bf2f(zp[(size_t)t * ZLD + C_HF]); iv[t] = bf2f(zp[(size_t)t * ZLD + C_HI]);
          const float ls = -fsoftplus(-zf);
          float lf; if (lb > 0.f) { const float a_ = loglb, b_ = log1m + ls, mx = fmaxf(a_, b_); lf = mx + flog(fexp(a_ - mx) + fexp(b_ - mx)); } else lf = ls;
          run += lf; bl[t] = run; qv[t] = zq; kv[t] = (1.f - lb) * fexp(ls - zf); }
      QTOT[tq * 128 + ch] = run; }
    __syncthreads();
    { const float t0 = QTOT[ch], t1 = QTOT[128 + ch], t2 = QTOT[256 + ch], t3 = QTOT[384 + ch];
      const float pre = (tq > 0 ? t0 : 0.f) + (tq > 1 ? t1 : 0.f) + (tq > 2 ? t2 : 0.f), bref = t0 + t1, blast = bref + t2 + t3;
      unsigned qw[8], kw[8], iw[8];
#pragma unroll
      for (int t = 0; t < 16; t += 2) { const float b0 = pre + bl[t] - bref, b1 = pre + bl[t + 1] - bref;
          qw[t >> 1] = pk2(qv[t] * fexp(b0), qv[t + 1] * fexp(b1)); kw[t >> 1] = pk2(kv[t] * fexp(-b0), kv[t + 1] * fexp(-b1)); iw[t >> 1] = pk2(iv[t], iv[t + 1]); }
      LAS u32x4* dq = (LAS u32x4*)(lds + HG_QT + ch * HG_STR + tq * 32); dq[0] = (u32x4){qw[0], qw[1], qw[2], qw[3]}; dq[1] = (u32x4){qw[4], qw[5], qw[6], qw[7]};
      LAS u32x4* dk = (LAS u32x4*)(lds + HG_KT + ch * HG_STR + tq * 32); dk[0] = (u32x4){kw[0], kw[1], kw[2], kw[3]}; dk[1] = (u32x4){kw[4], kw[5], kw[6], kw[7]};
      LAS u32x4* di = (LAS u32x4*)(lds + HG_IT + ch * HG_STR + tq * 32); di[0] = (u32x4){iw[0], iw[1], iw[2], iw[3]}; di[1] = (u32x4){iw[4], iw[5], iw[6], iw[7]};
      if (tq == 0) { float* VE = (float*)(p->ws + WS_HGVE) + (size_t)unit * 256; VE[ch] = fexp(bref); VE[128 + ch] = fexp(blast); EBD[ch] = fexp(blast - bref); } }
    __syncthreads();
#pragma unroll
    for (int k2 = 0; k2 < 2; ++k2) { const int ti = 2 * wid + k2, tb = ti >> 2, sb = ti & 3;
        f32x4 acc = (f32x4){0.f, 0.f, 0.f, 0.f};
        if (sb <= tb) {
#pragma unroll
            for (int dp = 0; dp < 4; ++dp) acc = MFMA16(hg_trfrag(lds + HG_QT, 16 * tb, 32 * dp, lane), hg_trfrag(lds + HG_KT, 16 * sb, 32 * dp, lane), acc); }
        const int s = 16 * sb + c16;
#pragma unroll
        for (int e = 0; e < 4; ++e) { const int t = 16 * tb + 4 * g + e; *(LAS bf16_t*)(lds + HG_SC + t * HG_STR + s * 2) = f2bf((s <= t) ? acc[e] : 0.f); }
        ((bf16x8*)(p->ws + WS_HGQF))[((size_t)unit * 16 + ti) * 64 + lane] = hg_trfrag(lds + HG_QT, 16 * (ti >> 2), 32 * (ti & 3), lane); }
    __syncthreads();
    bf16x8 ib[2];
#pragma unroll
    for (int ks = 0; ks < 2; ++ks) ib[ks] = *(const LAS bf16x8*)(lds + HG_IT + (16 * wid + c16) * HG_STR + (8 * g + 32 * ks) * 2);
    f32x4* IN = (f32x4*)(p->ws + WS_HGIN) + ((size_t)unit * 8 + wid) * 4 * 64;
#pragma unroll
    for (int tb = 0; tb < 4; ++tb) { f32x4 acc = (f32x4){0.f, 0.f, 0.f, 0.f};
#pragma unroll
        for (int ks = 0; ks < 2; ++ks) acc = MFMA16(*(const LAS bf16x8*)(lds + HG_SC + (16 * tb + c16) * HG_STR + (8 * g + 32 * ks) * 2), ib[ks], acc);
        IN[tb * 64 + lane] = acc; }
    f32x4* DS = (f32x4*)(p->ws + WS_HGDS) + ((size_t)unit * 8 + wid) * 8 * 64;
#pragma unroll
    for (int db = 0; db < 8; ++db) { f32x4 tmp = (f32x4){0.f, 0.f, 0.f, 0.f};
#pragma unroll
        for (int ks = 0; ks < 2; ++ks) tmp = MFMA16(*(const LAS bf16x8*)(lds + HG_KT + (16 * db + c16) * HG_STR + (8 * g + 32 * ks) * 2), ib[ks], tmp);
        const f32x4 ed = *(const LAS f32x4*)(EBD + 16 * db + 4 * g);
        DS[db * 64 + lane] = tmp * ed; }
}
DI void phase_hg_scan(KP p, int unit) {
    const int tid = TID(), lane = tid & 63, wid = RFL(tid >> 6), g = lane >> 4;
    f32x4 st[8];
#pragma unroll
    for (int db = 0; db < 8; ++db) st[db] = (f32x4){0.f, 0.f, 0.f, 0.f};
    const float* VE0 = (const float*)(p->ws + WS_HGVE) + (size_t)unit * HG_NC * 256;
    const f32x4* DS0 = (const f32x4*)(p->ws + WS_HGDS) + ((size_t)unit * HG_NC * 8 + wid) * 8 * 64 + lane;
    bf16x8* SF0 = (bf16x8*)(p->ws + WS_HGSF) + ((size_t)unit * HG_NC * 8 + wid) * 4 * 64 + lane;
    f32x4 ds[8], el[8], er[8];
#pragma unroll
    for (int db = 0; db < 8; ++db) { ds[db] = DS0[db * 64]; el[db] = *(const f32x4*)(VE0 + 128 + 16 * db + 4 * g); er[db] = *(const f32x4*)(VE0 + 16 * db + 4 * g); }
    for (int c = 0; c < HG_NC; ++c) {
        const int cn = (c + 1 < HG_NC) ? c + 1 : c;
        f32x4 dsn[8], eln[8], ern[8];
#pragma unroll
        for (int db = 0; db < 8; ++db) { dsn[db] = DS0[((size_t)cn * 8 * 8 + db) * 64]; eln[db] = *(const f32x4*)(VE0 + (size_t)cn * 256 + 128 + 16 * db + 4 * g); ern[db] = *(const f32x4*)(VE0 + (size_t)cn * 256 + 16 * db + 4 * g); }
#pragma unroll
        for (int dp = 0; dp < 4; ++dp) { const f32x4 a0 = st[2 * dp] * er[2 * dp], a1 = st[2 * dp + 1] * er[2 * dp + 1];
            SF0[((size_t)c * 8 * 4 + dp) * 64] = pack8(a0[0], a0[1], a0[2], a0[3], a1[0], a1[1], a1[2], a1[3]); }
#pragma unroll
        for (int db = 0; db < 8; ++db) { st[db] = el[db] * st[db] + ds[db]; ds[db] = dsn[db]; el[db] = eln[db]; er[db] = ern[db]; }
    }
}
DI void phase_hg_out(KP p, int layer, lptr lds, int unit) {
    const int tid = TID(), lane = tid & 63, wid = RFL(tid >> 6), g = lane >> 4, c16 = lane & 15;
    const int c = unit % HG_NC, bh = unit / HG_NC, h = bh % HH, b = bh / HH;
    const bf16_t* Z = (const bf16_t*)(p->ws + WS_Z); const size_t row0 = (size_t)b * S + (size_t)c * 64;
    LAS float* PS = (LAS float*)(lds + HG_VEC);
    const float gnorm = p->in[I_HGNORM][(size_t)layer * 128 + 16 * wid + c16];
    const bf16x8* QF = (const bf16x8*)(p->ws + WS_HGQF) + (size_t)unit * 16 * 64 + lane;
    const bf16x8* SF = (const bf16x8*)(p->ws + WS_HGSF) + ((size_t)unit * 8 + wid) * 4 * 64 + lane;
    const f32x4* IN = (const f32x4*)(p->ws + WS_HGIN) + ((size_t)unit * 8 + wid) * 4 * 64 + lane;
    bf16x8 sf[4];
#pragma unroll
    for (int dp = 0; dp < 4; ++dp) sf[dp] = SF[dp * 64];
    f32x4 ot[4];
#pragma unroll
    for (int tb = 0; tb < 4; ++tb) { f32x4 acc = IN[tb * 64];
#pragma unroll
        for (int dp = 0; dp < 4; ++dp) acc = MFMA16(QF[(tb * 4 + dp) * 64], sf[dp], acc);
        ot[tb] = acc; }
    if (c == 0 && g == 0) { const float* OEX = (const float*)(p->ws + WS_OEX) + (size_t)bh * FX_T * 128 + 16 * wid + c16;
#pragma unroll
        for (int e = 0; e < FX_T; ++e) ot[0][e] = OEX[e * 128]; }
    __syncthreads();
#pragma unroll
    for (int tb = 0; tb < 4; ++tb)
#pragma unroll
        for (int e = 0; e < 4; ++e) { float v = ot[tb][e] * ot[tb][e]; v += __shfl_xor(v, 1); v += __shfl_xor(v, 2); v += __shfl_xor(v, 4); v += __shfl_xor(v, 8);
            if (c16 == 0) PS[wid * 64 + 16 * tb + 4 * g + e] = v; }
    __syncthreads();
    const int e_col = h * 128 + 16 * wid + c16;
#pragma unroll
    for (int tb = 0; tb < 4; ++tb)
#pragma unroll
        for (int e = 0; e < 4; ++e) { const int t = 16 * tb + 4 * g + e; float ss = 0.f;
#pragma unroll
            for (int w = 0; w < 8; ++w) ss += PS[w * 64 + t];
            const float gate = bf2f(Z[(row0 + t) * ZLD + C_HG + e_col]);
            ((bf16_t*)(p->ws + WS_Y))[(row0 + t) * (4 * MIX) + 1 * MIX + e_col] = f2bf(ot[tb][e] * frsq(ss * (1.f / 128.f) + RMS_EPS) * gnorm * fsilu(gate)); }
}
DI f32x4 lerp4(const bf16_t* zc, const bf16_t* zp, bool hp, const float* mu) {
    const u32x2 c = *(const u32x2*)zc; u32x2 pv = (u32x2){0u, 0u}; if (hp) pv = *(const u32x2*)zp; const f32x4 m4 = *(const f32x4*)mu;
    f32x4 o; const float c0 = bflo(c.x), c1 = bfhi(c.x), c2 = bflo(c.y), c3 = bfhi(c.y);
    o[0] = c0 + (bflo(pv.x) - c0) * m4[0]; o[1] = c1 + (bfhi(pv.x) - c1) * m4[1]; o[2] = c2 + (bflo(pv.y) - c2) * m4[2]; o[3] = c3 + (bfhi(pv.y) - c3) * m4[3]; return o; }
DI void rw_prep_item(KP p, int layer, int item, int lane) {
    const int r = lane & 31, hh = lane >> 5;
    const int hd = item % RH, tt = item / RH;
    const size_t m = (size_t)tt * 32 + r; const int t = (int)(m % S), b = (int)(m / S); const bool hp = t > 0;
    const bf16_t* Z = (const bf16_t*)(p->ws + WS_Z); const bf16_t* zc = Z + m * ZLD; const bf16_t* zp = hp ? zc - ZLD : zc;
    const float* mu = p->in[I_MU] + (size_t)layer * RW_MIX;
    bf16x8 xw[4], xa[4], xv[2];
#pragma unroll
    for (int s = 0; s < 4; ++s) { const int jj = 16 * s + 8 * hh;
        const f32x4 w0v = lerp4(zc + C_RM + 3 * MIX + jj, zp + C_RM + 3 * MIX + jj, hp, mu + 3 * MIX + jj), w1v = lerp4(zc + C_RM + 3 * MIX + jj + 4, zp + C_RM + 3 * MIX + jj + 4, hp, mu + 3 * MIX + jj + 4);
        xw[s] = pack8(tanhf(w0v[0]), tanhf(w0v[1]), tanhf(w0v[2]), tanhf(w0v[3]), tanhf(w1v[0]), tanhf(w1v[1]), tanhf(w1v[2]), tanhf(w1v[3]));
        const f32x4 a0v = lerp4(zc + C_RM + 3 * MIX + 64 + jj, zp + C_RM + 3 * MIX + 64 + jj, hp, mu + 3 * MIX + 64 + jj), a1v = lerp4(zc + C_RM + 3 * MIX + 64 + jj + 4, zp + C_RM + 3 * MIX + 64 + jj + 4, hp, mu + 3 * MIX + 64 + jj + 4);
        xa[s] = pack8(a0v[0], a0v[1], a0v[2], a0v[3], a1v[0], a1v[1], a1v[2], a1v[3]); SCHED_FENCE(); }
    if (layer > 0) { const float* vmu = p->in[I_VMU] + (size_t)(layer - 1) * 32;
#pragma unroll
        for (int s = 0; s < 2; ++s) { const int jj = 16 * s + 8 * hh;
            const f32x4 v0v = lerp4(zc + C_VD + jj, zp + C_VD + jj, hp, vmu + jj), v1v = lerp4(zc + C_VD + jj + 4, zp + C_VD + jj + 4, hp, vmu + jj + 4);
            xv[s] = pack8(v0v[0], v0v[1], v0v[2], v0v[3], v1v[0], v1v[1], v1v[2], v1v[3]); } }
    else { xv[0] = xw[0]; xv[1] = xw[0]; }
    const bf16_t* W2T = (const bf16_t*)(p->ws + SM_W2T) + (size_t)layer * MIX * 64; const bf16_t* A2T = (const bf16_t*)(p->ws + SM_A2T) + (size_t)layer * MIX * 64;
    const bf16_t* V2T = (const bf16_t*)(p->ws + SM_V2T) + (size_t)layer * MIX * 32;
    float* SCI = (float*)(p->ws + WS_SCI) + (((size_t)b * RH + hd) * S + t) * 384;
    float* VF = (float*)(p->ws + WS_VF) + m * MIX;
    const float* w0 = p->in[I_W0] + (size_t)layer * MIX; const float* a0 = p->in[I_A0] + (size_t)layer * MIX; const float* kkp = p->in[I_KK] + (size_t)layer * MIX;
    const float* kap = p->in[I_KA] + (size_t)layer * MIX; const float* rkp = p->in[I_RK] + (size_t)layer * MIX; const float* v0 = p->in[I_V0] + (size_t)(layer > 0 ? layer - 1 : 0) * MIX;
    float ssq = 0.f;
#pragma unroll 1
    for (int cg = 0; cg < 8; ++cg) {
        const int ch = hd * 64 + 32 * (cg >> 2) + 8 * (cg & 3) + 4 * hh;
        const f32x4 k4 = lerp4(zc + C_RM + MIX + ch, zp + C_RM + MIX + ch, hp, mu + MIX + ch), kq = *(const f32x4*)(kkp + ch);
        ssq += (k4[0] * kq[0] * k4[0] * kq[0] + k4[1] * kq[1] * k4[1] * kq[1]) + (k4[2] * kq[2] * k4[2] * kq[2] + k4[3] * kq[3] * k4[3] * kq[3]); }
    ssq += __shfl_xor(ssq, 32);
    const float kinv = 1.f / fmaxf(sqrtf(ssq), 1e-12f);
    float bon = 0.f;
#pragma unroll 1
    for (int cb = 0; cb < 2; ++cb) {
        const int chA = hd * 64 + 32 * cb + r;
        f32x16 lw, la, lv;
#pragma unroll
        for (int i = 0; i < 16; ++i) { lw[i] = 0.f; la[i] = 0.f; lv[i] = 0.f; }
#pragma unroll
        for (int s = 0; s < 4; ++s) { lw = MFMA32(*(const bf16x8*)(W2T + (size_t)chA * 64 + 16 * s + 8 * hh), xw[s], lw);
                                      la = MFMA32(*(const bf16x8*)(A2T + (size_t)chA * 64 + 16 * s + 8 * hh), xa[s], la); }
        if (layer > 0) {
#pragma unroll
            for (int s = 0; s < 2; ++s) lv = MFMA32(*(const bf16x8*)(V2T + (size_t)chA * 32 + 16 * s + 8 * hh), xv[s], lv); }
#pragma unroll
        for (int gq = 0; gq < 4; ++gq) { f32x4 o_w, o_k, o_a, o_b; const int cl = 32 * cb + 8 * gq + 4 * hh, ch = hd * 64 + cl;
            const f32x4 r4 = lerp4(zc + C_RM + ch, zp + C_RM + ch, hp, mu + ch), k4 = lerp4(zc + C_RM + MIX + ch, zp + C_RM + MIX + ch, hp, mu + MIX + ch);
            f32x4 v4 = lerp4(zc + C_RM + 2 * MIX + ch, zp + C_RM + 2 * MIX + ch, hp, mu + 2 * MIX + ch);
            const f32x4 w04 = *(const f32x4*)(w0 + ch), a04 = *(const f32x4*)(a0 + ch), kq = *(const f32x4*)(kkp + ch), ka4 = *(const f32x4*)(kap + ch), rk4 = *(const f32x4*)(rkp + ch);
            if (layer == 0) { if (t >= FX_T) *(f32x4*)(VF + ch) = v4; }
            else { const f32x4 vf = *(const f32x4*)(VF + ch), v04 = *(const f32x4*)(v0 + ch);
#pragma unroll
                for (int e = 0; e < 4; ++e) v4[e] = v4[e] + (vf[e] - v4[e]) * fsigmoid(v04[e] + lv[4 * gq + e]); }
#pragma unroll
            for (int e = 0; e < 4; ++e) { const int i = 4 * gq + e;
                const float wlog = -fsoftplus(-(w04[e] + lw[i])) - 0.5f; o_w[e] = fexp(-fexp(wlog));
                const float a = fsigmoid(a04[e] + la[i]);
                const float kk = k4[e] * kq[e] * kinv; const float k2 = k4[e] * (1.f + (a - 1.f) * ka4[e]);
                bon += r4[e] * k2 * rk4[e];
                o_k[e] = k2; o_a[e] = -kk; o_b[e] = kk * a; }
            if (t >= FX_T) {
            *(f32x4*)(SCI + 0 * 64 + cl) = r4; *(f32x4*)(SCI + 1 * 64 + cl) = o_w; *(f32x4*)(SCI + 2 * 64 + cl) = o_k;
            *(f32x4*)(SCI + 3 * 64 + cl) = v4; *(f32x4*)(SCI + 4 * 64 + cl) = o_a; *(f32x4*)(SCI + 5 * 64 + cl) = o_b; } SCHED_FENCE(); }
    }
    bon += __shfl_xor(bon, 32);
    if (hh == 0 && t >= FX_T) ((float*)(p->ws + WS_BON))[m * RH + hd] = bon;
}
DI void phase_rw_prep(KP p, int layer) {
    const int tid = TID(), lane = tid & 63, wave = tid >> 6;
    constexpr int NITEM = (M / 32) * RH;
    for (int it = blockIdx.x * 8 + wave; it < NITEM; it += gridDim.x * 8) rw_prep_item(p, layer, it, lane);
}

constexpr int RC_GT = 0, RC_SL = 8192, RC_RH = 16384, RC_OL = 18432, RC_GAM = 22528, RC_BYTES = 22784;
constexpr int RC_NSUB = S / 16;
DI bf16x8 frag4_lds(lptr p) { const u32x2 w = *(const LAS u32x2*)p; u32x4 o; o.x = w.x; o.y = w.y; o.z = 0u; o.w = 0u; return __builtin_bit_cast(bf16x8, o); }
DI bf16x8 frag4_acc(const f32x4& x) { u32x4 o; o.x = pk2(x[0], x[1]); o.y = pk2(x[2], x[3]); o.z = 0u; o.w = 0u; return __builtin_bit_cast(bf16x8, o); }
DI void rw_local_item(KP p, lptr wl, int item, int lane) {
    const int j = item % RC_NSUB, bh = item / RC_NSUB, g = lane >> 4, c16 = lane & 15;
    const float* SCI = (const float*)(p->ws + WS_SCI) + ((size_t)bh * S + (size_t)j * 16) * 384;
    unsigned char* rec = p->ws + WS_RC + (size_t)item * RC_BYTES;
    { float at[16], vt[16], bt[16], kt[16]; float lw = 0.f, gp = 1.f;
#pragma unroll
      for (int t = 0; t < 16; ++t) { const float* s = SCI + t * 384 + lane; const float rr = s[0], w = s[64], k = s[128], v = s[192], a = s[256], b = s[320];
          lw += flog(w); const float gt = fexp(lw), gi = fexp(-lw);
          at[t] = a * gp; vt[t] = v; bt[t] = b * gi; kt[t] = k * gi; gp = gt;
          *(LAS bf16_t*)(wl + t * 128 + lane * 2) = f2bf(at[t]); *(LAS bf16_t*)(wl + 2048 + t * 128 + lane * 2) = f2bf(rr * gt);
          *(LAS bf16_t*)(wl + 4096 + t * 128 + lane * 2) = f2bf(bt[t]); *(LAS bf16_t*)(wl + 6144 + t * 128 + lane * 2) = f2bf(kt[t]); }
      ((float*)(rec + RC_GAM))[lane] = gp;
#pragma unroll
      for (int hfl = 0; hfl < 2; ++hfl) { u32x4 w0, w1, w2, w3; const int t0 = 8 * hfl;
          w0.x = pk2(at[t0], at[t0 + 1]); w0.y = pk2(at[t0 + 2], at[t0 + 3]); w0.z = pk2(at[t0 + 4], at[t0 + 5]); w0.w = pk2(at[t0 + 6], at[t0 + 7]);
          w1.x = pk2(vt[t0], vt[t0 + 1]); w1.y = pk2(vt[t0 + 2], vt[t0 + 3]); w1.z = pk2(vt[t0 + 4], vt[t0 + 5]); w1.w = pk2(vt[t0 + 6], vt[t0 + 7]);
          w2.x = pk2(bt[t0] * gp, bt[t0 + 1] * gp); w2.y = pk2(bt[t0 + 2] * gp, bt[t0 + 3] * gp); w2.z = pk2(bt[t0 + 4] * gp, bt[t0 + 5] * gp); w2.w = pk2(bt[t0 + 6] * gp, bt[t0 + 7] * gp);
          w3.x = pk2(kt[t0] * gp, kt[t0 + 1] * gp); w3.y = pk2(kt[t0 + 2] * gp, kt[t0 + 3] * gp); w3.z = pk2(kt[t0 + 4] * gp, kt[t0 + 5] * gp); w3.w = pk2(kt[t0 + 6] * gp, kt[t0 + 7] * gp);
          *(LAS u32x4*)(wl + 8192 + lane * 32 + 16 * hfl) = w0; *(LAS u32x4*)(wl + 10240 + lane * 32 + 16 * hfl) = w1;
          *(LAS u32x4*)(wl + 12288 + lane * 32 + 16 * hfl) = w2; *(LAS u32x4*)(wl + 14336 + lane * 32 + 16 * hfl) = w3; } }
    WAVE_SYNC();
    f32x4 nab = (f32x4){0.f, 0.f, 0.f, 0.f}, nak = nab, mrb = nab, mrk = nab;
#pragma unroll
    for (int ks = 0; ks < 2; ++ks) { const int off = c16 * 128 + (32 * ks + 8 * g) * 2;
        const bf16x8 fa = *(const LAS bf16x8*)(wl + off), fr = *(const LAS bf16x8*)(wl + 2048 + off), fb = *(const LAS bf16x8*)(wl + 4096 + off), fk = *(const LAS bf16x8*)(wl + 6144 + off);
        nab = MFMA16(fa, fb, nab); nak = MFMA16(fa, fk, nak); mrb = MFMA16(fr, fb, mrb); mrk = MFMA16(fr, fk, mrk); }
    f32x4 rt[4];
#pragma unroll
    for (int cb = 0; cb < 4; ++cb)
#pragma unroll
        for (int e = 0; e < 4; ++e) rt[cb][e] = bf2f(*(const LAS bf16_t*)(wl + 2048 + (4 * g + e) * 128 + (16 * cb + c16) * 2));
    WAVE_SYNC();
#pragma unroll
    for (int e = 0; e < 4; ++e) { const int t = 4 * g + e, i = c16;
        *(LAS float*)(wl + (t * 16 + i) * 4) = (i < t) ? nab[e] : 0.f;
        *(LAS bf16_t*)(wl + 1024 + (t * 16 + i) * 2) = f2bf((i < t) ? nak[e] : 0.f);
        *(LAS bf16_t*)(wl + 1536 + (t * 16 + i) * 2) = f2bf((i <= t) ? mrb[e] : 0.f);
        *(LAS bf16_t*)(wl + 2048 + (t * 16 + i) * 2) = f2bf((i <= t) ? mrk[e] : 0.f); }
    WAVE_SYNC();
    { float tr[16];
#pragma unroll
      for (int t = 0; t < 16; ++t) { float acc = (c16 == t) ? 1.f : 0.f;
#pragma unroll
          for (int s = 0; s < t; ++s) acc += *(const LAS float*)(wl + (t * 16 + s) * 4) * tr[s];
          tr[t] = acc; if (g == 0) *(LAS bf16_t*)(wl + 2560 + (t * 16 + c16) * 2) = f2bf(acc); } }
    WAVE_SYNC();
    const bf16x8 tf = frag4_lds(wl + 2560 + c16 * 32 + 8 * g), nakf = frag4_lds(wl + 1024 + c16 * 32 + 8 * g), mrbf = frag4_lds(wl + 1536 + c16 * 32 + 8 * g), mrkf = frag4_lds(wl + 2048 + c16 * 32 + 8 * g);
    const f32x4 z4 = (f32x4){0.f, 0.f, 0.f, 0.f};
    bf16x8 ahf[4], plf[4];
#pragma unroll
    for (int cb = 0; cb < 4; ++cb) { const f32x4 ah = MFMA16(tf, frag4_lds(wl + 8192 + (16 * cb + c16) * 32 + 8 * g), z4); ahf[cb] = frag4_acc(ah);
        const f32x4 rh = MFMA16(mrbf, ahf[cb], rt[cb]);
#pragma unroll
        for (int e = 0; e < 4; ++e) ((bf16_t*)(rec + RC_RH))[(4 * g + e) * 64 + 16 * cb + c16] = f2bf(rh[e]); }
#pragma unroll
    for (int vb = 0; vb < 4; ++vb) { const bf16x8 vf = frag4_lds(wl + 10240 + (16 * vb + c16) * 32 + 8 * g);
        const f32x4 q = MFMA16(nakf, vf, z4); const f32x4 pl = MFMA16(tf, frag4_acc(q), z4); plf[vb] = frag4_acc(pl);
        f32x4 ol = MFMA16(mrbf, plf[vb], z4); ol = MFMA16(mrkf, vf, ol);
        ((f32x4*)(rec + RC_OL))[vb * 64 + lane] = ol; }
#pragma unroll
    for (int kb2 = 0; kb2 < 4; ++kb2) { const bf16x8 bbf = frag4_lds(wl + 12288 + (16 * kb2 + c16) * 32 + 8 * g), kkf = frag4_lds(wl + 14336 + (16 * kb2 + c16) * 32 + 8 * g);
#pragma unroll
        for (int kb = 0; kb < 4; ++kb) { const f32x4 gp4 = MFMA16(ahf[kb], bbf, z4);
            u32x2 w; w.x = pk2(gp4[0], gp4[1]); w.y = pk2(gp4[2], gp4[3]); *(u32x2*)((bf16_t*)(rec + RC_GT) + (16 * kb2 + c16) * 64 + 16 * kb + 4 * g) = w; }
#pragma unroll
        for (int vb = 0; vb < 4; ++vb) { f32x4 sl = MFMA16(plf[vb], bbf, z4); sl = MFMA16(frag4_lds(wl + 10240 + (16 * vb + c16) * 32 + 8 * g), kkf, sl);
            u32x2 w; w.x = pk2(sl[0], sl[1]); w.y = pk2(sl[2], sl[3]); ((u32x2*)(rec + RC_SL))[(vb * 4 + kb2) * 64 + lane] = w; } }
    WAVE_SYNC();
}
DI void phase_rw_local(KP p, lptr lds) {
    const int tid = TID(), lane = tid & 63, wave = RFL(tid >> 6);
    constexpr int NITEM = NB * RH * RC_NSUB;
    for (int it = blockIdx.x * 8 + wave; it < NITEM; it += gridDim.x * 8) rw_local_item(p, lds + wave * 16384, it, lane);
}
constexpr int RS_STR = 144;
DI void phase_rw_scan(KP p, lptr lds, int unit) {
    const int tid = TID(), lane = tid & 63, wid = RFL(tid >> 6), g = lane >> 4, c16 = lane & 15;
    const int vb = wid >> 1, kb0 = 2 * (wid & 1), hd = unit % RH, b = unit / RH;
    const unsigned char* rec0 = p->ws + WS_RC + (size_t)unit * RC_NSUB * RC_BYTES;
    float* SCO = (float*)(p->ws + WS_SCO) + (size_t)b * S * MIX + hd * 64;
    f32x4 st[2]; st[0] = (f32x4){0.f, 0.f, 0.f, 0.f}; st[1] = st[0];
    __syncthreads();
    for (int j = 0; j < RC_NSUB; ++j) { const unsigned char* rec = rec0 + (size_t)j * RC_BYTES; const lptr img = lds + (j & 1) * (64 * RS_STR);
        bf16x8 gt[2][2]; u32x2 slw[2]; float gam[2];
#pragma unroll
        for (int tl = 0; tl < 2; ++tl) { const int kcol = 16 * (kb0 + tl) + c16;
#pragma unroll
            for (int ks = 0; ks < 2; ++ks) gt[tl][ks] = *(const bf16x8*)((const bf16_t*)(rec + RC_GT) + kcol * 64 + 32 * ks + 8 * g);
            slw[tl] = ((const u32x2*)(rec + RC_SL))[(vb * 4 + kb0 + tl) * 64 + lane]; gam[tl] = ((const float*)(rec + RC_GAM))[kcol]; }
        bf16x8 rh[2]; f32x4 ol = (f32x4){0.f, 0.f, 0.f, 0.f};
        if (wid < 4) {
#pragma unroll
            for (int ks = 0; ks < 2; ++ks) rh[ks] = *(const bf16x8*)((const bf16_t*)(rec + RC_RH) + c16 * 64 + 32 * ks + 8 * g);
            ol = ((const f32x4*)(rec + RC_OL))[wid * 64 + lane]; }
#pragma unroll
        for (int tl = 0; tl < 2; ++tl)
#pragma unroll
            for (int e = 0; e < 4; ++e) *(LAS bf16_t*)(img + (16 * vb + 4 * g + e) * RS_STR + (16 * (kb0 + tl) + c16) * 2) = f2bf(st[tl][e]);
        __syncthreads();
        bf16x8 af[2];
#pragma unroll
        for (int ks = 0; ks < 2; ++ks) af[ks] = *(const LAS bf16x8*)(img + (16 * vb + c16) * RS_STR + (32 * ks + 8 * g) * 2);
        if (wid < 4) {
            f32x4 o = ol;
#pragma unroll
            for (int ks = 0; ks < 2; ++ks) o = MFMA16(rh[ks], *(const LAS bf16x8*)(img + (16 * wid + c16) * RS_STR + (32 * ks + 8 * g) * 2), o);
#pragma unroll
            for (int e = 0; e < 4; ++e) SCO[(size_t)(16 * j + 4 * g + e) * MIX + 16 * wid + c16] = o[e]; }
#pragma unroll
        for (int tl = 0; tl < 2; ++tl) { f32x4 nw = (f32x4){0.f, 0.f, 0.f, 0.f};
#pragma unroll
            for (int ks = 0; ks < 2; ++ks) nw = MFMA16(af[ks], gt[tl][ks], nw);
            st[tl][0] = st[tl][0] * gam[tl] + nw[0] + bflo(slw[tl].x); st[tl][1] = st[tl][1] * gam[tl] + nw[1] + bfhi(slw[tl].x);
            st[tl][2] = st[tl][2] * gam[tl] + nw[2] + bflo(slw[tl].y); st[tl][3] = st[tl][3] * gam[tl] + nw[3] + bfhi(slw[tl].y); }
    }
}

DI void phase_rw_post(KP p, int layer) {
    const size_t gt = (size_t)blockIdx.x * 512 + TID(), NGT = (size_t)gridDim.x * 512;
    const bf16_t* Z = (const bf16_t*)(p->ws + WS_Z); const float* SCO = (const float*)(p->ws + WS_SCO); const float* BON = (const float*)(p->ws + WS_BON);
    const float* lg = p->in[I_LNXG] + (size_t)layer * MIX; const float* lbv = p->in[I_LNXB] + (size_t)layer * MIX;
    for (size_t i = gt; i < (size_t)M * (MIX / 16); i += NGT) { const size_t m = i / (MIX / 16); const int c0 = (int)(i % (MIX / 16)) * 16, hd = c0 >> 6; const int t = (int)(m % S), b = (int)(m / S);
        float o[16]; float s1 = 0.f; const float* osrc = (t < FX_T) ? (const float*)(p->ws + WS_OEXC) + ((size_t)b * FX_T + t) * MIX + c0 : SCO + m * MIX + c0;
#pragma unroll
        for (int j = 0; j < 4; ++j) { const f32x4 v = *(const f32x4*)(osrc + 4 * j); o[4 * j] = v[0]; o[4 * j + 1] = v[1]; o[4 * j + 2] = v[2]; o[4 * j + 3] = v[3]; s1 += (v[0] + v[1]) + (v[2] + v[3]); }
        s1 += __shfl_xor(s1, 1); s1 += __shfl_xor(s1, 2); const float mean = s1 * (1.f / 64.f); float s2 = 0.f;
#pragma unroll
        for (int j = 0; j < 16; ++j) { o[j] -= mean; s2 += o[j] * o[j]; }
        s2 += __shfl_xor(s2, 1); s2 += __shfl_xor(s2, 2); const float rstd = frsq(s2 * (1.f / 64.f) + RW_LN_EPS);
        const float bon = BON[m * RH + hd]; const float* vsrc = (const float*)(p->ws + WS_SCI) + (((size_t)b * RH + hd) * S + t) * 384 + 192 + (c0 & 63);
        const bf16_t* gp = Z + m * ZLD + C_RG + c0; bf16_t* yp = (bf16_t*)(p->ws + WS_Y) + m * (4 * MIX) + 2 * MIX + c0;
        unsigned w[8];
#pragma unroll
        for (int j = 0; j < 16; j += 2) { const float y0 = (o[j] * rstd * lg[c0 + j] + lbv[c0 + j] + bon * vsrc[j]) * fsilu(bf2f(gp[j])), y1 = (o[j + 1] * rstd * lg[c0 + j + 1] + lbv[c0 + j + 1] + bon * vsrc[j + 1]) * fsilu(bf2f(gp[j + 1]));
            w[j >> 1] = pk2(y0, y1); }
        *(u32x4*)(yp) = (u32x4){w[0], w[1], w[2], w[3]}; *(u32x4*)(yp + 8) = (u32x4){w[4], w[5], w[6], w[7]}; }
}

DI void phase_ln(KP p, int layer) {
    const int tid = TID(), lane = tid & 63, wave = tid >> 6;
    const float alpha = sqrtf(sqrtf(2.f * (float)L));
    const float* hprev = (layer == 0) ? p->in[I_X] : (const float*)(p->ws + WS_H); const float* outf = (const float*)(p->ws + WS_OUTF);
    float* hnew = (layer == L - 1) ? p->out : (float*)(p->ws + WS_H); bf16_t* xn = (bf16_t*)(p->ws + WS_XN);
    const float* lg = p->in[I_LNG] + (size_t)layer * D; const float* lbv = p->in[I_LNB] + (size_t)layer * D;
    constexpr int NV = D / 256;
    for (size_t m = (size_t)blockIdx.x * 8 + wave; m < (size_t)M; m += (size_t)gridDim.x * 8) {
        f32x4 v[NV]; float s = 0.f;
#pragma unroll
        for (int j = 0; j < NV; ++j) { const f32x4 a = *(const f32x4*)(hprev + m * D + 256 * j + 4 * lane), o = *(const f32x4*)(outf + m * D + 256 * j + 4 * lane); v[j] = a * alpha + o; s += (v[j][0] + v[j][1]) + (v[j][2] + v[j][3]); }
#pragma unroll
        for (int o = 1; o < 64; o <<= 1) s += __shfl_xor(s, o);
        const float mean = s * (1.f / D); float s2 = 0.f;
#pragma unroll
        for (int j = 0; j < NV; ++j) { v[j] = v[j] - mean; s2 += (v[j][0] * v[j][0] + v[j][1] * v[j][1]) + (v[j][2] * v[j][2] + v[j][3] * v[j][3]); }
#pragma unroll
        for (int o = 1; o < 64; o <<= 1) s2 += __shfl_xor(s2, o);
        const float rstd = 1.f / sqrtf(s2 * (1.f / D) + LN_EPS);
#pragma unroll
        for (int j = 0; j < NV; ++j) { const f32x4 g4 = *(const f32x4*)(lg + 256 * j + 4 * lane), b4 = *(const f32x4*)(lbv + 256 * j + 4 * lane); const f32x4 y = v[j] * rstd * g4 + b4;
            *(f32x4*)(hnew + m * D + 256 * j + 4 * lane) = y; u32x2 w; w.x = pk2(y[0], y[1]); w.y = pk2(y[2], y[3]); *(u32x2*)(xn + m * D + 256 * j + 4 * lane) = w; }
    }
}
constexpr int FX_NS_HG = 3 * MIX / 64, FX_NS_RW = RW_MIX / 64, FX_NSTRIP = FX_NS_HG + FX_NS_RW + 1;
DI void phase_fx_project(KP p, int layer, lptr lds, int strip) {
    const int tid = TID(), c = tid & 63, kg = tid >> 6;
    const float* hsrc = (layer == 0) ? p->in[I_X] : (const float*)(p->ws + WS_H);
    LAS float* HR = (LAS float*)lds;
    __syncthreads();
    for (int i = tid; i < FX_ROWS * D / 4; i += 512) { const int r = i / (D / 4), k4 = i % (D / 4); const size_t m = (size_t)(r / FX_T) * S + (r % FX_T);
        *(LAS f32x4*)(HR + r * D + 4 * k4) = *(const f32x4*)(hsrc + m * D + 4 * k4); }
    __syncthreads();
    int col0, ncol, ldw; const float* W;
    if (strip < FX_NS_HG) { col0 = C_HQ + 64 * strip; ncol = 64; ldw = IN_COLS; W = p->in[I_WIN] + (size_t)layer * D * IN_COLS + col0; }
    else if (strip < FX_NS_HG + FX_NS_RW) { col0 = C_RM + 64 * (strip - FX_NS_HG); ncol = 64; ldw = IN_COLS; W = p->in[I_WIN] + (size_t)layer * D * IN_COLS + col0; }
    else { col0 = C_VD; ncol = 32; ldw = 32; W = p->in[I_V1] + (size_t)(layer > 0 ? layer - 1 : 0) * D * 32; if (layer == 0) ncol = 0; }
    float acc[FX_ROWS];
#pragma unroll
    for (int r = 0; r < FX_ROWS; ++r) acc[r] = 0.f;
    if (c < ncol) {
        for (int k = kg * (D / 8); k < (kg + 1) * (D / 8); ++k) { const float w = W[(size_t)k * ldw + c];
#pragma unroll
            for (int r = 0; r < FX_ROWS; ++r) acc[r] += HR[r * D + k] * w; } }
    __syncthreads();
    LAS float* RED = (LAS float*)lds;
#pragma unroll
    for (int r = 0; r < FX_ROWS; ++r) RED[(kg * FX_ROWS + r) * 64 + c] = acc[r];
    __syncthreads();
    for (int i = tid; i < FX_ROWS * 64; i += 512) { const int r = i >> 6, cc = i & 63; float s = 0.f;
#pragma unroll
        for (int g = 0; g < 8; ++g) s += RED[(g * FX_ROWS + r) * 64 + cc];
        if (cc < ncol) ((float*)(p->ws + WS_ZF))[(size_t)r * ZLD + col0 + cc] = s; }
}
DI float wave_sum64(float v) {
#pragma unroll
    for (int o = 1; o < 64; o <<= 1) v += __shfl_xor(v, o);
    return v; }
DI void fx_rwkv(KP p, int layer, int item, int lane) {
    const int hd = item % RH, b = item / RH, ch = hd * 64 + lane;
    const float* ZF = (const float*)(p->ws + WS_ZF) + (size_t)b * FX_T * ZLD;
    const float* mu = p->in[I_MU] + (size_t)layer * RW_MIX;
    const float mur = mu[ch], muk = mu[MIX + ch], muv = mu[2 * MIX + ch], muw = mu[3 * MIX + lane], mua = mu[3 * MIX + 64 + lane];
    const float muvd = (layer > 0 && lane < 32) ? p->in[I_VMU][(size_t)(layer - 1) * 32 + lane] : 0.f;
    const float* w2 = p->in[I_W2] + (size_t)layer * 64 * MIX + ch; const float* a2 = p->in[I_A2] + (size_t)layer * 64 * MIX + ch;
    const float* v2 = p->in[I_V2] + (size_t)(layer > 0 ? layer - 1 : 0) * 32 * MIX + ch;
    const float w0 = p->in[I_W0][(size_t)layer * MIX + ch], a0 = p->in[I_A0][(size_t)layer * MIX + ch], kq = p->in[I_KK][(size_t)layer * MIX + ch], ka = p->in[I_KA][(size_t)layer * MIX + ch], rk = p->in[I_RK][(size_t)layer * MIX + ch];
    const float v0 = p->in[I_V0][(size_t)(layer > 0 ? layer - 1 : 0) * MIX + ch];
    float rv[FX_T], kv[FX_T], vv[FX_T], tw[FX_T], ad[FX_T], vd[FX_T];
    { float pr = 0.f, pk = 0.f, pv = 0.f, pw = 0.f, pa = 0.f, pvd = 0.f;
#pragma unroll
      for (int t = 0; t < FX_T; ++t) { const float* z = ZF + (size_t)t * ZLD;
          const float cr = z[C_RM + ch], ck = z[C_RM + MIX + ch], cv = z[C_RM + 2 * MIX + ch], cw = z[C_RM + 3 * MIX + lane], ca = z[C_RM + 3 * MIX + 64 + lane], cvd = (layer > 0 && lane < 32) ? z[C_VD + lane] : 0.f;
          rv[t] = cr + (pr - cr) * mur; kv[t] = ck + (pk - ck) * muk; vv[t] = cv + (pv - cv) * muv;
          tw[t] = tanhf(cw + (pw - cw) * muw); ad[t] = ca + (pa - ca) * mua; vd[t] = cvd + (pvd - cvd) * muvd;
          pr = cr; pk = ck; pv = cv; pw = cw; pa = ca; pvd = cvd; } }
    float lwv[FX_T], lav[FX_T], lvv[FX_T];
#pragma unroll
    for (int t = 0; t < FX_T; ++t) { lwv[t] = 0.f; lav[t] = 0.f; lvv[t] = 0.f; }
#pragma unroll 8
    for (int j = 0; j < 64; ++j) { const float w2j = w2[(size_t)j * MIX], a2j = a2[(size_t)j * MIX];
#pragma unroll
        for (int t = 0; t < FX_T; ++t) { lwv[t] += __shfl(tw[t], j) * w2j; lav[t] += __shfl(ad[t], j) * a2j; } }
    if (layer > 0) {
#pragma unroll 8
        for (int j = 0; j < 32; ++j) { const float v2j = v2[(size_t)j * MIX];
#pragma unroll
            for (int t = 0; t < FX_T; ++t) lvv[t] += __shfl(vd[t], j) * v2j; } }
    float xs[2 * FX_T - 1], ys[2 * FX_T - 1];
#pragma unroll
    for (int t = 0; t < FX_T; ++t) { const float r = rv[t], k = kv[t], lw = lwv[t], la = lav[t], lv = lvv[t]; float v = vv[t];
        const float wlog = -(fmaxf(-(w0 + lw), 0.f) + log1pf(expf(-fabsf(w0 + lw)))) - 0.5f, decay = expf(-expf(wlog));
        const float a = 1.f / (1.f + expf(-(a0 + la)));
        const size_t m = (size_t)b * S + t; float* VF = (float*)(p->ws + WS_VF) + m * MIX;
        if (layer == 0) VF[ch] = v; else { const float vf = VF[ch]; v = v + (vf - v) / (1.f + expf(-(v0 + lv))); }
        float kk = k * kq; const float nrm = sqrtf(wave_sum64(kk * kk)); kk = kk / fmaxf(nrm, 1e-12f);
        const float k2 = k * (1.f + (a - 1.f) * ka);
        const float bon = wave_sum64(r * k2 * rk);
        float* SCI = (float*)(p->ws + WS_SCI) + (((size_t)b * RH + hd) * S + t) * 384;
        SCI[lane] = r; SCI[64 + lane] = decay; SCI[128 + lane] = k2; SCI[192 + lane] = v; SCI[256 + lane] = -kk; SCI[320 + lane] = kk * a;
        if (lane == 0) ((float*)(p->ws + WS_BON))[m * RH + hd] = bon;
        { const float an = -kk, bn = kk * a; float sa = 0.f, ov = 0.f;
          const int nt = (t == 0) ? 0 : 2 * t - 1;
#pragma unroll
          for (int i = 0; i < 2 * FX_T - 1; ++i) if (i < nt) { sa += xs[i] * wave_sum64(ys[i] * an); ys[i] *= decay; ov += xs[i] * wave_sum64(ys[i] * r); }
          if (t > 0) { ov += sa * wave_sum64(bn * r); }
          ov += v * wave_sum64(k2 * r);
#pragma unroll
          for (int i = 0; i < 2 * FX_T - 1; ++i) { if (t > 0 && i == nt) { xs[i] = sa; ys[i] = bn; } if (i == ((t == 0) ? 0 : nt + 1)) { xs[i] = v; ys[i] = k2; } }
          ((float*)(p->ws + WS_OEXC))[((size_t)b * FX_T + t) * MIX + ch] = ov; } }
}
DI void fx_hgrn(KP p, int layer, int item, int lane) {
    const int h = item % HH, b = item / HH;
    const float* ZF = (const float*)(p->ws + WS_ZF) + (size_t)b * FX_T * ZLD; const float* LBp = (const float*)(p->ws + SM_LB);
    float q[FX_T][2], kx[FX_T][2], Bc[FX_T][2], iv[FX_T][2];
#pragma unroll
    for (int u = 0; u < 2; ++u) { const int d = h * 128 + lane + 64 * u; const float lb = LBp[(size_t)layer * MIX + d]; float run = 0.f;
#pragma unroll
        for (int t = 0; t < FX_T; ++t) { const float* z = ZF + (size_t)t * ZLD; const float zf = z[C_HF + d]; q[t][u] = z[C_HQ + d]; iv[t][u] = z[C_HI + d];
            const float sg = 1.f / (1.f + expf(-zf)); run += logf(lb + (1.f - lb) * sg); Bc[t][u] = run; kx[t][u] = (1.f - lb) * (1.f - sg); } }
    float* OEX = (float*)(p->ws + WS_OEX) + (size_t)item * FX_T * 128;
#pragma unroll
    for (int t = 0; t < FX_T; ++t) { float o0 = 0.f, o1 = 0.f;
#pragma unroll
        for (int s = 0; s <= t; ++s) { const float c = wave_sum64(q[t][0] * kx[s][0] * expf(Bc[t][0] - Bc[s][0]) + q[t][1] * kx[s][1] * expf(Bc[t][1] - Bc[s][1])); o0 += c * iv[s][0]; o1 += c * iv[s][1]; }
        OEX[t * 128 + lane] = o0; OEX[t * 128 + 64 + lane] = o1; }
}
DI void phase_fx_fix(KP p, int layer) {
    const int tid = TID(), lane = tid & 63, gw = blockIdx.x * 8 + (tid >> 6), NGW = gridDim.x * 8;
    for (int it = gw; it < NB * RH + NB * HH; it += NGW) { if (it < NB * RH) fx_rwkv(p, layer, it, lane); else fx_hgrn(p, layer, it - NB * RH, lane); }
}
constexpr int NWAVES = 8, LDS_RING = 131072, MISC_OFF = LDS_RING + 320, LDS_BYTES = 147456;
constexpr int CW_BAR = 4096, CW_WQ = 16384;
enum { PH_INPROJ = 0, PH_RWPREP, PH_RWLOC, PH_MIX, PH_RWPOST, PH_BRANCH, PH_SUM, PH_OUT, PH_LN, PH_COUNT };
constexpr int U_SCAN = NB * RH, U_HG = NB * HH, U_HGC = NB * HH * (S / 64), U_AA = NB * AH * (S / 128), U_AD = NB * SH * (S / 256), U_MIX = U_SCAN + U_HG + U_AA + U_AD;

struct Args { Params p; int do_pro, l_lo, l_hi, ph_lo, ph_hi, mega, pad0, pad1; };

#ifndef EMU
#define XB_TMO      128
#define XB_XCNT(j)  (256  + 64 * (j))
#define XB_XSUB(j)  (1280 + 64 * (j))
#define XB_XGEN(j)  (2304 + 64 * (j))
#define XB_TOP      3328
#define XB_TOPGEN   3392
#define XCD_BAR_WORDS 3456
#define XB_SPIN_CAP (1u << 18)
__device__ __forceinline__ unsigned xb_ld(unsigned* p)              { return __hip_atomic_load(p, __ATOMIC_RELAXED, __HIP_MEMORY_SCOPE_AGENT); }
__device__ __forceinline__ unsigned xb_add(unsigned* p, unsigned v) { return __hip_atomic_fetch_add(p, v, __ATOMIC_RELAXED, __HIP_MEMORY_SCOPE_AGENT); }
__device__ __forceinline__ unsigned xb_xcc_id() { return (unsigned)__builtin_amdgcn_s_getreg((3 << 11) | 20) & 0xFu; }
#define XB_SPIN(cond, bar) do { unsigned _sp = 0; while (cond) { __builtin_amdgcn_s_sleep(1); \
    if ((++_sp & 255u) == 0u) { if (xb_ld(&(bar)[XB_TMO])) break; if (_sp > XB_SPIN_CAP) { atomicAdd(&(bar)[XB_TMO], 1u); break; } } } } while (0)
struct XcdBarrier { unsigned* bar; unsigned x; volatile LAS unsigned* st; };
__device__ __forceinline__ XcdBarrier xcd_barrier_post(unsigned* bar, volatile LAS unsigned* st) {
    XcdBarrier b; b.bar = bar; b.x = xb_xcc_id(); b.st = st;
    if (threadIdx.x == 0) (void)xb_add(&bar[XB_XCNT(b.x)], 1u);
    return b;
}
__device__ __forceinline__ void xcd_barrier_complete(unsigned* bar, unsigned x, unsigned& nloc, unsigned& nx) {
    const unsigned G = gridDim.x * gridDim.y * gridDim.z;
    unsigned sum, cnt, mine, sp = 0u;
    for (;;) {
        sum = 0u; cnt = 0u; mine = 0u;
#pragma unroll
        for (unsigned j = 0; j < 16; ++j) { const unsigned c = xb_ld(&bar[XB_XCNT(j)]); sum += c; cnt += (c > 0u) ? 1u : 0u; mine = (j == x) ? c : mine; }
        if (sum == G) break;
        __builtin_amdgcn_s_sleep(1);
        if ((++sp & 255u) == 0u) { if (xb_ld(&bar[XB_TMO])) break; if (sp > XB_SPIN_CAP) { atomicAdd(&bar[XB_TMO], 1u); break; } }
    }
    nloc = mine > 0u ? mine : 1u; nx = cnt > 0u ? cnt : 1u;
}
__device__ __forceinline__ void xcd_barrier(const XcdBarrier& b) {
    asm volatile("s_waitcnt vmcnt(0)" ::: "memory");
    __syncthreads();
    if (threadIdx.x == 0) {
        unsigned* bar = b.bar;
        __builtin_amdgcn_s_waitcnt(0);
        unsigned nloc = b.st[0], nx = b.st[1];
        if (nloc == 0u) { xcd_barrier_complete(bar, b.x, nloc, nx); b.st[0] = nloc; b.st[1] = nx; }
        const unsigned old = xb_add(&bar[XB_XSUB(b.x)], 1u);
        const unsigned gen = old / nloc;
        if (old + 1u == (gen + 1u) * nloc) {
            __builtin_amdgcn_fence(__ATOMIC_RELEASE, "agent");
            asm volatile("s_waitcnt vmcnt(0)" ::: "memory");
            const unsigned og = xb_add(&bar[XB_TOP], 1u);
            const unsigned tg = og / nx;
            if (og + 1u == (tg + 1u) * nx) xb_add(&bar[XB_TOPGEN], 1u);
            else XB_SPIN(xb_ld(&bar[XB_TOPGEN]) == tg, bar);
            __builtin_amdgcn_fence(__ATOMIC_ACQUIRE, "agent");
            xb_add(&bar[XB_XGEN(b.x)], 1u);
            asm volatile("s_waitcnt vmcnt(0)" ::: "memory");
        } else {
            XB_SPIN(xb_ld(&bar[XB_XGEN(b.x)]) == gen, bar);
            __builtin_amdgcn_fence(__ATOMIC_ACQUIRE, "agent");
            asm volatile("s_waitcnt vmcnt(0)" ::: "memory");
        }
    }
    __syncthreads();
}
#endif

DI int next_unit(unsigned* head, lptr lds) {
    LAS int* slot = (LAS int*)(lds + MISC_OFF + 64);
    __syncthreads();
#ifdef EMU
    if (threadIdx.x == 0) { *slot = (int)(*head); *head += 1; }
#else
    if (threadIdx.x == 0) *slot = (int)__hip_atomic_fetch_add(head, 1u, __ATOMIC_RELAXED, __HIP_MEMORY_SCOPE_AGENT);
#endif
    __syncthreads();
    return *slot;
}

#ifndef DBG_PHMASK
#define DBG_PHMASK 0xffff
#endif
struct BranchOrder {
    pg8::StaticOrder so;
    DM bool next(int i, pg8::Unit& u) const { if (!so.next(i, u)) return false; u.ka = (u.pn / (D / 256)) * MIX; return true; }
    DM void a_ready(const pg8::Unit&) const {}
    DM void done(const pg8::Unit&) const {}
};
#ifndef PROBE_REP
#define PROBE_REP 0
#endif
#ifndef PROBE_PREPSEL
#define PROBE_PREPSEL 7
#endif
#ifndef PROBE_MIXREP
#define PROBE_MIXREP 15
#endif
#ifndef DBG_MIXMASK
#define DBG_MIXMASK 15
#endif
DI void run_phase(KP p, int rep, int l, int ph, lptr lds) {
    unsigned char* ws = p->ws;
    if (!((DBG_PHMASK >> ph) & 1)) return;
    if (ph == PH_INPROJ) {
        pg8::Gemm g{(const bf16_t*)(ws + WS_XN), (const bf16_t*)(ws + WS_WIN) + (size_t)l * NP * D, M, NP, D, D, D};
        EpiInproj E{(bf16_t*)(ws + WS_Z), ZLD, (bf16_t*)(ws + WS_RHO), CG0 / 256};
#ifndef EMU
        pg8::StaticOrder so; so.init(M, NP, gridDim.x, blockIdx.x);
        pg8::gemm_phase<EpiInproj, pg8::StaticOrder, true, true, D, D, D>((LAS unsigned char*)lds, g, so, E);
#endif
        for (int s = blockIdx.x; s < FX_NSTRIP; s += gridDim.x) phase_fx_project(p, l, lds, s);
    } else if (ph == PH_RWPREP) {
        const int psel = rep ? PROBE_PREPSEL : 7;
        if (psel & 1) phase_rw_prep(p, l);
        if (psel & 2) phase_fx_fix(p, l);
        if (psel & 4) for (int u = blockIdx.x; u < U_HGC; u += gridDim.x) phase_hg_local(p, l, lds, u);
    } else if (ph == PH_RWLOC) {
        phase_rw_local(p, lds);
    } else if (ph == PH_MIX) {
        unsigned* head = (unsigned*)(ws + WS_CTL) + CW_WQ + 64 * l + (rep ? 32 * 64 : 0);
        for (;;) { int u = next_unit(head, lds); if (u >= U_MIX) break;
            const int mm = rep ? PROBE_MIXREP : DBG_MIXMASK;
            if (u < U_SCAN) { if (mm & 1) phase_rw_scan(p, lds, u); continue; } u -= U_SCAN;
            if (u < U_HG) { if (mm & 2) phase_hg_scan(p, u); continue; } u -= U_HG;
            if (u < U_AA) { if (mm & 4) phase_att_a(p, l, lds, u); continue; } u -= U_AA;
            if (mm & 8) phase_att_d(p, l, lds, u); }
    } else if (ph == PH_RWPOST) {
        phase_rw_post(p, l);
        for (int u = blockIdx.x; u < U_HGC; u += gridDim.x) phase_hg_out(p, l, lds, u);
    } else if (ph == PH_BRANCH) {
        pg8::Gemm g{(const bf16_t*)(ws + WS_Y), (const bf16_t*)(ws + WS_WBR) + (size_t)l * 4 * D * MIX, M, 4 * D, MIX, 4 * MIX, MIX};
        EpiGateP E{(bf16_t*)(ws + WS_P), 4 * D, (const bf16_t*)(ws + WS_RHO)};
#ifndef EMU
        BranchOrder bo; bo.so.init(M, 4 * D, gridDim.x, blockIdx.x);
        pg8::gemm_phase<EpiGateP, BranchOrder, true, true, 4 * MIX, MIX, MIX>((LAS unsigned char*)lds, g, bo, E);
#endif
    } else if (ph == PH_SUM) {
        const size_t gt = (size_t)blockIdx.x * 512 + TID(), NGT = (size_t)gridDim.x * 512; const u32x4* P4 = (const u32x4*)(ws + WS_P); u32x4* MG4 = (u32x4*)(ws + WS_MG);
        for (size_t i = gt; i < (size_t)M * D / 8; i += NGT) { const size_t m = i / (D / 8), c = i % (D / 8); const u32x4* src = P4 + m * (4 * D / 8) + c;
            const u32x4 a0 = src[0], a1 = src[D / 8], a2 = src[2 * (D / 8)], a3 = src[3 * (D / 8)]; u32x4 o;
            o.x = pk2((bflo(a0.x) + bflo(a1.x)) + (bflo(a2.x) + bflo(a3.x)), (bfhi(a0.x) + bfhi(a1.x)) + (bfhi(a2.x) + bfhi(a3.x))); o.y = pk2((bflo(a0.y) + bflo(a1.y)) + (bflo(a2.y) + bflo(a3.y)), (bfhi(a0.y) + bfhi(a1.y)) + (bfhi(a2.y) + bfhi(a3.y)));
            o.z = pk2((bflo(a0.z) + bflo(a1.z)) + (bflo(a2.z) + bflo(a3.z)), (bfhi(a0.z) + bfhi(a1.z)) + (bfhi(a2.z) + bfhi(a3.z))); o.w = pk2((bflo(a0.w) + bflo(a1.w)) + (bflo(a2.w) + bflo(a3.w)), (bfhi(a0.w) + bfhi(a1.w)) + (bfhi(a2.w) + bfhi(a3.w)));
            MG4[i] = o; }
    } else if (ph == PH_OUT) {
        pg8::Gemm g{(const bf16_t*)(ws + WS_MG), (const bf16_t*)(ws + WS_WOUT) + (size_t)l * D * D, M, D, D, D, D};
        EpiF32 E{(float*)(ws + WS_OUTF), D};
#ifndef EMU
        pg8::StaticOrder so; so.init(M, D, gridDim.x, blockIdx.x);
        pg8::gemm_phase<EpiF32, pg8::StaticOrder, true, true, D, D, D>((LAS unsigned char*)lds, g, so, E);
#endif
    } else if (ph == PH_LN) {
        phase_ln(p, l);
    }
}

#ifndef EMU
__global__ void __launch_bounds__(NWAVES * 64, 2) fwd(Args a) {
    extern __shared__ __attribute__((aligned(16))) unsigned char lds_raw[];
    lptr lds = (lptr)lds_raw;
    volatile LAS unsigned* MISC = (volatile LAS unsigned*)(lds + MISC_OFF);
    for (int u = threadIdx.x; u < (LDS_BYTES - LDS_RING) / 4; u += NWAVES * 64) ((LAS unsigned*)(lds + LDS_RING))[u] = 0u;
    __syncthreads();
    typedef const __attribute__((address_space(4))) Args* KA;
    KA ka = (KA)__builtin_amdgcn_kernarg_segment_ptr();
    const int mega = ka->mega, do_pro = ka->do_pro, l_lo = ka->l_lo, l_hi = ka->l_hi, ph_lo = ka->ph_lo, ph_hi = ka->ph_hi;
    auto kp = [&]() -> KP { KA k2 = ka; asm volatile("" : "+s"(k2)); return &k2->p; };
    XcdBarrier bar; bar.bar = (unsigned*)(ka->p.ws + WS_CTL) + CW_BAR; bar.x = 0; bar.st = nullptr;
    if (mega) bar = xcd_barrier_post((unsigned*)(ka->p.ws + WS_CTL) + CW_BAR, MISC + 8);
#define SEAM() do { if (mega) xcd_barrier(bar); } while (0)
    if (do_pro != 0 && ((DBG_PHMASK >> 8) & 1) != 0) { phase_prologue(kp(), lds); SEAM(); }
    for (int l = l_lo; l < l_hi; ++l) {
        if (ph_lo <= PH_INPROJ && PH_INPROJ < ph_hi) { run_phase(kp(), 0, l, PH_INPROJ, lds); SEAM(); if ((PROBE_REP >> PH_INPROJ) & 1) { run_phase(kp(), 1, l, PH_INPROJ, lds); SEAM(); } }
        if (ph_lo <= PH_RWPREP && PH_RWPREP < ph_hi) { run_phase(kp(), 0, l, PH_RWPREP, lds); SEAM(); if ((PROBE_REP >> PH_RWPREP) & 1) { run_phase(kp(), 1, l, PH_RWPREP, lds); SEAM(); } }
        if (ph_lo <= PH_RWLOC && PH_RWLOC < ph_hi) { run_phase(kp(), 0, l, PH_RWLOC, lds); SEAM(); if ((PROBE_REP >> PH_RWLOC) & 1) { run_phase(kp(), 1, l, PH_RWLOC, lds); SEAM(); } }
        if (ph_lo <= PH_MIX && PH_MIX < ph_hi) { run_phase(kp(), 0, l, PH_MIX, lds); SEAM(); if ((PROBE_REP >> PH_MIX) & 1) { run_phase(kp(), 1, l, PH_MIX, lds); SEAM(); } }
        if (ph_lo <= PH_RWPOST && PH_RWPOST < ph_hi) { run_phase(kp(), 0, l, PH_RWPOST, lds); SEAM(); if ((PROBE_REP >> PH_RWPOST) & 1) { run_phase(kp(), 1, l, PH_RWPOST, lds); SEAM(); } }
        if (ph_lo <= PH_BRANCH && PH_BRANCH < ph_hi) { run_phase(kp(), 0, l, PH_BRANCH, lds); SEAM(); if ((PROBE_REP >> PH_BRANCH) & 1) { run_phase(kp(), 1, l, PH_BRANCH, lds); SEAM(); } }
        if (ph_lo <= PH_SUM && PH_SUM < ph_hi) { run_phase(kp(), 0, l, PH_SUM, lds); SEAM(); if ((PROBE_REP >> PH_SUM) & 1) { run_phase(kp(), 1, l, PH_SUM, lds); SEAM(); } }
        if (ph_lo <= PH_OUT && PH_OUT < ph_hi) { run_phase(kp(), 0, l, PH_OUT, lds); SEAM(); if ((PROBE_REP >> PH_OUT) & 1) { run_phase(kp(), 1, l, PH_OUT, lds); SEAM(); } }
        if (ph_lo <= PH_LN && PH_LN < ph_hi) { run_phase(kp(), 0, l, PH_LN, lds); SEAM(); }
    }
#undef SEAM
}

#ifndef MK_MEGA
#define MK_MEGA 1
#endif
extern "C" void kernel_launch(void* const* d_in, const int* in_sizes, int n_in, void* d_out, int out_size, void* d_ws, size_t ws_size, hipStream_t stream) {
    static int grid = 0;
    if (grid == 0) {
        if (n_in != 25 || in_sizes[0] != M * D || out_size != M * D || ws_size < WS_END) { fprintf(stderr, "kernel_launch: shape/workspace mismatch (n_in %d, in0 %d, out %d, ws %zu need %zu)\n", n_in, n_in > 0 ? in_sizes[0] : -1, out_size, ws_size, (size_t)WS_END); grid = -1; return; }
        int dev = 0, cus = 0, per_cu = 0;
        if (hipGetDevice(&dev) != hipSuccess || hipDeviceGetAttribute(&cus, hipDeviceAttributeMultiprocessorCount, dev) != hipSuccess) { grid = -1; return; }
        if (hipFuncSetAttribute((const void*)fwd, hipFuncAttributeMaxDynamicSharedMemorySize, LDS_BYTES) != hipSuccess) { fprintf(stderr, "kernel_launch: hipFuncSetAttribute failed\n"); grid = -1; return; }
        if (hipOccupancyMaxActiveBlocksPerMultiprocessor(&per_cu, (const void*)fwd, NWAVES * 64, LDS_BYTES) != hipSuccess || per_cu < 1) fprintf(stderr, "kernel_launch: occupancy query says %d\n", per_cu);
        (void)hipGetLastError();
        grid = cus;
    }
    if (grid < 0) return;
    (void)hipMemsetAsync((char*)d_ws + WS_CTL, 0, CTL_BYTES, stream);
    Args a{};
    for (int i = 0; i < 25; ++i) a.p.in[i] = (const float*)d_in[i];
    a.p.out = (float*)d_out; a.p.ws = (unsigned char*)d_ws;
    if (MK_MEGA) {
        a.do_pro = 1; a.l_lo = 0; a.l_hi = L; a.ph_lo = 0; a.ph_hi = PH_COUNT; a.mega = 1;
        hipLaunchKernelGGL(fwd, dim3(grid), dim3(NWAVES * 64), LDS_BYTES, stream, a);
    } else {
        a.mega = 0; a.do_pro = 1; a.l_lo = 0; a.l_hi = 0; a.ph_lo = 0; a.ph_hi = 0;
        hipLaunchKernelGGL(fwd, dim3(grid), dim3(NWAVES * 64), LDS_BYTES, stream, a);
        a.do_pro = 0;
        for (int l = 0; l < L; ++l) for (int ph = 0; ph < PH_COUNT; ++ph) { a.l_lo = l; a.l_hi = l + 1; a.ph_lo = ph; a.ph_hi = ph + 1;
            hipLaunchKernelGGL(fwd, dim3(grid), dim3(NWAVES * 64), LDS_BYTES, stream, a); }
    }
}
#endif
```

```cpp
#ifdef EMU
#include "emu.h"
#else
#include <hip/hip_runtime.h>
#include <cstdio>
#include <cstdint>
#endif

#ifndef CFG_D_MODEL
#define CFG_D_MODEL 2048
#endif
#ifndef CFG_BATCH
#define CFG_BATCH 4
#endif
#ifndef CFG_SEQ
#define CFG_SEQ 4096
#endif
#ifndef CFG_DEPTH
#define CFG_DEPTH 4
#endif
constexpr int D = CFG_D_MODEL, NB = CFG_BATCH, S = CFG_SEQ, L = CFG_DEPTH, MIX = D / 2, M = NB * S;
constexpr int AH = MIX / 128, HH = MIX / 128, RH = MIX / 64, SH = MIX / 128;
constexpr int RW_MIX = 3 * MIX + 128;
constexpr int C_AQ = 0, C_AK = MIX, C_AV = 2 * MIX, C_AG = 3 * MIX, C_HQ = 4 * MIX, C_HF = 5 * MIX, C_HI = 6 * MIX, C_HG = 7 * MIX;
constexpr int C_RM = 8 * MIX, C_RG = C_RM + RW_MIX, C_SQ = C_RG + MIX, C_SK = C_SQ + MIX, C_SV = C_SK + MIX, C_SG = C_SV + MIX, C_MG = C_SG + MIX;
constexpr int IN_COLS = C_MG + 4 * D;
constexpr int C_VD = C_MG, CG0 = ((C_MG + 32 + 255) / 256) * 256, NP = CG0 + 4 * D, ZLD = CG0;
constexpr float LN_EPS = 1e-5f, RMS_EPS = 1e-6f, RW_LN_EPS = 64e-5f;
constexpr float LOG2E = 1.4426950408889634f, LN2 = 0.6931471805599453f;

constexpr size_t al256(size_t x) { return (x + 255) & ~(size_t)255; }
constexpr size_t WS_CTL = 0, CTL_BYTES = 1u << 20;
constexpr size_t SM_LAM = CTL_BYTES;
constexpr size_t SM_LB = SM_LAM + 256;
constexpr size_t SM_BT = al256(SM_LB + (size_t)3 * L * MIX * 4);
constexpr size_t SM_W2T = al256(SM_BT + (size_t)AH * 132 * 4);
constexpr size_t SM_A2T = al256(SM_W2T + (size_t)L * MIX * 64 * 2);
constexpr size_t SM_V2T = al256(SM_A2T + (size_t)L * MIX * 64 * 2);
constexpr size_t WS_WIN = al256(SM_V2T + (size_t)L * MIX * 32 * 2);
constexpr size_t WS_WBR = al256(WS_WIN + (size_t)L * NP * D * 2);
constexpr size_t WS_WOUT = al256(WS_WBR + (size_t)L * D * 4 * MIX * 2);
constexpr size_t WS_XN = al256(WS_WOUT + (size_t)L * D * D * 2);
constexpr size_t WS_H = al256(WS_XN + (size_t)M * D * 2);
constexpr size_t WS_Z = al256(WS_H + (size_t)M * D * 4);
constexpr size_t WS_Y = al256(WS_Z + (size_t)M * ZLD * 2);
constexpr size_t WS_RHO = al256(WS_Y + (size_t)M * 4 * MIX * 2);
constexpr size_t WS_P = al256(WS_RHO + (size_t)M * 4 * D * 2);
constexpr size_t WS_MG = al256(WS_P + (size_t)M * 4 * D * 2);
constexpr size_t WS_OUTF = al256(WS_MG + (size_t)M * D * 2);
constexpr size_t WS_VF = al256(WS_OUTF + (size_t)M * D * 4);
constexpr size_t WS_VV = al256(WS_VF + (size_t)M * MIX * 4);
constexpr size_t WS_SCO = al256(WS_VV + (size_t)M * MIX * 4);
constexpr size_t WS_BON = al256(WS_SCO + (size_t)M * MIX * 4);
constexpr size_t HG_CHUNKS = (size_t)NB * (MIX / 128) * (S / 64);
constexpr size_t WS_HGQF = al256(WS_BON + (size_t)M * RH * 4);
constexpr size_t WS_HGIN = al256(WS_HGQF + HG_CHUNKS * 16 * 64 * 16);
constexpr size_t WS_HGDS = al256(WS_HGIN + HG_CHUNKS * 8 * 4 * 64 * 16);
constexpr size_t WS_HGVE = al256(WS_HGDS + HG_CHUNKS * 8 * 8 * 64 * 16);
constexpr size_t WS_HGSF = al256(WS_HGVE + HG_CHUNKS * 256 * 4);
constexpr int FX_T = 4, FX_ROWS = NB * FX_T;
constexpr size_t WS_ZF = al256(WS_HGSF + HG_CHUNKS * 8 * 4 * 64 * 16);
constexpr size_t WS_OEX = al256(WS_ZF + (size_t)FX_ROWS * ZLD * 4);
constexpr size_t WS_OEXC = al256(WS_OEX + (size_t)NB * (MIX / 128) * FX_T * 128 * 4);
constexpr size_t WS_END = al256(WS_OEXC + (size_t)NB * FX_T * MIX * 4);
constexpr size_t WS_RC = WS_P;
static_assert((size_t)NB * (MIX / 64) * (S / 16) * 22784 <= WS_VF - WS_P, "RWKV records fit the aliased region");

typedef unsigned short bf16_t;
typedef short bf16x8 __attribute__((ext_vector_type(8)));
typedef short s16x4 __attribute__((ext_vector_type(4)));
typedef float f32x16 __attribute__((ext_vector_type(16)));
typedef float f32x4 __attribute__((ext_vector_type(4)));
typedef float f32x2 __attribute__((ext_vector_type(2)));
typedef unsigned u32x4 __attribute__((ext_vector_type(4)));
typedef unsigned u32x2 __attribute__((ext_vector_type(2)));
#ifdef EMU
#define DI static inline
#define DM inline
#define LAS
#define GAS
#define WAVE_SYNC() emu_wave_barrier()
#define MFMA32(a, b, c) emu_mfma32(a, b, c)
#define MFMA16(a, b, c) emu_mfma16(a, b, c)
#define TR_READ(p) emu_tr_read((const void*)(p))
#define ROW_ROR(x, n) emu_row_ror(x, n)
#define ANY(p) emu_any(p)
#define RFL(x) (x)
DI float ex2(float x) { return exp2f(x); }
DI float lg2(float x) { return log2f(x); }
DI float frcp(float x) { return 1.f / x; }
DI float frsq(float x) { return 1.f / sqrtf(x); }
DI float u2f(unsigned u) { float f; memcpy(&f, &u, 4); return f; }
DI unsigned f2u(float f) { unsigned u; memcpy(&u, &f, 4); return u; }
#else
#define DI __device__ __forceinline__
#define DM __device__ __forceinline__
#define LAS __attribute__((address_space(3)))
#define GAS __attribute__((address_space(1)))
#define WAVE_SYNC() do { __builtin_amdgcn_fence(__ATOMIC_RELEASE, "wavefront"); __builtin_amdgcn_wave_barrier(); __builtin_amdgcn_fence(__ATOMIC_ACQUIRE, "wavefront"); } while (0)
#define MFMA32(a, b, c) __builtin_amdgcn_mfma_f32_32x32x16_bf16((a), (b), (c), 0, 0, 0)
#define MFMA16(a, b, c) __builtin_amdgcn_mfma_f32_16x16x32_bf16((a), (b), (c), 0, 0, 0)
typedef short v4i16_t __attribute__((ext_vector_type(4)));
#define TR_READ(p) __builtin_bit_cast(s16x4, __builtin_amdgcn_ds_read_tr16_b64_v4i16((LAS v4i16_t*)(p)))
#define ROW_ROR(x, n) __builtin_bit_cast(float, __builtin_amdgcn_update_dpp(0, __builtin_bit_cast(int, (x)), 0x120 + (n), 0xf, 0xf, false))
#define ANY(p) __any(p)
#define RFL(x) __builtin_amdgcn_readfirstlane(x)
DI float ex2(float x) { return __builtin_amdgcn_exp2f(x); }
DI float lg2(float x) { return __builtin_amdgcn_logf(x); }
DI float frcp(float x) { return __builtin_amdgcn_rcpf(x); }
DI float frsq(float x) { return __builtin_amdgcn_rsqf(x); }
DI float u2f(unsigned u) { return __builtin_bit_cast(float, u); }
DI unsigned f2u(float f) { return __builtin_bit_cast(unsigned, f); }
#endif
#ifdef EMU
#define SCHED_FENCE()
#else
#define SCHED_FENCE() __builtin_amdgcn_sched_barrier(0)
#endif
typedef LAS char* lptr;
#ifdef EMU
DI int TID() { return (int)threadIdx.x; }
#else
DI int TID() { int t = (int)threadIdx.x; asm volatile("" : "+v"(t)); return t; }
#endif
DI float bf2f(bf16_t v) { return u2f(((unsigned)v) << 16); }
DI bf16_t f2bf(float f) { unsigned u = f2u(f); return (bf16_t)((u + 0x7fffu + ((u >> 16) & 1u)) >> 16); }
#ifdef EMU
DI unsigned pk2(float lo, float hi) { return (unsigned)f2bf(lo) | ((unsigned)f2bf(hi) << 16); }
#else
typedef __bf16 bf16x2_hw __attribute__((ext_vector_type(2)));
DI unsigned pk2(float lo, float hi) { const f32x2 v = {lo, hi}; return __builtin_bit_cast(unsigned, __builtin_convertvector(v, bf16x2_hw)); }
#endif
DI float bflo(unsigned w) { return u2f(w << 16); }
DI float bfhi(unsigned w) { return u2f(w & 0xffff0000u); }
DI float fexp(float x) { return ex2(x * LOG2E); }
DI float flog(float x) { return lg2(x) * LN2; }
DI float fsigmoid(float x) { return frcp(1.f + fexp(-x)); }
DI float fsilu(float x) { return x * fsigmoid(x); }
DI float fsoftplus(float x) { return fmaxf(x, 0.f) + flog(1.f + fexp(-fabsf(x))); }
DI int crow(int i, int h) { return (i & 3) + 8 * (i >> 2) + 4 * h; }
DI bf16x8 pack8(float a0, float a1, float a2, float a3, float a4, float a5, float a6, float a7) {
    u32x4 w; w.x = pk2(a0, a1); w.y = pk2(a2, a3); w.z = pk2(a4, a5); w.w = pk2(a6, a7); return __builtin_bit_cast(bf16x8, w);
}
DI bf16x8 cat4(s16x4 lo, s16x4 hi) { return __builtin_shufflevector(lo, hi, 0, 1, 2, 3, 4, 5, 6, 7); }

struct Params {
    const float* in[25];
    float* out;
    unsigned char* ws;
};
#ifdef EMU
typedef const Params* KP;
#else
typedef const __attribute__((address_space(4))) Params* KP;
#endif
enum { I_X = 0, I_WIN, I_REL, I_LAM, I_SUBLN, I_HGLOW, I_HGNORM, I_MU, I_W0, I_W2, I_A0, I_A2, I_V1, I_VMU, I_V0, I_V2, I_KK, I_KA, I_RK, I_LNXG, I_LNXB, I_WBR, I_WOUT, I_LNG, I_LNB };
namespace pg8 {
#ifdef EMU
#define PG8_LAS
#else
#define PG8_LAS __attribute__((address_space(3)))
#endif
typedef unsigned short bf16_t;
typedef short bf16x8 __attribute__((ext_vector_type(8)));
typedef float f32x4 __attribute__((ext_vector_type(4)));
typedef unsigned u32x4 __attribute__((ext_vector_type(4)));
constexpr int BM = 256, BK = 64, HALF = 128, HTB = HALF * BK * 2  , STAGE_BYTES = 8 * HTB, NXCD = 8, WGM = 8;

__host__ __device__ __forceinline__ int lds_byte(int r, int c) { const int st = (r >> 4) * 2 + (c >> 5), rr = r & 15, cc = c & 31, ob = rr * 64 + cc * 2; return st * 1024 + (ob ^ (((ob >> 9) & 1) << 5)); }
__host__ __device__ __forceinline__ void stage_rc(int b, int& R, int& C) { const int st = b / 1024, sb = b % 1024, swz = sb ^ (((sb >> 9) & 1) << 5); R = (st >> 1) * 16 + swz / 64; C = (st & 1) * 32 + (swz % 64) / 2; }
__host__ __device__ __forceinline__ int perm32(int rho) { const int n = rho >> 4, i = rho & 15; return 8 * (i >> 2) + 4 * n + (i & 3); }

struct Unit { int pm, pn, ka; };
struct Gemm { const bf16_t* A; const bf16_t* Bt; int M, N, K, lda, ldb; };

struct StaticOrder {
    int nM, nN, nwg, G, c;
    __host__ __device__ void init(int M, int N, int G_, int c_) { nM = M / BM; nN = N / BM; nwg = nM * nN; G = G_; c = c_; }
    __host__ __device__ bool next(int i, Unit& u) const {
        const long L = (long)i * G + c; if (L >= nwg) return false;
        int wgid = (int)L; { const int q = nwg / NXCD, r = nwg % NXCD, xcd = wgid % NXCD, off = wgid / NXCD; wgid = (xcd < r ? xcd * (q + 1) : r * (q + 1) + (xcd - r) * q) + off; }
        const int nig = WGM * nN, gid = wgid / nig, fm = gid * WGM, gsz = (nM - fm) < WGM ? (nM - fm) : WGM;
        u.pm = fm + ((wgid % nig) % gsz); u.pn = (wgid % nig) / gsz; u.ka = 0; return true;
    }
    __device__ __forceinline__ void a_ready(const Unit&) const {}
    __device__ __forceinline__ void done(const Unit&) const {}
};
#ifndef EMU
template <class Epi, class Sched, bool ALIGN_EPI, bool SP2, int LDA, int LDB, int KDIM>
__device__ __forceinline__ void gemm_phase(PG8_LAS unsigned char* lds, const Gemm g, const Sched& S, const Epi& E) {
    const int tid = TID(), wid = __builtin_amdgcn_readfirstlane(tid >> 6), lane = tid & 63, wr = wid >> 2, wc = wid & 3, fr = lane & 15, fq = lane >> 4;
    constexpr int K = KDIM, nt = K / BK;
    unsigned voffA, voffB;
    { int R, C; stage_rc(tid * 16, R, C); const int Rb = Epi::PERM ? ((R & ~31) + perm32(R & 31)) : R;
      voffA = (unsigned)(R * LDA + C) * 2u; voffB = (unsigned)(Rb * LDB + C) * 2u; }
    const size_t qA = (size_t)64 * LDA * 2, qB = (size_t)64 * LDB * 2;
    const size_t kstep = (size_t)(BK * 2);
    const size_t hstepA = (size_t)HALF * LDA * 2, hstepB = (size_t)HALF * LDB * 2;
    const size_t tstepA = 2 * hstepA, tstepB = 2 * hstepB;
    const unsigned ldsw = (unsigned)wid * 1024u;
    const int aoff = lds_byte(wr * 64 + fr, fq * 8), boff = lds_byte(wc * 32 + fr, fq * 8);
#define PG8_SA(b, h) (((b) * 2 + (h)) * HTB)
#define PG8_SB(b, h) ((4 + (b) * 2 + (h)) * HTB)
#define PG8_STAGE_X(bufoff, gbase, voff, q) do { _Pragma("unroll") for (int _i = 0; _i < 2; ++_i) \
        __builtin_amdgcn_global_load_lds((const unsigned*)((const char*)(gbase) + (size_t)_i * (q) + (voff)), (PG8_LAS unsigned*)(lds + (bufoff) + ldsw + _i * 8192), 16, 0, 0); } while (0)
#define PG8_STAGE_A(bufoff, gbase) PG8_STAGE_X(bufoff, gbase, voffA, qA)
#define PG8_STAGE_B(bufoff, gbase) PG8_STAGE_X(bufoff, gbase, voffB, qB)
#define PG8_LDA(dst, b, h) do { _Pragma("unroll") for (int m = 0; m < 4; ++m) _Pragma("unroll") for (int k = 0; k < 2; ++k) dst[m][k] = *(const PG8_LAS bf16x8*)(lds + PG8_SA(b, h) + aoff + m * 2048 + k * 1024); } while (0)
#define PG8_LDB(dst, b, h) do { _Pragma("unroll") for (int n = 0; n < 2; ++n) _Pragma("unroll") for (int k = 0; k < 2; ++k) dst[n][k] = *(const PG8_LAS bf16x8*)(lds + PG8_SB(b, h) + boff + n * 2048 + k * 1024); } while (0)
#define PG8_MMA(ai, bj, At, Bt) do { __builtin_amdgcn_s_setprio(1); _Pragma("unroll") for (int m = 0; m < 4; ++m) _Pragma("unroll") for (int n = 0; n < 2; ++n) _Pragma("unroll") for (int k = 0; k < 2; ++k) \
        acc[ai][bj][m][n] = __builtin_amdgcn_mfma_f32_16x16x32_bf16(Bt[n][k], At[m][k], acc[ai][bj][m][n], 0, 0, 0); __builtin_amdgcn_s_setprio(0); } while (0)
#define PG8_WAIT_V(n) asm volatile("s_waitcnt vmcnt(" #n ")" ::: "memory")
#define PG8_WAIT_L(n) asm volatile("s_waitcnt lgkmcnt(" #n ")" ::: "memory")
#define PG8_BAR __builtin_amdgcn_s_barrier()
#define PG8_SCHED __builtin_amdgcn_sched_barrier(0)
    Unit cur, nxt; int ui = 0;
    if (!S.next(0, cur)) return;
    f32x4 acc[2][2][4][2];
#pragma unroll
    for (int a = 0; a < 2; ++a)
#pragma unroll
        for (int b = 0; b < 2; ++b)
#pragma unroll
            for (int m = 0; m < 4; ++m)
#pragma unroll
                for (int n = 0; n < 2; ++n) acc[a][b][m][n] = (f32x4){0.f, 0.f, 0.f, 0.f};
    bf16x8 At[4][2], B0[2][2], B1[2][2];
    const char* cA = (const char*)g.A + (size_t)cur.pm * tstepA + (size_t)cur.ka * 2; const char* cB = (const char*)g.Bt + (size_t)cur.pn * tstepB;
    S.a_ready(cur);
    if constexpr (SP2) {
        PG8_STAGE_B(PG8_SB(0, 0), cB); PG8_STAGE_B(PG8_SB(0, 1), cB + hstepB); PG8_STAGE_A(PG8_SA(0, 0), cA); PG8_STAGE_A(PG8_SA(0, 1), cA + hstepA);
        if (wr == 1) PG8_BAR;
        PG8_WAIT_V(2); PG8_BAR;
        PG8_STAGE_B(PG8_SB(1, 0), cB + kstep); PG8_STAGE_A(PG8_SA(1, 0), cA + kstep); PG8_STAGE_B(PG8_SB(1, 1), cB + hstepB + kstep);
        PG8_WAIT_V(6); PG8_BAR;
    } else {
        PG8_STAGE_B(PG8_SB(0, 0), cB); PG8_STAGE_A(PG8_SA(0, 0), cA); PG8_STAGE_B(PG8_SB(0, 1), cB + hstepB); PG8_STAGE_A(PG8_SA(0, 1), cA + hstepA);
        if (wr == 1) PG8_BAR;
        PG8_WAIT_V(4); PG8_BAR;
        PG8_STAGE_B(PG8_SB(1, 0), cB + kstep); PG8_STAGE_A(PG8_SA(1, 0), cA + kstep); PG8_STAGE_B(PG8_SB(1, 1), cB + hstepB + kstep);
        PG8_WAIT_V(6); PG8_BAR;
    }
    for (;;) {
        const bool has_next = S.next(ui + 1, nxt);
        const char* nA = has_next ? (const char*)g.A + (size_t)nxt.pm * tstepA + (size_t)nxt.ka * 2 : cA; const char* nB = has_next ? (const char*)g.Bt + (size_t)nxt.pn * tstepB : cB;
        for (int t = 0; t < nt; t += 2) {
            if constexpr (Epi::MIDK > 0) { if (t > 0 && (t % Epi::MIDK) == 0) E.mid(acc, cur, t / Epi::MIDK - 1, wr, wc, fr, fq); }
            const bool last = (t == nt - 2);
            const char* a1 = cA + (size_t)(t + 1) * kstep;
            const char* a2 = last ? nA : cA + (size_t)(t + 2) * kstep; const char* b2 = last ? nB : cB + (size_t)(t + 2) * kstep;
            const char* a3 = a2 + kstep; const char* b3 = b2 + kstep;
            if (last && has_next) S.a_ready(nxt);
            if constexpr (SP2) {
            PG8_LDB(B0, 0, 0); PG8_LDB(B1, 0, 1); PG8_SCHED; PG8_LDA(At, 0, 0); PG8_STAGE_A(PG8_SA(1, 1), a1 + hstepA);
            PG8_WAIT_V(8); PG8_WAIT_L(0); PG8_BAR; PG8_MMA(0, 0, At, B0); PG8_MMA(0, 1, At, B1); PG8_BAR; PG8_SCHED;
            PG8_LDA(At, 0, 1); PG8_STAGE_B(PG8_SB(0, 0), b2); PG8_STAGE_B(PG8_SB(0, 1), b2 + hstepB); PG8_STAGE_A(PG8_SA(0, 0), a2);
            PG8_WAIT_V(8); PG8_WAIT_L(0); PG8_BAR; PG8_MMA(1, 0, At, B0); PG8_MMA(1, 1, At, B1); PG8_BAR; PG8_SCHED;
            PG8_LDB(B0, 1, 0); PG8_LDB(B1, 1, 1); PG8_SCHED; PG8_LDA(At, 1, 0); PG8_STAGE_A(PG8_SA(0, 1), a2 + hstepA);
            PG8_WAIT_V(8); PG8_WAIT_L(0); PG8_BAR; PG8_MMA(0, 0, At, B0); PG8_MMA(0, 1, At, B1); PG8_BAR; PG8_SCHED;
            PG8_LDA(At, 1, 1); PG8_STAGE_B(PG8_SB(1, 0), b3); PG8_STAGE_B(PG8_SB(1, 1), b3 + hstepB); PG8_STAGE_A(PG8_SA(1, 0), a3);
            PG8_WAIT_V(8); PG8_WAIT_L(0); PG8_BAR; PG8_MMA(1, 0, At, B0); PG8_MMA(1, 1, At, B1); PG8_BAR; PG8_SCHED;
            } else {
            PG8_LDB(B0, 0, 0); PG8_SCHED; PG8_LDA(At, 0, 0); PG8_STAGE_A(PG8_SA(1, 1), a1 + hstepA);
            PG8_WAIT_L(8); PG8_BAR; PG8_WAIT_L(0); PG8_MMA(0, 0, At, B0); PG8_BAR; PG8_SCHED;
            PG8_LDB(B1, 0, 1); PG8_STAGE_B(PG8_SB(0, 0), b2);
            PG8_BAR; PG8_WAIT_L(0); PG8_MMA(0, 1, At, B1); PG8_BAR;
            PG8_LDA(At, 0, 1); PG8_STAGE_A(PG8_SA(0, 0), a2);
            PG8_BAR; PG8_WAIT_L(0); PG8_MMA(1, 0, At, B0); PG8_BAR; PG8_SCHED;
            PG8_STAGE_B(PG8_SB(0, 1), b2 + hstepB);
            PG8_WAIT_V(6); PG8_BAR; PG8_MMA(1, 1, At, B1); PG8_BAR;
            PG8_LDB(B0, 1, 0); PG8_SCHED; PG8_LDA(At, 1, 0); PG8_STAGE_A(PG8_SA(0, 1), a2 + hstepA);
            PG8_WAIT_L(8); PG8_BAR; PG8_WAIT_L(0); PG8_MMA(0, 0, At, B0); PG8_BAR; PG8_SCHED;
            PG8_LDB(B1, 1, 1); PG8_STAGE_B(PG8_SB(1, 0), b3);
            PG8_BAR; PG8_WAIT_L(0); PG8_MMA(0, 1, At, B1); PG8_BAR;
            PG8_LDA(At, 1, 1); PG8_STAGE_A(PG8_SA(1, 0), a3);
            PG8_BAR; PG8_WAIT_L(0); PG8_MMA(1, 0, At, B0); PG8_BAR; PG8_SCHED;
            PG8_STAGE_B(PG8_SB(1, 1), b3 + hstepB);
            PG8_WAIT_V(6); PG8_BAR; PG8_MMA(1, 1, At, B1); PG8_BAR;
            }
        }
        if constexpr (ALIGN_EPI) { if (wr == 0) PG8_BAR; }
        if constexpr (!Epi::AFTER_DRAIN) { E(acc, cur, wr, wc, fr, fq); S.done(cur); }
        if (!has_next) break;
#pragma unroll
        for (int a = 0; a < 2; ++a)
#pragma unroll
            for (int b = 0; b < 2; ++b)
#pragma unroll
                for (int m = 0; m < 4; ++m)
#pragma unroll
                    for (int n = 0; n < 2; ++n) acc[a][b][m][n] = (f32x4){0.f, 0.f, 0.f, 0.f};
        cur = nxt; cA = nA; cB = nB; ++ui;
        if constexpr (ALIGN_EPI) { if (wr == 1) PG8_BAR; }
    }
    PG8_WAIT_V(0);
    if constexpr (!ALIGN_EPI) { if (wr == 0) PG8_BAR; }
    PG8_BAR;
    if constexpr (Epi::AFTER_DRAIN) { E.fused(acc, cur, wr, wc, fr, fq, lds, wid, lane); S.done(cur); }
#undef PG8_SA
#undef PG8_SB
#undef PG8_STAGE_X
#undef PG8_STAGE_A
#undef PG8_STAGE_B
#undef PG8_LDA
#undef PG8_LDB
#undef PG8_MMA
#undef PG8_WAIT_V
#undef PG8_WAIT_L
#undef PG8_BAR
#undef PG8_SCHED
}
#endif
}
#ifdef EMU
#define EPI_COORDS()
#else
#define EPI_COORDS() { const int t_ = TID(); const int w_ = RFL(t_ >> 6), l_ = t_ & 63; wr = w_ >> 2; wc = w_ & 3; fr = l_ & 15; fq = l_ >> 4; }
#endif
struct EpiInproj {
    static constexpr bool PERM = true, AFTER_DRAIN = false; static constexpr int MIDK = 0;
    bf16_t* O; int ldc; bf16_t* RHO; int gate_pn0;
    DM void operator()(const f32x4 (&acc)[2][2][4][2], const pg8::Unit& u, int wr, int wc, int fr, int fq) const {
        const int row0 = u.pm * 256 + wr * 64 + fr;
        if (u.pn < gate_pn0) { const int col0 = u.pn * 256 + wc * 32 + 8 * fq;
#pragma unroll
            for (int ai = 0; ai < 2; ++ai)
#pragma unroll
                for (int m = 0; m < 4; ++m) { bf16_t* rowp = O + (size_t)(row0 + ai * 128 + m * 16) * ldc + col0;
#pragma unroll
                    for (int bj = 0; bj < 2; ++bj) { const f32x4 v0 = acc[ai][bj][m][0], v1 = acc[ai][bj][m][1];
                        u32x4 w; w.x = pk2(v0[0], v0[1]); w.y = pk2(v0[2], v0[3]); w.z = pk2(v1[0], v1[1]); w.w = pk2(v1[2], v1[3]);
                        *(u32x4*)(rowp + bj * 128) = w; } }
        } else {
            const int T = u.pn - gate_pn0, pnc = T >> 2, bjc = (T & 3) >> 1, wcc = 2 * (T & 1) + (wc >> 1), fqc = fq, nc = wc & 1;
            bf16_t* base = RHO + ((((size_t)u.pm * (D / 256) + pnc) * 4) * 8 + (wr * 4 + wcc)) * (size_t)(16 * 64 * 8) + bjc * 512 + (fqc * 16 + fr) * 8 + nc * 4;
            constexpr size_t SEG_STRIDE = (size_t)8 * 16 * 64 * 8;
#pragma unroll
            for (int ai = 0; ai < 2; ++ai)
#pragma unroll
                for (int m = 0; m < 4; ++m) { bf16_t* rp = base + (ai * 4 + m) * 1024; float r0[4], r1[4], r2[4], r3[4];
#pragma unroll
                    for (int e = 0; e < 4; ++e) { const float d0 = 1.f + fexp(-acc[ai][0][m][0][e]), d1 = 1.f + fexp(-acc[ai][0][m][1][e]), d2 = 1.f + fexp(-acc[ai][1][m][0][e]), d3 = 1.f + fexp(-acc[ai][1][m][1][e]);
                        const float i0 = frcp(d0), i1 = frcp(d1), i2 = frcp(d2), i3 = frcp(d3);
                        r0[e] = i0; r1[e] = i1; r2[e] = i2; r3[e] = i3; }
                    u32x2 w; w.x = pk2(r0[0], r0[1]); w.y = pk2(r0[2], r0[3]); *(u32x2*)(rp) = w; w.x = pk2(r1[0], r1[1]); w.y = pk2(r1[2], r1[3]); *(u32x2*)(rp + SEG_STRIDE) = w;
                    w.x = pk2(r2[0], r2[1]); w.y = pk2(r2[2], r2[3]); *(u32x2*)(rp + 2 * SEG_STRIDE) = w; w.x = pk2(r3[0], r3[1]); w.y = pk2(r3[2], r3[3]); *(u32x2*)(rp + 3 * SEG_STRIDE) = w; } }
    }
};
struct EpiGateP {
    static constexpr bool PERM = false, AFTER_DRAIN = false; static constexpr int MIDK = 0;
    bf16_t* O; int ldc; const bf16_t* SG;
    DM void operator()(const f32x4 (&acc)[2][2][4][2], const pg8::Unit& u, int wr, int wc, int fr, int fq) const {
        const int n = u.pn / (D / 256), pnc = u.pn % (D / 256);
        const u32x4* base = (const u32x4*)(SG + ((((size_t)u.pm * (D / 256) + pnc) * 4 + n) * 8 + (wr * 4 + wc)) * (size_t)(16 * 64 * 8)) + (fq * 16 + fr);
        const int row0 = u.pm * 256 + wr * 64 + fr, col0 = u.pn * 256 + wc * 32 + 4 * fq;
#pragma unroll
        for (int ai = 0; ai < 2; ++ai)
#pragma unroll
            for (int m = 0; m < 4; ++m) { bf16_t* rowp = O + (size_t)(row0 + ai * 128 + m * 16) * ldc + col0;
#pragma unroll
                for (int bj = 0; bj < 2; ++bj) { const u32x4 g = base[((ai * 4 + m) * 2 + bj) * 64]; const f32x4 v0 = acc[ai][bj][m][0], v1 = acc[ai][bj][m][1];
                    u32x2 w0, w1; w0.x = pk2(v0[0] * bflo(g.x), v0[1] * bfhi(g.x)); w0.y = pk2(v0[2] * bflo(g.y), v0[3] * bfhi(g.y)); w1.x = pk2(v1[0] * bflo(g.z), v1[1] * bfhi(g.z)); w1.y = pk2(v1[2] * bflo(g.w), v1[3] * bfhi(g.w));
                    *(u32x2*)(rowp + bj * 128) = w0; *(u32x2*)(rowp + bj * 128 + 16) = w1; } }
    }
};
struct EpiF32 {
    static constexpr bool PERM = false, AFTER_DRAIN = false; static constexpr int MIDK = 0;
    float* O; int ldc;
    DM void operator()(const f32x4 (&acc)[2][2][4][2], const pg8::Unit& u, int wr, int wc, int fr, int fq) const {
        const int row0 = u.pm * 256 + wr * 64 + fr, col0 = u.pn * 256 + wc * 32 + 4 * fq;
#pragma unroll
        for (int ai = 0; ai < 2; ++ai)
#pragma unroll
            for (int m = 0; m < 4; ++m) { float* rowp = O + (size_t)(row0 + ai * 128 + m * 16) * ldc + col0;
#pragma unroll
                for (int bj = 0; bj < 2; ++bj)
#pragma unroll
                    for (int n = 0; n < 2; ++n) *(f32x4*)(rowp + bj * 128 + n * 16) = acc[ai][bj][m][n]; }
    }
};

#ifdef EMU
template <class Epi> static void emu_gemm(const pg8::Gemm g, const Epi& E, int ka_div = 0, int ka_mul = 0) {
    if (g.M % 256 || g.N % 256) { printf("emu_gemm: M %d N %d not multiples of 256\n", g.M, g.N); exit(1); }
    std::vector<float> C((size_t)256 * 256);
    const int seglen = (Epi::MIDK > 0) ? Epi::MIDK * 64 : g.K, nseg = g.K / seglen;
    for (int pm = 0; pm < g.M / 256; ++pm) for (int pn = 0; pn < g.N / 256; ++pn) {
        pg8::Unit u{pm, pn, 0};
        std::fill(C.begin(), C.end(), 0.f);
        for (int sg = 0; sg < nseg; ++sg) {
            for (int i = 0; i < 256; ++i) for (int j = 0; j < 256; ++j) { float a = 0.f; const bf16_t* ar = g.A + (size_t)(pm * 256 + i) * g.lda + sg * seglen + (ka_div ? (pn / ka_div) * ka_mul : 0); const bf16_t* br = g.Bt + (size_t)(pn * 256 + j) * g.ldb + sg * seglen;
                for (int k = 0; k < seglen; ++k) a += bf2f(ar[k]) * bf2f(br[k]); C[(size_t)i * 256 + j] += a; }
            const bool fin = (sg == nseg - 1);
            for (int wid = 0; wid < 8; ++wid) for (int lane = 0; lane < 64; ++lane) { const int wr = wid >> 2, wc = wid & 3, fr = lane & 15, fq = lane >> 4;
                f32x4 acc[2][2][4][2];
                for (int ai = 0; ai < 2; ++ai) for (int bj = 0; bj < 2; ++bj) for (int m = 0; m < 4; ++m) for (int n = 0; n < 2; ++n) for (int e = 0; e < 4; ++e) {
                    const int r = 128 * ai + 64 * wr + 16 * m + fr; const int c = Epi::PERM ? (128 * bj + 32 * wc + 8 * fq + 4 * n + e) : (128 * bj + 32 * wc + 16 * n + 4 * fq + e);
                    acc[ai][bj][m][n][e] = C[(size_t)r * 256 + c]; }
                if (fin) E(acc, u, wr, wc, fr, fq);
                else { if constexpr (Epi::MIDK > 0) E.mid(acc, u, sg, wr, wc, fr, fq);
                    for (int ai = 0; ai < 2; ++ai) for (int bj = 0; bj < 2; ++bj) for (int m = 0; m < 4; ++m) for (int n = 0; n < 2; ++n) for (int e = 0; e < 4; ++e) {
                        const int r = 128 * ai + 64 * wr + 16 * m + fr; const int c = Epi::PERM ? (128 * bj + 32 * wc + 8 * fq + 4 * n + e) : (128 * bj + 32 * wc + 16 * n + 4 * fq + e);
                        C[(size_t)r * 256 + c] = acc[ai][bj][m][n][e]; } } }
        }
    }
}
#endif
DI int gate_row(int sc) { const int n = sc / D, j = sc % D, jl = j & 63; return CG0 + 256 * (j >> 6) + 128 * (n >> 1) + 32 * (jl >> 4) + 8 * ((jl >> 2) & 3) + 4 * (n & 1) + (jl & 3); }
template <bool GATE> DI void transpose_item(const float* W, int N, bf16_t* dst, size_t ld_dst, int row_off, int col_off, LAS float* scr, int kb, int nb, int lane) {
    const int k0 = 64 * kb, n0 = 32 * nb;
#pragma unroll 8
    for (int i = 0; i < 32; ++i) { const int kk = 2 * i + (lane >> 5); scr[kk * 33 + (lane & 31)] = W[(size_t)(k0 + kk) * N + n0 + (lane & 31)]; }
    WAVE_SYNC();
    const int c = lane & 7;
#pragma unroll
    for (int j = 0; j < 4; ++j) { const int n = (lane >> 3) + 8 * j; const LAS float* s = scr + (8 * c) * 33 + n;
        u32x4 o; o.x = pk2(s[0 * 33], s[1 * 33]); o.y = pk2(s[2 * 33], s[3 * 33]); o.z = pk2(s[4 * 33], s[5 * 33]); o.w = pk2(s[6 * 33], s[7 * 33]);
        const int drow = GATE ? gate_row(n0 + n - C_MG) : (row_off + n0 + n);
        *(u32x4*)(dst + (size_t)drow * ld_dst + col_off + k0 + 8 * c) = o; }
    WAVE_SYNC();
}
__device__ const unsigned char T5_THR[15] = {19, 21, 24, 27, 31, 35, 40, 46, 52, 59, 67, 77, 87, 99, 113};
DI int t5_bucket(int n) { if (n < 16) return n; int b = 16;
#pragma unroll
    for (int i = 0; i < 15; ++i) b += (n >= (int)T5_THR[i]) ? 1 : 0;
    return b; }

DI void phase_prologue(KP p, lptr lds) {
    const int tid = TID(), lane = tid & 63, wave = tid >> 6;
    const int gw = blockIdx.x * 8 + wave, NGW = gridDim.x * 8;
    const size_t gt = (size_t)blockIdx.x * 512 + tid, NGT = (size_t)gridDim.x * 512;
    LAS float* scr = (LAS float*)(lds + wave * 8704);
    bf16_t* WIN = (bf16_t*)(p->ws + WS_WIN); bf16_t* WBR = (bf16_t*)(p->ws + WS_WBR); bf16_t* WOUT = (bf16_t*)(p->ws + WS_WOUT);
    constexpr int NI_IN = (D / 64) * (IN_COLS / 32), NI_V1 = (D / 64) * 1, NI_BR = (MIX / 64) * (D / 32), NI_OUT = (D / 64) * (D / 32);
    constexpr int PER_L = NI_IN + NI_V1 + 4 * NI_BR + NI_OUT;
    for (int it = gw; it < L * PER_L; it += NGW) {
        const int l = it / PER_L; int r = it % PER_L;
        if (r < NI_IN) { const int nblk = IN_COLS / 32, nb = r % nblk; const float* src = p->in[I_WIN] + (size_t)l * D * IN_COLS; bf16_t* dstw = WIN + (size_t)l * NP * D;
            if (32 * nb >= C_MG) transpose_item<true>(src, IN_COLS, dstw, D, 0, 0, scr, r / nblk, nb, lane); else transpose_item<false>(src, IN_COLS, dstw, D, 0, 0, scr, r / nblk, nb, lane); continue; } r -= NI_IN;
        if (r < NI_V1) { if (l > 0) transpose_item<false>(p->in[I_V1] + (size_t)(l - 1) * D * 32, 32, WIN + (size_t)l * NP * D, D, C_VD, 0, scr, r, 0, lane); continue; } r -= NI_V1;
        if (r < 4 * NI_BR) { const int n = r / NI_BR, rr = r % NI_BR, nblk = D / 32;
            transpose_item<false>(p->in[I_WBR] + ((size_t)l * 4 + n) * MIX * D, D, WBR + (size_t)l * 4 * D * MIX, MIX, n * D, 0, scr, rr / nblk, rr % nblk, lane); continue; } r -= 4 * NI_BR;
        { const int nblk = D / 32; transpose_item<false>(p->in[I_WOUT] + (size_t)l * D * D, D, WOUT + (size_t)l * D * D, D, 0, 0, scr, r / nblk, r % nblk, lane); }
    }
    for (int l = 0; l < L; ++l) { const int r0 = (l == 0) ? C_VD : C_VD + 32; const size_t n8 = (size_t)(CG0 - r0) * D / 8; u32x4* dst = (u32x4*)(WIN + ((size_t)l * NP + r0) * D);
        for (size_t i = gt; i < n8; i += NGT) dst[i] = (u32x4){0u, 0u, 0u, 0u}; }
    { const f32x4* x4 = (const f32x4*)p->in[I_X]; u32x2* xn = (u32x2*)(p->ws + WS_XN);
      for (size_t i = gt; i < (size_t)M * D / 4; i += NGT) { const f32x4 v = x4[i]; u32x2 o; o.x = pk2(v[0], v[1]); o.y = pk2(v[2], v[3]); xn[i] = o; } }
    { bf16_t* W2T = (bf16_t*)(p->ws + SM_W2T); bf16_t* A2T = (bf16_t*)(p->ws + SM_A2T); bf16_t* V2T = (bf16_t*)(p->ws + SM_V2T);
      for (size_t i = gt; i < (size_t)L * MIX * 64; i += NGT) { const int j = (int)(i % 64); const int c = (int)((i / 64) % MIX); const int l = (int)(i / ((size_t)64 * MIX));
          W2T[i] = f2bf(p->in[I_W2][((size_t)l * 64 + j) * MIX + c]); A2T[i] = f2bf(p->in[I_A2][((size_t)l * 64 + j) * MIX + c]); }
      for (size_t i = gt; i < (size_t)L * MIX * 32; i += NGT) { const int j = (int)(i % 32); const int c = (int)((i / 32) % MIX); const int l = (int)(i / ((size_t)32 * MIX));
          V2T[i] = (l > 0) ? f2bf(p->in[I_V2][((size_t)(l - 1) * 32 + j) * MIX + c]) : (bf16_t)0; } }
    if (blockIdx.x == 0) {
        float* LAM = (float*)(p->ws + SM_LAM); float* LB = (float*)(p->ws + SM_LB); float* BT = (float*)(p->ws + SM_BT);
        if (tid < L) { const float* lm = p->in[I_LAM] + (size_t)tid * 256; float s1 = 0.f, s2 = 0.f;
            for (int i = 0; i < 64; ++i) { s1 += lm[i] * lm[64 + i]; s2 += lm[128 + i] * lm[192 + i]; }
            const float li = 0.8f - 0.6f * expf(-0.3f * (float)tid); LAM[tid] = expf(s1) - expf(s2) + li; LAM[L + tid] = li; }
        for (int c = tid; c < MIX; c += 512) { float mx = -1e30f; for (int l = 0; l < L; ++l) mx = fmaxf(mx, p->in[I_HGLOW][(size_t)l * MIX + c]);
            float den = 0.f; for (int l = 0; l < L; ++l) den += expf(p->in[I_HGLOW][(size_t)l * MIX + c] - mx);
            float cum = 0.f; for (int l = 0; l < L; ++l) { if (l > 0) cum += expf(p->in[I_HGLOW][(size_t)l * MIX + c] - mx) / den;
                LB[(size_t)l * MIX + c] = cum; LB[(size_t)(L + l) * MIX + c] = (l > 0) ? logf(cum) : -1e30f; LB[(size_t)(2 * L + l) * MIX + c] = log1pf(-cum); } }
        for (int i = tid; i < AH * 132; i += 512) { const int h = i / 132, d = i % 132; const int bk = (d >= 128) ? 31 : t5_bucket(d); BT[i] = p->in[I_REL][bk * AH + h] * LOG2E; }
    }
}
constexpr int ATT_KSTR = 272, ATT_VSTR = 320;
constexpr int ATT_K_OFF = 0, ATT_V_OFF = 64 * ATT_KSTR, ATT_BUF = ATT_V_OFF + 64 * ATT_VSTR, ATT_BT_OFF = 2 * ATT_BUF, ATT_X_OFF = 0;
struct KVRegs { u32x4 k[2], v[2]; };
DI void load_kv(KVRegs& rg, const bf16_t* Z, size_t row0, int kcol, int vcol, int tid) {
#pragma unroll
    for (int i = 0; i < 2; ++i) { const int pc = tid + 512 * i, row = pc >> 4, c16 = pc & 15;
        rg.k[i] = *(const u32x4*)(Z + (row0 + row) * ZLD + kcol + c16 * 8);
        rg.v[i] = *(const u32x4*)(Z + (row0 + row) * ZLD + vcol + c16 * 8); }
}
DI void store_kv(const KVRegs& rg, lptr lds, int tid) {
#pragma unroll
    for (int i = 0; i < 2; ++i) { const int pc = tid + 512 * i, row = pc >> 4, c16 = pc & 15;
        *(LAS u32x4*)(lds + ATT_K_OFF + row * ATT_KSTR + c16 * 16) = rg.k[i];
        *(LAS u32x4*)(lds + ATT_V_OFF + row * ATT_VSTR + c16 * 16) = rg.v[i]; }
}
DI void pv_acc(f32x16 (&o)[4], const f32x16& pt, lptr lds, int kh, int lane) {
    const int hh = lane >> 5, gsub = (lane >> 4) & 1, i16 = lane & 15, qq = i16 >> 2, pp = i16 & 3;
#pragma unroll
    for (int s = 0; s < 2; ++s) {
        const bf16x8 pb = pack8(pt[8 * s], pt[8 * s + 1], pt[8 * s + 2], pt[8 * s + 3], pt[8 * s + 4], pt[8 * s + 5], pt[8 * s + 6], pt[8 * s + 7]);
        const lptr vrow = lds + ATT_V_OFF + (32 * kh + 16 * s + 4 * hh + qq) * ATT_VSTR + gsub * 32 + pp * 8;
#pragma unroll
        for (int db = 0; db < 4; ++db) {
            const s16x4 lo = TR_READ(vrow + db * 64), hi = TR_READ(vrow + 8 * ATT_VSTR + db * 64);
            o[db] = MFMA32(cat4(lo, hi), pb, o[db]); }
    }
}
DI void phase_att_a(KP p, int layer, lptr lds, int unit) {
    const int tid = TID(), lane = tid & 63, wid = RFL(tid >> 6), r = lane & 31, hh = lane >> 5;
    constexpr int NQB = S / 128;
    const int qb = NQB - 1 - (unit / (NB * AH)), bh = unit % (NB * AH), h = bh % AH, b = bh / AH;
    const int mp = wid & 1, qs = wid >> 1, q0 = qb * 128, qw0 = q0 + 32 * qs, q = qw0 + r;
    const bf16_t* Z = (const bf16_t*)(p->ws + WS_Z); const size_t rowb = (size_t)b * S;
    const float* LAM = (const float*)(p->ws + SM_LAM); const float lam_full = LAM[layer], lam_init = LAM[L + layer];
    LAS float* BT = (LAS float*)(lds + ATT_BT_OFF);
    __syncthreads();
    if (tid < 132) BT[tid] = ((const float*)(p->ws + SM_BT))[h * 132 + tid];
    bf16x8 qf[4];
    { const bf16_t* qp = Z + (rowb + q) * ZLD + C_AQ + h * 128 + mp * 64 + 8 * hh; const float qsc = 0.125f * LOG2E;
#pragma unroll
      for (int ds = 0; ds < 4; ++ds) { const u32x4 w = *(const u32x4*)(qp + 16 * ds);
          qf[ds] = pack8(bflo(w.x) * qsc, bfhi(w.x) * qsc, bflo(w.y) * qsc, bfhi(w.y) * qsc, bflo(w.z) * qsc, bfhi(w.z) * qsc, bflo(w.w) * qsc, bfhi(w.w) * qsc); } }
    f32x16 o[4];
#pragma unroll
    for (int db = 0; db < 4; ++db)
#pragma unroll
        for (int i = 0; i < 16; ++i) o[db][i] = 0.f;
    float mrun = -INFINITY, lrun = 0.f;
    const int nkt = (q0 + 128) / 64;
    KVRegs rg; load_kv(rg, Z, rowb, C_AK + h * 128, C_AV + h * 128, tid);
    store_kv(rg, lds, tid);
    if (nkt > 1) load_kv(rg, Z, rowb + 64, C_AK + h * 128, C_AV + h * 128, tid);
    __syncthreads();
    for (int kt = 0; kt < nkt; ++kt) {
        const int k0 = kt * 64; const lptr buf = lds + (kt & 1) * ATT_BUF;
        if (kt + 1 < nkt) store_kv(rg, lds + ((kt + 1) & 1) * ATT_BUF, tid);
        if (kt + 2 < nkt) load_kv(rg, Z, rowb + k0 + 128, C_AK + h * 128, C_AV + h * 128, tid);
        if (k0 <= qw0 + 31) {
            const bool two = (k0 + 32 <= qw0 + 31);
            const bool far = (qw0 - (k0 + 63) >= 128);
            const float cinit = far ? BT[128] : 0.f;
            f32x16 sc0, sc1;
#pragma unroll
            for (int i = 0; i < 16; ++i) { sc0[i] = cinit; sc1[i] = cinit; }
#pragma unroll
            for (int ds = 0; ds < 4; ++ds) { sc0 = MFMA32(*(const LAS bf16x8*)(buf + ATT_K_OFF + r * ATT_KSTR + mp * 128 + ds * 32 + hh * 16), qf[ds], sc0);
                if (two) sc1 = MFMA32(*(const LAS bf16x8*)(buf + ATT_K_OFF + (32 + r) * ATT_KSTR + mp * 128 + ds * 32 + hh * 16), qf[ds], sc1); }
            if (!far) {
#pragma unroll
                for (int i = 0; i < 16; ++i) { const int d0 = q - (k0 + crow(i, hh)), d1 = d0 - 32; const int i0 = d0 < 0 ? 0 : (d0 > 128 ? 128 : d0), i1 = d1 < 0 ? 0 : (d1 > 128 ? 128 : d1);
                    sc0[i] = (d0 < 0) ? -INFINITY : sc0[i] + BT[i0]; sc1[i] = (d1 < 0 || !two) ? -INFINITY : sc1[i] + BT[i1]; }
            }
            float mx = fmaxf(sc0[0], sc1[0]);
#pragma unroll
            for (int i = 1; i < 16; ++i) mx = fmaxf(mx, fmaxf(sc0[i], sc1[i]));
            mx = fmaxf(mx, __shfl_xor(mx, 32));
            const float mnew = fmaxf(mrun, mx), alpha = ex2(mrun - mnew);
            float sum = 0.f;
#pragma unroll
            for (int i = 0; i < 16; ++i) { const float e0 = ex2(sc0[i] - mnew), e1 = ex2(sc1[i] - mnew); sc0[i] = e0; sc1[i] = e1; sum += e0 + e1; }
            sum += __shfl_xor(sum, 32);
            lrun = lrun * alpha + sum; mrun = mnew;
            if (ANY(alpha != 1.f)) {
#pragma unroll
                for (int db = 0; db < 4; ++db)
#pragma unroll
                    for (int i = 0; i < 16; ++i) o[db][i] *= alpha; }
            pv_acc(o, sc0, buf, 0, lane); if (two) pv_acc(o, sc1, buf, 1, lane);
        }
        __syncthreads();
    }
    __syncthreads();
    const float inv = 1.f / lrun;
    LAS float* X = (LAS float*)(lds + ATT_X_OFF) + (qs * 32 + r) * 132;
    if (mp == 1) {
#pragma unroll
        for (int db = 0; db < 4; ++db)
#pragma unroll
            for (int g = 0; g < 4; ++g) { f32x4 v; v[0] = o[db][4 * g] * inv * lam_full; v[1] = o[db][4 * g + 1] * inv * lam_full; v[2] = o[db][4 * g + 2] * inv * lam_full; v[3] = o[db][4 * g + 3] * inv * lam_full;
                *(LAS f32x4*)(X + 32 * db + 8 * g + 4 * hh) = v; }
    }
    __syncthreads();
    if (mp == 0) {
        float ss = 0.f;
#pragma unroll
        for (int db = 0; db < 4; ++db)
#pragma unroll
            for (int g = 0; g < 4; ++g) { const f32x4 x1 = *(const LAS f32x4*)(X + 32 * db + 8 * g + 4 * hh);
#pragma unroll
                for (int e = 0; e < 4; ++e) { const float x = o[db][4 * g + e] * inv - x1[e]; o[db][4 * g + e] = x; ss += x * x; } }
        ss += __shfl_xor(ss, 32);
        const float rinv = frsq(ss * (1.f / 128.f) + RMS_EPS) * (1.f - lam_init);
        const float* sg = p->in[I_SUBLN] + (size_t)layer * 128;
        const bf16_t* gp = Z + (rowb + q) * ZLD + C_AG + h * 128; bf16_t* yp = (bf16_t*)(p->ws + WS_Y) + (rowb + q) * (4 * MIX) + 0 * MIX + h * 128;
#pragma unroll
        for (int db = 0; db < 4; ++db)
#pragma unroll
            for (int g = 0; g < 4; ++g) { const int d = 32 * db + 8 * g + 4 * hh; const u32x2 gw = *(const u32x2*)(gp + d); const f32x4 sv = *(const f32x4*)(sg + d);
                u32x2 w; w.x = pk2(o[db][4 * g] * rinv * sv[0] * fsilu(bflo(gw.x)), o[db][4 * g + 1] * rinv * sv[1] * fsilu(bfhi(gw.x)));
                w.y = pk2(o[db][4 * g + 2] * rinv * sv[2] * fsilu(bflo(gw.y)), o[db][4 * g + 3] * rinv * sv[3] * fsilu(bfhi(gw.y)));
                *(u32x2*)(yp + d) = w; }
    }
}

constexpr float SB_CUT = -110.f;
DI void phase_att_d(KP p, int layer, lptr lds, int unit) {
    const int tid = TID(), lane = tid & 63, wid = RFL(tid >> 6), r = lane & 31, hh = lane >> 5;
    constexpr int NQB = S / 256;
    const int qb = NQB - 1 - (unit / (NB * SH)), bh = unit % (NB * SH), h = bh % SH, b = bh / SH;
    const int q0 = qb * 256, qw0 = q0 + 32 * wid, q = qw0 + r;
    const bf16_t* Z = (const bf16_t*)(p->ws + WS_Z); const size_t rowb = (size_t)b * S;
    LAS int* FLG = (LAS int*)(lds + ATT_BT_OFF);
    bf16x8 qf[8];
    { const bf16_t* qp = Z + (rowb + q) * ZLD + C_SQ + h * 128 + 8 * hh; const float qsc = 0.08838834764831845f;
#pragma unroll
      for (int ds = 0; ds < 8; ++ds) { const u32x4 w = *(const u32x4*)(qp + 16 * ds);
          qf[ds] = pack8(bflo(w.x) * qsc, bfhi(w.x) * qsc, bflo(w.y) * qsc, bfhi(w.y) * qsc, bflo(w.z) * qsc, bfhi(w.z) * qsc, bflo(w.w) * qsc, bfhi(w.w) * qsc); } }
    f32x16 o[4];
#pragma unroll
    for (int db = 0; db < 4; ++db)
#pragma unroll
        for (int i = 0; i < 16; ++i) o[db][i] = 0.f;
    float carry = 0.f;
    const int kt_hi = (q0 + 255) / 64;
    __syncthreads();
    KVRegs rg; load_kv(rg, Z, rowb + (size_t)kt_hi * 64, C_SK + h * 128, C_SV + h * 128, tid);
    store_kv(rg, lds + (kt_hi & 1) * ATT_BUF, tid);
    if (kt_hi > 0) load_kv(rg, Z, rowb + (size_t)(kt_hi - 1) * 64, C_SK + h * 128, C_SV + h * 128, tid);
    __syncthreads();
    for (int kt = kt_hi; kt >= 0; --kt) {
        const int k0 = kt * 64; const lptr buf = lds + (kt & 1) * ATT_BUF;
        if (kt > 0) store_kv(rg, lds + ((kt - 1) & 1) * ATT_BUF, tid);
        if (kt > 1) load_kv(rg, Z, rowb + k0 - 128, C_SK + h * 128, C_SV + h * 128, tid);
        if (k0 < qw0 + 31) {
#pragma unroll 1
            for (int kh = 1; kh >= 0; --kh) {
                if (k0 + 32 * kh >= qw0 + 31) continue;
                f32x16 z;
#pragma unroll
                for (int i = 0; i < 16; ++i) z[i] = 0.f;
#pragma unroll
                for (int ds = 0; ds < 8; ++ds) { const bf16x8 a = *(const LAS bf16x8*)(buf + ATT_K_OFF + (32 * kh + r) * ATT_KSTR + ds * 32 + hh * 16); z = MFMA32(a, qf[ds], z); }
                f32x16 lk; float gsum[4];
#pragma unroll
                for (int g = 0; g < 4; ++g) { gsum[g] = 0.f;
#pragma unroll
                    for (int e = 0; e < 4; ++e) { const int i = 4 * g + e; const bool valid = (k0 + 32 * kh + crow(i, hh)) < q; const float sp = fsoftplus(z[i]);
                        lk[i] = valid ? -sp : 0.f; z[i] = valid ? (z[i] - sp) : -INFINITY; gsum[g] += lk[i]; } }
                float og[4];
#pragma unroll
                for (int g = 0; g < 4; ++g) og[g] = __shfl_xor(gsum[g], 32);
                float suf[4]; float run = 0.f;
#pragma unroll
                for (int g = 3; g >= 0; --g) {
                    if (hh == 1) { suf[g] = run; run += gsum[g] + og[g]; }
                    else { suf[g] = run + og[g]; run += gsum[g] + og[g]; }
                }
#pragma unroll
                for (int g = 0; g < 4; ++g) { float inner = 0.f;
#pragma unroll
                    for (int e = 3; e >= 0; --e) { const int i = 4 * g + e; const float between = carry + suf[g] + inner; inner += lk[i]; z[i] = ex2((z[i] + between) * LOG2E); } }
                carry += run;
                pv_acc(o, z, buf, kh, lane);
            }
        }
        const int active = ANY(carry > SB_CUT) ? 1 : 0;
        if (lane == 0) FLG[(kt & 1) * 8 + wid] = active;
        __syncthreads();
        int anyact = 0;
#pragma unroll
        for (int w = 0; w < 8; ++w) anyact |= FLG[(kt & 1) * 8 + w];
        if (!anyact) break;
    }
    const bf16_t* gp = Z + (rowb + q) * ZLD + C_SG + h * 128; bf16_t* yp = (bf16_t*)(p->ws + WS_Y) + (rowb + q) * (4 * MIX) + 3 * MIX + h * 128;
#pragma unroll
    for (int db = 0; db < 4; ++db)
#pragma unroll
        for (int g = 0; g < 4; ++g) { const int d = 32 * db + 8 * g + 4 * hh; const u32x2 gw = *(const u32x2*)(gp + d);
            u32x2 w; w.x = pk2(o[db][4 * g] * fsilu(bflo(gw.x)), o[db][4 * g + 1] * fsilu(bfhi(gw.x)));
            w.y = pk2(o[db][4 * g + 2] * fsilu(bflo(gw.y)), o[db][4 * g + 3] * fsilu(bfhi(gw.y)));
            *(u32x2*)(yp + d) = w; }
}
constexpr int HG_STR = 144;
constexpr int HG_QT = 0, HG_KT = 128 * HG_STR, HG_IT = 2 * 128 * HG_STR, HG_SC = 3 * 128 * HG_STR, HG_VEC = HG_SC + 64 * HG_STR;
DI bf16x8 hg_trfrag(lptr img, int col0, int dbase, int lane) {
    const int g = lane >> 4, i16 = lane & 15, qq = i16 >> 2, pp = i16 & 3;
    const lptr a = img + (dbase + 4 * g + qq) * HG_STR + (col0 + 4 * pp) * 2;
    return cat4(TR_READ(a), TR_READ(a + 16 * HG_STR));
}
constexpr int HG_NC = S / 64, HG_NCH = NB * HH * HG_NC;
DI void phase_hg_local(KP p, int layer, lptr lds, int unit) {
    const int tid = TID(), lane = tid & 63, wid = RFL(tid >> 6), g = lane >> 4, c16 = lane & 15;
    const int c = unit % HG_NC, bh = unit / HG_NC, h = bh % HH, b = bh / HH;
    const bf16_t* Z = (const bf16_t*)(p->ws + WS_Z); const size_t row0 = (size_t)b * S + (size_t)c * 64;
    const float* LBp = (const float*)(p->ws + SM_LB);
    LAS float* EBD = (LAS float*)(lds + HG_VEC); LAS float* QTOT = EBD + 128;
    const int ch = tid & 127, tq = tid >> 7;
    const float lb = LBp[(size_t)layer * MIX + h * 128 + ch], loglb = LBp[(size_t)(L + layer) * MIX + h * 128 + ch], log1m = LBp[(size_t)(2 * L + layer) * MIX + h * 128 + ch];
    __syncthreads();
    float bl[16], qv[16], kv[16], iv[16];
    { const bf16_t* zp = Z + (row0 + 16 * tq) * ZLD + h * 128 + ch; float run = 0.f;
#pragma unroll
      for (int t = 0; t < 16; ++t) { const float zq = bf2f(zp[(size_t)t * ZLD + C_HQ]), zf = bf2f(zp[(size_t)t * ZLD + C_HF]); iv[t] = bf2f(zp[(size_t)t * ZLD + C_HI]);
          const float ls = -fsoftplus(-zf);
          float lf; if (lb > 0.f) { const float a_ = loglb, b_ = log1m + ls, mx = fmaxf(a_, b_); lf = mx + flog(fexp(a_ - mx) + fexp(b_ - mx)); } else lf = ls;
          run += lf; bl[t] = run; qv[t] = zq; kv[t] = (1.f - lb) * fexp(ls - zf); }
      QTOT[tq * 128 + ch] = run; }
    __syncthreads();
    { const float t0 = QTOT[ch], t1 = QTOT[128 + ch], t2 = QTOT[256 + ch], t3 = QTOT[384 + ch];
      const float pre = (tq > 0 ? t0 : 0.f) + (tq > 1 ? t1 : 0.f) + (tq > 2 ? t2 : 0.f), bref = t0 + t1, blast = bref + t2 + t3;
      unsigned qw[8], kw[8], iw[8];
#pragma unroll
      for (int t = 0; t < 16; t += 2) { const float b0 = pre + bl[t] - bref, b1 = pre + bl[t + 1] - bref;
          qw[t >> 1] = pk2(qv[t] * fexp(b0), qv[t + 1] * fexp(b1)); kw[t >> 1] = pk2(kv[t] * fexp(-b0), kv[t + 1] * fexp(-b1)); iw[t >> 1] = pk2(iv[t], iv[t + 1]); }
      LAS u32x4* dq = (LAS u32x4*)(lds + HG_QT + ch * HG_STR + tq * 32); dq[0] = (u32x4){qw[0], qw[1], qw[2], qw[3]}; dq[1] = (u32x4){qw[4], qw[5], qw[6], qw[7]};
      LAS u32x4* dk = (LAS u32x4*)(lds + HG_KT + ch * HG_STR + tq * 32); dk[0] = (u32x4){kw[0], kw[1], kw[2], kw[3]}; dk[1] = (u32x4){kw[4], kw[5], kw[6], kw[7]};
      LAS u32x4* di = (LAS u32x4*)(lds + HG_IT + ch * HG_STR + tq * 32); di[0] = (u32x4){iw[0], iw[1], iw[2], iw[3]}; di[1] = (u32x4){iw[4], iw[5], iw[6], iw[7]};
      if (tq == 0) { float* VE = (float*)(p->ws + WS_HGVE) + (size_t)unit * 256; VE[ch] = fexp(bref); VE[128 + ch] = fexp(blast); EBD[ch] = fexp(blast - bref); } }
    __syncthreads();
#pragma unroll
    for (int k2 = 0; k2 < 2; ++k2) { const int ti = 2 * wid + k2, tb = ti >> 2, sb = ti & 3;
        f32x4 acc = (f32x4){0.f, 0.f, 0.f, 0.f};
        if (sb <= tb) {
#pragma unroll
            for (int dp = 0; dp < 4; ++dp) acc = MFMA16(hg_trfrag(lds + HG_QT, 16 * tb, 32 * dp, lane), hg_trfrag(lds + HG_KT, 16 * sb, 32 * dp, lane), acc); }
        const int s = 16 * sb + c16;
#pragma unroll
        for (int e = 0; e < 4; ++e) { const int t = 16 * tb + 4 * g + e; *(LAS bf16_t*)(lds + HG_SC + t * HG_STR + s * 2) = f2bf((s <= t) ? acc[e] : 0.f); }
        ((bf16x8*)(p->ws + WS_HGQF))[((size_t)unit * 16 + ti) * 64 + lane] = hg_trfrag(lds + HG_QT, 16 * (ti >> 2), 32 * (ti & 3), lane); }
    __syncthreads();
    bf16x8 ib[2];
#pragma unroll
    for (int ks = 0; ks < 2; ++ks) ib[ks] = *(const LAS bf16x8*)(lds + HG_IT + (16 * wid + c16) * HG_STR + (8 * g + 32 * ks) * 2);
    f32x4* IN = (f32x4*)(p->ws + WS_HGIN) + ((size_t)unit * 8 + wid) * 4 * 64;
#pragma unroll
    for (int tb = 0; tb < 4; ++tb) { f32x4 acc = (f32x4){0.f, 0.f, 0.f, 0.f};
#pragma unroll
        for (int ks = 0; ks < 2; ++ks) acc = MFMA16(*(const LAS bf16x8*)(lds + HG_SC + (16 * tb + c16) * HG_STR + (8 * g + 32 * ks) * 2), ib[ks], acc);
        IN[tb * 64 + lane] = acc; }
    f32x4* DS = (f32x4*)(p->ws + WS_HGDS) + ((size_t)unit * 8 + wid) * 8 * 64;
#pragma unroll
    for (int db = 0; db < 8; ++db) { f32x4 tmp = (f32x4){0.f, 0.f, 0.f, 0.f};
#pragma unroll
        for (int ks = 0; ks < 2; ++ks) tmp = MFMA16(*(const LAS bf16x8*)(lds + HG_KT + (16 * db + c16) * HG_STR + (8 * g + 32 * ks) * 2), ib[ks], tmp);
        const f32x4 ed = *(const LAS f32x4*)(EBD + 16 * db + 4 * g);
        DS[db * 64 + lane] = tmp * ed; }
}
DI void phase_hg_scan(KP p, int unit) {
    const int tid = TID(), lane = tid & 63, wid = RFL(tid >> 6), g = lane >> 4;
    f32x4 st[8];
#pragma unroll
    for (int db = 0; db < 8; ++db) st[db] = (f32x4){0.f, 0.f, 0.f, 0.f};
    const float* VE0 = (const float*)(p->ws + WS_HGVE) + (size_t)unit * HG_NC * 256;
    const f32x4* DS0 = (const f32x4*)(p->ws + WS_HGDS) + ((size_t)unit * HG_NC * 8 + wid) * 8 * 64 + lane;
    bf16x8* SF0 = (bf16x8*)(p->ws + WS_HGSF) + ((size_t)unit * HG_NC * 8 + wid) * 4 * 64 + lane;
    f32x4 ds[8], el[8], er[8];
#pragma unroll
    for (int db = 0; db < 8; ++db) { ds[db] = DS0[db * 64]; el[db] = *(const f32x4*)(VE0 + 128 + 16 * db + 4 * g); er[db] = *(const f32x4*)(VE0 + 16 * db + 4 * g); }
    for (int c = 0; c < HG_NC; ++c) {
        const int cn = (c + 1 < HG_NC) ? c + 1 : c;
        f32x4 dsn[8], eln[8], ern[8];
#pragma unroll
        for (int db = 0; db < 8; ++db) { dsn[db] = DS0[((size_t)cn * 8 * 8 + db) * 64]; eln[db] = *(const f32x4*)(VE0 + (size_t)cn * 256 + 128 + 16 * db + 4 * g); ern[db] = *(const f32x4*)(VE0 + (size_t)cn * 256 + 16 * db + 4 * g); }
#pragma unroll
        for (int dp = 0; dp < 4; ++dp) { const f32x4 a0 = st[2 * dp] * er[2 * dp], a1 = st[2 * dp + 1] * er[2 * dp + 1];
            SF0[((size_t)c * 8 * 4 + dp) * 64] = pack8(a0[0], a0[1], a0[2], a0[3], a1[0], a1[1], a1[2], a1[3]); }
#pragma unroll
        for (int db = 0; db < 8; ++db) { st[db] = el[db] * st[db] + ds[db]; ds[db] = dsn[db]; el[db] = eln[db]; er[db] = ern[db]; }
    }
}
DI void phase_hg_out(KP p, int layer, lptr lds, int unit) {
    const int tid = TID(), lane = tid & 63, wid = RFL(tid >> 6), g = lane >> 4, c16 = lane & 15;
    const int c = unit % HG_NC, bh = unit / HG_NC, h = bh % HH, b = bh / HH;
    const bf16_t* Z = (const bf16_t*)(p->ws + WS_Z); const size_t row0 = (size_t)b * S + (size_t)c * 64;
    LAS float* PS = (LAS float*)(lds + HG_VEC);
    const float gnorm = p->in[I_HGNORM][(size_t)layer * 128 + 16 * wid + c16];
    const bf16x8* QF = (const bf16x8*)(p->ws + WS_HGQF) + (size_t)unit * 16 * 64 + lane;
    const bf16x8* SF = (const bf16x8*)(p->ws + WS_HGSF) + ((size_t)unit * 8 + wid) * 4 * 64 + lane;
    const f32x4* IN = (const f32x4*)(p->ws + WS_HGIN) + ((size_t)unit * 8 + wid) * 4 * 64 + lane;
    bf16x8 sf[4];
#pragma unroll
    for (int dp = 0; dp < 4; ++dp) sf[dp] = SF[dp * 64];
    f32x4 ot[4];
#pragma unroll
    for (int tb = 0; tb < 4; ++tb) { f32x4 acc = IN[tb * 64];
#pragma unroll
        for (int dp = 0; dp < 4; ++dp) acc = MFMA16(QF[(tb * 4 + dp) * 64], sf[dp], acc);
        ot[tb] = acc; }
    if (c == 0 && g == 0) { const float* OEX = (const float*)(p->ws + WS_OEX) + (size_t)bh * FX_T * 128 + 16 * wid + c16;
#pragma unroll
        for (int e = 0; e < FX_T; ++e) ot[0][e] = OEX[e * 128]; }
    __syncthreads();
#pragma unroll
    for (int tb = 0; tb < 4; ++tb)
#pragma unroll
        for (int e = 0; e < 4; ++e) { float v = ot[tb][e] * ot[tb][e]; v += __shfl_xor(v, 1); v += __shfl_xor(v, 2); v += __shfl_xor(v, 4); v += __shfl_xor(v, 8);
            if (c16 == 0) PS[wid * 64 + 16 * tb + 4 * g + e] = v; }
    __syncthreads();
    const int e_col = h * 128 + 16 * wid + c16;
#pragma unroll
    for (int tb = 0; tb < 4; ++tb)
#pragma unroll
        for (int e = 0; e < 4; ++e) { const int t = 16 * tb + 4 * g + e; float ss = 0.f;
#pragma unroll
            for (int w = 0; w < 8; ++w) ss += PS[w * 64 + t];
            const float gate = bf2f(Z[(row0 + t) * ZLD + C_HG + e_col]);
            ((bf16_t*)(p->ws + WS_Y))[(row0 + t) * (4 * MIX) + 1 * MIX + e_col] = f2bf(ot[tb][e] * frsq(ss * (1.f / 128.f) + RMS_EPS) * gnorm * fsilu(gate)); }
}
constexpr int RC_GT = 0, RC_SL = 8192, RC_RH = 16384, RC_OL = 18432, RC_GAM = 22528, RC_BYTES = 22784;
constexpr int RC_NSUB = S / 16;
DI bf16x8 frag4_lds(lptr p) { const u32x2 w = *(const LAS u32x2*)p; u32x4 o; o.x = w.x; o.y = w.y; o.z = 0u; o.w = 0u; return __builtin_bit_cast(bf16x8, o); }
DI bf16x8 frag4_acc(const f32x4& x) { u32x4 o; o.x = pk2(x[0], x[1]); o.y = pk2(x[2], x[3]); o.z = 0u; o.w = 0u; return __builtin_bit_cast(bf16x8, o); }
DI float gbf(const bf16_t* p) { return bf2f(*p); }
DI void rw_local_item(KP p, int layer, lptr wl, int item, int lane) {
    const int j = item % RC_NSUB, bh = item / RC_NSUB, hd = bh % RH, b = bh / RH, g = lane >> 4, c16 = lane & 15;
    const int t0 = 16 * j; const size_t m0 = (size_t)b * S + t0;
    unsigned char* rec = p->ws + WS_RC + (size_t)item * RC_BYTES;
    const bf16_t* Z = (const bf16_t*)(p->ws + WS_Z); const float* mu = p->in[I_MU] + (size_t)layer * RW_MIX;
    bf16x8 xw[2], xa[2], xv; xv = (bf16x8){0, 0, 0, 0, 0, 0, 0, 0};
    { const bf16_t* cur = Z + (m0 + c16) * ZLD; const bool hp = (t0 + c16) > 0; const bf16_t* prv = hp ? cur - ZLD : cur;
#pragma unroll
      for (int ks = 0; ks < 2; ++ks) { const int jj = 32 * ks + 8 * g;
          const u32x4 cw = *(const u32x4*)(cur + C_RM + 3 * MIX + jj), ca = *(const u32x4*)(cur + C_RM + 3 * MIX + 64 + jj); u32x4 pw = (u32x4){0u, 0u, 0u, 0u}, pa = pw;
          if (hp) { pw = *(const u32x4*)(prv + C_RM + 3 * MIX + jj); pa = *(const u32x4*)(prv + C_RM + 3 * MIX + 64 + jj); }
          const f32x4 m0v = *(const f32x4*)(mu + 3 * MIX + jj), m1v = *(const f32x4*)(mu + 3 * MIX + jj + 4), n0v = *(const f32x4*)(mu + 3 * MIX + 64 + jj), n1v = *(const f32x4*)(mu + 3 * MIX + 64 + jj + 4);
#define LRP(c, q, m) ((c) + ((q) - (c)) * (m))
          xw[ks] = pack8(tanhf(LRP(bflo(cw.x), bflo(pw.x), m0v[0])), tanhf(LRP(bfhi(cw.x), bfhi(pw.x), m0v[1])), tanhf(LRP(bflo(cw.y), bflo(pw.y), m0v[2])), tanhf(LRP(bfhi(cw.y), bfhi(pw.y), m0v[3])),
                         tanhf(LRP(bflo(cw.z), bflo(pw.z), m1v[0])), tanhf(LRP(bfhi(cw.z), bfhi(pw.z), m1v[1])), tanhf(LRP(bflo(cw.w), bflo(pw.w), m1v[2])), tanhf(LRP(bfhi(cw.w), bfhi(pw.w), m1v[3])));
          xa[ks] = pack8(LRP(bflo(ca.x), bflo(pa.x), n0v[0]), LRP(bfhi(ca.x), bfhi(pa.x), n0v[1]), LRP(bflo(ca.y), bflo(pa.y), n0v[2]), LRP(bfhi(ca.y), bfhi(pa.y), n0v[3]),
                         LRP(bflo(ca.z), bflo(pa.z), n1v[0]), LRP(bfhi(ca.z), bfhi(pa.z), n1v[1]), LRP(bflo(ca.w), bflo(pa.w), n1v[2]), LRP(bfhi(ca.w), bfhi(pa.w), n1v[3])); }
      if (layer > 0) { const float* vmu = p->in[I_VMU] + (size_t)(layer - 1) * 32 + 8 * g; const u32x4 cv = *(const u32x4*)(cur + C_VD + 8 * g); u32x4 pv = (u32x4){0u, 0u, 0u, 0u}; if (hp) pv = *(const u32x4*)(prv + C_VD + 8 * g);
          const f32x4 m0v = *(const f32x4*)vmu, m1v = *(const f32x4*)(vmu + 4);
          xv = pack8(LRP(bflo(cv.x), bflo(pv.x), m0v[0]), LRP(bfhi(cv.x), bfhi(pv.x), m0v[1]), LRP(bflo(cv.y), bflo(pv.y), m0v[2]), LRP(bfhi(cv.y), bfhi(pv.y), m0v[3]),
                     LRP(bflo(cv.z), bflo(pv.z), m1v[0]), LRP(bfhi(cv.z), bfhi(pv.z), m1v[1]), LRP(bflo(cv.w), bflo(pv.w), m1v[2]), LRP(bfhi(cv.w), bfhi(pv.w), m1v[3])); }
#undef LRP
    }
    const bf16_t* W2T = (const bf16_t*)(p->ws + SM_W2T) + (size_t)layer * MIX * 64; const bf16_t* A2T = (const bf16_t*)(p->ws + SM_A2T) + (size_t)layer * MIX * 64;
    const bf16_t* V2T = (const bf16_t*)(p->ws + SM_V2T) + (size_t)layer * MIX * 32;
    const bf16_t* zg = Z + (m0 + 4 * g) * ZLD + C_RM + hd * 64 + c16; const bool hpg = (t0 + 4 * g) > 0;
    float ssq[4] = {0.f, 0.f, 0.f, 0.f};
#pragma unroll
    for (int cb = 0; cb < 4; ++cb) { const int ch = hd * 64 + 16 * cb + c16; const float mk = mu[MIX + ch], kk0 = p->in[I_KK][(size_t)layer * MIX + ch]; float pk = hpg ? gbf(zg - ZLD + MIX + 16 * cb) : 0.f;
#pragma unroll
        for (int e = 0; e < 4; ++e) { const float ck = gbf(zg + (size_t)e * ZLD + MIX + 16 * cb), kk = (ck + (pk - ck) * mk) * kk0; ssq[e] += kk * kk; pk = ck; } }
#pragma unroll
    for (int e = 0; e < 4; ++e) { float s = ssq[e]; s += __shfl_xor(s, 1); s += __shfl_xor(s, 2); s += __shfl_xor(s, 4); s += __shfl_xor(s, 8); ssq[e] = 1.f / fmaxf(sqrtf(s), 1e-12f); }
    float bon[4] = {0.f, 0.f, 0.f, 0.f};
#pragma unroll 1
    for (int cb = 0; cb < 4; ++cb) { const int chl = 16 * cb + c16, ch = hd * 64 + chl; const f32x4 z4 = (f32x4){0.f, 0.f, 0.f, 0.f};
        f32x4 lw = z4, la = z4, lv = z4;
#pragma unroll
        for (int ks = 0; ks < 2; ++ks) { lw = MFMA16(xw[ks], *(const bf16x8*)(W2T + (size_t)ch * 64 + 32 * ks + 8 * g), lw); la = MFMA16(xa[ks], *(const bf16x8*)(A2T + (size_t)ch * 64 + 32 * ks + 8 * g), la); }
        if (layer > 0) lv = MFMA16(xv, *(const bf16x8*)(V2T + (size_t)ch * 32 + 8 * g), lv);
        const float mr = mu[ch], mk = mu[MIX + ch], mv = mu[2 * MIX + ch];
        const float w0 = p->in[I_W0][(size_t)layer * MIX + ch], a0 = p->in[I_A0][(size_t)layer * MIX + ch], kk0 = p->in[I_KK][(size_t)layer * MIX + ch], ka = p->in[I_KA][(size_t)layer * MIX + ch];
        const float rk = p->in[I_RK][(size_t)layer * MIX + ch], v0 = p->in[I_V0][(size_t)(layer > 0 ? layer - 1 : 0) * MIX + ch];
        const bf16_t* zc = zg + 16 * cb;
        float pr = 0.f, pk = 0.f, pv = 0.f; if (hpg) { pr = gbf(zc - ZLD); pk = gbf(zc - ZLD + MIX); pv = gbf(zc - ZLD + 2 * MIX); }
        float rr[4], lg[4], k2[4], vv[4], kn[4], aa[4];
#pragma unroll
        for (int e = 0; e < 4; ++e) { const int tl = 4 * g + e, tq = t0 + tl; const float cr = gbf(zc + (size_t)e * ZLD), ck = gbf(zc + (size_t)e * ZLD + MIX), cv = gbf(zc + (size_t)e * ZLD + 2 * MIX);
            rr[e] = cr + (pr - cr) * mr; const float k = ck + (pk - ck) * mk; float v = cv + (pv - cv) * mv; pr = cr; pk = ck; pv = cv;
            const float wlog = -fsoftplus(-(w0 + lw[e])) - 0.5f; aa[e] = fsigmoid(a0 + la[e]);
            float* VF = (float*)(p->ws + WS_VF) + (m0 + tl) * MIX + ch;
            if (layer == 0) { if (tq >= FX_T) *VF = v; } else { const float vf = *VF; v = v + (vf - v) * fsigmoid(v0 + lv[e]); }
            if (tq >= FX_T) ((float*)(p->ws + WS_VV))[(m0 + tl) * MIX + ch] = v;
            kn[e] = k * kk0 * ssq[e]; k2[e] = k * (1.f + (aa[e] - 1.f) * ka); vv[e] = v; lg[e] = -fexp(wlog);
            bon[e] += rr[e] * k2[e] * rk; }
        float pre[4]; pre[0] = lg[0]; pre[1] = pre[0] + lg[1]; pre[2] = pre[1] + lg[2]; pre[3] = pre[2] + lg[3];
        const float G0 = __shfl(pre[3], c16), G1 = __shfl(pre[3], 16 + c16), G2 = __shfl(pre[3], 32 + c16), G3 = __shfl(pre[3], 48 + c16);
        const float P = (g > 0 ? G0 : 0.f) + (g > 1 ? G1 : 0.f) + (g > 2 ? G2 : 0.f), tot = (G0 + G1) + (G2 + G3), gC = fexp(tot);
        if (g == 0) ((float*)(rec + RC_GAM))[chl] = gC;
        float av[4], bv[4], kv[4];
#pragma unroll
        for (int e = 0; e < 4; ++e) { const float lwt = P + pre[e], gt = fexp(lwt), gp = fexp(lwt - lg[e]), gi = fexp(-lwt); const int t = 4 * g + e;
            av[e] = -kn[e] * gp; bv[e] = kn[e] * aa[e] * gi; kv[e] = k2[e] * gi;
            *(LAS bf16_t*)(wl + t * 128 + chl * 2) = f2bf(av[e]); *(LAS bf16_t*)(wl + 2048 + t * 128 + chl * 2) = f2bf(rr[e] * gt);
            *(LAS bf16_t*)(wl + 4096 + t * 128 + chl * 2) = f2bf(bv[e]); *(LAS bf16_t*)(wl + 6144 + t * 128 + chl * 2) = f2bf(kv[e]); }
        *(LAS u32x2*)(wl + 8192 + chl * 32 + 8 * g) = (u32x2){pk2(av[0], av[1]), pk2(av[2], av[3])}; *(LAS u32x2*)(wl + 10240 + chl * 32 + 8 * g) = (u32x2){pk2(vv[0], vv[1]), pk2(vv[2], vv[3])};
        *(LAS u32x2*)(wl + 12288 + chl * 32 + 8 * g) = (u32x2){pk2(bv[0] * gC, bv[1] * gC), pk2(bv[2] * gC, bv[3] * gC)}; *(LAS u32x2*)(wl + 14336 + chl * 32 + 8 * g) = (u32x2){pk2(kv[0] * gC, kv[1] * gC), pk2(kv[2] * gC, kv[3] * gC)}; }
#pragma unroll
    for (int e = 0; e < 4; ++e) { float bs = bon[e]; bs += __shfl_xor(bs, 1); bs += __shfl_xor(bs, 2); bs += __shfl_xor(bs, 4); bs += __shfl_xor(bs, 8);
        if (c16 == 0 && t0 + 4 * g + e >= FX_T) ((float*)(p->ws + WS_BON))[(m0 + 4 * g + e) * RH + hd] = bs; }
    WAVE_SYNC();
    f32x4 nab = (f32x4){0.f, 0.f, 0.f, 0.f}, nak = nab, mrb = nab, mrk = nab;
#pragma unroll
    for (int ks = 0; ks < 2; ++ks) { const int off = c16 * 128 + (32 * ks + 8 * g) * 2;
        const bf16x8 fa = *(const LAS bf16x8*)(wl + off), fr = *(const LAS bf16x8*)(wl + 2048 + off), fb = *(const LAS bf16x8*)(wl + 4096 + off), fk = *(const LAS bf16x8*)(wl + 6144 + off);
        nab = MFMA16(fa, fb, nab); nak = MFMA16(fa, fk, nak); mrb = MFMA16(fr, fb, mrb); mrk = MFMA16(fr, fk, mrk); }
    f32x4 rt[4];
#pragma unroll
    for (int cb = 0; cb < 4; ++cb)
#pragma unroll
        for (int e = 0; e < 4; ++e) rt[cb][e] = bf2f(*(const LAS bf16_t*)(wl + 2048 + (4 * g + e) * 128 + (16 * cb + c16) * 2));
    WAVE_SYNC();
#pragma unroll
    for (int e = 0; e < 4; ++e) { const int t = 4 * g + e, i = c16;
        *(LAS float*)(wl + (t * 16 + i) * 4) = (i < t) ? nab[e] : 0.f;
        *(LAS bf16_t*)(wl + 1024 + (t * 16 + i) * 2) = f2bf((i < t) ? nak[e] : 0.f);
        *(LAS bf16_t*)(wl + 1536 + (t * 16 + i) * 2) = f2bf((i <= t) ? mrb[e] : 0.f);
        *(LAS bf16_t*)(wl + 2048 + (t * 16 + i) * 2) = f2bf((i <= t) ? mrk[e] : 0.f); }
    WAVE_SYNC();
    { float tr[16];
#pragma unroll
      for (int t = 0; t < 16; ++t) { float acc = (c16 == t) ? 1.f : 0.f;
#pragma unroll
          for (int s = 0; s < t; ++s) acc += *(const LAS float*)(wl + (t * 16 + s) * 4) * tr[s];
          tr[t] = acc; if (g == 0) *(LAS bf16_t*)(wl + 2560 + (t * 16 + c16) * 2) = f2bf(acc); } }
    WAVE_SYNC();
    const bf16x8 tf = frag4_lds(wl + 2560 + c16 * 32 + 8 * g), nakf = frag4_lds(wl + 1024 + c16 * 32 + 8 * g), mrbf = frag4_lds(wl + 1536 + c16 * 32 + 8 * g), mrkf = frag4_lds(wl + 2048 + c16 * 32 + 8 * g);
    const f32x4 z4 = (f32x4){0.f, 0.f, 0.f, 0.f};
    bf16x8 ahf[4], plf[4];
#pragma unroll
    for (int cb = 0; cb < 4; ++cb) { const f32x4 ah = MFMA16(tf, frag4_lds(wl + 8192 + (16 * cb + c16) * 32 + 8 * g), z4); ahf[cb] = frag4_acc(ah);
        const f32x4 rh = MFMA16(mrbf, ahf[cb], rt[cb]);
#pragma unroll
        for (int e = 0; e < 4; ++e) ((bf16_t*)(rec + RC_RH))[(4 * g + e) * 64 + 16 * cb + c16] = f2bf(rh[e]); }
#pragma unroll
    for (int vb = 0; vb < 4; ++vb) { const bf16x8 vf = frag4_lds(wl + 10240 + (16 * vb + c16) * 32 + 8 * g);
        const f32x4 q = MFMA16(nakf, vf, z4); const f32x4 pl = MFMA16(tf, frag4_acc(q), z4); plf[vb] = frag4_acc(pl);
        f32x4 ol = MFMA16(mrbf, plf[vb], z4); ol = MFMA16(mrkf, vf, ol);
        ((f32x4*)(rec + RC_OL))[vb * 64 + lane] = ol; }
#pragma unroll
    for (int kb2 = 0; kb2 < 4; ++kb2) { const bf16x8 bbf = frag4_lds(wl + 12288 + (16 * kb2 + c16) * 32 + 8 * g), kkf = frag4_lds(wl + 14336 + (16 * kb2 + c16) * 32 + 8 * g);
#pragma unroll
        for (int kb = 0; kb < 4; ++kb) { const f32x4 gp4 = MFMA16(ahf[kb], bbf, z4);
            u32x2 w; w.x = pk2(gp4[0], gp4[1]); w.y = pk2(gp4[2], gp4[3]); *(u32x2*)((bf16_t*)(rec + RC_GT) + (16 * kb2 + c16) * 64 + 16 * kb + 4 * g) = w; }
#pragma unroll
        for (int vb = 0; vb < 4; ++vb) { f32x4 sl = MFMA16(plf[vb], bbf, z4); sl = MFMA16(frag4_lds(wl + 10240 + (16 * vb + c16) * 32 + 8 * g), kkf, sl);
            u32x2 w; w.x = pk2(sl[0], sl[1]); w.y = pk2(sl[2], sl[3]); ((u32x2*)(rec + RC_SL))[(vb * 4 + kb2) * 64 + lane] = w; } }
    WAVE_SYNC();
}
DI void phase_rw_local(KP p, int layer, lptr lds) {
    const int tid = TID(), lane = tid & 63, wave = RFL(tid >> 6);
    constexpr int NITEM = NB * RH * RC_NSUB;
    for (int it = blockIdx.x * 8 + wave; it < NITEM; it += gridDim.x * 8) rw_local_item(p, layer, lds + wave * 16384, it, lane);
}
constexpr int RS_STR = 144;
DI void phase_rw_scan(KP p, lptr lds, int unit) {
    const int tid = TID(), lane = tid & 63, wid = RFL(tid >> 6), g = lane >> 4, c16 = lane & 15;
    const int vb = wid >> 1, kb0 = 2 * (wid & 1), hd = unit % RH, b = unit / RH;
    const unsigned char* rec0 = p->ws + WS_RC + (size_t)unit * RC_NSUB * RC_BYTES;
    float* SCO = (float*)(p->ws + WS_SCO) + (size_t)b * S * MIX + hd * 64;
    f32x4 st[2]; st[0] = (f32x4){0.f, 0.f, 0.f, 0.f}; st[1] = st[0];
    __syncthreads();
    for (int j = 0; j < RC_NSUB; ++j) { const unsigned char* rec = rec0 + (size_t)j * RC_BYTES; const lptr img = lds + (j & 1) * (64 * RS_STR);
        bf16x8 gt[2][2]; u32x2 slw[2]; float gam[2];
#pragma unroll
        for (int tl = 0; tl < 2; ++tl) { const int kcol = 16 * (kb0 + tl) + c16;
#pragma unroll
            for (int ks = 0; ks < 2; ++ks) gt[tl][ks] = *(const bf16x8*)((const bf16_t*)(rec + RC_GT) + kcol * 64 + 32 * ks + 8 * g);
            slw[tl] = ((const u32x2*)(rec + RC_SL))[(vb * 4 + kb0 + tl) * 64 + lane]; gam[tl] = ((const float*)(rec + RC_GAM))[kcol]; }
        bf16x8 rh[2]; f32x4 ol = (f32x4){0.f, 0.f, 0.f, 0.f};
        if (wid < 4) {
#pragma unroll
            for (int ks = 0; ks < 2; ++ks) rh[ks] = *(const bf16x8*)((const bf16_t*)(rec + RC_RH) + c16 * 64 + 32 * ks + 8 * g);
            ol = ((const f32x4*)(rec + RC_OL))[wid * 64 + lane]; }
#pragma unroll
        for (int tl = 0; tl < 2; ++tl)
#pragma unroll
            for (int e = 0; e < 4; ++e) *(LAS bf16_t*)(img + (16 * vb + 4 * g + e) * RS_STR + (16 * (kb0 + tl) + c16) * 2) = f2bf(st[tl][e]);
        __syncthreads();
        bf16x8 af[2];
#pragma unroll
        for (int ks = 0; ks < 2; ++ks) af[ks] = *(const LAS bf16x8*)(img + (16 * vb + c16) * RS_STR + (32 * ks + 8 * g) * 2);
        if (wid < 4) {
            f32x4 o = ol;
#pragma unroll
            for (int ks = 0; ks < 2; ++ks) o = MFMA16(rh[ks], *(const LAS bf16x8*)(img + (16 * wid + c16) * RS_STR + (32 * ks + 8 * g) * 2), o);
#pragma unroll
            for (int e = 0; e < 4; ++e) SCO[(size_t)(16 * j + 4 * g + e) * MIX + 16 * wid + c16] = o[e]; }
#pragma unroll
        for (int tl = 0; tl < 2; ++tl) { f32x4 nw = (f32x4){0.f, 0.f, 0.f, 0.f};
#pragma unroll
            for (int ks = 0; ks < 2; ++ks) nw = MFMA16(af[ks], gt[tl][ks], nw);
            st[tl][0] = st[tl][0] * gam[tl] + nw[0] + bflo(slw[tl].x); st[tl][1] = st[tl][1] * gam[tl] + nw[1] + bfhi(slw[tl].x);
            st[tl][2] = st[tl][2] * gam[tl] + nw[2] + bflo(slw[tl].y); st[tl][3] = st[tl][3] * gam[tl] + nw[3] + bfhi(slw[tl].y); }
    }
}

DI void phase_rw_post(KP p, int layer) {
    const size_t gt = (size_t)blockIdx.x * 512 + TID(), NGT = (size_t)gridDim.x * 512;
    const bf16_t* Z = (const bf16_t*)(p->ws + WS_Z); const float* SCO = (const float*)(p->ws + WS_SCO); const float* BON = (const float*)(p->ws + WS_BON);
    const float* lg = p->in[I_LNXG] + (size_t)layer * MIX; const float* lbv = p->in[I_LNXB] + (size_t)layer * MIX;
    for (size_t i = gt; i < (size_t)M * (MIX / 16); i += NGT) { const size_t m = i / (MIX / 16); const int c0 = (int)(i % (MIX / 16)) * 16, hd = c0 >> 6; const int t = (int)(m % S), b = (int)(m / S);
        float o[16]; float s1 = 0.f; const float* osrc = (t < FX_T) ? (const float*)(p->ws + WS_OEXC) + ((size_t)b * FX_T + t) * MIX + c0 : SCO + m * MIX + c0;
#pragma unroll
        for (int j = 0; j < 4; ++j) { const f32x4 v = *(const f32x4*)(osrc + 4 * j); o[4 * j] = v[0]; o[4 * j + 1] = v[1]; o[4 * j + 2] = v[2]; o[4 * j + 3] = v[3]; s1 += (v[0] + v[1]) + (v[2] + v[3]); }
        s1 += __shfl_xor(s1, 1); s1 += __shfl_xor(s1, 2); const float mean = s1 * (1.f / 64.f); float s2 = 0.f;
#pragma unroll
        for (int j = 0; j < 16; ++j) { o[j] -= mean; s2 += o[j] * o[j]; }
        s2 += __shfl_xor(s2, 1); s2 += __shfl_xor(s2, 2); const float rstd = frsq(s2 * (1.f / 64.f) + RW_LN_EPS);
        const float bon = BON[m * RH + hd]; const float* vsrc = (const float*)(p->ws + WS_VV) + m * MIX + c0;
        const bf16_t* gp = Z + m * ZLD + C_RG + c0; bf16_t* yp = (bf16_t*)(p->ws + WS_Y) + m * (4 * MIX) + 2 * MIX + c0;
        unsigned w[8];
#pragma unroll
        for (int j = 0; j < 16; j += 2) { const float y0 = (o[j] * rstd * lg[c0 + j] + lbv[c0 + j] + bon * vsrc[j]) * fsilu(bf2f(gp[j])), y1 = (o[j + 1] * rstd * lg[c0 + j + 1] + lbv[c0 + j + 1] + bon * vsrc[j + 1]) * fsilu(bf2f(gp[j + 1]));
            w[j >> 1] = pk2(y0, y1); }
        *(u32x4*)(yp) = (u32x4){w[0], w[1], w[2], w[3]}; *(u32x4*)(yp + 8) = (u32x4){w[4], w[5], w[6], w[7]}; }
}

DI void phase_ln(KP p, int layer) {
    const int tid = TID(), lane = tid & 63, wave = tid >> 6;
    const float alpha = sqrtf(sqrtf(2.f * (float)L));
    const float* hprev = (layer == 0) ? p->in[I_X] : (const float*)(p->ws + WS_H); const float* outf = (const float*)(p->ws + WS_OUTF);
    float* hnew = (layer == L - 1) ? p->out : (float*)(p->ws + WS_H); bf16_t* xn = (bf16_t*)(p->ws + WS_XN);
    const float* lg = p->in[I_LNG] + (size_t)layer * D; const float* lbv = p->in[I_LNB] + (size_t)layer * D;
    constexpr int NV = D / 256;
    for (size_t m = (size_t)blockIdx.x * 8 + wave; m < (size_t)M; m += (size_t)gridDim.x * 8) {
        f32x4 v[NV]; float s = 0.f;
#pragma unroll
        for (int j = 0; j < NV; ++j) { const f32x4 a = *(const f32x4*)(hprev + m * D + 256 * j + 4 * lane), o = *(const f32x4*)(outf + m * D + 256 * j + 4 * lane); v[j] = a * alpha + o; s += (v[j][0] + v[j][1]) + (v[j][2] + v[j][3]); }
#pragma unroll
        for (int o = 1; o < 64; o <<= 1) s += __shfl_xor(s, o);
        const float mean = s * (1.f / D); float s2 = 0.f;
#pragma unroll
        for (int j = 0; j < NV; ++j) { v[j] = v[j] - mean; s2 += (v[j][0] * v[j][0] + v[j][1] * v[j][1]) + (v[j][2] * v[j][2] + v[j][3] * v[j][3]); }
#pragma unroll
        for (int o = 1; o < 64; o <<= 1) s2 += __shfl_xor(s2, o);
        const float rstd = 1.f / sqrtf(s2 * (1.f / D) + LN_EPS);
#pragma unroll
        for (int j = 0; j < NV; ++j) { const f32x4 g4 = *(const f32x4*)(lg + 256 * j + 4 * lane), b4 = *(const f32x4*)(lbv + 256 * j + 4 * lane); const f32x4 y = v[j] * rstd * g4 + b4;
            *(f32x4*)(hnew + m * D + 256 * j + 4 * lane) = y; u32x2 w; w.x = pk2(y[0], y[1]); w.y = pk2(y[2], y[3]); *(u32x2*)(xn + m * D + 256 * j + 4 * lane) = w; }
    }
}
constexpr int FX_NS_HG = 3 * MIX / 64, FX_NS_RW = RW_MIX / 64, FX_NSTRIP = FX_NS_HG + FX_NS_RW + 1;
DI void phase_fx_project(KP p, int layer, lptr lds, int strip) {
    const int tid = TID(), c = tid & 63, kg = tid >> 6;
    const float* hsrc = (layer == 0) ? p->in[I_X] : (const float*)(p->ws + WS_H);
    LAS float* HR = (LAS float*)lds;
    __syncthreads();
    for (int i = tid; i < FX_ROWS * D / 4; i += 512) { const int r = i / (D / 4), k4 = i % (D / 4); const size_t m = (size_t)(r / FX_T) * S + (r % FX_T);
        *(LAS f32x4*)(HR + r * D + 4 * k4) = *(const f32x4*)(hsrc + m * D + 4 * k4); }
    __syncthreads();
    int col0, ncol, ldw; const float* W;
    if (strip < FX_NS_HG) { col0 = C_HQ + 64 * strip; ncol = 64; ldw = IN_COLS; W = p->in[I_WIN] + (size_t)layer * D * IN_COLS + col0; }
    else if (strip < FX_NS_HG + FX_NS_RW) { col0 = C_RM + 64 * (strip - FX_NS_HG); ncol = 64; ldw = IN_COLS; W = p->in[I_WIN] + (size_t)layer * D * IN_COLS + col0; }
    else { col0 = C_VD; ncol = 32; ldw = 32; W = p->in[I_V1] + (size_t)(layer > 0 ? layer - 1 : 0) * D * 32; if (layer == 0) ncol = 0; }
    float acc[FX_ROWS];
#pragma unroll
    for (int r = 0; r < FX_ROWS; ++r) acc[r] = 0.f;
    if (c < ncol) {
        for (int k = kg * (D / 8); k < (kg + 1) * (D / 8); ++k) { const float w = W[(size_t)k * ldw + c];
#pragma unroll
            for (int r = 0; r < FX_ROWS; ++r) acc[r] += HR[r * D + k] * w; } }
    __syncthreads();
    LAS float* RED = (LAS float*)lds;
#pragma unroll
    for (int r = 0; r < FX_ROWS; ++r) RED[(kg * FX_ROWS + r) * 64 + c] = acc[r];
    __syncthreads();
    for (int i = tid; i < FX_ROWS * 64; i += 512) { const int r = i >> 6, cc = i & 63; float s = 0.f;
#pragma unroll
        for (int g = 0; g < 8; ++g) s += RED[(g * FX_ROWS + r) * 64 + cc];
        if (cc < ncol) ((float*)(p->ws + WS_ZF))[(size_t)r * ZLD + col0 + cc] = s; }
}
DI float wave_sum64(float v) {
#pragma unroll
    for (int o = 1; o < 64; o <<= 1) v += __shfl_xor(v, o);
    return v; }
DI void fx_rwkv(KP p, int layer, int item, int lane) {
    const int hd = item % RH, b = item / RH, ch = hd * 64 + lane;
    const float* ZF = (const float*)(p->ws + WS_ZF) + (size_t)b * FX_T * ZLD;
    const float* mu = p->in[I_MU] + (size_t)layer * RW_MIX;
    const float mur = mu[ch], muk = mu[MIX + ch], muv = mu[2 * MIX + ch], muw = mu[3 * MIX + lane], mua = mu[3 * MIX + 64 + lane];
    const float muvd = (layer > 0 && lane < 32) ? p->in[I_VMU][(size_t)(layer - 1) * 32 + lane] : 0.f;
    const float* w2 = p->in[I_W2] + (size_t)layer * 64 * MIX + ch; const float* a2 = p->in[I_A2] + (size_t)layer * 64 * MIX + ch;
    const float* v2 = p->in[I_V2] + (size_t)(layer > 0 ? layer - 1 : 0) * 32 * MIX + ch;
    const float w0 = p->in[I_W0][(size_t)layer * MIX + ch], a0 = p->in[I_A0][(size_t)layer * MIX + ch], kq = p->in[I_KK][(size_t)layer * MIX + ch], ka = p->in[I_KA][(size_t)layer * MIX + ch], rk = p->in[I_RK][(size_t)layer * MIX + ch];
    const float v0 = p->in[I_V0][(size_t)(layer > 0 ? layer - 1 : 0) * MIX + ch];
    float rv[FX_T], kv[FX_T], vv[FX_T], tw[FX_T], ad[FX_T], vd[FX_T];
    { float pr = 0.f, pk = 0.f, pv = 0.f, pw = 0.f, pa = 0.f, pvd = 0.f;
#pragma unroll
      for (int t = 0; t < FX_T; ++t) { const float* z = ZF + (size_t)t * ZLD;
          const float cr = z[C_RM + ch], ck = z[C_RM + MIX + ch], cv = z[C_RM + 2 * MIX + ch], cw = z[C_RM + 3 * MIX + lane], ca = z[C_RM + 3 * MIX + 64 + lane], cvd = (layer > 0 && lane < 32) ? z[C_VD + lane] : 0.f;
          rv[t] = cr + (pr - cr) * mur; kv[t] = ck + (pk - ck) * muk; vv[t] = cv + (pv - cv) * muv;
          tw[t] = tanhf(cw + (pw - cw) * muw); ad[t] = ca + (pa - ca) * mua; vd[t] = cvd + (pvd - cvd) * muvd;
          pr = cr; pk = ck; pv = cv; pw = cw; pa = ca; pvd = cvd; } }
    float lwv[FX_T], lav[FX_T], lvv[FX_T];
#pragma unroll
    for (int t = 0; t < FX_T; ++t) { lwv[t] = 0.f; lav[t] = 0.f; lvv[t] = 0.f; }
#pragma unroll 8
    for (int j = 0; j < 64; ++j) { const float w2j = w2[(size_t)j * MIX], a2j = a2[(size_t)j * MIX];
#pragma unroll
        for (int t = 0; t < FX_T; ++t) { lwv[t] += __shfl(tw[t], j) * w2j; lav[t] += __shfl(ad[t], j) * a2j; } }
    if (layer > 0) {
#pragma unroll 8
        for (int j = 0; j < 32; ++j) { const float v2j = v2[(size_t)j * MIX];
#pragma unroll
            for (int t = 0; t < FX_T; ++t) lvv[t] += __shfl(vd[t], j) * v2j; } }
    float xs[2 * FX_T - 1], ys[2 * FX_T - 1];
#pragma unroll
    for (int t = 0; t < FX_T; ++t) { const float r = rv[t], k = kv[t], lw = lwv[t], la = lav[t], lv = lvv[t]; float v = vv[t];
        const float wlog = -(fmaxf(-(w0 + lw), 0.f) + log1pf(expf(-fabsf(w0 + lw)))) - 0.5f, decay = expf(-expf(wlog));
        const float a = 1.f / (1.f + expf(-(a0 + la)));
        const size_t m = (size_t)b * S + t; float* VF = (float*)(p->ws + WS_VF) + m * MIX;
        if (layer == 0) VF[ch] = v; else { const float vf = VF[ch]; v = v + (vf - v) / (1.f + expf(-(v0 + lv))); }
        float kk = k * kq; const float nrm = sqrtf(wave_sum64(kk * kk)); kk = kk / fmaxf(nrm, 1e-12f);
        const float k2 = k * (1.f + (a - 1.f) * ka);
        const float bon = wave_sum64(r * k2 * rk);
        ((float*)(p->ws + WS_VV))[m * MIX + ch] = v;
        if (lane == 0) ((float*)(p->ws + WS_BON))[m * RH + hd] = bon;
        { const float an = -kk, bn = kk * a; float sa = 0.f, ov = 0.f;
          const int nt = (t == 0) ? 0 : 2 * t - 1;
#pragma unroll
          for (int i = 0; i < 2 * FX_T - 1; ++i) if (i < nt) { sa += xs[i] * wave_sum64(ys[i] * an); ys[i] *= decay; ov += xs[i] * wave_sum64(ys[i] * r); }
          if (t > 0) { ov += sa * wave_sum64(bn * r); }
          ov += v * wave_sum64(k2 * r);
#pragma unroll
          for (int i = 0; i < 2 * FX_T - 1; ++i) { if (t > 0 && i == nt) { xs[i] = sa; ys[i] = bn; } if (i == ((t == 0) ? 0 : nt + 1)) { xs[i] = v; ys[i] = k2; } }
          ((float*)(p->ws + WS_OEXC))[((size_t)b * FX_T + t) * MIX + ch] = ov; } }
}
DI void fx_hgrn(KP p, int layer, int item, int lane) {
    const int h = item % HH, b = item / HH;
    const float* ZF = (const float*)(p->ws + WS_ZF) + (size_t)b * FX_T * ZLD; const float* LBp = (const float*)(p->ws + SM_LB);
    float q[FX_T][2], kx[FX_T][2], Bc[FX_T][2], iv[FX_T][2];
#pragma unroll
    for (int u = 0; u < 2; ++u) { const int d = h * 128 + lane + 64 * u; const float lb = LBp[(size_t)layer * MIX + d]; float run = 0.f;
#pragma unroll
        for (int t = 0; t < FX_T; ++t) { const float* z = ZF + (size_t)t * ZLD; const float zf = z[C_HF + d]; q[t][u] = z[C_HQ + d]; iv[t][u] = z[C_HI + d];
            const float sg = 1.f / (1.f + expf(-zf)); run += logf(lb + (1.f - lb) * sg); Bc[t][u] = run; kx[t][u] = (1.f - lb) * (1.f - sg); } }
    float* OEX = (float*)(p->ws + WS_OEX) + (size_t)item * FX_T * 128;
#pragma unroll
    for (int t = 0; t < FX_T; ++t) { float o0 = 0.f, o1 = 0.f;
#pragma unroll
        for (int s = 0; s <= t; ++s) { const float c = wave_sum64(q[t][0] * kx[s][0] * expf(Bc[t][0] - Bc[s][0]) + q[t][1] * kx[s][1] * expf(Bc[t][1] - Bc[s][1])); o0 += c * iv[s][0]; o1 += c * iv[s][1]; }
        OEX[t * 128 + lane] = o0; OEX[t * 128 + 64 + lane] = o1; }
}
DI void phase_fx_fix(KP p, int layer) {
    const int tid = TID(), lane = tid & 63, gw = blockIdx.x * 8 + (tid >> 6), NGW = gridDim.x * 8;
    for (int it = gw; it < NB * RH + NB * HH; it += NGW) { if (it < NB * RH) fx_rwkv(p, layer, it, lane); else fx_hgrn(p, layer, it - NB * RH, lane); }
}
constexpr int NWAVES = 8, LDS_RING = 131072, MISC_OFF = LDS_RING + 320, LDS_BYTES = 147456;
constexpr int CW_BAR = 4096, CW_WQ = 16384;
enum { PH_INPROJ = 0, PH_RWPREP, PH_RWLOC, PH_MIX, PH_RWPOST, PH_BRANCH, PH_SUM, PH_OUT, PH_LN, PH_COUNT };
constexpr int U_SCAN = NB * RH, U_HG = NB * HH, U_HGC = NB * HH * (S / 64), U_AA = NB * AH * (S / 128), U_AD = NB * SH * (S / 256), U_MIX = U_SCAN + U_HG + U_AA + U_AD;

struct Args { Params p; int do_pro, l_lo, l_hi, ph_lo, ph_hi, mega, pad0, pad1; };

#ifndef EMU
#define XB_TMO      128
#define XB_XCNT(j)  (256  + 64 * (j))
#define XB_XSUB(j)  (1280 + 64 * (j))
#define XB_XGEN(j)  (2304 + 64 * (j))
#define XB_TOP      3328
#define XB_TOPGEN   3392
#define XCD_BAR_WORDS 3456
#define XB_SPIN_CAP (1u << 18)
__device__ __forceinline__ unsigned xb_ld(unsigned* p)              { return __hip_atomic_load(p, __ATOMIC_RELAXED, __HIP_MEMORY_SCOPE_AGENT); }
__device__ __forceinline__ unsigned xb_add(unsigned* p, unsigned v) { return __hip_atomic_fetch_add(p, v, __ATOMIC_RELAXED, __HIP_MEMORY_SCOPE_AGENT); }
__device__ __forceinline__ unsigned xb_xcc_id() { return (unsigned)__builtin_amdgcn_s_getreg((3 << 11) | 20) & 0xFu; }
#define XB_SPIN(cond, bar) do { unsigned _sp = 0; while (cond) { __builtin_amdgcn_s_sleep(1); \
    if ((++_sp & 255u) == 0u) { if (xb_ld(&(bar)[XB_TMO])) break; if (_sp > XB_SPIN_CAP) { atomicAdd(&(bar)[XB_TMO], 1u); break; } } } } while (0)
struct XcdBarrier { unsigned* bar; unsigned x; volatile LAS unsigned* st; };
__device__ __forceinline__ XcdBarrier xcd_barrier_post(unsigned* bar, volatile LAS unsigned* st) {
    XcdBarrier b; b.bar = bar; b.x = xb_xcc_id(); b.st = st;
    if (threadIdx.x == 0) (void)xb_add(&bar[XB_XCNT(b.x)], 1u);
    return b;
}
__device__ __forceinline__ void xcd_barrier_complete(unsigned* bar, unsigned x, unsigned& nloc, unsigned& nx) {
    const unsigned G = gridDim.x * gridDim.y * gridDim.z;
    unsigned sum, cnt, mine, sp = 0u;
    for (;;) {
        sum = 0u; cnt = 0u; mine = 0u;
#pragma unroll
        for (unsigned j = 0; j < 16; ++j) { const unsigned c = xb_ld(&bar[XB_XCNT(j)]); sum += c; cnt += (c > 0u) ? 1u : 0u; mine = (j == x) ? c : mine; }
        if (sum == G) break;
        __builtin_amdgcn_s_sleep(1);
        if ((++sp & 255u) == 0u) { if (xb_ld(&bar[XB_TMO])) break; if (sp > XB_SPIN_CAP) { atomicAdd(&bar[XB_TMO], 1u); break; } }
    }
    nloc = mine > 0u ? mine : 1u; nx = cnt > 0u ? cnt : 1u;
}
__device__ __forceinline__ void xcd_barrier(const XcdBarrier& b) {
    asm volatile("s_waitcnt vmcnt(0)" ::: "memory");
    __syncthreads();
    if (threadIdx.x == 0) {
        unsigned* bar = b.bar;
        __builtin_amdgcn_s_waitcnt(0);
        unsigned nloc = b.st[0], nx = b.st[1];
        if (nloc == 0u) { xcd_barrier_complete(bar, b.x, nloc, nx); b.st[0] = nloc; b.st[1] = nx; }
        const unsigned old = xb_add(&bar[XB_XSUB(b.x)], 1u);
        const unsigned gen = old / nloc;
        if (old + 1u == (gen + 1u) * nloc) {
            __builtin_amdgcn_fence(__ATOMIC_RELEASE, "agent");
            asm volatile("s_waitcnt vmcnt(0)" ::: "memory");
            const unsigned og = xb_add(&bar[XB_TOP], 1u);
            const unsigned tg = og / nx;
            if (og + 1u == (tg + 1u) * nx) xb_add(&bar[XB_TOPGEN], 1u);
            else XB_SPIN(xb_ld(&bar[XB_TOPGEN]) == tg, bar);
            __builtin_amdgcn_fence(__ATOMIC_ACQUIRE, "agent");
            xb_add(&bar[XB_XGEN(b.x)], 1u);
            asm volatile("s_waitcnt vmcnt(0)" ::: "memory");
        } else {
            XB_SPIN(xb_ld(&bar[XB_XGEN(b.x)]) == gen, bar);
            __builtin_amdgcn_fence(__ATOMIC_ACQUIRE, "agent");
            asm volatile("s_waitcnt vmcnt(0)" ::: "memory");
        }
    }
    __syncthreads();
}
#endif

DI int next_unit(unsigned* head, lptr lds) {
    LAS int* slot = (LAS int*)(lds + MISC_OFF + 64);
    __syncthreads();
#ifdef EMU
    if (threadIdx.x == 0) { *slot = (int)(*head); *head += 1; }
#else
    if (threadIdx.x == 0) *slot = (int)__hip_atomic_fetch_add(head, 1u, __ATOMIC_RELAXED, __HIP_MEMORY_SCOPE_AGENT);
#endif
    __syncthreads();
    return *slot;
}

#ifndef DBG_PHMASK
#define DBG_PHMASK 0xffff
#endif
struct BranchOrder {
    pg8::StaticOrder so;
    DM bool next(int i, pg8::Unit& u) const { if (!so.next(i, u)) return false; u.ka = (u.pn / (D / 256)) * MIX; return true; }
    DM void a_ready(const pg8::Unit&) const {}
    DM void done(const pg8::Unit&) const {}
};
#ifndef PROBE_REP
#define PROBE_REP 0
#endif
#ifndef PROBE_PREPSEL
#define PROBE_PREPSEL 7
#endif
#ifndef PROBE_MIXREP
#define PROBE_MIXREP 15
#endif
#ifndef DBG_MIXMASK
#define DBG_MIXMASK 15
#endif
DI void run_phase(KP p, int rep, int l, int ph, lptr lds) {
    unsigned char* ws = p->ws;
    if (!((DBG_PHMASK >> ph) & 1)) return;
    if (ph == PH_INPROJ) {
        pg8::Gemm g{(const bf16_t*)(ws + WS_XN), (const bf16_t*)(ws + WS_WIN) + (size_t)l * NP * D, M, NP, D, D, D};
        EpiInproj E{(bf16_t*)(ws + WS_Z), ZLD, (bf16_t*)(ws + WS_RHO), CG0 / 256};
#ifndef EMU
        pg8::StaticOrder so; so.init(M, NP, gridDim.x, blockIdx.x);
        pg8::gemm_phase<EpiInproj, pg8::StaticOrder, true, true, D, D, D>((LAS unsigned char*)lds, g, so, E);
#endif
        { const int first = (M / 256) * (NP / 256) % (int)gridDim.x;
          for (int s = ((int)blockIdx.x - first + (int)gridDim.x) % (int)gridDim.x; s < FX_NSTRIP; s += gridDim.x) phase_fx_project(p, l, lds, s); }
    } else if (ph == PH_RWPREP) {
        const int psel = rep ? PROBE_PREPSEL : 7;
        if (psel & 1) phase_rw_local(p, l, lds);
        if (psel & 2) phase_fx_fix(p, l);
        if (psel & 4) for (int u = blockIdx.x; u < U_HGC; u += gridDim.x) phase_hg_local(p, l, lds, u);
    } else if (ph == PH_RWLOC) {
    } else if (ph == PH_MIX) {
        unsigned* head = (unsigned*)(ws + WS_CTL) + CW_WQ + 64 * l + (rep ? 32 * 64 : 0);
        for (;;) { int u = next_unit(head, lds); if (u >= U_MIX) break;
            const int mm = rep ? PROBE_MIXREP : DBG_MIXMASK;
            if (u < U_SCAN) { if (mm & 1) phase_rw_scan(p, lds, u); continue; } u -= U_SCAN;
            if (u < U_HG) { if (mm & 2) phase_hg_scan(p, u); continue; } u -= U_HG;
            if (u < U_AA) { if (mm & 4) phase_att_a(p, l, lds, u); continue; } u -= U_AA;
            if (mm & 8) phase_att_d(p, l, lds, u); }
    } else if (ph == PH_RWPOST) {
        phase_rw_post(p, l);
        for (int u = blockIdx.x; u < U_HGC; u += gridDim.x) phase_hg_out(p, l, lds, u);
    } else if (ph == PH_BRANCH) {
        pg8::Gemm g{(const bf16_t*)(ws + WS_Y), (const bf16_t*)(ws + WS_WBR) + (size_t)l * 4 * D * MIX, M, 4 * D, MIX, 4 * MIX, MIX};
        EpiGateP E{(bf16_t*)(ws + WS_P), 4 * D, (const bf16_t*)(ws + WS_RHO)};
#ifndef EMU
        BranchOrder bo; bo.so.init(M, 4 * D, gridDim.x, blockIdx.x);
        pg8::gemm_phase<EpiGateP, BranchOrder, true, true, 4 * MIX, MIX, MIX>((LAS unsigned char*)lds, g, bo, E);
#endif
    } else if (ph == PH_SUM) {
        const size_t gt = (size_t)blockIdx.x * 512 + TID(), NGT = (size_t)gridDim.x * 512; const u32x4* P4 = (const u32x4*)(ws + WS_P); u32x4* MG4 = (u32x4*)(ws + WS_MG);
        for (size_t i = gt; i < (size_t)M * D / 8; i += NGT) { const size_t m = i / (D / 8), c = i % (D / 8); const u32x4* src = P4 + m * (4 * D / 8) + c;
            const u32x4 a0 = src[0], a1 = src[D / 8], a2 = src[2 * (D / 8)], a3 = src[3 * (D / 8)]; u32x4 o;
            o.x = pk2((bflo(a0.x) + bflo(a1.x)) + (bflo(a2.x) + bflo(a3.x)), (bfhi(a0.x) + bfhi(a1.x)) + (bfhi(a2.x) + bfhi(a3.x))); o.y = pk2((bflo(a0.y) + bflo(a1.y)) + (bflo(a2.y) + bflo(a3.y)), (bfhi(a0.y) + bfhi(a1.y)) + (bfhi(a2.y) + bfhi(a3.y)));
            o.z = pk2((bflo(a0.z) + bflo(a1.z)) + (bflo(a2.z) + bflo(a3.z)), (bfhi(a0.z) + bfhi(a1.z)) + (bfhi(a2.z) + bfhi(a3.z))); o.w = pk2((bflo(a0.w) + bflo(a1.w)) + (bflo(a2.w) + bflo(a3.w)), (bfhi(a0.w) + bfhi(a1.w)) + (bfhi(a2.w) + bfhi(a3.w)));
            MG4[i] = o; }
    } else if (ph == PH_OUT) {
        pg8::Gemm g{(const bf16_t*)(ws + WS_MG), (const bf16_t*)(ws + WS_WOUT) + (size_t)l * D * D, M, D, D, D, D};
        EpiF32 E{(float*)(ws + WS_OUTF), D};
#ifndef EMU
        pg8::StaticOrder so; so.init(M, D, gridDim.x, blockIdx.x);
        pg8::gemm_phase<EpiF32, pg8::StaticOrder, true, true, D, D, D>((LAS unsigned char*)lds, g, so, E);
#endif
    } else if (ph == PH_LN) {
        phase_ln(p, l);
    }
}

#ifndef EMU
__global__ void __launch_bounds__(NWAVES * 64, 2) fwd(Args a) {
    extern __shared__ __attribute__((aligned(16))) unsigned char lds_raw[];
    lptr lds = (lptr)lds_raw;
    volatile LAS unsigned* MISC = (volatile LAS unsigned*)(lds + MISC_OFF);
    for (int u = threadIdx.x; u < (LDS_BYTES - LDS_RING) / 4; u += NWAVES * 64) ((LAS unsigned*)(lds + LDS_RING))[u] = 0u;
    __syncthreads();
    typedef const __attribute__((address_space(4))) Args* KA;
    KA ka = (KA)__builtin_amdgcn_kernarg_segment_ptr();
    const int mega = ka->mega, do_pro = ka->do_pro, l_lo = ka->l_lo, l_hi = ka->l_hi, ph_lo = ka->ph_lo, ph_hi = ka->ph_hi;
    auto kp = [&]() -> KP { KA k2 = ka; asm volatile("" : "+s"(k2)); return &k2->p; };
    XcdBarrier bar; bar.bar = (unsigned*)(ka->p.ws + WS_CTL) + CW_BAR; bar.x = 0; bar.st = nullptr;
    if (mega) bar = xcd_barrier_post((unsigned*)(ka->p.ws + WS_CTL) + CW_BAR, MISC + 8);
#define SEAM() do { if (mega) xcd_barrier(bar); } while (0)
    if (do_pro != 0 && ((DBG_PHMASK >> 8) & 1) != 0) { phase_prologue(kp(), lds); SEAM(); }
    for (int l = l_lo; l < l_hi; ++l) {
        if (ph_lo <= PH_INPROJ && PH_INPROJ < ph_hi) { run_phase(kp(), 0, l, PH_INPROJ, lds); SEAM(); if ((PROBE_REP >> PH_INPROJ) & 1) { run_phase(kp(), 1, l, PH_INPROJ, lds); SEAM(); } }
        if (ph_lo <= PH_RWPREP && PH_RWPREP < ph_hi) { run_phase(kp(), 0, l, PH_RWPREP, lds); SEAM(); if ((PROBE_REP >> PH_RWPREP) & 1) { run_phase(kp(), 1, l, PH_RWPREP, lds); SEAM(); } }
        if (ph_lo <= PH_MIX && PH_MIX < ph_hi) { run_phase(kp(), 0, l, PH_MIX, lds); SEAM(); if ((PROBE_REP >> PH_MIX) & 1) { run_phase(kp(), 1, l, PH_MIX, lds); SEAM(); } }
        if (ph_lo <= PH_RWPOST && PH_RWPOST < ph_hi) { run_phase(kp(), 0, l, PH_RWPOST, lds); SEAM(); if ((PROBE_REP >> PH_RWPOST) & 1) { run_phase(kp(), 1, l, PH_RWPOST, lds); SEAM(); } }
        if (ph_lo <= PH_BRANCH && PH_BRANCH < ph_hi) { run_phase(kp(), 0, l, PH_BRANCH, lds); SEAM(); if ((PROBE_REP >> PH_BRANCH) & 1) { run_phase(kp(), 1, l, PH_BRANCH, lds); SEAM(); } }
        if (ph_lo <= PH_SUM && PH_SUM < ph_hi) { run_phase(kp(), 0, l, PH_SUM, lds); SEAM(); if ((PROBE_REP >> PH_SUM) & 1) { run_phase(kp(), 1, l, PH_SUM, lds); SEAM(); } }
        if (ph_lo <= PH_OUT && PH_OUT < ph_hi) { run_phase(kp(), 0, l, PH_OUT, lds); SEAM(); if ((PROBE_REP >> PH_OUT) & 1) { run_phase(kp(), 1, l, PH_OUT, lds); SEAM(); } }
        if (ph_lo <= PH_LN && PH_LN < ph_hi) { run_phase(kp(), 0, l, PH_LN, lds); SEAM(); }
    }
#undef SEAM
}

#ifndef MK_MEGA
#define MK_MEGA 1
#endif
extern "C" void kernel_launch(void* const* d_in, const int* in_sizes, int n_in, void* d_out, int out_size, void* d_ws, size_t ws_size, hipStream_t stream) {
    static int grid = 0;
    if (grid == 0) {
        if (n_in != 25 || in_sizes[0] != M * D || out_size != M * D || ws_size < WS_END) { fprintf(stderr, "kernel_launch: shape/workspace mismatch (n_in %d, in0 %d, out %d, ws %zu need %zu)\n", n_in, n_in > 0 ? in_sizes[0] : -1, out_size, ws_size, (size_t)WS_END); grid = -1; return; }
        int dev = 0, cus = 0, per_cu = 0;
        if (hipGetDevice(&dev) != hipSuccess || hipDeviceGetAttribute(&cus, hipDeviceAttributeMultiprocessorCount, dev) != hipSuccess) { grid = -1; return; }
        if (hipFuncSetAttribute((const void*)fwd, hipFuncAttributeMaxDynamicSharedMemorySize, LDS_BYTES) != hipSuccess) { fprintf(stderr, "kernel_launch: hipFuncSetAttribute failed\n"); grid = -1; return; }
        if (hipOccupancyMaxActiveBlocksPerMultiprocessor(&per_cu, (const void*)fwd, NWAVES * 64, LDS_BYTES) != hipSuccess || per_cu < 1) fprintf(stderr, "kernel_launch: occupancy query says %d\n", per_cu);
        (void)hipGetLastError();
        grid = cus;
    }
    if (grid < 0) return;
    (void)hipMemsetAsync((char*)d_ws + WS_CTL, 0, CTL_BYTES, stream);
    Args a{};
    for (int i = 0; i < 25; ++i) a.p.in[i] = (const float*)d_in[i];
    a.p.out = (float*)d_out; a.p.ws = (unsigned char*)d_ws;
    if (MK_MEGA) {
        a.do_pro = 1; a.l_lo = 0; a.l_hi = L; a.ph_lo = 0; a.ph_hi = PH_COUNT; a.mega = 1;
        hipLaunchKernelGGL(fwd, dim3(grid), dim3(NWAVES * 64), LDS_BYTES, stream, a);
    } else {
        a.mega = 0; a.do_pro = 1; a.l_lo = 0; a.l_hi = 0; a.ph_lo = 0; a.ph_hi = 0;
        hipLaunchKernelGGL(fwd, dim3(grid), dim3(NWAVES * 64), LDS_BYTES, stream, a);
        a.do_pro = 0;
        for (int l = 0; l < L; ++l) for (int ph = 0; ph < PH_COUNT; ++ph) { a.l_lo = l; a.l_hi = l + 1; a.ph_lo = ph; a.ph_hi = ph + 1;
            hipLaunchKernelGGL(fwd, dim3(grid), dim3(NWAVES * 64), LDS_BYTES, stream, a); }
    }
}
#endif
```

```cpp
#ifdef EMU
#include "emu.h"
#else
#include <hip/hip_runtime.h>
#include <cstdio>
#include <cstdint>
#endif

#ifndef CFG_D_MODEL
#define CFG_D_MODEL 2048
#endif
#ifndef CFG_BATCH
#define CFG_BATCH 4
#endif
#ifndef CFG_SEQ
#define CFG_SEQ 4096
#endif
#ifndef CFG_DEPTH
#define CFG_DEPTH 4
#endif
constexpr int D = CFG_D_MODEL, NB = CFG_BATCH, S = CFG_SEQ, L = CFG_DEPTH, MIX = D / 2, M = NB * S;
constexpr int AH = MIX / 128, HH = MIX / 128, RH = MIX / 64, SH = MIX / 128;
constexpr int RW_MIX = 3 * MIX + 128;
constexpr int C_AQ = 0, C_AK = MIX, C_AV = 2 * MIX, C_AG = 3 * MIX, C_HQ = 4 * MIX, C_HF = 5 * MIX, C_HI = 6 * MIX, C_HG = 7 * MIX;
constexpr int C_RM = 8 * MIX, C_RG = C_RM + RW_MIX, C_SQ = C_RG + MIX, C_SK = C_SQ + MIX, C_SV = C_SK + MIX, C_SG = C_SV + MIX, C_MG = C_SG + MIX;
constexpr int IN_COLS = C_MG + 4 * D;
constexpr int C_VD = C_MG, CG0 = ((C_MG + 32 + 255) / 256) * 256, NP = CG0 + 4 * D, ZLD = CG0;
constexpr float LN_EPS = 1e-5f, RMS_EPS = 1e-6f, RW_LN_EPS = 64e-5f;
constexpr float LOG2E = 1.4426950408889634f, LN2 = 0.6931471805599453f;

constexpr size_t al256(size_t x) { return (x + 255) & ~(size_t)255; }
constexpr size_t WS_CTL = 0, CTL_BYTES = 1u << 20;
constexpr size_t SM_LAM = CTL_BYTES;
constexpr size_t SM_LB = SM_LAM + 256;
constexpr size_t SM_BT = al256(SM_LB + (size_t)3 * L * MIX * 4);
constexpr size_t SM_W2T = al256(SM_BT + (size_t)AH * 132 * 4);
constexpr size_t SM_A2T = al256(SM_W2T + (size_t)L * MIX * 64 * 2);
constexpr size_t SM_V2T = al256(SM_A2T + (size_t)L * MIX * 64 * 2);
constexpr size_t WS_WIN = al256(SM_V2T + (size_t)L * MIX * 32 * 2);
constexpr size_t WS_WBR = al256(WS_WIN + (size_t)L * NP * D * 2);
constexpr size_t WS_WOUT = al256(WS_WBR + (size_t)L * D * 4 * MIX * 2);
constexpr size_t WS_XN = al256(WS_WOUT + (size_t)L * D * D * 2);
constexpr size_t WS_H = al256(WS_XN + (size_t)M * D * 2);
constexpr size_t WS_Z = al256(WS_H + (size_t)M * D * 4);
constexpr size_t WS_Y = al256(WS_Z + (size_t)M * ZLD * 2);
constexpr size_t WS_RHO = al256(WS_Y + (size_t)M * 4 * MIX * 2);
constexpr size_t WS_P = al256(WS_RHO + (size_t)M * 4 * D * 2);
constexpr size_t WS_MG = al256(WS_P + (size_t)M * 4 * D * 2);
constexpr size_t WS_OUTF = al256(WS_MG + (size_t)M * D * 2);
constexpr size_t WS_VF = al256(WS_OUTF + (size_t)M * D * 4);
constexpr size_t WS_VV = al256(WS_VF + (size_t)M * MIX * 4);
constexpr size_t WS_SCO = al256(WS_VV + (size_t)M * MIX * 4);
constexpr size_t WS_BON = al256(WS_SCO + (size_t)M * MIX * 4);
constexpr size_t HG_CHUNKS = (size_t)NB * (MIX / 128) * (S / 64);
constexpr size_t WS_HGQF = al256(WS_BON + (size_t)M * RH * 4);
constexpr size_t WS_HGIN = al256(WS_HGQF + HG_CHUNKS * 16 * 64 * 16);
constexpr size_t WS_HGDS = al256(WS_HGIN + HG_CHUNKS * 8 * 4 * 64 * 16);
constexpr size_t WS_HGVE = al256(WS_HGDS + HG_CHUNKS * 8 * 8 * 64 * 16);
constexpr size_t WS_HGSF = al256(WS_HGVE + HG_CHUNKS * 256 * 4);
constexpr int FX_T = 4, FX_ROWS = NB * FX_T;
constexpr size_t WS_ZF = al256(WS_HGSF + HG_CHUNKS * 8 * 4 * 64 * 16);
constexpr size_t WS_OEX = al256(WS_ZF + (size_t)FX_ROWS * ZLD * 4);
constexpr size_t WS_OEXC = al256(WS_OEX + (size_t)NB * (MIX / 128) * FX_T * 128 * 4);
constexpr size_t WS_END = al256(WS_OEXC + (size_t)NB * FX_T * MIX * 4);
constexpr size_t WS_RC = WS_P;
static_assert((size_t)NB * (MIX / 64) * (S / 16) * 22784 <= WS_VF - WS_P, "RWKV records fit the aliased region");

typedef unsigned short bf16_t;
typedef short bf16x8 __attribute__((ext_vector_type(8)));
typedef short s16x4 __attribute__((ext_vector_type(4)));
typedef float f32x16 __attribute__((ext_vector_type(16)));
typedef float f32x4 __attribute__((ext_vector_type(4)));
typedef float f32x2 __attribute__((ext_vector_type(2)));
typedef unsigned u32x4 __attribute__((ext_vector_type(4)));
typedef unsigned u32x2 __attribute__((ext_vector_type(2)));
#ifdef EMU
#define DI static inline
#define DM inline
#define LAS
#define GAS
#define WAVE_SYNC() emu_wave_barrier()
#define MFMA32(a, b, c) emu_mfma32(a, b, c)
#define MFMA16(a, b, c) emu_mfma16(a, b, c)
#define TR_READ(p) emu_tr_read((const void*)(p))
#define ROW_ROR(x, n) emu_row_ror(x, n)
#define ANY(p) emu_any(p)
#define RFL(x) (x)
DI float ex2(float x) { return exp2f(x); }
DI float lg2(float x) { return log2f(x); }
DI float frcp(float x) { return 1.f / x; }
DI float frsq(float x) { return 1.f / sqrtf(x); }
DI float u2f(unsigned u) { float f; memcpy(&f, &u, 4); return f; }
DI unsigned f2u(float f) { unsigned u; memcpy(&u, &f, 4); return u; }
#else
#define DI __device__ __forceinline__
#define DM __device__ __forceinline__
#define LAS __attribute__((address_space(3)))
#define GAS __attribute__((address_space(1)))
#define WAVE_SYNC() do { __builtin_amdgcn_fence(__ATOMIC_RELEASE, "wavefront"); __builtin_amdgcn_wave_barrier(); __builtin_amdgcn_fence(__ATOMIC_ACQUIRE, "wavefront"); } while (0)
#define MFMA32(a, b, c) __builtin_amdgcn_mfma_f32_32x32x16_bf16((a), (b), (c), 0, 0, 0)
#define MFMA16(a, b, c) __builtin_amdgcn_mfma_f32_16x16x32_bf16((a), (b), (c), 0, 0, 0)
typedef short v4i16_t __attribute__((ext_vector_type(4)));
#define TR_READ(p) __builtin_bit_cast(s16x4, __builtin_amdgcn_ds_read_tr16_b64_v4i16((LAS v4i16_t*)(p)))
#define ROW_ROR(x, n) __builtin_bit_cast(float, __builtin_amdgcn_update_dpp(0, __builtin_bit_cast(int, (x)), 0x120 + (n), 0xf, 0xf, false))
#define ANY(p) __any(p)
#define RFL(x) __builtin_amdgcn_readfirstlane(x)
DI float ex2(float x) { return __builtin_amdgcn_exp2f(x); }
DI float lg2(float x) { return __builtin_amdgcn_logf(x); }
DI float frcp(float x) { return __builtin_amdgcn_rcpf(x); }
DI float frsq(float x) { return __builtin_amdgcn_rsqf(x); }
DI float u2f(unsigned u) { return __builtin_bit_cast(float, u); }
DI unsigned f2u(float f) { return __builtin_bit_cast(unsigned, f); }
#endif
#ifdef EMU
#define SCHED_FENCE()
#else
#define SCHED_FENCE() __builtin_amdgcn_sched_barrier(0)
#endif
typedef LAS char* lptr;
#ifdef EMU
DI int TID() { return (int)threadIdx.x; }
#else
DI int TID() { int t = (int)threadIdx.x; asm volatile("" : "+v"(t)); return t; }
#endif
DI float bf2f(bf16_t v) { return u2f(((unsigned)v) << 16); }
DI bf16_t f2bf(float f) { unsigned u = f2u(f); return (bf16_t)((u + 0x7fffu + ((u >> 16) & 1u)) >> 16); }
#ifdef EMU
DI unsigned pk2(float lo, float hi) { return (unsigned)f2bf(lo) | ((unsigned)f2bf(hi) << 16); }
#else
typedef __bf16 bf16x2_hw __attribute__((ext_vector_type(2)));
DI unsigned pk2(float lo, float hi) { const f32x2 v = {lo, hi}; return __builtin_bit_cast(unsigned, __builtin_convertvector(v, bf16x2_hw)); }
#endif
DI float bflo(unsigned w) { return u2f(w << 16); }
DI float bfhi(unsigned w) { return u2f(w & 0xffff0000u); }
DI float fexp(float x) { return ex2(x * LOG2E); }
DI float flog(float x) { return lg2(x) * LN2; }
DI float fsigmoid(float x) { return frcp(1.f + fexp(-x)); }
DI float fsilu(float x) { return x * fsigmoid(x); }
DI float fsoftplus(float x) { return fmaxf(x, 0.f) + flog(1.f + fexp(-fabsf(x))); }
DI int crow(int i, int h) { return (i & 3) + 8 * (i >> 2) + 4 * h; }
DI bf16x8 pack8(float a0, float a1, float a2, float a3, float a4, float a5, float a6, float a7) {
    u32x4 w; w.x = pk2(a0, a1); w.y = pk2(a2, a3); w.z = pk2(a4, a5); w.w = pk2(a6, a7); return __builtin_bit_cast(bf16x8, w);
}
DI bf16x8 cat4(s16x4 lo, s16x4 hi) { return __builtin_shufflevector(lo, hi, 0, 1, 2, 3, 4, 5, 6, 7); }

struct Params {
    const float* in[25];
    float* out;
    unsigned char* ws;
};
#ifdef EMU
typedef const Params* KP;
#else
typedef const __attribute__((address_space(4))) Params* KP;
#endif
enum { I_X = 0, I_WIN, I_REL, I_LAM, I_SUBLN, I_HGLOW, I_HGNORM, I_MU, I_W0, I_W2, I_A0, I_A2, I_V1, I_VMU, I_V0, I_V2, I_KK, I_KA, I_RK, I_LNXG, I_LNXB, I_WBR, I_WOUT, I_LNG, I_LNB };
namespace pg8 {
#ifdef EMU
#define PG8_LAS
#else
#define PG8_LAS __attribute__((address_space(3)))
#endif
typedef unsigned short bf16_t;
typedef short bf16x8 __attribute__((ext_vector_type(8)));
typedef float f32x4 __attribute__((ext_vector_type(4)));
typedef unsigned u32x4 __attribute__((ext_vector_type(4)));
constexpr int BM = 256, BK = 64, HALF = 128, HTB = HALF * BK * 2  , STAGE_BYTES = 8 * HTB, NXCD = 8, WGM = 8;

__host__ __device__ __forceinline__ int lds_byte(int r, int c) { const int st = (r >> 4) * 2 + (c >> 5), rr = r & 15, cc = c & 31, ob = rr * 64 + cc * 2; return st * 1024 + (ob ^ (((ob >> 9) & 1) << 5)); }
__host__ __device__ __forceinline__ void stage_rc(int b, int& R, int& C) { const int st = b / 1024, sb = b % 1024, swz = sb ^ (((sb >> 9) & 1) << 5); R = (st >> 1) * 16 + swz / 64; C = (st & 1) * 32 + (swz % 64) / 2; }
__host__ __device__ __forceinline__ int perm32(int rho) { const int n = rho >> 4, i = rho & 15; return 8 * (i >> 2) + 4 * n + (i & 3); }

struct Unit { int pm, pn, ka; };
struct Gemm { const bf16_t* A; const bf16_t* Bt; int M, N, K, lda, ldb; };

struct StaticOrder {
    int nM, nN, nwg, G, c;
    __host__ __device__ void init(int M, int N, int G_, int c_) { nM = M / BM; nN = N / BM; nwg = nM * nN; G = G_; c = c_; }
    __host__ __device__ bool next(int i, Unit& u) const {
        const long L = (long)i * G + c; if (L >= nwg) return false;
        int wgid = (int)L; { const int q = nwg / NXCD, r = nwg % NXCD, xcd = wgid % NXCD, off = wgid / NXCD; wgid = (xcd < r ? xcd * (q + 1) : r * (q + 1) + (xcd - r) * q) + off; }
        const int nig = WGM * nN, gid = wgid / nig, fm = gid * WGM, gsz = (nM - fm) < WGM ? (nM - fm) : WGM;
        u.pm = fm + ((wgid % nig) % gsz); u.pn = (wgid % nig) / gsz; u.ka = 0; return true;
    }
    __device__ __forceinline__ void a_ready(const Unit&) const {}
    __device__ __forceinline__ void done(const Unit&) const {}
};
#ifndef EMU
template <class Epi, class Sched, bool ALIGN_EPI, bool SP2, int LDA, int LDB, int KDIM>
__device__ __forceinline__ void gemm_phase(PG8_LAS unsigned char* lds, const Gemm g, const Sched& S, const Epi& E) {
    const int tid = TID(), wid = __builtin_amdgcn_readfirstlane(tid >> 6), lane = tid & 63, wr = wid >> 2, wc = wid & 3, fr = lane & 15, fq = lane >> 4;
    constexpr int K = KDIM, nt = K / BK;
    unsigned voffA, voffB;
    { int R, C; stage_rc(tid * 16, R, C); const int Rb = Epi::PERM ? ((R & ~31) + perm32(R & 31)) : R;
      voffA = (unsigned)(R * LDA + C) * 2u; voffB = (unsigned)(Rb * LDB + C) * 2u; }
    const size_t qA = (size_t)64 * LDA * 2, qB = (size_t)64 * LDB * 2;
    const size_t kstep = (size_t)(BK * 2);
    const size_t hstepA = (size_t)HALF * LDA * 2, hstepB = (size_t)HALF * LDB * 2;
    const size_t tstepA = 2 * hstepA, tstepB = 2 * hstepB;
    const unsigned ldsw = (unsigned)wid * 1024u;
    const int aoff = lds_byte(wr * 64 + fr, fq * 8), boff = lds_byte(wc * 32 + fr, fq * 8);
#define PG8_SA(b, h) (((b) * 2 + (h)) * HTB)
#define PG8_SB(b, h) ((4 + (b) * 2 + (h)) * HTB)
#define PG8_STAGE_X(bufoff, gbase, voff, q) do { _Pragma("unroll") for (int _i = 0; _i < 2; ++_i) \
        __builtin_amdgcn_global_load_lds((const unsigned*)((const char*)(gbase) + (size_t)_i * (q) + (voff)), (PG8_LAS unsigned*)(lds + (bufoff) + ldsw + _i * 8192), 16, 0, 0); } while (0)
#define PG8_STAGE_A(bufoff, gbase) PG8_STAGE_X(bufoff, gbase, voffA, qA)
#define PG8_STAGE_B(bufoff, gbase) PG8_STAGE_X(bufoff, gbase, voffB, qB)
#define PG8_LDA(dst, b, h) do { _Pragma("unroll") for (int m = 0; m < 4; ++m) _Pragma("unroll") for (int k = 0; k < 2; ++k) dst[m][k] = *(const PG8_LAS bf16x8*)(lds + PG8_SA(b, h) + aoff + m * 2048 + k * 1024); } while (0)
#define PG8_LDB(dst, b, h) do { _Pragma("unroll") for (int n = 0; n < 2; ++n) _Pragma("unroll") for (int k = 0; k < 2; ++k) dst[n][k] = *(const PG8_LAS bf16x8*)(lds + PG8_SB(b, h) + boff + n * 2048 + k * 1024); } while (0)
#define PG8_MMA(ai, bj, At, Bt) do { __builtin_amdgcn_s_setprio(1); _Pragma("unroll") for (int m = 0; m < 4; ++m) _Pragma("unroll") for (int n = 0; n < 2; ++n) _Pragma("unroll") for (int k = 0; k < 2; ++k) \
        acc[ai][bj][m][n] = __builtin_amdgcn_mfma_f32_16x16x32_bf16(Bt[n][k], At[m][k], acc[ai][bj][m][n], 0, 0, 0); __builtin_amdgcn_s_setprio(0); } while (0)
#define PG8_WAIT_V(n) asm volatile("s_waitcnt vmcnt(" #n ")" ::: "memory")
#define PG8_WAIT_L(n) asm volatile("s_waitcnt lgkmcnt(" #n ")" ::: "memory")
#define PG8_BAR __builtin_amdgcn_s_barrier()
#define PG8_SCHED __builtin_amdgcn_sched_barrier(0)
    Unit cur, nxt; int ui = 0;
    if (!S.next(0, cur)) return;
    f32x4 acc[2][2][4][2];
#pragma unroll
    for (int a = 0; a < 2; ++a)
#pragma unroll
        for (int b = 0; b < 2; ++b)
#pragma unroll
            for (int m = 0; m < 4; ++m)
#pragma unroll
                for (int n = 0; n < 2; ++n) acc[a][b][m][n] = (f32x4){0.f, 0.f, 0.f, 0.f};
    bf16x8 At[4][2], B0[2][2], B1[2][2];
    const char* cA = (const char*)g.A + (size_t)cur.pm * tstepA + (size_t)cur.ka * 2; const char* cB = (const char*)g.Bt + (size_t)cur.pn * tstepB;
    S.a_ready(cur);
    if constexpr (SP2) {
        PG8_STAGE_B(PG8_SB(0, 0), cB); PG8_STAGE_B(PG8_SB(0, 1), cB + hstepB); PG8_STAGE_A(PG8_SA(0, 0), cA); PG8_STAGE_A(PG8_SA(0, 1), cA + hstepA);
        if (wr == 1) PG8_BAR;
        PG8_WAIT_V(2); PG8_BAR;
        PG8_STAGE_B(PG8_SB(1, 0), cB + kstep); PG8_STAGE_A(PG8_SA(1, 0), cA + kstep); PG8_STAGE_B(PG8_SB(1, 1), cB + hstepB + kstep);
        PG8_WAIT_V(6); PG8_BAR;
    } else {
        PG8_STAGE_B(PG8_SB(0, 0), cB); PG8_STAGE_A(PG8_SA(0, 0), cA); PG8_STAGE_B(PG8_SB(0, 1), cB + hstepB); PG8_STAGE_A(PG8_SA(0, 1), cA + hstepA);
        if (wr == 1) PG8_BAR;
        PG8_WAIT_V(4); PG8_BAR;
        PG8_STAGE_B(PG8_SB(1, 0), cB + kstep); PG8_STAGE_A(PG8_SA(1, 0), cA + kstep); PG8_STAGE_B(PG8_SB(1, 1), cB + hstepB + kstep);
        PG8_WAIT_V(6); PG8_BAR;
    }
    for (;;) {
        const bool has_next = S.next(ui + 1, nxt);
        const char* nA = has_next ? (const char*)g.A + (size_t)nxt.pm * tstepA + (size_t)nxt.ka * 2 : cA; const char* nB = has_next ? (const char*)g.Bt + (size_t)nxt.pn * tstepB : cB;
        auto kbody = [&](const int t) __attribute__((always_inline)) {
            const bool last = (t == nt - 2);
            const char* a1 = cA + (size_t)(t + 1) * kstep;
            const char* a2 = last ? nA : cA + (size_t)(t + 2) * kstep; const char* b2 = last ? nB : cB + (size_t)(t + 2) * kstep;
            const char* a3 = a2 + kstep; const char* b3 = b2 + kstep;
            if (last && has_next) S.a_ready(nxt);
            if constexpr (SP2) {
            PG8_LDB(B0, 0, 0); PG8_LDB(B1, 0, 1); PG8_SCHED; PG8_LDA(At, 0, 0); PG8_STAGE_A(PG8_SA(1, 1), a1 + hstepA);
            PG8_WAIT_V(8); PG8_WAIT_L(0); PG8_BAR; PG8_MMA(0, 0, At, B0); PG8_MMA(0, 1, At, B1); PG8_BAR; PG8_SCHED;
            PG8_LDA(At, 0, 1); PG8_STAGE_B(PG8_SB(0, 0), b2); PG8_STAGE_B(PG8_SB(0, 1), b2 + hstepB); PG8_STAGE_A(PG8_SA(0, 0), a2);
            PG8_WAIT_V(8); PG8_WAIT_L(0); PG8_BAR; PG8_MMA(1, 0, At, B0); PG8_MMA(1, 1, At, B1); PG8_BAR; PG8_SCHED;
            PG8_LDB(B0, 1, 0); PG8_LDB(B1, 1, 1); PG8_SCHED; PG8_LDA(At, 1, 0); PG8_STAGE_A(PG8_SA(0, 1), a2 + hstepA);
            PG8_WAIT_V(8); PG8_WAIT_L(0); PG8_BAR; PG8_MMA(0, 0, At, B0); PG8_MMA(0, 1, At, B1); PG8_BAR; PG8_SCHED;
            PG8_LDA(At, 1, 1); PG8_STAGE_B(PG8_SB(1, 0), b3); PG8_STAGE_B(PG8_SB(1, 1), b3 + hstepB); PG8_STAGE_A(PG8_SA(1, 0), a3);
            PG8_WAIT_V(8); PG8_WAIT_L(0); PG8_BAR; PG8_MMA(1, 0, At, B0); PG8_MMA(1, 1, At, B1); PG8_BAR; PG8_SCHED;
            } else {
            PG8_LDB(B0, 0, 0); PG8_SCHED; PG8_LDA(At, 0, 0); PG8_STAGE_A(PG8_SA(1, 1), a1 + hstepA);
            PG8_WAIT_L(8); PG8_BAR; PG8_WAIT_L(0); PG8_MMA(0, 0, At, B0); PG8_BAR; PG8_SCHED;
            PG8_LDB(B1, 0, 1); PG8_STAGE_B(PG8_SB(0, 0), b2);
            PG8_BAR; PG8_WAIT_L(0); PG8_MMA(0, 1, At, B1); PG8_BAR;
            PG8_LDA(At, 0, 1); PG8_STAGE_A(PG8_SA(0, 0), a2);
            PG8_BAR; PG8_WAIT_L(0); PG8_MMA(1, 0, At, B0); PG8_BAR; PG8_SCHED;
            PG8_STAGE_B(PG8_SB(0, 1), b2 + hstepB);
            PG8_WAIT_V(6); PG8_BAR; PG8_MMA(1, 1, At, B1); PG8_BAR;
            PG8_LDB(B0, 1, 0); PG8_SCHED; PG8_LDA(At, 1, 0); PG8_STAGE_A(PG8_SA(0, 1), a2 + hstepA);
            PG8_WAIT_L(8); PG8_BAR; PG8_WAIT_L(0); PG8_MMA(0, 0, At, B0); PG8_BAR; PG8_SCHED;
            PG8_LDB(B1, 1, 1); PG8_STAGE_B(PG8_SB(1, 0), b3);
            PG8_BAR; PG8_WAIT_L(0); PG8_MMA(0, 1, At, B1); PG8_BAR;
            PG8_LDA(At, 1, 1); PG8_STAGE_A(PG8_SA(1, 0), a3);
            PG8_BAR; PG8_WAIT_L(0); PG8_MMA(1, 0, At, B0); PG8_BAR; PG8_SCHED;
            PG8_STAGE_B(PG8_SB(1, 1), b3 + hstepB);
            PG8_WAIT_V(6); PG8_BAR; PG8_MMA(1, 1, At, B1); PG8_BAR;
            }
        };
        if constexpr (Epi::MIDK > 0) {
#pragma unroll 1
            for (int t0 = 0; t0 < nt; t0 += Epi::MIDK) { if (t0 > 0) E.mid(acc, cur, t0 / Epi::MIDK - 1, wr, wc, fr, fq);
#pragma unroll 1
                for (int t = t0; t < t0 + Epi::MIDK; t += 2) kbody(t); }
        } else {
            for (int t = 0; t < nt; t += 2) kbody(t);
        }
        if constexpr (ALIGN_EPI) { if (wr == 0) PG8_BAR; }
        if constexpr (!Epi::AFTER_DRAIN) { E(acc, cur, wr, wc, fr, fq); S.done(cur); }
        if (!has_next) break;
#pragma unroll
        for (int a = 0; a < 2; ++a)
#pragma unroll
            for (int b = 0; b < 2; ++b)
#pragma unroll
                for (int m = 0; m < 4; ++m)
#pragma unroll
                    for (int n = 0; n < 2; ++n) acc[a][b][m][n] = (f32x4){0.f, 0.f, 0.f, 0.f};
        cur = nxt; cA = nA; cB = nB; ++ui;
        if constexpr (ALIGN_EPI) { if (wr == 1) PG8_BAR; }
    }
    PG8_WAIT_V(0);
    if constexpr (!ALIGN_EPI) { if (wr == 0) PG8_BAR; }
    PG8_BAR;
    if constexpr (Epi::AFTER_DRAIN) { E.fused(acc, cur, wr, wc, fr, fq, lds, wid, lane); S.done(cur); }
#undef PG8_SA
#undef PG8_SB
#undef PG8_STAGE_X
#undef PG8_STAGE_A
#undef PG8_STAGE_B
#undef PG8_LDA
#undef PG8_LDB
#undef PG8_MMA
#undef PG8_WAIT_V
#undef PG8_WAIT_L
#undef PG8_BAR
#undef PG8_SCHED
}
#endif
}
#ifdef EMU
#define EPI_COORDS()
#else
#define EPI_COORDS() { const int t_ = TID(); const int w_ = RFL(t_ >> 6), l_ = t_ & 63; wr = w_ >> 2; wc = w_ & 3; fr = l_ & 15; fq = l_ >> 4; }
#endif
struct EpiInproj {
    static constexpr bool PERM = true, AFTER_DRAIN = false; static constexpr int MIDK = 0;
    bf16_t* O; int ldc; bf16_t* RHO; int gate_pn0;
    DM void operator()(const f32x4 (&acc)[2][2][4][2], const pg8::Unit& u, int wr, int wc, int fr, int fq) const {
        const int row0 = u.pm * 256 + wr * 64 + fr;
        if (u.pn < gate_pn0) { const int col0 = u.pn * 256 + wc * 32 + 8 * fq;
#pragma unroll
            for (int ai = 0; ai < 2; ++ai)
#pragma unroll
                for (int m = 0; m < 4; ++m) { bf16_t* rowp = O + (size_t)(row0 + ai * 128 + m * 16) * ldc + col0;
#pragma unroll
                    for (int bj = 0; bj < 2; ++bj) { const f32x4 v0 = acc[ai][bj][m][0], v1 = acc[ai][bj][m][1];
                        u32x4 w; w.x = pk2(v0[0], v0[1]); w.y = pk2(v0[2], v0[3]); w.z = pk2(v1[0], v1[1]); w.w = pk2(v1[2], v1[3]);
                        *(u32x4*)(rowp + bj * 128) = w; } }
        } else {
            const int T = u.pn - gate_pn0, pnc = T >> 2, bjc = (T & 3) >> 1, wcc = 2 * (T & 1) + (wc >> 1), fqc = fq, nc = wc & 1;
            bf16_t* base = RHO + ((((size_t)u.pm * (D / 256) + pnc) * 4) * 8 + (wr * 4 + wcc)) * (size_t)(16 * 64 * 8) + bjc * 512 + (fqc * 16 + fr) * 8 + nc * 4;
            constexpr size_t SEG_STRIDE = (size_t)8 * 16 * 64 * 8;
#pragma unroll
            for (int ai = 0; ai < 2; ++ai)
#pragma unroll
                for (int m = 0; m < 4; ++m) { bf16_t* rp = base + (ai * 4 + m) * 1024; float r0[4], r1[4], r2[4], r3[4];
#pragma unroll
                    for (int e = 0; e < 4; ++e) { const float d0 = 1.f + fexp(-acc[ai][0][m][0][e]), d1 = 1.f + fexp(-acc[ai][0][m][1][e]), d2 = 1.f + fexp(-acc[ai][1][m][0][e]), d3 = 1.f + fexp(-acc[ai][1][m][1][e]);
                        const float i0 = frcp(d0), i1 = frcp(d1), i2 = frcp(d2), i3 = frcp(d3);
                        r0[e] = d1 * i0; r1[e] = d2 * i1; r2[e] = d3 * i2; r3[e] = i3; }
                    u32x2 w; w.x = pk2(r0[0], r0[1]); w.y = pk2(r0[2], r0[3]); *(u32x2*)(rp) = w; w.x = pk2(r1[0], r1[1]); w.y = pk2(r1[2], r1[3]); *(u32x2*)(rp + SEG_STRIDE) = w;
                    w.x = pk2(r2[0], r2[1]); w.y = pk2(r2[2], r2[3]); *(u32x2*)(rp + 2 * SEG_STRIDE) = w; w.x = pk2(r3[0], r3[1]); w.y = pk2(r3[2], r3[3]); *(u32x2*)(rp + 3 * SEG_STRIDE) = w; } }
    }
};
struct EpiGateP {
    static constexpr bool PERM = false, AFTER_DRAIN = false; static constexpr int MIDK = 0;
    bf16_t* O; int ldc; const bf16_t* SG;
    DM void operator()(const f32x4 (&acc)[2][2][4][2], const pg8::Unit& u, int wr, int wc, int fr, int fq) const {
        const int n = u.pn / (D / 256), pnc = u.pn % (D / 256);
        const u32x4* base = (const u32x4*)(SG + ((((size_t)u.pm * (D / 256) + pnc) * 4 + n) * 8 + (wr * 4 + wc)) * (size_t)(16 * 64 * 8)) + (fq * 16 + fr);
        const int row0 = u.pm * 256 + wr * 64 + fr, col0 = u.pn * 256 + wc * 32 + 4 * fq;
#pragma unroll
        for (int ai = 0; ai < 2; ++ai)
#pragma unroll
            for (int m = 0; m < 4; ++m) { bf16_t* rowp = O + (size_t)(row0 + ai * 128 + m * 16) * ldc + col0;
#pragma unroll
                for (int bj = 0; bj < 2; ++bj) { const u32x4 g = base[((ai * 4 + m) * 2 + bj) * 64]; const f32x4 v0 = acc[ai][bj][m][0], v1 = acc[ai][bj][m][1];
                    u32x2 w0, w1; w0.x = pk2(v0[0] * bflo(g.x), v0[1] * bfhi(g.x)); w0.y = pk2(v0[2] * bflo(g.y), v0[3] * bfhi(g.y)); w1.x = pk2(v1[0] * bflo(g.z), v1[1] * bfhi(g.z)); w1.y = pk2(v1[2] * bflo(g.w), v1[3] * bfhi(g.w));
                    *(u32x2*)(rowp + bj * 128) = w0; *(u32x2*)(rowp + bj * 128 + 16) = w1; } }
    }
};
struct EpiMerged {
    static constexpr bool PERM = false, AFTER_DRAIN = false; static constexpr int MIDK = MIX / 64;
    bf16_t* O; int ldc; const bf16_t* RHO;
    DM void mid(f32x4 (&acc)[2][2][4][2], const pg8::Unit& u, int seg, int wr, int wc, int fr, int fq) const {
        EPI_COORDS();
        const u32x4* base = (const u32x4*)(RHO + ((((size_t)u.pm * (D / 256) + u.pn) * 4 + seg) * 8 + (wr * 4 + wc)) * (size_t)(16 * 64 * 8)) + (fq * 16 + fr);
#pragma unroll
        for (int q = 0; q < 2; ++q) { u32x4 gv[8];
#pragma unroll
            for (int i = 0; i < 8; ++i) gv[i] = base[(q * 8 + i) * 64];
#pragma unroll
            for (int i = 0; i < 8; ++i) { const int idx = q * 8 + i, ai = idx >> 3, m = (idx >> 1) & 3, bj = idx & 1; const u32x4 g = gv[i];
                acc[ai][bj][m][0] = acc[ai][bj][m][0] * (f32x4){bflo(g.x), bfhi(g.x), bflo(g.y), bfhi(g.y)}; acc[ai][bj][m][1] = acc[ai][bj][m][1] * (f32x4){bflo(g.z), bfhi(g.z), bflo(g.w), bfhi(g.w)}; }
            SCHED_FENCE(); }
    }
    DM void operator()(const f32x4 (&acc)[2][2][4][2], const pg8::Unit& u, int wr, int wc, int fr, int fq) const {
        EPI_COORDS();
        const u32x4* base = (const u32x4*)(RHO + ((((size_t)u.pm * (D / 256) + u.pn) * 4 + 3) * 8 + (wr * 4 + wc)) * (size_t)(16 * 64 * 8)) + (fq * 16 + fr);
        const int row0 = u.pm * 256 + wr * 64 + fr, col0 = u.pn * 256 + wc * 32 + 4 * fq;
#pragma unroll
        for (int ai = 0; ai < 2; ++ai)
#pragma unroll
            for (int m = 0; m < 4; ++m) { bf16_t* rowp = O + (size_t)(row0 + ai * 128 + m * 16) * ldc + col0;
#pragma unroll
                for (int bj = 0; bj < 2; ++bj) { const u32x4 g = base[((ai * 4 + m) * 2 + bj) * 64]; const f32x4 v0 = acc[ai][bj][m][0], v1 = acc[ai][bj][m][1];
                    u32x2 w0, w1; w0.x = pk2(v0[0] * bflo(g.x), v0[1] * bfhi(g.x)); w0.y = pk2(v0[2] * bflo(g.y), v0[3] * bfhi(g.y)); w1.x = pk2(v1[0] * bflo(g.z), v1[1] * bfhi(g.z)); w1.y = pk2(v1[2] * bflo(g.w), v1[3] * bfhi(g.w));
                    *(u32x2*)(rowp + bj * 128) = w0; *(u32x2*)(rowp + bj * 128 + 16) = w1; } }
    }
};
struct EpiF32 {
    static constexpr bool PERM = false, AFTER_DRAIN = false; static constexpr int MIDK = 0;
    float* O; int ldc;
    DM void operator()(const f32x4 (&acc)[2][2][4][2], const pg8::Unit& u, int wr, int wc, int fr, int fq) const {
        const int row0 = u.pm * 256 + wr * 64 + fr, col0 = u.pn * 256 + wc * 32 + 4 * fq;
#pragma unroll
        for (int ai = 0; ai < 2; ++ai)
#pragma unroll
            for (int m = 0; m < 4; ++m) { float* rowp = O + (size_t)(row0 + ai * 128 + m * 16) * ldc + col0;
#pragma unroll
                for (int bj = 0; bj < 2; ++bj)
#pragma unroll
                    for (int n = 0; n < 2; ++n) *(f32x4*)(rowp + bj * 128 + n * 16) = acc[ai][bj][m][n]; }
    }
};

#ifdef EMU
template <class Epi> static void emu_gemm(const pg8::Gemm g, const Epi& E, int ka_div = 0, int ka_mul = 0) {
    if (g.M % 256 || g.N % 256) { printf("emu_gemm: M %d N %d not multiples of 256\n", g.M, g.N); exit(1); }
    std::vector<float> C((size_t)256 * 256);
    const int seglen = (Epi::MIDK > 0) ? Epi::MIDK * 64 : g.K, nseg = g.K / seglen;
    for (int pm = 0; pm < g.M / 256; ++pm) for (int pn = 0; pn < g.N / 256; ++pn) {
        pg8::Unit u{pm, pn, 0};
        std::fill(C.begin(), C.end(), 0.f);
        for (int sg = 0; sg < nseg; ++sg) {
            for (int i = 0; i < 256; ++i) for (int j = 0; j < 256; ++j) { float a = 0.f; const bf16_t* ar = g.A + (size_t)(pm * 256 + i) * g.lda + sg * seglen + (ka_div ? (pn / ka_div) * ka_mul : 0); const bf16_t* br = g.Bt + (size_t)(pn * 256 + j) * g.ldb + sg * seglen;
                for (int k = 0; k < seglen; ++k) a += bf2f(ar[k]) * bf2f(br[k]); C[(size_t)i * 256 + j] += a; }
            const bool fin = (sg == nseg - 1);
            for (int wid = 0; wid < 8; ++wid) for (int lane = 0; lane < 64; ++lane) { const int wr = wid >> 2, wc = wid & 3, fr = lane & 15, fq = lane >> 4;
                f32x4 acc[2][2][4][2];
                for (int ai = 0; ai < 2; ++ai) for (int bj = 0; bj < 2; ++bj) for (int m = 0; m < 4; ++m) for (int n = 0; n < 2; ++n) for (int e = 0; e < 4; ++e) {
                    const int r = 128 * ai + 64 * wr + 16 * m + fr; const int c = Epi::PERM ? (128 * bj + 32 * wc + 8 * fq + 4 * n + e) : (128 * bj + 32 * wc + 16 * n + 4 * fq + e);
                    acc[ai][bj][m][n][e] = C[(size_t)r * 256 + c]; }
                if (fin) E(acc, u, wr, wc, fr, fq);
                else { if constexpr (Epi::MIDK > 0) E.mid(acc, u, sg, wr, wc, fr, fq);
                    for (int ai = 0; ai < 2; ++ai) for (int bj = 0; bj < 2; ++bj) for (int m = 0; m < 4; ++m) for (int n = 0; n < 2; ++n) for (int e = 0; e < 4; ++e) {
                        const int r = 128 * ai + 64 * wr + 16 * m + fr; const int c = Epi::PERM ? (128 * bj + 32 * wc + 8 * fq + 4 * n + e) : (128 * bj + 32 * wc + 16 * n + 4 * fq + e);
                        C[(size_t)r * 256 + c] = acc[ai][bj][m][n][e]; } } }
        }
    }
}
#endif
DI int gate_row(int sc) { const int n = sc / D, j = sc % D, jl = j & 63; return CG0 + 256 * (j >> 6) + 128 * (n >> 1) + 32 * (jl >> 4) + 8 * ((jl >> 2) & 3) + 4 * (n & 1) + (jl & 3); }
template <bool GATE> DI void transpose_item(const float* W, int N, bf16_t* dst, size_t ld_dst, int row_off, int col_off, LAS float* scr, int kb, int nb, int lane) {
    const int k0 = 64 * kb, n0 = 32 * nb;
#pragma unroll 8
    for (int i = 0; i < 32; ++i) { const int kk = 2 * i + (lane >> 5); scr[kk * 33 + (lane & 31)] = W[(size_t)(k0 + kk) * N + n0 + (lane & 31)]; }
    WAVE_SYNC();
    const int c = lane & 7;
#pragma unroll
    for (int j = 0; j < 4; ++j) { const int n = (lane >> 3) + 8 * j; const LAS float* s = scr + (8 * c) * 33 + n;
        u32x4 o; o.x = pk2(s[0 * 33], s[1 * 33]); o.y = pk2(s[2 * 33], s[3 * 33]); o.z = pk2(s[4 * 33], s[5 * 33]); o.w = pk2(s[6 * 33], s[7 * 33]);
        const int drow = GATE ? gate_row(n0 + n - C_MG) : (row_off + n0 + n);
        *(u32x4*)(dst + (size_t)drow * ld_dst + col_off + k0 + 8 * c) = o; }
    WAVE_SYNC();
}
__device__ const unsigned char T5_THR[15] = {19, 21, 24, 27, 31, 35, 40, 46, 52, 59, 67, 77, 87, 99, 113};
DI int t5_bucket(int n) { if (n < 16) return n; int b = 16;
#pragma unroll
    for (int i = 0; i < 15; ++i) b += (n >= (int)T5_THR[i]) ? 1 : 0;
    return b; }

DI void phase_prologue(KP p, lptr lds) {
    const int tid = TID(), lane = tid & 63, wave = tid >> 6;
    const int gw = blockIdx.x * 8 + wave, NGW = gridDim.x * 8;
    const size_t gt = (size_t)blockIdx.x * 512 + tid, NGT = (size_t)gridDim.x * 512;
    LAS float* scr = (LAS float*)(lds + wave * 8704);
    bf16_t* WIN = (bf16_t*)(p->ws + WS_WIN); bf16_t* WBR = (bf16_t*)(p->ws + WS_WBR); bf16_t* WOUT = (bf16_t*)(p->ws + WS_WOUT);
    constexpr int NI_IN = (D / 64) * (IN_COLS / 32), NI_V1 = (D / 64) * 1, NI_BR = (MIX / 64) * (D / 32), NI_OUT = (D / 64) * (D / 32);
    constexpr int PER_L = NI_IN + NI_V1 + 4 * NI_BR + NI_OUT;
    for (int it = gw; it < L * PER_L; it += NGW) {
        const int l = it / PER_L; int r = it % PER_L;
        if (r < NI_IN) { const int nblk = IN_COLS / 32, nb = r % nblk; const float* src = p->in[I_WIN] + (size_t)l * D * IN_COLS; bf16_t* dstw = WIN + (size_t)l * NP * D;
            if (32 * nb >= C_MG) transpose_item<true>(src, IN_COLS, dstw, D, 0, 0, scr, r / nblk, nb, lane); else transpose_item<false>(src, IN_COLS, dstw, D, 0, 0, scr, r / nblk, nb, lane); continue; } r -= NI_IN;
        if (r < NI_V1) { if (l > 0) transpose_item<false>(p->in[I_V1] + (size_t)(l - 1) * D * 32, 32, WIN + (size_t)l * NP * D, D, C_VD, 0, scr, r, 0, lane); continue; } r -= NI_V1;
        if (r < 4 * NI_BR) { const int n = r / NI_BR, rr = r % NI_BR, nblk = D / 32;
            transpose_item<false>(p->in[I_WBR] + ((size_t)l * 4 + n) * MIX * D, D, WBR + (size_t)l * D * 4 * MIX, 4 * MIX, 0, n * MIX, scr, rr / nblk, rr % nblk, lane); continue; } r -= 4 * NI_BR;
        { const int nblk = D / 32; transpose_item<false>(p->in[I_WOUT] + (size_t)l * D * D, D, WOUT + (size_t)l * D * D, D, 0, 0, scr, r / nblk, r % nblk, lane); }
    }
    for (int l = 0; l < L; ++l) { const int r0 = (l == 0) ? C_VD : C_VD + 32; const size_t n8 = (size_t)(CG0 - r0) * D / 8; u32x4* dst = (u32x4*)(WIN + ((size_t)l * NP + r0) * D);
        for (size_t i = gt; i < n8; i += NGT) dst[i] = (u32x4){0u, 0u, 0u, 0u}; }
    { const f32x4* x4 = (const f32x4*)p->in[I_X]; u32x2* xn = (u32x2*)(p->ws + WS_XN);
      for (size_t i = gt; i < (size_t)M * D / 4; i += NGT) { const f32x4 v = x4[i]; u32x2 o; o.x = pk2(v[0], v[1]); o.y = pk2(v[2], v[3]); xn[i] = o; } }
    { bf16_t* W2T = (bf16_t*)(p->ws + SM_W2T); bf16_t* A2T = (bf16_t*)(p->ws + SM_A2T); bf16_t* V2T = (bf16_t*)(p->ws + SM_V2T);
      for (size_t i = gt; i < (size_t)L * MIX * 64; i += NGT) { const int j = (int)(i % 64); const int c = (int)((i / 64) % MIX); const int l = (int)(i / ((size_t)64 * MIX));
          W2T[i] = f2bf(p->in[I_W2][((size_t)l * 64 + j) * MIX + c]); A2T[i] = f2bf(p->in[I_A2][((size_t)l * 64 + j) * MIX + c]); }
      for (size_t i = gt; i < (size_t)L * MIX * 32; i += NGT) { const int j = (int)(i % 32); const int c = (int)((i / 32) % MIX); const int l = (int)(i / ((size_t)32 * MIX));
          V2T[i] = (l > 0) ? f2bf(p->in[I_V2][((size_t)(l - 1) * 32 + j) * MIX + c]) : (bf16_t)0; } }
    if (blockIdx.x == 0) {
        float* LAM = (float*)(p->ws + SM_LAM); float* LB = (float*)(p->ws + SM_LB); float* BT = (float*)(p->ws + SM_BT);
        if (tid < L) { const float* lm = p->in[I_LAM] + (size_t)tid * 256; float s1 = 0.f, s2 = 0.f;
            for (int i = 0; i < 64; ++i) { s1 += lm[i] * lm[64 + i]; s2 += lm[128 + i] * lm[192 + i]; }
            const float li = 0.8f - 0.6f * expf(-0.3f * (float)tid); LAM[tid] = expf(s1) - expf(s2) + li; LAM[L + tid] = li; }
        for (int c = tid; c < MIX; c += 512) { float mx = -1e30f; for (int l = 0; l < L; ++l) mx = fmaxf(mx, p->in[I_HGLOW][(size_t)l * MIX + c]);
            float den = 0.f; for (int l = 0; l < L; ++l) den += expf(p->in[I_HGLOW][(size_t)l * MIX + c] - mx);
            float cum = 0.f; for (int l = 0; l < L; ++l) { if (l > 0) cum += expf(p->in[I_HGLOW][(size_t)l * MIX + c] - mx) / den;
                LB[(size_t)l * MIX + c] = cum; LB[(size_t)(L + l) * MIX + c] = (l > 0) ? logf(cum) : -1e30f; LB[(size_t)(2 * L + l) * MIX + c] = log1pf(-cum); } }
        for (int i = tid; i < AH * 132; i += 512) { const int h = i / 132, d = i % 132; const int bk = (d >= 128) ? 31 : t5_bucket(d); BT[i] = p->in[I_REL][bk * AH + h] * LOG2E; }
    }
}
constexpr int ATT_KSTR = 272, ATT_VSTR = 320;
constexpr int ATT_K_OFF = 0, ATT_V_OFF = 64 * ATT_KSTR, ATT_BUF = ATT_V_OFF + 64 * ATT_VSTR, ATT_BT_OFF = 2 * ATT_BUF, ATT_X_OFF = 0;
struct KVRegs { u32x4 k[2], v[2]; };
DI void load_kv(KVRegs& rg, const bf16_t* Z, size_t row0, int kcol, int vcol, int tid) {
#pragma unroll
    for (int i = 0; i < 2; ++i) { const int pc = tid + 512 * i, row = pc >> 4, c16 = pc & 15;
        rg.k[i] = *(const u32x4*)(Z + (row0 + row) * ZLD + kcol + c16 * 8);
        rg.v[i] = *(const u32x4*)(Z + (row0 + row) * ZLD + vcol + c16 * 8); }
}
DI void store_kv(const KVRegs& rg, lptr lds, int tid) {
#pragma unroll
    for (int i = 0; i < 2; ++i) { const int pc = tid + 512 * i, row = pc >> 4, c16 = pc & 15;
        *(LAS u32x4*)(lds + ATT_K_OFF + row * ATT_KSTR + c16 * 16) = rg.k[i];
        *(LAS u32x4*)(lds + ATT_V_OFF + row * ATT_VSTR + c16 * 16) = rg.v[i]; }
}
DI void pv_acc(f32x16 (&o)[4], const f32x16& pt, lptr lds, int kh, int lane) {
    const int hh = lane >> 5, gsub = (lane >> 4) & 1, i16 = lane & 15, qq = i16 >> 2, pp = i16 & 3;
#pragma unroll
    for (int s = 0; s < 2; ++s) {
        const bf16x8 pb = pack8(pt[8 * s], pt[8 * s + 1], pt[8 * s + 2], pt[8 * s + 3], pt[8 * s + 4], pt[8 * s + 5], pt[8 * s + 6], pt[8 * s + 7]);
        const lptr vrow = lds + ATT_V_OFF + (32 * kh + 16 * s + 4 * hh + qq) * ATT_VSTR + gsub * 32 + pp * 8;
#pragma unroll
        for (int db = 0; db < 4; ++db) {
            const s16x4 lo = TR_READ(vrow + db * 64), hi = TR_READ(vrow + 8 * ATT_VSTR + db * 64);
            o[db] = MFMA32(cat4(lo, hi), pb, o[db]); }
    }
}
DI void phase_att_a(KP p, int layer, lptr lds, int unit) {
    const int tid = TID(), lane = tid & 63, wid = RFL(tid >> 6), r = lane & 31, hh = lane >> 5;
    constexpr int NQB = S / 128;
    const int qb = NQB - 1 - (unit / (NB * AH)), bh = unit % (NB * AH), h = bh % AH, b = bh / AH;
    const int mp = wid & 1, qs = wid >> 1, q0 = qb * 128, qw0 = q0 + 32 * qs, q = qw0 + r;
    const bf16_t* Z = (const bf16_t*)(p->ws + WS_Z); const size_t rowb = (size_t)b * S;
    const float* LAM = (const float*)(p->ws + SM_LAM); const float lam_full = LAM[layer], lam_init = LAM[L + layer];
    LAS float* BT = (LAS float*)(lds + ATT_BT_OFF);
    __syncthreads();
    if (tid < 132) BT[tid] = ((const float*)(p->ws + SM_BT))[h * 132 + tid];
    bf16x8 qf[4];
    { const bf16_t* qp = Z + (rowb + q) * ZLD + C_AQ + h * 128 + mp * 64 + 8 * hh; const float qsc = 0.125f * LOG2E;
#pragma unroll
      for (int ds = 0; ds < 4; ++ds) { const u32x4 w = *(const u32x4*)(qp + 16 * ds);
          qf[ds] = pack8(bflo(w.x) * qsc, bfhi(w.x) * qsc, bflo(w.y) * qsc, bfhi(w.y) * qsc, bflo(w.z) * qsc, bfhi(w.z) * qsc, bflo(w.w) * qsc, bfhi(w.w) * qsc); } }
    f32x16 o[4];
#pragma unroll
    for (int db = 0; db < 4; ++db)
#pragma unroll
        for (int i = 0; i < 16; ++i) o[db][i] = 0.f;
    float mrun = -INFINITY, lrun = 0.f;
    const int nkt = (q0 + 128) / 64;
    KVRegs rg; load_kv(rg, Z, rowb, C_AK + h * 128, C_AV + h * 128, tid);
    store_kv(rg, lds, tid);
    if (nkt > 1) load_kv(rg, Z, rowb + 64, C_AK + h * 128, C_AV + h * 128, tid);
    __syncthreads();
    for (int kt = 0; kt < nkt; ++kt) {
        const int k0 = kt * 64; const lptr buf = lds + (kt & 1) * ATT_BUF;
        if (kt + 1 < nkt) store_kv(rg, lds + ((kt + 1) & 1) * ATT_BUF, tid);
        if (kt + 2 < nkt) load_kv(rg, Z, rowb + k0 + 128, C_AK + h * 128, C_AV + h * 128, tid);
        if (k0 <= qw0 + 31) {
            const bool two = (k0 + 32 <= qw0 + 31);
            const bool far = (qw0 - (k0 + 63) >= 128);
            const float cinit = far ? BT[128] : 0.f;
            f32x16 sc0, sc1;
#pragma unroll
            for (int i = 0; i < 16; ++i) { sc0[i] = cinit; sc1[i] = cinit; }
#pragma unroll
            for (int ds = 0; ds < 4; ++ds) { sc0 = MFMA32(*(const LAS bf16x8*)(buf + ATT_K_OFF + r * ATT_KSTR + mp * 128 + ds * 32 + hh * 16), qf[ds], sc0);
                if (two) sc1 = MFMA32(*(const LAS bf16x8*)(buf + ATT_K_OFF + (32 + r) * ATT_KSTR + mp * 128 + ds * 32 + hh * 16), qf[ds], sc1); }
            if (!far) {
#pragma unroll
                for (int i = 0; i < 16; ++i) { const int d0 = q - (k0 + crow(i, hh)), d1 = d0 - 32; const int i0 = d0 < 0 ? 0 : (d0 > 128 ? 128 : d0), i1 = d1 < 0 ? 0 : (d1 > 128 ? 128 : d1);
                    sc0[i] = (d0 < 0) ? -INFINITY : sc0[i] + BT[i0]; sc1[i] = (d1 < 0 || !two) ? -INFINITY : sc1[i] + BT[i1]; }
            }
            float mx = fmaxf(sc0[0], sc1[0]);
#pragma unroll
            for (int i = 1; i < 16; ++i) mx = fmaxf(mx, fmaxf(sc0[i], sc1[i]));
            mx = fmaxf(mx, __shfl_xor(mx, 32));
            const float mnew = fmaxf(mrun, mx), alpha = ex2(mrun - mnew);
            float sum = 0.f;
#pragma unroll
            for (int i = 0; i < 16; ++i) { const float e0 = ex2(sc0[i] - mnew), e1 = ex2(sc1[i] - mnew); sc0[i] = e0; sc1[i] = e1; sum += e0 + e1; }
            sum += __shfl_xor(sum, 32);
            lrun = lrun * alpha + sum; mrun = mnew;
            if (ANY(alpha != 1.f)) {
#pragma unroll
                for (int db = 0; db < 4; ++db)
#pragma unroll
                    for (int i = 0; i < 16; ++i) o[db][i] *= alpha; }
            pv_acc(o, sc0, buf, 0, lane); if (two) pv_acc(o, sc1, buf, 1, lane);
        }
        __syncthreads();
    }
    __syncthreads();
    const float inv = 1.f / lrun;
    LAS float* X = (LAS float*)(lds + ATT_X_OFF) + (qs * 32 + r) * 132;
    if (mp == 1) {
#pragma unroll
        for (int db = 0; db < 4; ++db)
#pragma unroll
            for (int g = 0; g < 4; ++g) { f32x4 v; v[0] = o[db][4 * g] * inv * lam_full; v[1] = o[db][4 * g + 1] * inv * lam_full; v[2] = o[db][4 * g + 2] * inv * lam_full; v[3] = o[db][4 * g + 3] * inv * lam_full;
                *(LAS f32x4*)(X + 32 * db + 8 * g + 4 * hh) = v; }
    }
    __syncthreads();
    if (mp == 0) {
        float ss = 0.f;
#pragma unroll
        for (int db = 0; db < 4; ++db)
#pragma unroll
            for (int g = 0; g < 4; ++g) { const f32x4 x1 = *(const LAS f32x4*)(X + 32 * db + 8 * g + 4 * hh);
#pragma unroll
                for (int e = 0; e < 4; ++e) { const float x = o[db][4 * g + e] * inv - x1[e]; o[db][4 * g + e] = x; ss += x * x; } }
        ss += __shfl_xor(ss, 32);
        const float rinv = frsq(ss * (1.f / 128.f) + RMS_EPS) * (1.f - lam_init);
        const float* sg = p->in[I_SUBLN] + (size_t)layer * 128;
        const bf16_t* gp = Z + (rowb + q) * ZLD + C_AG + h * 128; bf16_t* yp = (bf16_t*)(p->ws + WS_Y) + (rowb + q) * (4 * MIX) + 0 * MIX + h * 128;
#pragma unroll
        for (int db = 0; db < 4; ++db)
#pragma unroll
            for (int g = 0; g < 4; ++g) { const int d = 32 * db + 8 * g + 4 * hh; const u32x2 gw = *(const u32x2*)(gp + d); const f32x4 sv = *(const f32x4*)(sg + d);
                u32x2 w; w.x = pk2(o[db][4 * g] * rinv * sv[0] * fsilu(bflo(gw.x)), o[db][4 * g + 1] * rinv * sv[1] * fsilu(bfhi(gw.x)));
                w.y = pk2(o[db][4 * g + 2] * rinv * sv[2] * fsilu(bflo(gw.y)), o[db][4 * g + 3] * rinv * sv[3] * fsilu(bfhi(gw.y)));
                *(u32x2*)(yp + d) = w; }
    }
}

constexpr float SB_CUT = -110.f;
DI void phase_att_d(KP p, int layer, lptr lds, int unit) {
    const int tid = TID(), lane = tid & 63, wid = RFL(tid >> 6), r = lane & 31, hh = lane >> 5;
    constexpr int NQB = S / 256;
    const int qb = NQB - 1 - (unit / (NB * SH)), bh = unit % (NB * SH), h = bh % SH, b = bh / SH;
    const int q0 = qb * 256, qw0 = q0 + 32 * wid, q = qw0 + r;
    const bf16_t* Z = (const bf16_t*)(p->ws + WS_Z); const size_t rowb = (size_t)b * S;
    LAS int* FLG = (LAS int*)(lds + ATT_BT_OFF);
    bf16x8 qf[8];
    { const bf16_t* qp = Z + (rowb + q) * ZLD + C_SQ + h * 128 + 8 * hh; const float qsc = 0.08838834764831845f;
#pragma unroll
      for (int ds = 0; ds < 8; ++ds) { const u32x4 w = *(const u32x4*)(qp + 16 * ds);
          qf[ds] = pack8(bflo(w.x) * qsc, bfhi(w.x) * qsc, bflo(w.y) * qsc, bfhi(w.y) * qsc, bflo(w.z) * qsc, bfhi(w.z) * qsc, bflo(w.w) * qsc, bfhi(w.w) * qsc); } }
    f32x16 o[4];
#pragma unroll
    for (int db = 0; db < 4; ++db)
#pragma unroll
        for (int i = 0; i < 16; ++i) o[db][i] = 0.f;
    float carry = 0.f;
    const int kt_hi = (q0 + 255) / 64;
    __syncthreads();
    KVRegs rg; load_kv(rg, Z, rowb + (size_t)kt_hi * 64, C_SK + h * 128, C_SV + h * 128, tid);
    store_kv(rg, lds + (kt_hi & 1) * ATT_BUF, tid);
    if (kt_hi > 0) load_kv(rg, Z, rowb + (size_t)(kt_hi - 1) * 64, C_SK + h * 128, C_SV + h * 128, tid);
    __syncthreads();
    for (int kt = kt_hi; kt >= 0; --kt) {
        const int k0 = kt * 64; const lptr buf = lds + (kt & 1) * ATT_BUF;
        if (kt > 0) store_kv(rg, lds + ((kt - 1) & 1) * ATT_BUF, tid);
        if (kt > 1) load_kv(rg, Z, rowb + k0 - 128, C_SK + h * 128, C_SV + h * 128, tid);
        if (k0 < qw0 + 31) {
#pragma unroll 1
            for (int kh = 1; kh >= 0; --kh) {
                if (k0 + 32 * kh >= qw0 + 31) continue;
                f32x16 z;
#pragma unroll
                for (int i = 0; i < 16; ++i) z[i] = 0.f;
#pragma unroll
                for (int ds = 0; ds < 8; ++ds) { const bf16x8 a = *(const LAS bf16x8*)(buf + ATT_K_OFF + (32 * kh + r) * ATT_KSTR + ds * 32 + hh * 16); z = MFMA32(a, qf[ds], z); }
                f32x16 lk; float gsum[4];
#pragma unroll
                for (int g = 0; g < 4; ++g) { gsum[g] = 0.f;
#pragma unroll
                    for (int e = 0; e < 4; ++e) { const int i = 4 * g + e; const bool valid = (k0 + 32 * kh + crow(i, hh)) < q; const float sp = fsoftplus(z[i]);
                        lk[i] = valid ? -sp : 0.f; z[i] = valid ? (z[i] - sp) : -INFINITY; gsum[g] += lk[i]; } }
                float og[4];
#pragma unroll
                for (int g = 0; g < 4; ++g) og[g] = __shfl_xor(gsum[g], 32);
                float suf[4]; float run = 0.f;
#pragma unroll
                for (int g = 3; g >= 0; --g) {
                    if (hh == 1) { suf[g] = run; run += gsum[g] + og[g]; }
                    else { suf[g] = run + og[g]; run += gsum[g] + og[g]; }
                }
#pragma unroll
                for (int g = 0; g < 4; ++g) { float inner = 0.f;
#pragma unroll
                    for (int e = 3; e >= 0; --e) { const int i = 4 * g + e; const float between = carry + suf[g] + inner; inner += lk[i]; z[i] = ex2((z[i] + between) * LOG2E); } }
                carry += run;
                pv_acc(o, z, buf, kh, lane);
            }
        }
        const int active = ANY(carry > SB_CUT) ? 1 : 0;
        if (lane == 0) FLG[(kt & 1) * 8 + wid] = active;
        __syncthreads();
        int anyact = 0;
#pragma unroll
        for (int w = 0; w < 8; ++w) anyact |= FLG[(kt & 1) * 8 + w];
        if (!anyact) break;
    }
    const bf16_t* gp = Z + (rowb + q) * ZLD + C_SG + h * 128; bf16_t* yp = (bf16_t*)(p->ws + WS_Y) + (rowb + q) * (4 * MIX) + 3 * MIX + h * 128;
#pragma unroll
    for (int db = 0; db < 4; ++db)
#pragma unroll
        for (int g = 0; g < 4; ++g) { const int d = 32 * db + 8 * g + 4 * hh; const u32x2 gw = *(const u32x2*)(gp + d);
            u32x2 w; w.x = pk2(o[db][4 * g] * fsilu(bflo(gw.x)), o[db][4 * g + 1] * fsilu(bfhi(gw.x)));
            w.y = pk2(o[db][4 * g + 2] * fsilu(bflo(gw.y)), o[db][4 * g + 3] * fsilu(bfhi(gw.y)));
            *(u32x2*)(yp + d) = w; }
}
constexpr int HG_STR = 144;
constexpr int HG_QT = 0, HG_KT = 128 * HG_STR, HG_IT = 2 * 128 * HG_STR, HG_SC = 3 * 128 * HG_STR, HG_VEC = HG_SC + 64 * HG_STR;
DI bf16x8 hg_trfrag(lptr img, int col0, int dbase, int lane) {
    const int g = lane >> 4, i16 = lane & 15, qq = i16 >> 2, pp = i16 & 3;
    const lptr a = img + (dbase + 4 * g + qq) * HG_STR + (col0 + 4 * pp) * 2;
    return cat4(TR_READ(a), TR_READ(a + 16 * HG_STR));
}
constexpr int HG_NC = S / 64, HG_NCH = NB * HH * HG_NC;
DI void phase_hg_local(KP p, int layer, lptr lds, int unit) {
    const int tid = TID(), lane = tid & 63, wid = RFL(tid >> 6), g = lane >> 4, c16 = lane & 15;
    const int c = unit % HG_NC, bh = unit / HG_NC, h = bh % HH, b = bh / HH;
    const bf16_t* Z = (const bf16_t*)(p->ws + WS_Z); const size_t row0 = (size_t)b * S + (size_t)c * 64;
    const float* LBp = (const float*)(p->ws + SM_LB);
    LAS float* EBD = (LAS float*)(lds + HG_VEC); LAS float* QTOT = EBD + 128;
    const int ch = tid & 127, tq = tid >> 7;
    const float lb = LBp[(size_t)layer * MIX + h * 128 + ch], loglb = LBp[(size_t)(L + layer) * MIX + h * 128 + ch], log1m = LBp[(size_t)(2 * L + layer) * MIX + h * 128 + ch];
    __syncthreads();
    float bl[16], qv[16], kv[16], iv[16];
    { const bf16_t* zp = Z + (row0 + 16 * tq) * ZLD + h * 128 + ch; float run = 0.f;
#pragma unroll
      for (int t = 0; t < 16; ++t) { const float zq = bf2f(zp[(size_t)t * ZLD + C_HQ]), zf = bf2f(zp[(size_t)t * ZLD + C_HF]); iv[t] = bf2f(zp[(size_t)t * ZLD + C_HI]);
          const float ls = -fsoftplus(-zf);
          float lf; if (lb > 0.f) { const float a_ = loglb, b_ = log1m + ls, mx = fmaxf(a_, b_); lf = mx + flog(fexp(a_ - mx) + fexp(b_ - mx)); } else lf = ls;
          run += lf; bl[t] = run; qv[t] = zq; kv[t] = (1.f - lb) * fexp(ls - zf); }
      QTOT[tq * 128 + ch] = run; }
    __syncthreads();
    { const float t0 = QTOT[ch], t1 = QTOT[128 + ch], t2 = QTOT[256 + ch], t3 = QTOT[384 + ch];
      const float pre = (tq > 0 ? t0 : 0.f) + (tq > 1 ? t1 : 0.f) + (tq > 2 ? t2 : 0.f), bref = t0 + t1, blast = bref + t2 + t3;
      unsigned qw[8], kw[8], iw[8];
#pragma unroll
      for (int t = 0; t < 16; t += 2) { const float b0 = pre + bl[t] - bref, b1 = pre + bl[t + 1] - bref;
          qw[t >> 1] = pk2(qv[t] * fexp(b0), qv[t + 1] * fexp(b1)); kw[t >> 1] = pk2(kv[t] * fexp(-b0), kv[t + 1] * fexp(-b1)); iw[t >> 1] = pk2(iv[t], iv[t + 1]); }
      LAS u32x4* dq = (LAS u32x4*)(lds + HG_QT + ch * HG_STR + tq * 32); dq[0] = (u32x4){qw[0], qw[1], qw[2], qw[3]}; dq[1] = (u32x4){qw[4], qw[5], qw[6], qw[7]};
      LAS u32x4* dk = (LAS u32x4*)(lds + HG_KT + ch * HG_STR + tq * 32); dk[0] = (u32x4){kw[0], kw[1], kw[2], kw[3]}; dk[1] = (u32x4){kw[4], kw[5], kw[6], kw[7]};
      LAS u32x4* di = (LAS u32x4*)(lds + HG_IT + ch * HG_STR + tq * 32); di[0] = (u32x4){iw[0], iw[1], iw[2], iw[3]}; di[1] = (u32x4){iw[4], iw[5], iw[6], iw[7]};
      if (tq == 0) { float* VE = (float*)(p->ws + WS_HGVE) + (size_t)unit * 256; VE[ch] = fexp(bref); VE[128 + ch] = fexp(blast); EBD[ch] = fexp(blast - bref); } }
    __syncthreads();
#pragma unroll
    for (int k2 = 0; k2 < 2; ++k2) { const int ti = 2 * wid + k2, tb = ti >> 2, sb = ti & 3;
        f32x4 acc = (f32x4){0.f, 0.f, 0.f, 0.f};
        if (sb <= tb) {
#pragma unroll
            for (int dp = 0; dp < 4; ++dp) acc = MFMA16(hg_trfrag(lds + HG_QT, 16 * tb, 32 * dp, lane), hg_trfrag(lds + HG_KT, 16 * sb, 32 * dp, lane), acc); }
        const int s = 16 * sb + c16;
#pragma unroll
        for (int e = 0; e < 4; ++e) { const int t = 16 * tb + 4 * g + e; *(LAS bf16_t*)(lds + HG_SC + t * HG_STR + s * 2) = f2bf((s <= t) ? acc[e] : 0.f); }
        ((bf16x8*)(p->ws + WS_HGQF))[((size_t)unit * 16 + ti) * 64 + lane] = hg_trfrag(lds + HG_QT, 16 * (ti >> 2), 32 * (ti & 3), lane); }
    __syncthreads();
    bf16x8 ib[2];
#pragma unroll
    for (int ks = 0; ks < 2; ++ks) ib[ks] = *(const LAS bf16x8*)(lds + HG_IT + (16 * wid + c16) * HG_STR + (8 * g + 32 * ks) * 2);
    f32x4* IN = (f32x4*)(p->ws + WS_HGIN) + ((size_t)unit * 8 + wid) * 4 * 64;
#pragma unroll
    for (int tb = 0; tb < 4; ++tb) { f32x4 acc = (f32x4){0.f, 0.f, 0.f, 0.f};
#pragma unroll
        for (int ks = 0; ks < 2; ++ks) acc = MFMA16(*(const LAS bf16x8*)(lds + HG_SC + (16 * tb + c16) * HG_STR + (8 * g + 32 * ks) * 2), ib[ks], acc);
        IN[tb * 64 + lane] = acc; }
    f32x4* DS = (f32x4*)(p->ws + WS_HGDS) + ((size_t)unit * 8 + wid) * 8 * 64;
#pragma unroll
    for (int db = 0; db < 8; ++db) { f32x4 tmp = (f32x4){0.f, 0.f, 0.f, 0.f};
#pragma unroll
        for (int ks = 0; ks < 2; ++ks) tmp = MFMA16(*(const LAS bf16x8*)(lds + HG_KT + (16 * db + c16) * HG_STR + (8 * g + 32 * ks) * 2), ib[ks], tmp);
        const f32x4 ed = *(const LAS f32x4*)(EBD + 16 * db + 4 * g);
        DS[db * 64 + lane] = tmp * ed; }
}
DI void phase_hg_scan(KP p, int unit) {
    const int tid = TID(), lane = tid & 63, wid = RFL(tid >> 6), g = lane >> 4;
    f32x4 st[8];
#pragma unroll
    for (int db = 0; db < 8; ++db) st[db] = (f32x4){0.f, 0.f, 0.f, 0.f};
    const float* VE0 = (const float*)(p->ws + WS_HGVE) + (size_t)unit * HG_NC * 256;
    const f32x4* DS0 = (const f32x4*)(p->ws + WS_HGDS) + ((size_t)unit * HG_NC * 8 + wid) * 8 * 64 + lane;
    bf16x8* SF0 = (bf16x8*)(p->ws + WS_HGSF) + ((size_t)unit * HG_NC * 8 + wid) * 4 * 64 + lane;
    f32x4 ds[8], el[8], er[8];
#pragma unroll
    for (int db = 0; db < 8; ++db) { ds[db] = DS0[db * 64]; el[db] = *(const f32x4*)(VE0 + 128 + 16 * db + 4 * g); er[db] = *(const f32x4*)(VE0 + 16 * db + 4 * g); }
    for (int c = 0; c < HG_NC; ++c) {
        const int cn = (c + 1 < HG_NC) ? c + 1 : c;
        f32x4 dsn[8], eln[8], ern[8];
#pragma unroll
        for (int db = 0; db < 8; ++db) { dsn[db] = DS0[((size_t)cn * 8 * 8 + db) * 64]; eln[db] = *(const f32x4*)(VE0 + (size_t)cn * 256 + 128 + 16 * db + 4 * g); ern[db] = *(const f32x4*)(VE0 + (size_t)cn * 256 + 16 * db + 4 * g); }
#pragma unroll
        for (int dp = 0; dp < 4; ++dp) { const f32x4 a0 = st[2 * dp] * er[2 * dp], a1 = st[2 * dp + 1] * er[2 * dp + 1];
            SF0[((size_t)c * 8 * 4 + dp) * 64] = pack8(a0[0], a0[1], a0[2], a0[3], a1[0], a1[1], a1[2], a1[3]); }
#pragma unroll
        for (int db = 0; db < 8; ++db) { st[db] = el[db] * st[db] + ds[db]; ds[db] = dsn[db]; el[db] = eln[db]; er[db] = ern[db]; }
    }
}
DI void phase_hg_out(KP p, int layer, lptr lds, int unit) {
    const int tid = TID(), lane = tid & 63, wid = RFL(tid >> 6), g = lane >> 4, c16 = lane & 15;
    const int c = unit % HG_NC, bh = unit / HG_NC, h = bh % HH, b = bh / HH;
    const bf16_t* Z = (const bf16_t*)(p->ws + WS_Z); const size_t row0 = (size_t)b * S + (size_t)c * 64;
    LAS float* PS = (LAS float*)(lds + HG_VEC);
    const float gnorm = p->in[I_HGNORM][(size_t)layer * 128 + 16 * wid + c16];
    const bf16x8* QF = (const bf16x8*)(p->ws + WS_HGQF) + (size_t)unit * 16 * 64 + lane;
    const bf16x8* SF = (const bf16x8*)(p->ws + WS_HGSF) + ((size_t)unit * 8 + wid) * 4 * 64 + lane;
    const f32x4* IN = (const f32x4*)(p->ws + WS_HGIN) + ((size_t)unit * 8 + wid) * 4 * 64 + lane;
    bf16x8 sf[4];
#pragma unroll
    for (int dp = 0; dp < 4; ++dp) sf[dp] = SF[dp * 64];
    f32x4 ot[4];
#pragma unroll
    for (int tb = 0; tb < 4; ++tb) { f32x4 acc = IN[tb * 64];
#pragma unroll
        for (int dp = 0; dp < 4; ++dp) acc = MFMA16(QF[(tb * 4 + dp) * 64], sf[dp], acc);
        ot[tb] = acc; }
    if (c == 0 && g == 0) { const float* OEX = (const float*)(p->ws + WS_OEX) + (size_t)bh * FX_T * 128 + 16 * wid + c16;
#pragma unroll
        for (int e = 0; e < FX_T; ++e) ot[0][e] = OEX[e * 128]; }
    __syncthreads();
#pragma unroll
    for (int tb = 0; tb < 4; ++tb)
#pragma unroll
        for (int e = 0; e < 4; ++e) { float v = ot[tb][e] * ot[tb][e]; v += __shfl_xor(v, 1); v += __shfl_xor(v, 2); v += __shfl_xor(v, 4); v += __shfl_xor(v, 8);
            if (c16 == 0) PS[wid * 64 + 16 * tb + 4 * g + e] = v; }
    __syncthreads();
    const int e_col = h * 128 + 16 * wid + c16;
#pragma unroll
    for (int tb = 0; tb < 4; ++tb)
#pragma unroll
        for (int e = 0; e < 4; ++e) { const int t = 16 * tb + 4 * g + e; float ss = 0.f;
#pragma unroll
            for (int w = 0; w < 8; ++w) ss += PS[w * 64 + t];
            const float gate = bf2f(Z[(row0 + t) * ZLD + C_HG + e_col]);
            ((bf16_t*)(p->ws + WS_Y))[(row0 + t) * (4 * MIX) + 1 * MIX + e_col] = f2bf(ot[tb][e] * frsq(ss * (1.f / 128.f) + RMS_EPS) * gnorm * fsilu(gate)); }
}
constexpr int RC_GT = 0, RC_SL = 8192, RC_RH = 16384, RC_OL = 18432, RC_GAM = 22528, RC_BYTES = 22784;
constexpr int RC_NSUB = S / 16;
DI bf16x8 frag4_lds(lptr p) { const u32x2 w = *(const LAS u32x2*)p; u32x4 o; o.x = w.x; o.y = w.y; o.z = 0u; o.w = 0u; return __builtin_bit_cast(bf16x8, o); }
DI bf16x8 frag4_acc(const f32x4& x) { u32x4 o; o.x = pk2(x[0], x[1]); o.y = pk2(x[2], x[3]); o.z = 0u; o.w = 0u; return __builtin_bit_cast(bf16x8, o); }
DI float gbf(const bf16_t* p) { return bf2f(*p); }
DI void rw_local_item(KP p, int layer, lptr wl, int item, int lane) {
    const int j = item % RC_NSUB, bh = item / RC_NSUB, hd = bh % RH, b = bh / RH, g = lane >> 4, c16 = lane & 15;
    const int t0 = 16 * j; const size_t m0 = (size_t)b * S + t0;
    unsigned char* rec = p->ws + WS_RC + (size_t)item * RC_BYTES;
    const bf16_t* Z = (const bf16_t*)(p->ws + WS_Z); const float* mu = p->in[I_MU] + (size_t)layer * RW_MIX;
    bf16x8 xw[2], xa[2], xv; xv = (bf16x8){0, 0, 0, 0, 0, 0, 0, 0};
    { const bf16_t* cur = Z + (m0 + c16) * ZLD; const bool hp = (t0 + c16) > 0; const bf16_t* prv = hp ? cur - ZLD : cur;
#pragma unroll
      for (int ks = 0; ks < 2; ++ks) { const int jj = 32 * ks + 8 * g;
          const u32x4 cw = *(const u32x4*)(cur + C_RM + 3 * MIX + jj), ca = *(const u32x4*)(cur + C_RM + 3 * MIX + 64 + jj); u32x4 pw = (u32x4){0u, 0u, 0u, 0u}, pa = pw;
          if (hp) { pw = *(const u32x4*)(prv + C_RM + 3 * MIX + jj); pa = *(const u32x4*)(prv + C_RM + 3 * MIX + 64 + jj); }
          const f32x4 m0v = *(const f32x4*)(mu + 3 * MIX + jj), m1v = *(const f32x4*)(mu + 3 * MIX + jj + 4), n0v = *(const f32x4*)(mu + 3 * MIX + 64 + jj), n1v = *(const f32x4*)(mu + 3 * MIX + 64 + jj + 4);
#define LRP(c, q, m) ((c) + ((q) - (c)) * (m))
          xw[ks] = pack8(tanhf(LRP(bflo(cw.x), bflo(pw.x), m0v[0])), tanhf(LRP(bfhi(cw.x), bfhi(pw.x), m0v[1])), tanhf(LRP(bflo(cw.y), bflo(pw.y), m0v[2])), tanhf(LRP(bfhi(cw.y), bfhi(pw.y), m0v[3])),
                         tanhf(LRP(bflo(cw.z), bflo(pw.z), m1v[0])), tanhf(LRP(bfhi(cw.z), bfhi(pw.z), m1v[1])), tanhf(LRP(bflo(cw.w), bflo(pw.w), m1v[2])), tanhf(LRP(bfhi(cw.w), bfhi(pw.w), m1v[3])));
          xa[ks] = pack8(LRP(bflo(ca.x), bflo(pa.x), n0v[0]), LRP(bfhi(ca.x), bfhi(pa.x), n0v[1]), LRP(bflo(ca.y), bflo(pa.y), n0v[2]), LRP(bfhi(ca.y), bfhi(pa.y), n0v[3]),
                         LRP(bflo(ca.z), bflo(pa.z), n1v[0]), LRP(bfhi(ca.z), bfhi(pa.z), n1v[1]), LRP(bflo(ca.w), bflo(pa.w), n1v[2]), LRP(bfhi(ca.w), bfhi(pa.w), n1v[3])); }
      if (layer > 0) { const float* vmu = p->in[I_VMU] + (size_t)(layer - 1) * 32 + 8 * g; const u32x4 cv = *(const u32x4*)(cur + C_VD + 8 * g); u32x4 pv = (u32x4){0u, 0u, 0u, 0u}; if (hp) pv = *(const u32x4*)(prv + C_VD + 8 * g);
          const f32x4 m0v = *(const f32x4*)vmu, m1v = *(const f32x4*)(vmu + 4);
          xv = pack8(LRP(bflo(cv.x), bflo(pv.x), m0v[0]), LRP(bfhi(cv.x), bfhi(pv.x), m0v[1]), LRP(bflo(cv.y), bflo(pv.y), m0v[2]), LRP(bfhi(cv.y), bfhi(pv.y), m0v[3]),
                     LRP(bflo(cv.z), bflo(pv.z), m1v[0]), LRP(bfhi(cv.z), bfhi(pv.z), m1v[1]), LRP(bflo(cv.w), bflo(pv.w), m1v[2]), LRP(bfhi(cv.w), bfhi(pv.w), m1v[3])); }
#undef LRP
    }
    const bf16_t* W2T = (const bf16_t*)(p->ws + SM_W2T) + (size_t)layer * MIX * 64; const bf16_t* A2T = (const bf16_t*)(p->ws + SM_A2T) + (size_t)layer * MIX * 64;
    const bf16_t* V2T = (const bf16_t*)(p->ws + SM_V2T) + (size_t)layer * MIX * 32;
    const bf16_t* zg = Z + (m0 + 4 * g) * ZLD + C_RM + hd * 64 + c16; const bool hpg = (t0 + 4 * g) > 0;
    float ssq[4] = {0.f, 0.f, 0.f, 0.f};
#pragma unroll
    for (int cb = 0; cb < 4; ++cb) { const int ch = hd * 64 + 16 * cb + c16; const float mk = mu[MIX + ch], kk0 = p->in[I_KK][(size_t)layer * MIX + ch]; float pk = hpg ? gbf(zg - ZLD + MIX + 16 * cb) : 0.f;
#pragma unroll
        for (int e = 0; e < 4; ++e) { const float ck = gbf(zg + (size_t)e * ZLD + MIX + 16 * cb), kk = (ck + (pk - ck) * mk) * kk0; ssq[e] += kk * kk; pk = ck; } }
#pragma unroll
    for (int e = 0; e < 4; ++e) { float s = ssq[e]; s += __shfl_xor(s, 1); s += __shfl_xor(s, 2); s += __shfl_xor(s, 4); s += __shfl_xor(s, 8); ssq[e] = 1.f / fmaxf(sqrtf(s), 1e-12f); }
    float bon[4] = {0.f, 0.f, 0.f, 0.f};
#pragma unroll 1
    for (int cb = 0; cb < 4; ++cb) { const int chl = 16 * cb + c16, ch = hd * 64 + chl; const f32x4 z4 = (f32x4){0.f, 0.f, 0.f, 0.f};
        f32x4 lw = z4, la = z4, lv = z4;
#pragma unroll
        for (int ks = 0; ks < 2; ++ks) { lw = MFMA16(xw[ks], *(const bf16x8*)(W2T + (size_t)ch * 64 + 32 * ks + 8 * g), lw); la = MFMA16(xa[ks], *(const bf16x8*)(A2T + (size_t)ch * 64 + 32 * ks + 8 * g), la); }
        if (layer > 0) lv = MFMA16(xv, *(const bf16x8*)(V2T + (size_t)ch * 32 + 8 * g), lv);
        const float mr = mu[ch], mk = mu[MIX + ch], mv = mu[2 * MIX + ch];
        const float w0 = p->in[I_W0][(size_t)layer * MIX + ch], a0 = p->in[I_A0][(size_t)layer * MIX + ch], kk0 = p->in[I_KK][(size_t)layer * MIX + ch], ka = p->in[I_KA][(size_t)layer * MIX + ch];
        const float rk = p->in[I_RK][(size_t)layer * MIX + ch], v0 = p->in[I_V0][(size_t)(layer > 0 ? layer - 1 : 0) * MIX + ch];
        const bf16_t* zc = zg + 16 * cb;
        float pr = 0.f, pk = 0.f, pv = 0.f; if (hpg) { pr = gbf(zc - ZLD); pk = gbf(zc - ZLD + MIX); pv = gbf(zc - ZLD + 2 * MIX); }
        float rr[4], lg[4], k2[4], vv[4], kn[4], aa[4];
#pragma unroll
        for (int e = 0; e < 4; ++e) { const int tl = 4 * g + e, tq = t0 + tl; const float cr = gbf(zc + (size_t)e * ZLD), ck = gbf(zc + (size_t)e * ZLD + MIX), cv = gbf(zc + (size_t)e * ZLD + 2 * MIX);
            rr[e] = cr + (pr - cr) * mr; const float k = ck + (pk - ck) * mk; float v = cv + (pv - cv) * mv; pr = cr; pk = ck; pv = cv;
            const float wlog = -fsoftplus(-(w0 + lw[e])) - 0.5f; aa[e] = fsigmoid(a0 + la[e]);
            float* VF = (float*)(p->ws + WS_VF) + (m0 + tl) * MIX + ch;
            if (layer == 0) { if (tq >= FX_T) *VF = v; } else { const float vf = *VF; v = v + (vf - v) * fsigmoid(v0 + lv[e]); }
            if (tq >= FX_T) ((float*)(p->ws + WS_VV))[(m0 + tl) * MIX + ch] = v;
            kn[e] = k * kk0 * ssq[e]; k2[e] = k * (1.f + (aa[e] - 1.f) * ka); vv[e] = v; lg[e] = -fexp(wlog);
            bon[e] += rr[e] * k2[e] * rk; }
        float pre[4]; pre[0] = lg[0]; pre[1] = pre[0] + lg[1]; pre[2] = pre[1] + lg[2]; pre[3] = pre[2] + lg[3];
        const float G0 = __shfl(pre[3], c16), G1 = __shfl(pre[3], 16 + c16), G2 = __shfl(pre[3], 32 + c16), G3 = __shfl(pre[3], 48 + c16);
        const float P = (g > 0 ? G0 : 0.f) + (g > 1 ? G1 : 0.f) + (g > 2 ? G2 : 0.f), tot = (G0 + G1) + (G2 + G3), gC = fexp(tot);
        if (g == 0) ((float*)(rec + RC_GAM))[chl] = gC;
        float av[4], bv[4], kv[4];
#pragma unroll
        for (int e = 0; e < 4; ++e) { const float lwt = P + pre[e], gt = fexp(lwt), gp = fexp(lwt - lg[e]), gi = fexp(-lwt); const int t = 4 * g + e;
            av[e] = -kn[e] * gp; bv[e] = kn[e] * aa[e] * gi; kv[e] = k2[e] * gi;
            *(LAS bf16_t*)(wl + t * 128 + chl * 2) = f2bf(av[e]); *(LAS bf16_t*)(wl + 2048 + t * 128 + chl * 2) = f2bf(rr[e] * gt);
            *(LAS bf16_t*)(wl + 4096 + t * 128 + chl * 2) = f2bf(bv[e]); *(LAS bf16_t*)(wl + 6144 + t * 128 + chl * 2) = f2bf(kv[e]); }
        *(LAS u32x2*)(wl + 8192 + chl * 32 + 8 * g) = (u32x2){pk2(av[0], av[1]), pk2(av[2], av[3])}; *(LAS u32x2*)(wl + 10240 + chl * 32 + 8 * g) = (u32x2){pk2(vv[0], vv[1]), pk2(vv[2], vv[3])};
        *(LAS u32x2*)(wl + 12288 + chl * 32 + 8 * g) = (u32x2){pk2(bv[0] * gC, bv[1] * gC), pk2(bv[2] * gC, bv[3] * gC)}; *(LAS u32x2*)(wl + 14336 + chl * 32 + 8 * g) = (u32x2){pk2(kv[0] * gC, kv[1] * gC), pk2(kv[2] * gC, kv[3] * gC)}; }
#pragma unroll
    for (int e = 0; e < 4; ++e) { float bs = bon[e]; bs += __shfl_xor(bs, 1); bs += __shfl_xor(bs, 2); bs += __shfl_xor(bs, 4); bs += __shfl_xor(bs, 8);
        if (c16 == 0 && t0 + 4 * g + e >= FX_T) ((float*)(p->ws + WS_BON))[(m0 + 4 * g + e) * RH + hd] = bs; }
    WAVE_SYNC();
    f32x4 nab = (f32x4){0.f, 0.f, 0.f, 0.f}, nak = nab, mrb = nab, mrk = nab;
#pragma unroll
    for (int ks = 0; ks < 2; ++ks) { const int off = c16 * 128 + (32 * ks + 8 * g) * 2;
        const bf16x8 fa = *(const LAS bf16x8*)(wl + off), fr = *(const LAS bf16x8*)(wl + 2048 + off), fb = *(const LAS bf16x8*)(wl + 4096 + off), fk = *(const LAS bf16x8*)(wl + 6144 + off);
        nab = MFMA16(fa, fb, nab); nak = MFMA16(fa, fk, nak); mrb = MFMA16(fr, fb, mrb); mrk = MFMA16(fr, fk, mrk); }
    f32x4 rt[4];
#pragma unroll
    for (int cb = 0; cb < 4; ++cb)
#pragma unroll
        for (int e = 0; e < 4; ++e) rt[cb][e] = bf2f(*(const LAS bf16_t*)(wl + 2048 + (4 * g + e) * 128 + (16 * cb + c16) * 2));
    WAVE_SYNC();
#pragma unroll
    for (int e = 0; e < 4; ++e) { const int t = 4 * g + e, i = c16;
        *(LAS float*)(wl + (t * 16 + i) * 4) = (i < t) ? nab[e] : 0.f;
        *(LAS bf16_t*)(wl + 1024 + (t * 16 + i) * 2) = f2bf((i < t) ? nak[e] : 0.f);
        *(LAS bf16_t*)(wl + 1536 + (t * 16 + i) * 2) = f2bf((i <= t) ? mrb[e] : 0.f);
        *(LAS bf16_t*)(wl + 2048 + (t * 16 + i) * 2) = f2bf((i <= t) ? mrk[e] : 0.f); }
    WAVE_SYNC();
    { float tr[16];
#pragma unroll
      for (int t = 0; t < 16; ++t) { float acc = (c16 == t) ? 1.f : 0.f;
#pragma unroll
          for (int s = 0; s < t; ++s) acc += *(const LAS float*)(wl + (t * 16 + s) * 4) * tr[s];
          tr[t] = acc; if (g == 0) *(LAS bf16_t*)(wl + 2560 + (t * 16 + c16) * 2) = f2bf(acc); } }
    WAVE_SYNC();
    const bf16x8 tf = frag4_lds(wl + 2560 + c16 * 32 + 8 * g), nakf = frag4_lds(wl + 1024 + c16 * 32 + 8 * g), mrbf = frag4_lds(wl + 1536 + c16 * 32 + 8 * g), mrkf = frag4_lds(wl + 2048 + c16 * 32 + 8 * g);
    const f32x4 z4 = (f32x4){0.f, 0.f, 0.f, 0.f};
    bf16x8 ahf[4], plf[4];
#pragma unroll
    for (int cb = 0; cb < 4; ++cb) { const f32x4 ah = MFMA16(tf, frag4_lds(wl + 8192 + (16 * cb + c16) * 32 + 8 * g), z4); ahf[cb] = frag4_acc(ah);
        const f32x4 rh = MFMA16(mrbf, ahf[cb], rt[cb]);
#pragma unroll
        for (int e = 0; e < 4; ++e) ((bf16_t*)(rec + RC_RH))[(4 * g + e) * 64 + 16 * cb + c16] = f2bf(rh[e]); }
#pragma unroll
    for (int vb = 0; vb < 4; ++vb) { const bf16x8 vf = frag4_lds(wl + 10240 + (16 * vb + c16) * 32 + 8 * g);
        const f32x4 q = MFMA16(nakf, vf, z4); const f32x4 pl = MFMA16(tf, frag4_acc(q), z4); plf[vb] = frag4_acc(pl);
        f32x4 ol = MFMA16(mrbf, plf[vb], z4); ol = MFMA16(mrkf, vf, ol);
        ((f32x4*)(rec + RC_OL))[vb * 64 + lane] = ol; }
#pragma unroll
    for (int kb2 = 0; kb2 < 4; ++kb2) { const bf16x8 bbf = frag4_lds(wl + 12288 + (16 * kb2 + c16) * 32 + 8 * g), kkf = frag4_lds(wl + 14336 + (16 * kb2 + c16) * 32 + 8 * g);
#pragma unroll
        for (int kb = 0; kb < 4; ++kb) { const f32x4 gp4 = MFMA16(ahf[kb], bbf, z4);
            u32x2 w; w.x = pk2(gp4[0], gp4[1]); w.y = pk2(gp4[2], gp4[3]); *(u32x2*)((bf16_t*)(rec + RC_GT) + (16 * kb2 + c16) * 64 + 16 * kb + 4 * g) = w; }
#pragma unroll
        for (int vb = 0; vb < 4; ++vb) { f32x4 sl = MFMA16(plf[vb], bbf, z4); sl = MFMA16(frag4_lds(wl + 10240 + (16 * vb + c16) * 32 + 8 * g), kkf, sl);
            u32x2 w; w.x = pk2(sl[0], sl[1]); w.y = pk2(sl[2], sl[3]); ((u32x2*)(rec + RC_SL))[(vb * 4 + kb2) * 64 + lane] = w; } }
    WAVE_SYNC();
}
DI void phase_rw_local(KP p, int layer, lptr lds) {
    const int tid = TID(), lane = tid & 63, wave = RFL(tid >> 6);
    constexpr int NITEM = NB * RH * RC_NSUB;
    for (int it = blockIdx.x * 8 + wave; it < NITEM; it += gridDim.x * 8) rw_local_item(p, layer, lds + wave * 16384, it, lane);
}
constexpr int RS_STR = 144;
DI void phase_rw_scan(KP p, lptr lds, int unit) {
    const int tid = TID(), lane = tid & 63, wid = RFL(tid >> 6), g = lane >> 4, c16 = lane & 15;
    const int vb = wid >> 1, kb0 = 2 * (wid & 1), hd = unit % RH, b = unit / RH;
    const unsigned char* rec0 = p->ws + WS_RC + (size_t)unit * RC_NSUB * RC_BYTES;
    float* SCO = (float*)(p->ws + WS_SCO) + (size_t)b * S * MIX + hd * 64;
    f32x4 st[2]; st[0] = (f32x4){0.f, 0.f, 0.f, 0.f}; st[1] = st[0];
    __syncthreads();
    for (int j = 0; j < RC_NSUB; ++j) { const unsigned char* rec = rec0 + (size_t)j * RC_BYTES; const lptr img = lds + (j & 1) * (64 * RS_STR);
        bf16x8 gt[2][2]; u32x2 slw[2]; float gam[2];
#pragma unroll
        for (int tl = 0; tl < 2; ++tl) { const int kcol = 16 * (kb0 + tl) + c16;
#pragma unroll
            for (int ks = 0; ks < 2; ++ks) gt[tl][ks] = *(const bf16x8*)((const bf16_t*)(rec + RC_GT) + kcol * 64 + 32 * ks + 8 * g);
            slw[tl] = ((const u32x2*)(rec + RC_SL))[(vb * 4 + kb0 + tl) * 64 + lane]; gam[tl] = ((const float*)(rec + RC_GAM))[kcol]; }
        bf16x8 rh[2]; f32x4 ol = (f32x4){0.f, 0.f, 0.f, 0.f};
        if (wid < 4) {
#pragma unroll
            for (int ks = 0; ks < 2; ++ks) rh[ks] = *(const bf16x8*)((const bf16_t*)(rec + RC_RH) + c16 * 64 + 32 * ks + 8 * g);
            ol = ((const f32x4*)(rec + RC_OL))[wid * 64 + lane]; }
#pragma unroll
        for (int tl = 0; tl < 2; ++tl)
#pragma unroll
            for (int e = 0; e < 4; ++e) *(LAS bf16_t*)(img + (16 * vb + 4 * g + e) * RS_STR + (16 * (kb0 + tl) + c16) * 2) = f2bf(st[tl][e]);
        __syncthreads();
        bf16x8 af[2];
#pragma unroll
        for (int ks = 0; ks < 2; ++ks) af[ks] = *(const LAS bf16x8*)(img + (16 * vb + c16) * RS_STR + (32 * ks + 8 * g) * 2);
        if (wid < 4) {
            f32x4 o = ol;
#pragma unroll
            for (int ks = 0; ks < 2; ++ks) o = MFMA16(rh[ks], *(const LAS bf16x8*)(img + (16 * wid + c16) * RS_STR + (32 * ks + 8 * g) * 2), o);
#pragma unroll
            for (int e = 0; e < 4; ++e) SCO[(size_t)(16 * j + 4 * g + e) * MIX + 16 * wid + c16] = o[e]; }
#pragma unroll
        for (int tl = 0; tl < 2; ++tl) { f32x4 nw = (f32x4){0.f, 0.f, 0.f, 0.f};
#pragma unroll
            for (int ks = 0; ks < 2; ++ks) nw = MFMA16(af[ks], gt[tl][ks], nw);
            st[tl][0] = st[tl][0] * gam[tl] + nw[0] + bflo(slw[tl].x); st[tl][1] = st[tl][1] * gam[tl] + nw[1] + bfhi(slw[tl].x);
            st[tl][2] = st[tl][2] * gam[tl] + nw[2] + bflo(slw[tl].y); st[tl][3] = st[tl][3] * gam[tl] + nw[3] + bfhi(slw[tl].y); }
    }
}

DI void phase_rw_post(KP p, int layer) {
    const size_t gt = (size_t)blockIdx.x * 512 + TID(), NGT = (size_t)gridDim.x * 512;
    const bf16_t* Z = (const bf16_t*)(p->ws + WS_Z); const float* SCO = (const float*)(p->ws + WS_SCO); const float* BON = (const float*)(p->ws + WS_BON);
    const float* lg = p->in[I_LNXG] + (size_t)layer * MIX; const float* lbv = p->in[I_LNXB] + (size_t)layer * MIX;
    for (size_t i = gt; i < (size_t)M * (MIX / 16); i += NGT) { const size_t m = i / (MIX / 16); const int c0 = (int)(i % (MIX / 16)) * 16, hd = c0 >> 6; const int t = (int)(m % S), b = (int)(m / S);
        float o[16]; float s1 = 0.f; const float* osrc = (t < FX_T) ? (const float*)(p->ws + WS_OEXC) + ((size_t)b * FX_T + t) * MIX + c0 : SCO + m * MIX + c0;
#pragma unroll
        for (int j = 0; j < 4; ++j) { const f32x4 v = *(const f32x4*)(osrc + 4 * j); o[4 * j] = v[0]; o[4 * j + 1] = v[1]; o[4 * j + 2] = v[2]; o[4 * j + 3] = v[3]; s1 += (v[0] + v[1]) + (v[2] + v[3]); }
        s1 += __shfl_xor(s1, 1); s1 += __shfl_xor(s1, 2); const float mean = s1 * (1.f / 64.f); float s2 = 0.f;
#pragma unroll
        for (int j = 0; j < 16; ++j) { o[j] -= mean; s2 += o[j] * o[j]; }
        s2 += __shfl_xor(s2, 1); s2 += __shfl_xor(s2, 2); const float rstd = frsq(s2 * (1.f / 64.f) + RW_LN_EPS);
        const float bon = BON[m * RH + hd]; const float* vsrc = (const float*)(p->ws + WS_VV) + m * MIX + c0;
        const bf16_t* gp = Z + m * ZLD + C_RG + c0; bf16_t* yp = (bf16_t*)(p->ws + WS_Y) + m * (4 * MIX) + 2 * MIX + c0;
        unsigned w[8];
#pragma unroll
        for (int j = 0; j < 16; j += 2) { const float y0 = (o[j] * rstd * lg[c0 + j] + lbv[c0 + j] + bon * vsrc[j]) * fsilu(bf2f(gp[j])), y1 = (o[j + 1] * rstd * lg[c0 + j + 1] + lbv[c0 + j + 1] + bon * vsrc[j + 1]) * fsilu(bf2f(gp[j + 1]));
            w[j >> 1] = pk2(y0, y1); }
        *(u32x4*)(yp) = (u32x4){w[0], w[1], w[2], w[3]}; *(u32x4*)(yp + 8) = (u32x4){w[4], w[5], w[6], w[7]}; }
}

DI void phase_ln(KP p, int layer) {
    const int tid = TID(), lane = tid & 63, wave = tid >> 6;
    const float alpha = sqrtf(sqrtf(2.f * (float)L));
    const float* hprev = (layer == 0) ? p->in[I_X] : (const float*)(p->ws + WS_H); const float* outf = (const float*)(p->ws + WS_OUTF);
    float* hnew = (layer == L - 1) ? p->out : (float*)(p->ws + WS_H); bf16_t* xn = (bf16_t*)(p->ws + WS_XN);
    const float* lg = p->in[I_LNG] + (size_t)layer * D; const float* lbv = p->in[I_LNB] + (size_t)layer * D;
    constexpr int NV = D / 256;
    for (size_t m = (size_t)blockIdx.x * 8 + wave; m < (size_t)M; m += (size_t)gridDim.x * 8) {
        f32x4 v[NV]; float s = 0.f;
#pragma unroll
        for (int j = 0; j < NV; ++j) { const f32x4 a = *(const f32x4*)(hprev + m * D + 256 * j + 4 * lane), o = *(const f32x4*)(outf + m * D + 256 * j + 4 * lane); v[j] = a * alpha + o; s += (v[j][0] + v[j][1]) + (v[j][2] + v[j][3]); }
#pragma unroll
        for (int o = 1; o < 64; o <<= 1) s += __shfl_xor(s, o);
        const float mean = s * (1.f / D); float s2 = 0.f;
#pragma unroll
        for (int j = 0; j < NV; ++j) { v[j] = v[j] - mean; s2 += (v[j][0] * v[j][0] + v[j][1] * v[j][1]) + (v[j][2] * v[j][2] + v[j][3] * v[j][3]); }
#pragma unroll
        for (int o = 1; o < 64; o <<= 1) s2 += __shfl_xor(s2, o);
        const float rstd = 1.f / sqrtf(s2 * (1.f / D) + LN_EPS);
#pragma unroll
        for (int j = 0; j < NV; ++j) { const f32x4 g4 = *(const f32x4*)(lg + 256 * j + 4 * lane), b4 = *(const f32x4*)(lbv + 256 * j + 4 * lane); const f32x4 y = v[j] * rstd * g4 + b4;
            *(f32x4*)(hnew + m * D + 256 * j + 4 * lane) = y; u32x2 w; w.x = pk2(y[0], y[1]); w.y = pk2(y[2], y[3]); *(u32x2*)(xn + m * D + 256 * j + 4 * lane) = w; }
    }
}
constexpr int FX_NS_HG = 3 * MIX / 64, FX_NS_RW = RW_MIX / 64, FX_NSTRIP = FX_NS_HG + FX_NS_RW + 1;
DI void phase_fx_project(KP p, int layer, lptr lds, int strip) {
    const int tid = TID(), c = tid & 63, kg = tid >> 6;
    const float* hsrc = (layer == 0) ? p->in[I_X] : (const float*)(p->ws + WS_H);
    LAS float* HR = (LAS float*)lds;
    __syncthreads();
    for (int i = tid; i < FX_ROWS * D / 4; i += 512) { const int r = i / (D / 4), k4 = i % (D / 4); const size_t m = (size_t)(r / FX_T) * S + (r % FX_T);
        *(LAS f32x4*)(HR + r * D + 4 * k4) = *(const f32x4*)(hsrc + m * D + 4 * k4); }
    __syncthreads();
    int col0, ncol, ldw; const float* W;
    if (strip < FX_NS_HG) { col0 = C_HQ + 64 * strip; ncol = 64; ldw = IN_COLS; W = p->in[I_WIN] + (size_t)layer * D * IN_COLS + col0; }
    else if (strip < FX_NS_HG + FX_NS_RW) { col0 = C_RM + 64 * (strip - FX_NS_HG); ncol = 64; ldw = IN_COLS; W = p->in[I_WIN] + (size_t)layer * D * IN_COLS + col0; }
    else { col0 = C_VD; ncol = 32; ldw = 32; W = p->in[I_V1] + (size_t)(layer > 0 ? layer - 1 : 0) * D * 32; if (layer == 0) ncol = 0; }
    float acc[FX_ROWS];
#pragma unroll
    for (int r = 0; r < FX_ROWS; ++r) acc[r] = 0.f;
    if (c < ncol) {
        for (int k = kg * (D / 8); k < (kg + 1) * (D / 8); ++k) { const float w = W[(size_t)k * ldw + c];
#pragma unroll
            for (int r = 0; r < FX_ROWS; ++r) acc[r] += HR[r * D + k] * w; } }
    __syncthreads();
    LAS float* RED = (LAS float*)lds;
#pragma unroll
    for (int r = 0; r < FX_ROWS; ++r) RED[(kg * FX_ROWS + r) * 64 + c] = acc[r];
    __syncthreads();
    for (int i = tid; i < FX_ROWS * 64; i += 512) { const int r = i >> 6, cc = i & 63; float s = 0.f;
#pragma unroll
        for (int g = 0; g < 8; ++g) s += RED[(g * FX_ROWS + r) * 64 + cc];
        if (cc < ncol) ((float*)(p->ws + WS_ZF))[(size_t)r * ZLD + col0 + cc] = s; }
}
DI float wave_sum64(float v) {
#pragma unroll
    for (int o = 1; o < 64; o <<= 1) v += __shfl_xor(v, o);
    return v; }
DI void fx_rwkv(KP p, int layer, int item, int lane) {
    const int hd = item % RH, b = item / RH, ch = hd * 64 + lane;
    const float* ZF = (const float*)(p->ws + WS_ZF) + (size_t)b * FX_T * ZLD;
    const float* mu = p->in[I_MU] + (size_t)layer * RW_MIX;
    const float mur = mu[ch], muk = mu[MIX + ch], muv = mu[2 * MIX + ch], muw = mu[3 * MIX + lane], mua = mu[3 * MIX + 64 + lane];
    const float muvd = (layer > 0 && lane < 32) ? p->in[I_VMU][(size_t)(layer - 1) * 32 + lane] : 0.f;
    const float* w2 = p->in[I_W2] + (size_t)layer * 64 * MIX + ch; const float* a2 = p->in[I_A2] + (size_t)layer * 64 * MIX + ch;
    const float* v2 = p->in[I_V2] + (size_t)(layer > 0 ? layer - 1 : 0) * 32 * MIX + ch;
    const float w0 = p->in[I_W0][(size_t)layer * MIX + ch], a0 = p->in[I_A0][(size_t)layer * MIX + ch], kq = p->in[I_KK][(size_t)layer * MIX + ch], ka = p->in[I_KA][(size_t)layer * MIX + ch], rk = p->in[I_RK][(size_t)layer * MIX + ch];
    const float v0 = p->in[I_V0][(size_t)(layer > 0 ? layer - 1 : 0) * MIX + ch];
    float rv[FX_T], kv[FX_T], vv[FX_T], tw[FX_T], ad[FX_T], vd[FX_T];
    { float pr = 0.f, pk = 0.f, pv = 0.f, pw = 0.f, pa = 0.f, pvd = 0.f;
#pragma unroll
      for (int t = 0; t < FX_T; ++t) { const float* z = ZF + (size_t)t * ZLD;
          const float cr = z[C_RM + ch], ck = z[C_RM + MIX + ch], cv = z[C_RM + 2 * MIX + ch], cw = z[C_RM + 3 * MIX + lane], ca = z[C_RM + 3 * MIX + 64 + lane], cvd = (layer > 0 && lane < 32) ? z[C_VD + lane] : 0.f;
          rv[t] = cr + (pr - cr) * mur; kv[t] = ck + (pk - ck) * muk; vv[t] = cv + (pv - cv) * muv;
          tw[t] = tanhf(cw + (pw - cw) * muw); ad[t] = ca + (pa - ca) * mua; vd[t] = cvd + (pvd - cvd) * muvd;
          pr = cr; pk = ck; pv = cv; pw = cw; pa = ca; pvd = cvd; } }
    float lwv[FX_T], lav[FX_T], lvv[FX_T];
#pragma unroll
    for (int t = 0; t < FX_T; ++t) { lwv[t] = 0.f; lav[t] = 0.f; lvv[t] = 0.f; }
#pragma unroll 8
    for (int j = 0; j < 64; ++j) { const float w2j = w2[(size_t)j * MIX], a2j = a2[(size_t)j * MIX];
#pragma unroll
        for (int t = 0; t < FX_T; ++t) { lwv[t] += __shfl(tw[t], j) * w2j; lav[t] += __shfl(ad[t], j) * a2j; } }
    if (layer > 0) {
#pragma unroll 8
        for (int j = 0; j < 32; ++j) { const float v2j = v2[(size_t)j * MIX];
#pragma unroll
            for (int t = 0; t < FX_T; ++t) lvv[t] += __shfl(vd[t], j) * v2j; } }
    float xs[2 * FX_T - 1], ys[2 * FX_T - 1];
#pragma unroll
    for (int t = 0; t < FX_T; ++t) { const float r = rv[t], k = kv[t], lw = lwv[t], la = lav[t], lv = lvv[t]; float v = vv[t];
        const float wlog = -(fmaxf(-(w0 + lw), 0.f) + log1pf(expf(-fabsf(w0 + lw)))) - 0.5f, decay = expf(-expf(wlog));
        const float a = 1.f / (1.f + expf(-(a0 + la)));
        const size_t m = (size_t)b * S + t; float* VF = (float*)(p->ws + WS_VF) + m * MIX;
        if (layer == 0) VF[ch] = v; else { const float vf = VF[ch]; v = v + (vf - v) / (1.f + expf(-(v0 + lv))); }
        float kk = k * kq; const float nrm = sqrtf(wave_sum64(kk * kk)); kk = kk / fmaxf(nrm, 1e-12f);
        const float k2 = k * (1.f + (a - 1.f) * ka);
        const float bon = wave_sum64(r * k2 * rk);
        ((float*)(p->ws + WS_VV))[m * MIX + ch] = v;
        if (lane == 0) ((float*)(p->ws + WS_BON))[m * RH + hd] = bon;
        { const float an = -kk, bn = kk * a; float sa = 0.f, ov = 0.f;
          const int nt = (t == 0) ? 0 : 2 * t - 1;
#pragma unroll
          for (int i = 0; i < 2 * FX_T - 1; ++i) if (i < nt) { sa += xs[i] * wave_sum64(ys[i] * an); ys[i] *= decay; ov += xs[i] * wave_sum64(ys[i] * r); }
          if (t > 0) { ov += sa * wave_sum64(bn * r); }
          ov += v * wave_sum64(k2 * r);
#pragma unroll
          for (int i = 0; i < 2 * FX_T - 1; ++i) { if (t > 0 && i == nt) { xs[i] = sa; ys[i] = bn; } if (i == ((t == 0) ? 0 : nt + 1)) { xs[i] = v; ys[i] = k2; } }
          ((float*)(p->ws + WS_OEXC))[((size_t)b * FX_T + t) * MIX + ch] = ov; } }
}
DI void fx_hgrn(KP p, int layer, int item, int lane) {
    const int h = item % HH, b = item / HH;
    const float* ZF = (const float*)(p->ws + WS_ZF) + (size_t)b * FX_T * ZLD; const float* LBp = (const float*)(p->ws + SM_LB);
    float q[FX_T][2], kx[FX_T][2], Bc[FX_T][2], iv[FX_T][2];
#pragma unroll
    for (int u = 0; u < 2; ++u) { const int d = h * 128 + lane + 64 * u; const float lb = LBp[(size_t)layer * MIX + d]; float run = 0.f;
#pragma unroll
        for (int t = 0; t < FX_T; ++t) { const float* z = ZF + (size_t)t * ZLD; const float zf = z[C_HF + d]; q[t][u] = z[C_HQ + d]; iv[t][u] = z[C_HI + d];
            const float sg = 1.f / (1.f + expf(-zf)); run += logf(lb + (1.f - lb) * sg); Bc[t][u] = run; kx[t][u] = (1.f - lb) * (1.f - sg); } }
    float* OEX = (float*)(p->ws + WS_OEX) + (size_t)item * FX_T * 128;
#pragma unroll
    for (int t = 0; t < FX_T; ++t) { float o0 = 0.f, o1 = 0.f;
#pragma unroll
        for (int s = 0; s <= t; ++s) { const float c = wave_sum64(q[t][0] * kx[s][0] * expf(Bc[t][0] - Bc[s][0]) + q[t][1] * kx[s][1] * expf(Bc[t][1] - Bc[s][1])); o0 += c * iv[s][0]; o1 += c * iv[s][1]; }
        OEX[t * 128 + lane] = o0; OEX[t * 128 + 64 + lane] = o1; }
}
DI void phase_fx_fix(KP p, int layer) {
    const int tid = TID(), lane = tid & 63, gw = blockIdx.x * 8 + (tid >> 6), NGW = gridDim.x * 8;
    for (int it = gw; it < NB * RH + NB * HH; it += NGW) { if (it < NB * RH) fx_rwkv(p, layer, it, lane); else fx_hgrn(p, layer, it - NB * RH, lane); }
}
constexpr int NWAVES = 8, LDS_RING = 131072, MISC_OFF = LDS_RING + 320, LDS_BYTES = 147456;
constexpr int CW_BAR = 4096, CW_WQ = 16384;
enum { PH_INPROJ = 0, PH_RWPREP, PH_RWLOC, PH_MIX, PH_RWPOST, PH_BRANCH, PH_SUM, PH_OUT, PH_LN, PH_COUNT };
constexpr int U_SCAN = NB * RH, U_HG = NB * HH, U_HGC = NB * HH * (S / 64), U_AA = NB * AH * (S / 128), U_AD = NB * SH * (S / 256), U_MIX = U_SCAN + U_HG + U_AA + U_AD;

struct Args { Params p; int do_pro, l_lo, l_hi, ph_lo, ph_hi, mega, pad0, pad1; };

#ifndef EMU
#define XB_TMO      128
#define XB_XCNT(j)  (256  + 64 * (j))
#define XB_XSUB(j)  (1280 + 64 * (j))
#define XB_XGEN(j)  (2304 + 64 * (j))
#define XB_TOP      3328
#define XB_TOPGEN   3392
#define XCD_BAR_WORDS 3456
#define XB_SPIN_CAP (1u << 18)
__device__ __forceinline__ unsigned xb_ld(unsigned* p)              { return __hip_atomic_load(p, __ATOMIC_RELAXED, __HIP_MEMORY_SCOPE_AGENT); }
__device__ __forceinline__ unsigned xb_add(unsigned* p, unsigned v) { return __hip_atomic_fetch_add(p, v, __ATOMIC_RELAXED, __HIP_MEMORY_SCOPE_AGENT); }
__device__ __forceinline__ unsigned xb_xcc_id() { return (unsigned)__builtin_amdgcn_s_getreg((3 << 11) | 20) & 0xFu; }
#define XB_SPIN(cond, bar) do { unsigned _sp = 0; while (cond) { __builtin_amdgcn_s_sleep(1); \
    if ((++_sp & 255u) == 0u) { if (xb_ld(&(bar)[XB_TMO])) break; if (_sp > XB_SPIN_CAP) { atomicAdd(&(bar)[XB_TMO], 1u); break; } } } } while (0)
struct XcdBarrier { unsigned* bar; unsigned x; volatile LAS unsigned* st; };
__device__ __forceinline__ XcdBarrier xcd_barrier_post(unsigned* bar, volatile LAS unsigned* st) {
    XcdBarrier b; b.bar = bar; b.x = xb_xcc_id(); b.st = st;
    if (threadIdx.x == 0) (void)xb_add(&bar[XB_XCNT(b.x)], 1u);
    return b;
}
__device__ __forceinline__ void xcd_barrier_complete(unsigned* bar, unsigned x, unsigned& nloc, unsigned& nx) {
    const unsigned G = gridDim.x * gridDim.y * gridDim.z;
    unsigned sum, cnt, mine, sp = 0u;
    for (;;) {
        sum = 0u; cnt = 0u; mine = 0u;
#pragma unroll
        for (unsigned j = 0; j < 16; ++j) { const unsigned c = xb_ld(&bar[XB_XCNT(j)]); sum += c; cnt += (c > 0u) ? 1u : 0u; mine = (j == x) ? c : mine; }
        if (sum == G) break;
        __builtin_amdgcn_s_sleep(1);
        if ((++sp & 255u) == 0u) { if (xb_ld(&bar[XB_TMO])) break; if (sp > XB_SPIN_CAP) { atomicAdd(&bar[XB_TMO], 1u); break; } }
    }
    nloc = mine > 0u ? mine : 1u; nx = cnt > 0u ? cnt : 1u;
}
__device__ __forceinline__ void xcd_barrier(const XcdBarrier& b) {
    asm volatile("s_waitcnt vmcnt(0)" ::: "memory");
    __syncthreads();
    if (threadIdx.x == 0) {
        unsigned* bar = b.bar;
        __builtin_amdgcn_s_waitcnt(0);
        unsigned nloc = b.st[0], nx = b.st[1];
        if (nloc == 0u) { xcd_barrier_complete(bar, b.x, nloc, nx); b.st[0] = nloc; b.st[1] = nx; }
        const unsigned old = xb_add(&bar[XB_XSUB(b.x)], 1u);
        const unsigned gen = old / nloc;
        if (old + 1u == (gen + 1u) * nloc) {
            __builtin_amdgcn_fence(__ATOMIC_RELEASE, "agent");
            asm volatile("s_waitcnt vmcnt(0)" ::: "memory");
            const unsigned og = xb_add(&bar[XB_TOP], 1u);
            const unsigned tg = og / nx;
            if (og + 1u == (tg + 1u) * nx) xb_add(&bar[XB_TOPGEN], 1u);
            else XB_SPIN(xb_ld(&bar[XB_TOPGEN]) == tg, bar);
            __builtin_amdgcn_fence(__ATOMIC_ACQUIRE, "agent");
            xb_add(&bar[XB_XGEN(b.x)], 1u);
            asm volatile("s_waitcnt vmcnt(0)" ::: "memory");
        } else {
            XB_SPIN(xb_ld(&bar[XB_XGEN(b.x)]) == gen, bar);
            __builtin_amdgcn_fence(__ATOMIC_ACQUIRE, "agent");
            asm volatile("s_waitcnt vmcnt(0)" ::: "memory");
        }
    }
    __syncthreads();
}
#endif

DI int next_unit(unsigned* head, lptr lds) {
    LAS int* slot = (LAS int*)(lds + MISC_OFF + 64);
    __syncthreads();
#ifdef EMU
    if (threadIdx.x == 0) { *slot = (int)(*head); *head += 1; }
#else
    if (threadIdx.x == 0) *slot = (int)__hip_atomic_fetch_add(head, 1u, __ATOMIC_RELAXED, __HIP_MEMORY_SCOPE_AGENT);
#endif
    __syncthreads();
    return *slot;
}

#ifndef DBG_PHMASK
#define DBG_PHMASK 0xffff
#endif
struct BranchOrder {
    pg8::StaticOrder so;
    DM bool next(int i, pg8::Unit& u) const { if (!so.next(i, u)) return false; u.ka = (u.pn / (D / 256)) * MIX; return true; }
    DM void a_ready(const pg8::Unit&) const {}
    DM void done(const pg8::Unit&) const {}
};
#ifndef PROBE_REP
#define PROBE_REP 0
#endif
#ifndef PROBE_PREPSEL
#define PROBE_PREPSEL 7
#endif
#ifndef PROBE_MIXREP
#define PROBE_MIXREP 15
#endif
#ifndef DBG_MIXMASK
#define DBG_MIXMASK 15
#endif
DI void run_phase(KP p, int rep, int l, int ph, lptr lds) {
    unsigned char* ws = p->ws;
    if (!((DBG_PHMASK >> ph) & 1)) return;
    if (ph == PH_INPROJ) {
        pg8::Gemm g{(const bf16_t*)(ws + WS_XN), (const bf16_t*)(ws + WS_WIN) + (size_t)l * NP * D, M, NP, D, D, D};
        EpiInproj E{(bf16_t*)(ws + WS_Z), ZLD, (bf16_t*)(ws + WS_RHO), CG0 / 256};
#ifndef EMU
        pg8::StaticOrder so; so.init(M, NP, gridDim.x, blockIdx.x);
        pg8::gemm_phase<EpiInproj, pg8::StaticOrder, true, true, D, D, D>((LAS unsigned char*)lds, g, so, E);
#endif
        { const int first = (M / 256) * (NP / 256) % (int)gridDim.x;
          for (int s = ((int)blockIdx.x - first + (int)gridDim.x) % (int)gridDim.x; s < FX_NSTRIP; s += gridDim.x) phase_fx_project(p, l, lds, s); }
    } else if (ph == PH_RWPREP) {
        const int psel = rep ? PROBE_PREPSEL : 7;
        if (psel & 1) phase_rw_local(p, l, lds);
        if (psel & 2) phase_fx_fix(p, l);
        if (psel & 4) for (int u = blockIdx.x; u < U_HGC; u += gridDim.x) phase_hg_local(p, l, lds, u);
    } else if (ph == PH_RWLOC) {
    } else if (ph == PH_MIX) {
        unsigned* head = (unsigned*)(ws + WS_CTL) + CW_WQ + 64 * l + (rep ? 32 * 64 : 0);
        for (;;) { int u = next_unit(head, lds); if (u >= U_MIX) break;
            const int mm = rep ? PROBE_MIXREP : DBG_MIXMASK;
            if (u < U_SCAN) { if (mm & 1) phase_rw_scan(p, lds, u); continue; } u -= U_SCAN;
            if (u < U_HG) { if (mm & 2) phase_hg_scan(p, u); continue; } u -= U_HG;
            if (u < U_AA) { if (mm & 4) phase_att_a(p, l, lds, u); continue; } u -= U_AA;
            if (mm & 8) phase_att_d(p, l, lds, u); }
    } else if (ph == PH_RWPOST) {
        phase_rw_post(p, l);
        for (int u = blockIdx.x; u < U_HGC; u += gridDim.x) phase_hg_out(p, l, lds, u);
    } else if (ph == PH_BRANCH) {
        pg8::Gemm g{(const bf16_t*)(ws + WS_Y), (const bf16_t*)(ws + WS_WBR) + (size_t)l * D * 4 * MIX, M, D, 4 * MIX, 4 * MIX, 4 * MIX};
        EpiMerged E{(bf16_t*)(ws + WS_MG), D, (const bf16_t*)(ws + WS_RHO)};
#ifndef EMU
        pg8::StaticOrder so; so.init(M, D, gridDim.x, blockIdx.x);
        pg8::gemm_phase<EpiMerged, pg8::StaticOrder, true, true, 4 * MIX, 4 * MIX, 4 * MIX>((LAS unsigned char*)lds, g, so, E);
#endif
    } else if (ph == PH_SUM) {
    } else if (ph == PH_OUT) {
        pg8::Gemm g{(const bf16_t*)(ws + WS_MG), (const bf16_t*)(ws + WS_WOUT) + (size_t)l * D * D, M, D, D, D, D};
        EpiF32 E{(float*)(ws + WS_OUTF), D};
#ifndef EMU
        pg8::StaticOrder so; so.init(M, D, gridDim.x, blockIdx.x);
        pg8::gemm_phase<EpiF32, pg8::StaticOrder, true, true, D, D, D>((LAS unsigned char*)lds, g, so, E);
#endif
    } else if (ph == PH_LN) {
        phase_ln(p, l);
    }
}

#ifndef EMU
__global__ void __launch_bounds__(NWAVES * 64, 2) fwd(Args a) {
    extern __shared__ __attribute__((aligned(16))) unsigned char lds_raw[];
    lptr lds = (lptr)lds_raw;
    volatile LAS unsigned* MISC = (volatile LAS unsigned*)(lds + MISC_OFF);
    for (int u = threadIdx.x; u < (LDS_BYTES - LDS_RING) / 4; u += NWAVES * 64) ((LAS unsigned*)(lds + LDS_RING))[u] = 0u;
    __syncthreads();
    typedef const __attribute__((address_space(4))) Args* KA;
    KA ka = (KA)__builtin_amdgcn_kernarg_segment_ptr();
    const int mega = ka->mega, do_pro = ka->do_pro, l_lo = ka->l_lo, l_hi = ka->l_hi, ph_lo = ka->ph_lo, ph_hi = ka->ph_hi;
    auto kp = [&]() -> KP { KA k2 = ka; asm volatile("" : "+s"(k2)); return &k2->p; };
    XcdBarrier bar; bar.bar = (unsigned*)(ka->p.ws + WS_CTL) + CW_BAR; bar.x = 0; bar.st = nullptr;
    if (mega) bar = xcd_barrier_post((unsigned*)(ka->p.ws + WS_CTL) + CW_BAR, MISC + 8);
#define SEAM() do { if (mega) xcd_barrier(bar); } while (0)
    if (do_pro != 0 && ((DBG_PHMASK >> 8) & 1) != 0) { phase_prologue(kp(), lds); SEAM(); }
    for (int l = l_lo; l < l_hi; ++l) {
        if (ph_lo <= PH_INPROJ && PH_INPROJ < ph_hi) { run_phase(kp(), 0, l, PH_INPROJ, lds); SEAM(); if ((PROBE_REP >> PH_INPROJ) & 1) { run_phase(kp(), 1, l, PH_INPROJ, lds); SEAM(); } }
        if (ph_lo <= PH_RWPREP && PH_RWPREP < ph_hi) { run_phase(kp(), 0, l, PH_RWPREP, lds); SEAM(); if ((PROBE_REP >> PH_RWPREP) & 1) { run_phase(kp(), 1, l, PH_RWPREP, lds); SEAM(); } }
        if (ph_lo <= PH_MIX && PH_MIX < ph_hi) { run_phase(kp(), 0, l, PH_MIX, lds); SEAM(); if ((PROBE_REP >> PH_MIX) & 1) { run_phase(kp(), 1, l, PH_MIX, lds); SEAM(); } }
        if (ph_lo <= PH_RWPOST && PH_RWPOST < ph_hi) { run_phase(kp(), 0, l, PH_RWPOST, lds); SEAM(); if ((PROBE_REP >> PH_RWPOST) & 1) { run_phase(kp(), 1, l, PH_RWPOST, lds); SEAM(); } }
        if (ph_lo <= PH_BRANCH && PH_BRANCH < ph_hi) { run_phase(kp(), 0, l, PH_BRANCH, lds); SEAM(); if ((PROBE_REP >> PH_BRANCH) & 1) { run_phase(kp(), 1, l, PH_BRANCH, lds); SEAM(); } }
        if (ph_lo <= PH_OUT && PH_OUT < ph_hi) { run_phase(kp(), 0, l, PH_OUT, lds); SEAM(); if ((PROBE_REP >> PH_OUT) & 1) { run_phase(kp(), 1, l, PH_OUT, lds); SEAM(); } }
        if (ph_lo <= PH_LN && PH_LN < ph_hi) { run_phase(kp(), 0, l, PH_LN, lds); SEAM(); }
    }
#undef SEAM
}

#ifndef MK_MEGA
#define MK_MEGA 1
#endif
extern "C" void kernel_launch(void* const* d_in, const int* in_sizes, int n_in, void* d_out, int out_size, void* d_ws, size_t ws_size, hipStream_t stream) {
    static int grid = 0;
    if (grid == 0) {
        if (n_in != 25 || in_sizes[0] != M * D || out_size != M * D || ws_size < WS_END) { fprintf(stderr, "kernel_launch: shape/workspace mismatch (n_in %d, in0 %d, out %d, ws %zu need %zu)\n", n_in, n_in > 0 ? in_sizes[0] : -1, out_size, ws_size, (size_t)WS_END); grid = -1; return; }
        int dev = 0, cus = 0, per_cu = 0;
        if (hipGetDevice(&dev) != hipSuccess || hipDeviceGetAttribute(&cus, hipDeviceAttributeMultiprocessorCount, dev) != hipSuccess) { grid = -1; return; }
        if (hipFuncSetAttribute((const void*)fwd, hipFuncAttributeMaxDynamicSharedMemorySize, LDS_BYTES) != hipSuccess) { fprintf(stderr, "kernel_launch: hipFuncSetAttribute failed\n"); grid = -1; return; }
        if (hipOccupancyMaxActiveBlocksPerMultiprocessor(&per_cu, (const void*)fwd, NWAVES * 64, LDS_BYTES) != hipSuccess || per_cu < 1) fprintf(stderr, "kernel_launch: occupancy query says %d\n", per_cu);
        (void)hipGetLastError();
        grid = cus;
    }
    if (grid < 0) return;
    (void)hipMemsetAsync((char*)d_ws + WS_CTL, 0, CTL_BYTES, stream);
    Args a{};
    for (int i = 0; i < 25; ++i) a.p.in[i] = (const float*)d_in[i];
    a.p.out = (float*)d_out; a.p.ws = (unsigned char*)d_ws;
    if (MK_MEGA) {
        a.do_pro = 1; a.l_lo = 0; a.l_hi = L; a.ph_lo = 0; a.ph_hi = PH_COUNT; a.mega = 1;
        hipLaunchKernelGGL(fwd, dim3(grid), dim3(NWAVES * 64), LDS_BYTES, stream, a);
    } else {
        a.mega = 0; a.do_pro = 1; a.l_lo = 0; a.l_hi = 0; a.ph_lo = 0; a.ph_hi = 0;
        hipLaunchKernelGGL(fwd, dim3(grid), dim3(NWAVES * 64), LDS_BYTES, stream, a);
        a.do_pro = 0;
        for (int l = 0; l < L; ++l) for (int ph = 0; ph < PH_COUNT; ++ph) { a.l_lo = l; a.l_hi = l + 1; a.ph_lo = ph; a.ph_hi = ph + 1;
            hipLaunchKernelGGL(fwd, dim3(grid), dim3(NWAVES * 64), LDS_BYTES, stream, a); }
    }
}
#endif
```

```cpp
#ifdef EMU
#include "emu.h"
#else
#include <hip/hip_runtime.h>
#include <cstdio>
#include <cstdint>
#endif

#ifndef CFG_D_MODEL
#define CFG_D_MODEL 2048
#endif
#ifndef CFG_BATCH
#define CFG_BATCH 4
#endif
#ifndef CFG_SEQ
#define CFG_SEQ 4096
#endif
#ifndef CFG_DEPTH
#define CFG_DEPTH 4
#endif
constexpr int D = CFG_D_MODEL, NB = CFG_BATCH, S = CFG_SEQ, L = CFG_DEPTH, MIX = D / 2, M = NB * S;
constexpr int AH = MIX / 128, HH = MIX / 128, RH = MIX / 64, SH = MIX / 128;
constexpr int RW_MIX = 3 * MIX + 128;
constexpr int C_AQ = 0, C_AK = MIX, C_AV = 2 * MIX, C_AG = 3 * MIX, C_HQ = 4 * MIX, C_HF = 5 * MIX, C_HI = 6 * MIX, C_HG = 7 * MIX;
constexpr int C_RM = 8 * MIX, C_RG = C_RM + RW_MIX, C_SQ = C_RG + MIX, C_SK = C_SQ + MIX, C_SV = C_SK + MIX, C_SG = C_SV + MIX, C_MG = C_SG + MIX;
constexpr int IN_COLS = C_MG + 4 * D;
constexpr int C_VD = C_MG, CG0 = ((C_MG + 32 + 255) / 256) * 256, NP = CG0 + 4 * D, ZLD = CG0;
constexpr float LN_EPS = 1e-5f, RMS_EPS = 1e-6f, RW_LN_EPS = 64e-5f;
constexpr float LOG2E = 1.4426950408889634f, LN2 = 0.6931471805599453f;

constexpr size_t al256(size_t x) { return (x + 255) & ~(size_t)255; }
constexpr size_t WS_CTL = 0, CTL_BYTES = 1u << 20;
constexpr size_t SM_LAM = CTL_BYTES;
constexpr size_t SM_LB = SM_LAM + 256;
constexpr size_t SM_BT = al256(SM_LB + (size_t)3 * L * MIX * 4);
constexpr size_t SM_W2T = al256(SM_BT + (size_t)AH * 132 * 4);
constexpr size_t SM_A2T = al256(SM_W2T + (size_t)L * MIX * 64 * 2);
constexpr size_t SM_V2T = al256(SM_A2T + (size_t)L * MIX * 64 * 2);
constexpr size_t WS_WIN = al256(SM_V2T + (size_t)L * MIX * 32 * 2);
constexpr size_t WS_WBR = al256(WS_WIN + (size_t)L * NP * D * 2);
constexpr size_t WS_WOUT = al256(WS_WBR + (size_t)L * D * 4 * MIX * 2);
constexpr size_t WS_XN = al256(WS_WOUT + (size_t)L * D * D * 2);
constexpr size_t WS_H = al256(WS_XN + (size_t)M * D * 2);
constexpr size_t WS_Z = al256(WS_H + (size_t)M * D * 4);
constexpr size_t WS_Y = al256(WS_Z + (size_t)M * ZLD * 2);
constexpr size_t WS_RHO = al256(WS_Y + (size_t)M * 4 * MIX * 2);
constexpr size_t WS_P = al256(WS_RHO + (size_t)M * 4 * D * 2);
constexpr size_t WS_MG = al256(WS_P + (size_t)M * 4 * D * 2);
constexpr size_t WS_OUTF = al256(WS_MG + (size_t)M * D * 2);
constexpr size_t WS_VF = al256(WS_OUTF + (size_t)M * D * 4);
constexpr size_t WS_VV = al256(WS_VF + (size_t)M * MIX * 4);
constexpr size_t WS_SCO = al256(WS_VV + (size_t)M * MIX * 4);
constexpr size_t WS_BON = al256(WS_SCO + (size_t)M * MIX * 4);
constexpr size_t HG_CHUNKS = (size_t)NB * (MIX / 128) * (S / 64);
constexpr size_t WS_HGQF = al256(WS_BON + (size_t)M * RH * 4);
constexpr size_t WS_HGIN = al256(WS_HGQF + HG_CHUNKS * 16 * 64 * 16);
constexpr size_t WS_HGDS = al256(WS_HGIN + HG_CHUNKS * 8 * 4 * 64 * 16);
constexpr size_t WS_HGVE = al256(WS_HGDS + HG_CHUNKS * 8 * 8 * 64 * 16);
constexpr size_t WS_HGSF = al256(WS_HGVE + HG_CHUNKS * 256 * 4);
constexpr int FX_T = 4, FX_ROWS = NB * FX_T;
constexpr size_t WS_ZF = al256(WS_HGSF + HG_CHUNKS * 8 * 4 * 64 * 16);
constexpr size_t WS_OEX = al256(WS_ZF + (size_t)FX_ROWS * ZLD * 4);
constexpr size_t WS_OEXC = al256(WS_OEX + (size_t)NB * (MIX / 128) * FX_T * 128 * 4);
constexpr size_t WS_END = al256(WS_OEXC + (size_t)NB * FX_T * MIX * 4);
constexpr size_t WS_RC = WS_P;
static_assert((size_t)NB * (MIX / 64) * (S / 16) * 22784 <= WS_VF - WS_P, "RWKV records fit the aliased region");

typedef unsigned short bf16_t;
typedef short bf16x8 __attribute__((ext_vector_type(8)));
typedef short s16x4 __attribute__((ext_vector_type(4)));
typedef float f32x16 __attribute__((ext_vector_type(16)));
typedef float f32x4 __attribute__((ext_vector_type(4)));
typedef float f32x2 __attribute__((ext_vector_type(2)));
typedef unsigned u32x4 __attribute__((ext_vector_type(4)));
typedef unsigned u32x2 __attribute__((ext_vector_type(2)));
#ifdef EMU
#define DI static inline
#define DM inline
#define LAS
#define GAS
#define WAVE_SYNC() emu_wave_barrier()
#define MFMA32(a, b, c) emu_mfma32(a, b, c)
#define MFMA16(a, b, c) emu_mfma16(a, b, c)
#define TR_READ(p) emu_tr_read((const void*)(p))
#define ROW_ROR(x, n) emu_row_ror(x, n)
#define ANY(p) emu_any(p)
#define RFL(x) (x)
DI float ex2(float x) { return exp2f(x); }
DI float lg2(float x) { return log2f(x); }
DI float frcp(float x) { return 1.f / x; }
DI float frsq(float x) { return 1.f / sqrtf(x); }
DI float u2f(unsigned u) { float f; memcpy(&f, &u, 4); return f; }
DI unsigned f2u(float f) { unsigned u; memcpy(&u, &f, 4); return u; }
#else
#define DI __device__ __forceinline__
#define DM __device__ __forceinline__
#define LAS __attribute__((address_space(3)))
#define GAS __attribute__((address_space(1)))
#define WAVE_SYNC() do { __builtin_amdgcn_fence(__ATOMIC_RELEASE, "wavefront"); __builtin_amdgcn_wave_barrier(); __builtin_amdgcn_fence(__ATOMIC_ACQUIRE, "wavefront"); } while (0)
#define MFMA32(a, b, c) __builtin_amdgcn_mfma_f32_32x32x16_bf16((a), (b), (c), 0, 0, 0)
#define MFMA16(a, b, c) __builtin_amdgcn_mfma_f32_16x16x32_bf16((a), (b), (c), 0, 0, 0)
typedef short v4i16_t __attribute__((ext_vector_type(4)));
#define TR_READ(p) __builtin_bit_cast(s16x4, __builtin_amdgcn_ds_read_tr16_b64_v4i16((LAS v4i16_t*)(p)))
#define ROW_ROR(x, n) __builtin_bit_cast(float, __builtin_amdgcn_update_dpp(0, __builtin_bit_cast(int, (x)), 0x120 + (n), 0xf, 0xf, false))
#define ANY(p) __any(p)
#define RFL(x) __builtin_amdgcn_readfirstlane(x)
DI float ex2(float x) { return __builtin_amdgcn_exp2f(x); }
DI float lg2(float x) { return __builtin_amdgcn_logf(x); }
DI float frcp(float x) { return __builtin_amdgcn_rcpf(x); }
DI float frsq(float x) { return __builtin_amdgcn_rsqf(x); }
DI float u2f(unsigned u) { return __builtin_bit_cast(float, u); }
DI unsigned f2u(float f) { return __builtin_bit_cast(unsigned, f); }
#endif
#ifdef EMU
#define SCHED_FENCE()
#else
#define SCHED_FENCE() __builtin_amdgcn_sched_barrier(0)
#endif
typedef LAS char* lptr;
#ifdef EMU
DI int TID() { return (int)threadIdx.x; }
#else
DI int TID() { int t = (int)threadIdx.x; asm volatile("" : "+v"(t)); return t; }
#endif
DI float bf2f(bf16_t v) { return u2f(((unsigned)v) << 16); }
DI bf16_t f2bf(float f) { unsigned u = f2u(f); return (bf16_t)((u + 0x7fffu + ((u >> 16) & 1u)) >> 16); }
#ifdef EMU
DI unsigned pk2(float lo, float hi) { return (unsigned)f2bf(lo) | ((unsigned)f2bf(hi) << 16); }
#else
typedef __bf16 bf16x2_hw __attribute__((ext_vector_type(2)));
DI unsigned pk2(float lo, float hi) { const f32x2 v = {lo, hi}; return __builtin_bit_cast(unsigned, __builtin_convertvector(v, bf16x2_hw)); }
#endif
DI float bflo(unsigned w) { return u2f(w << 16); }
DI float bfhi(unsigned w) { return u2f(w & 0xffff0000u); }
DI float fexp(float x) { return ex2(x * LOG2E); }
DI float flog(float x) { return lg2(x) * LN2; }
DI float fsigmoid(float x) { return frcp(1.f + fexp(-x)); }
DI float fsilu(float x) { return x * fsigmoid(x); }
DI float fsoftplus(float x) { return fmaxf(x, 0.f) + flog(1.f + fexp(-fabsf(x))); }
DI int crow(int i, int h) { return (i & 3) + 8 * (i >> 2) + 4 * h; }
DI bf16x8 pack8(float a0, float a1, float a2, float a3, float a4, float a5, float a6, float a7) {
    u32x4 w; w.x = pk2(a0, a1); w.y = pk2(a2, a3); w.z = pk2(a4, a5); w.w = pk2(a6, a7); return __builtin_bit_cast(bf16x8, w);
}
DI bf16x8 cat4(s16x4 lo, s16x4 hi) { return __builtin_shufflevector(lo, hi, 0, 1, 2, 3, 4, 5, 6, 7); }

struct Params {
    const float* in[25];
    float* out;
    unsigned char* ws;
};
#ifdef EMU
typedef const Params* KP;
#else
typedef const __attribute__((address_space(4))) Params* KP;
#endif
enum { I_X = 0, I_WIN, I_REL, I_LAM, I_SUBLN, I_HGLOW, I_HGNORM, I_MU, I_W0, I_W2, I_A0, I_A2, I_V1, I_VMU, I_V0, I_V2, I_KK, I_KA, I_RK, I_LNXG, I_LNXB, I_WBR, I_WOUT, I_LNG, I_LNB };
namespace pg8 {
#ifdef EMU
#define PG8_LAS
#else
#define PG8_LAS __attribute__((address_space(3)))
#endif
typedef unsigned short bf16_t;
typedef short bf16x8 __attribute__((ext_vector_type(8)));
typedef float f32x4 __attribute__((ext_vector_type(4)));
typedef unsigned u32x4 __attribute__((ext_vector_type(4)));
constexpr int BM = 256, BK = 64, HALF = 128, HTB = HALF * BK * 2  , STAGE_BYTES = 8 * HTB, NXCD = 8, WGM = 8;

__host__ __device__ __forceinline__ int lds_byte(int r, int c) { const int st = (r >> 4) * 2 + (c >> 5), rr = r & 15, cc = c & 31, ob = rr * 64 + cc * 2; return st * 1024 + (ob ^ (((ob >> 9) & 1) << 5)); }
__host__ __device__ __forceinline__ void stage_rc(int b, int& R, int& C) { const int st = b / 1024, sb = b % 1024, swz = sb ^ (((sb >> 9) & 1) << 5); R = (st >> 1) * 16 + swz / 64; C = (st & 1) * 32 + (swz % 64) / 2; }
__host__ __device__ __forceinline__ int perm32(int rho) { const int n = rho >> 4, i = rho & 15; return 8 * (i >> 2) + 4 * n + (i & 3); }

struct Unit { int pm, pn, ka; };
struct Gemm { const bf16_t* A; const bf16_t* Bt; int M, N, K, lda, ldb; };

struct StaticOrder {
    int nM, nN, nwg, G, c;
    __host__ __device__ void init(int M, int N, int G_, int c_) { nM = M / BM; nN = N / BM; nwg = nM * nN; G = G_; c = c_; }
    __host__ __device__ bool next(int i, Unit& u) const {
        const long L = (long)i * G + c; if (L >= nwg) return false;
        int wgid = (int)L; { const int q = nwg / NXCD, r = nwg % NXCD, xcd = wgid % NXCD, off = wgid / NXCD; wgid = (xcd < r ? xcd * (q + 1) : r * (q + 1) + (xcd - r) * q) + off; }
        const int nig = WGM * nN, gid = wgid / nig, fm = gid * WGM, gsz = (nM - fm) < WGM ? (nM - fm) : WGM;
        u.pm = fm + ((wgid % nig) % gsz); u.pn = (wgid % nig) / gsz; u.ka = 0; return true;
    }
    __device__ __forceinline__ void a_ready(const Unit&) const {}
    __device__ __forceinline__ void done(const Unit&) const {}
};
#ifndef EMU
template <class Epi, class Sched, bool ALIGN_EPI, bool SP2, int LDA, int LDB, int KDIM>
__device__ __forceinline__ void gemm_phase(PG8_LAS unsigned char* lds, const Gemm g, const Sched& S, const Epi& E) {
    const int tid = TID(), wid = __builtin_amdgcn_readfirstlane(tid >> 6), lane = tid & 63, wr = wid >> 2, wc = wid & 3, fr = lane & 15, fq = lane >> 4;
    constexpr int K = KDIM, nt = K / BK;
    unsigned voffA, voffB;
    { int R, C; stage_rc(tid * 16, R, C); const int Rb = Epi::PERM ? ((R & ~31) + perm32(R & 31)) : R;
      voffA = (unsigned)(R * LDA + C) * 2u; voffB = (unsigned)(Rb * LDB + C) * 2u; }
    const size_t qA = (size_t)64 * LDA * 2, qB = (size_t)64 * LDB * 2;
    const size_t kstep = (size_t)(BK * 2);
    const size_t hstepA = (size_t)HALF * LDA * 2, hstepB = (size_t)HALF * LDB * 2;
    const size_t tstepA = 2 * hstepA, tstepB = 2 * hstepB;
    const unsigned ldsw = (unsigned)wid * 1024u;
    const int aoff = lds_byte(wr * 64 + fr, fq * 8), boff = lds_byte(wc * 32 + fr, fq * 8);
#define PG8_SA(b, h) (((b) * 2 + (h)) * HTB)
#define PG8_SB(b, h) ((4 + (b) * 2 + (h)) * HTB)
#define PG8_STAGE_X(bufoff, gbase, voff, q) do { _Pragma("unroll") for (int _i = 0; _i < 2; ++_i) \
        __builtin_amdgcn_global_load_lds((const unsigned*)((const char*)(gbase) + (size_t)_i * (q) + (voff)), (PG8_LAS unsigned*)(lds + (bufoff) + ldsw + _i * 8192), 16, 0, 0); } while (0)
#define PG8_STAGE_A(bufoff, gbase) PG8_STAGE_X(bufoff, gbase, voffA, qA)
#define PG8_STAGE_B(bufoff, gbase) PG8_STAGE_X(bufoff, gbase, voffB, qB)
#define PG8_LDA(dst, b, h) do { _Pragma("unroll") for (int m = 0; m < 4; ++m) _Pragma("unroll") for (int k = 0; k < 2; ++k) dst[m][k] = *(const PG8_LAS bf16x8*)(lds + PG8_SA(b, h) + aoff + m * 2048 + k * 1024); } while (0)
#define PG8_LDB(dst, b, h) do { _Pragma("unroll") for (int n = 0; n < 2; ++n) _Pragma("unroll") for (int k = 0; k < 2; ++k) dst[n][k] = *(const PG8_LAS bf16x8*)(lds + PG8_SB(b, h) + boff + n * 2048 + k * 1024); } while (0)
#define PG8_MMA(ai, bj, At, Bt) do { __builtin_amdgcn_s_setprio(1); _Pragma("unroll") for (int m = 0; m < 4; ++m) _Pragma("unroll") for (int n = 0; n < 2; ++n) _Pragma("unroll") for (int k = 0; k < 2; ++k) \
        acc[ai][bj][m][n] = __builtin_amdgcn_mfma_f32_16x16x32_bf16(Bt[n][k], At[m][k], acc[ai][bj][m][n], 0, 0, 0); __builtin_amdgcn_s_setprio(0); } while (0)
#define PG8_WAIT_V(n) asm volatile("s_waitcnt vmcnt(" #n ")" ::: "memory")
#define PG8_WAIT_L(n) asm volatile("s_waitcnt lgkmcnt(" #n ")" ::: "memory")
#define PG8_BAR __builtin_amdgcn_s_barrier()
#define PG8_SCHED __builtin_amdgcn_sched_barrier(0)
    Unit cur, nxt; int ui = 0;
    if (!S.next(0, cur)) return;
    f32x4 acc[2][2][4][2];
#pragma unroll
    for (int a = 0; a < 2; ++a)
#pragma unroll
        for (int b = 0; b < 2; ++b)
#pragma unroll
            for (int m = 0; m < 4; ++m)
#pragma unroll
                for (int n = 0; n < 2; ++n) acc[a][b][m][n] = (f32x4){0.f, 0.f, 0.f, 0.f};
    bf16x8 At[4][2], B0[2][2], B1[2][2];
    const char* cA = (const char*)g.A + (size_t)cur.pm * tstepA + (size_t)cur.ka * 2; const char* cB = (const char*)g.Bt + (size_t)cur.pn * tstepB;
    S.a_ready(cur);
    if constexpr (SP2) {
        PG8_STAGE_B(PG8_SB(0, 0), cB); PG8_STAGE_B(PG8_SB(0, 1), cB + hstepB); PG8_STAGE_A(PG8_SA(0, 0), cA); PG8_STAGE_A(PG8_SA(0, 1), cA + hstepA);
        if (wr == 1) PG8_BAR;
        PG8_WAIT_V(2); PG8_BAR;
        PG8_STAGE_B(PG8_SB(1, 0), cB + kstep); PG8_STAGE_A(PG8_SA(1, 0), cA + kstep); PG8_STAGE_B(PG8_SB(1, 1), cB + hstepB + kstep);
        PG8_WAIT_V(6); PG8_BAR;
    } else {
        PG8_STAGE_B(PG8_SB(0, 0), cB); PG8_STAGE_A(PG8_SA(0, 0), cA); PG8_STAGE_B(PG8_SB(0, 1), cB + hstepB); PG8_STAGE_A(PG8_SA(0, 1), cA + hstepA);
        if (wr == 1) PG8_BAR;
        PG8_WAIT_V(4); PG8_BAR;
        PG8_STAGE_B(PG8_SB(1, 0), cB + kstep); PG8_STAGE_A(PG8_SA(1, 0), cA + kstep); PG8_STAGE_B(PG8_SB(1, 1), cB + hstepB + kstep);
        PG8_WAIT_V(6); PG8_BAR;
    }
    for (;;) {
        const bool has_next = S.next(ui + 1, nxt);
        const char* nA = has_next ? (const char*)g.A + (size_t)nxt.pm * tstepA + (size_t)nxt.ka * 2 : cA; const char* nB = has_next ? (const char*)g.Bt + (size_t)nxt.pn * tstepB : cB;
        auto kbody = [&](const int t) __attribute__((always_inline)) {
            const bool last = (t == nt - 2);
            const char* a1 = cA + (size_t)(t + 1) * kstep;
            const char* a2 = last ? nA : cA + (size_t)(t + 2) * kstep; const char* b2 = last ? nB : cB + (size_t)(t + 2) * kstep;
            const char* a3 = a2 + kstep; const char* b3 = b2 + kstep;
            if (last && has_next) S.a_ready(nxt);
            if constexpr (SP2) {
            PG8_LDB(B0, 0, 0); PG8_LDB(B1, 0, 1); PG8_SCHED; PG8_LDA(At, 0, 0); PG8_STAGE_A(PG8_SA(1, 1), a1 + hstepA);
            PG8_WAIT_V(8); PG8_WAIT_L(0); PG8_BAR; PG8_MMA(0, 0, At, B0); PG8_MMA(0, 1, At, B1); PG8_BAR; PG8_SCHED;
            PG8_LDA(At, 0, 1); PG8_STAGE_B(PG8_SB(0, 0), b2); PG8_STAGE_B(PG8_SB(0, 1), b2 + hstepB); PG8_STAGE_A(PG8_SA(0, 0), a2);
            PG8_WAIT_V(8); PG8_WAIT_L(0); PG8_BAR; PG8_MMA(1, 0, At, B0); PG8_MMA(1, 1, At, B1); PG8_BAR; PG8_SCHED;
            PG8_LDB(B0, 1, 0); PG8_LDB(B1, 1, 1); PG8_SCHED; PG8_LDA(At, 1, 0); PG8_STAGE_A(PG8_SA(0, 1), a2 + hstepA);
            PG8_WAIT_V(8); PG8_WAIT_L(0); PG8_BAR; PG8_MMA(0, 0, At, B0); PG8_MMA(0, 1, At, B1); PG8_BAR; PG8_SCHED;
            PG8_LDA(At, 1, 1); PG8_STAGE_B(PG8_SB(1, 0), b3); PG8_STAGE_B(PG8_SB(1, 1), b3 + hstepB); PG8_STAGE_A(PG8_SA(1, 0), a3);
            PG8_WAIT_V(8); PG8_WAIT_L(0); PG8_BAR; PG8_MMA(1, 0, At, B0); PG8_MMA(1, 1, At, B1); PG8_BAR; PG8_SCHED;
            } else {
            PG8_LDB(B0, 0, 0); PG8_SCHED; PG8_LDA(At, 0, 0); PG8_STAGE_A(PG8_SA(1, 1), a1 + hstepA);
            PG8_WAIT_L(8); PG8_BAR; PG8_WAIT_L(0); PG8_MMA(0, 0, At, B0); PG8_BAR; PG8_SCHED;
            PG8_LDB(B1, 0, 1); PG8_STAGE_B(PG8_SB(0, 0), b2);
            PG8_BAR; PG8_WAIT_L(0); PG8_MMA(0, 1, At, B1); PG8_BAR;
            PG8_LDA(At, 0, 1); PG8_STAGE_A(PG8_SA(0, 0), a2);
            PG8_BAR; PG8_WAIT_L(0); PG8_MMA(1, 0, At, B0); PG8_BAR; PG8_SCHED;
            PG8_STAGE_B(PG8_SB(0, 1), b2 + hstepB);
            PG8_WAIT_V(6); PG8_BAR; PG8_MMA(1, 1, At, B1); PG8_BAR;
            PG8_LDB(B0, 1, 0); PG8_SCHED; PG8_LDA(At, 1, 0); PG8_STAGE_A(PG8_SA(0, 1), a2 + hstepA);
            PG8_WAIT_L(8); PG8_BAR; PG8_WAIT_L(0); PG8_MMA(0, 0, At, B0); PG8_BAR; PG8_SCHED;
            PG8_LDB(B1, 1, 1); PG8_STAGE_B(PG8_SB(1, 0), b3);
            PG8_BAR; PG8_WAIT_L(0); PG8_MMA(0, 1, At, B1); PG8_BAR;
            PG8_LDA(At, 1, 1); PG8_STAGE_A(PG8_SA(1, 0), a3);
            PG8_BAR; PG8_WAIT_L(0); PG8_MMA(1, 0, At, B0); PG8_BAR; PG8_SCHED;
            PG8_STAGE_B(PG8_SB(1, 1), b3 + hstepB);
            PG8_WAIT_V(6); PG8_BAR; PG8_MMA(1, 1, At, B1); PG8_BAR;
            }
        };
        if constexpr (Epi::MIDK > 0) {
#pragma unroll 1
            for (int t0 = 0; t0 < nt; t0 += Epi::MIDK) { if (t0 > 0) E.mid(acc, cur, t0 / Epi::MIDK - 1, wr, wc, fr, fq);
#pragma unroll 1
                for (int t = t0; t < t0 + Epi::MIDK; t += 2) kbody(t); }
        } else {
            for (int t = 0; t < nt; t += 2) kbody(t);
        }
        if constexpr (ALIGN_EPI) { if (wr == 0) PG8_BAR; }
        if constexpr (!Epi::AFTER_DRAIN) { E(acc, cur, wr, wc, fr, fq); S.done(cur); }
        if (!has_next) break;
#pragma unroll
        for (int a = 0; a < 2; ++a)
#pragma unroll
            for (int b = 0; b < 2; ++b)
#pragma unroll
                for (int m = 0; m < 4; ++m)
#pragma unroll
                    for (int n = 0; n < 2; ++n) acc[a][b][m][n] = (f32x4){0.f, 0.f, 0.f, 0.f};
        cur = nxt; cA = nA; cB = nB; ++ui;
        if constexpr (ALIGN_EPI) { if (wr == 1) PG8_BAR; }
    }
    PG8_WAIT_V(0);
    if constexpr (!ALIGN_EPI) { if (wr == 0) PG8_BAR; }
    PG8_BAR;
    if constexpr (Epi::AFTER_DRAIN) { E.fused(acc, cur, wr, wc, fr, fq, lds, wid, lane); S.done(cur); }
#undef PG8_SA
#undef PG8_SB
#undef PG8_STAGE_X
#undef PG8_STAGE_A
#undef PG8_STAGE_B
#undef PG8_LDA
#undef PG8_LDB
#undef PG8_MMA
#undef PG8_WAIT_V
#undef PG8_WAIT_L
#undef PG8_BAR
#undef PG8_SCHED
}
#endif
}
#ifdef EMU
#define EPI_COORDS()
#else
#define EPI_COORDS() { const int t_ = TID(); const int w_ = RFL(t_ >> 6), l_ = t_ & 63; wr = w_ >> 2; wc = w_ & 3; fr = l_ & 15; fq = l_ >> 4; }
#endif
struct EpiInproj {
    static constexpr bool PERM = true, AFTER_DRAIN = false; static constexpr int MIDK = 0;
    bf16_t* O; int ldc; bf16_t* RHO; int gate_pn0;
    DM void operator()(const f32x4 (&acc)[2][2][4][2], const pg8::Unit& u, int wr, int wc, int fr, int fq) const {
        const int row0 = u.pm * 256 + wr * 64 + fr;
        if (u.pn < gate_pn0) { const int col0 = u.pn * 256 + wc * 32 + 8 * fq;
#pragma unroll
            for (int ai = 0; ai < 2; ++ai)
#pragma unroll
                for (int m = 0; m < 4; ++m) { bf16_t* rowp = O + (size_t)(row0 + ai * 128 + m * 16) * ldc + col0;
#pragma unroll
                    for (int bj = 0; bj < 2; ++bj) { const f32x4 v0 = acc[ai][bj][m][0], v1 = acc[ai][bj][m][1];
                        u32x4 w; w.x = pk2(v0[0], v0[1]); w.y = pk2(v0[2], v0[3]); w.z = pk2(v1[0], v1[1]); w.w = pk2(v1[2], v1[3]);
                        *(u32x4*)(rowp + bj * 128) = w; } }
        } else {
            const int T = u.pn - gate_pn0, pnc = T >> 2, bjc = (T & 3) >> 1, wcc = 2 * (T & 1) + (wc >> 1), fqc = fq, nc = wc & 1;
            bf16_t* base = RHO + ((((size_t)u.pm * (D / 256) + pnc) * 4) * 8 + (wr * 4 + wcc)) * (size_t)(16 * 64 * 8) + bjc * 512 + (fqc * 16 + fr) * 8 + nc * 4;
            constexpr size_t SEG_STRIDE = (size_t)8 * 16 * 64 * 8;
#pragma unroll
            for (int ai = 0; ai < 2; ++ai)
#pragma unroll
                for (int m = 0; m < 4; ++m) { bf16_t* rp = base + (ai * 4 + m) * 1024; float r0[4], r1[4], r2[4], r3[4];
#pragma unroll
                    for (int e = 0; e < 4; ++e) { const float d0 = 1.f + fexp(-acc[ai][0][m][0][e]), d1 = 1.f + fexp(-acc[ai][0][m][1][e]), d2 = 1.f + fexp(-acc[ai][1][m][0][e]), d3 = 1.f + fexp(-acc[ai][1][m][1][e]);
                        const float i0 = frcp(d0), i1 = frcp(d1), i2 = frcp(d2), i3 = frcp(d3);
                        r0[e] = d1 * i0; r1[e] = d2 * i1; r2[e] = d3 * i2; r3[e] = i3; }
                    u32x2 w; w.x = pk2(r0[0], r0[1]); w.y = pk2(r0[2], r0[3]); *(u32x2*)(rp) = w; w.x = pk2(r1[0], r1[1]); w.y = pk2(r1[2], r1[3]); *(u32x2*)(rp + SEG_STRIDE) = w;
                    w.x = pk2(r2[0], r2[1]); w.y = pk2(r2[2], r2[3]); *(u32x2*)(rp + 2 * SEG_STRIDE) = w; w.x = pk2(r3[0], r3[1]); w.y = pk2(r3[2], r3[3]); *(u32x2*)(rp + 3 * SEG_STRIDE) = w; } }
    }
};
struct EpiGateP {
    static constexpr bool PERM = false, AFTER_DRAIN = false; static constexpr int MIDK = 0;
    bf16_t* O; int ldc; const bf16_t* SG;
    DM void operator()(const f32x4 (&acc)[2][2][4][2], const pg8::Unit& u, int wr, int wc, int fr, int fq) const {
        const int n = u.pn / (D / 256), pnc = u.pn % (D / 256);
        const u32x4* base = (const u32x4*)(SG + ((((size_t)u.pm * (D / 256) + pnc) * 4 + n) * 8 + (wr * 4 + wc)) * (size_t)(16 * 64 * 8)) + (fq * 16 + fr);
        const int row0 = u.pm * 256 + wr * 64 + fr, col0 = u.pn * 256 + wc * 32 + 4 * fq;
#pragma unroll
        for (int ai = 0; ai < 2; ++ai)
#pragma unroll
            for (int m = 0; m < 4; ++m) { bf16_t* rowp = O + (size_t)(row0 + ai * 128 + m * 16) * ldc + col0;
#pragma unroll
                for (int bj = 0; bj < 2; ++bj) { const u32x4 g = base[((ai * 4 + m) * 2 + bj) * 64]; const f32x4 v0 = acc[ai][bj][m][0], v1 = acc[ai][bj][m][1];
                    u32x2 w0, w1; w0.x = pk2(v0[0] * bflo(g.x), v0[1] * bfhi(g.x)); w0.y = pk2(v0[2] * bflo(g.y), v0[3] * bfhi(g.y)); w1.x = pk2(v1[0] * bflo(g.z), v1[1] * bfhi(g.z)); w1.y = pk2(v1[2] * bflo(g.w), v1[3] * bfhi(g.w));
                    *(u32x2*)(rowp + bj * 128) = w0; *(u32x2*)(rowp + bj * 128 + 16) = w1; } }
    }
};
struct EpiMerged {
    static constexpr bool PERM = false, AFTER_DRAIN = false; static constexpr int MIDK = MIX / 64;
    bf16_t* O; int ldc; const bf16_t* RHO;
    DM void mid(f32x4 (&acc)[2][2][4][2], const pg8::Unit& u, int seg, int wr, int wc, int fr, int fq) const {
        EPI_COORDS();
        const u32x4* base = (const u32x4*)(RHO + ((((size_t)u.pm * (D / 256) + u.pn) * 4 + seg) * 8 + (wr * 4 + wc)) * (size_t)(16 * 64 * 8)) + (fq * 16 + fr);
#pragma unroll
        for (int q = 0; q < 2; ++q) { u32x4 gv[8];
#pragma unroll
            for (int i = 0; i < 8; ++i) gv[i] = base[(q * 8 + i) * 64];
#pragma unroll
            for (int i = 0; i < 8; ++i) { const int idx = q * 8 + i, ai = idx >> 3, m = (idx >> 1) & 3, bj = idx & 1; const u32x4 g = gv[i];
                acc[ai][bj][m][0] = acc[ai][bj][m][0] * (f32x4){bflo(g.x), bfhi(g.x), bflo(g.y), bfhi(g.y)}; acc[ai][bj][m][1] = acc[ai][bj][m][1] * (f32x4){bflo(g.z), bfhi(g.z), bflo(g.w), bfhi(g.w)}; }
            SCHED_FENCE(); }
    }
    DM void operator()(const f32x4 (&acc)[2][2][4][2], const pg8::Unit& u, int wr, int wc, int fr, int fq) const {
        EPI_COORDS();
        const u32x4* base = (const u32x4*)(RHO + ((((size_t)u.pm * (D / 256) + u.pn) * 4 + 3) * 8 + (wr * 4 + wc)) * (size_t)(16 * 64 * 8)) + (fq * 16 + fr);
        const int row0 = u.pm * 256 + wr * 64 + fr, col0 = u.pn * 256 + wc * 32 + 4 * fq;
#pragma unroll
        for (int ai = 0; ai < 2; ++ai)
#pragma unroll
            for (int m = 0; m < 4; ++m) { bf16_t* rowp = O + (size_t)(row0 + ai * 128 + m * 16) * ldc + col0;
#pragma unroll
                for (int bj = 0; bj < 2; ++bj) { const u32x4 g = base[((ai * 4 + m) * 2 + bj) * 64]; const f32x4 v0 = acc[ai][bj][m][0], v1 = acc[ai][bj][m][1];
                    u32x2 w0, w1; w0.x = pk2(v0[0] * bflo(g.x), v0[1] * bfhi(g.x)); w0.y = pk2(v0[2] * bflo(g.y), v0[3] * bfhi(g.y)); w1.x = pk2(v1[0] * bflo(g.z), v1[1] * bfhi(g.z)); w1.y = pk2(v1[2] * bflo(g.w), v1[3] * bfhi(g.w));
                    *(u32x2*)(rowp + bj * 128) = w0; *(u32x2*)(rowp + bj * 128 + 16) = w1; } }
    }
};
struct EpiF32 {
    static constexpr bool PERM = false, AFTER_DRAIN = false; static constexpr int MIDK = 0;
    float* O; int ldc;
    DM void operator()(const f32x4 (&acc)[2][2][4][2], const pg8::Unit& u, int wr, int wc, int fr, int fq) const {
        const int row0 = u.pm * 256 + wr * 64 + fr, col0 = u.pn * 256 + wc * 32 + 4 * fq;
#pragma unroll
        for (int ai = 0; ai < 2; ++ai)
#pragma unroll
            for (int m = 0; m < 4; ++m) { float* rowp = O + (size_t)(row0 + ai * 128 + m * 16) * ldc + col0;
#pragma unroll
                for (int bj = 0; bj < 2; ++bj)
#pragma unroll
                    for (int n = 0; n < 2; ++n) *(f32x4*)(rowp + bj * 128 + n * 16) = acc[ai][bj][m][n]; }
    }
};

#ifdef EMU
template <class Epi> static void emu_gemm(const pg8::Gemm g, const Epi& E, int ka_div = 0, int ka_mul = 0) {
    if (g.M % 256 || g.N % 256) { printf("emu_gemm: M %d N %d not multiples of 256\n", g.M, g.N); exit(1); }
    std::vector<float> C((size_t)256 * 256);
    const int seglen = (Epi::MIDK > 0) ? Epi::MIDK * 64 : g.K, nseg = g.K / seglen;
    for (int pm = 0; pm < g.M / 256; ++pm) for (int pn = 0; pn < g.N / 256; ++pn) {
        pg8::Unit u{pm, pn, 0};
        std::fill(C.begin(), C.end(), 0.f);
        for (int sg = 0; sg < nseg; ++sg) {
            for (int i = 0; i < 256; ++i) for (int j = 0; j < 256; ++j) { float a = 0.f; const bf16_t* ar = g.A + (size_t)(pm * 256 + i) * g.lda + sg * seglen + (ka_div ? (pn / ka_div) * ka_mul : 0); const bf16_t* br = g.Bt + (size_t)(pn * 256 + j) * g.ldb + sg * seglen;
                for (int k = 0; k < seglen; ++k) a += bf2f(ar[k]) * bf2f(br[k]); C[(size_t)i * 256 + j] += a; }
            const bool fin = (sg == nseg - 1);
            for (int wid = 0; wid < 8; ++wid) for (int lane = 0; lane < 64; ++lane) { const int wr = wid >> 2, wc = wid & 3, fr = lane & 15, fq = lane >> 4;
                f32x4 acc[2][2][4][2];
                for (int ai = 0; ai < 2; ++ai) for (int bj = 0; bj < 2; ++bj) for (int m = 0; m < 4; ++m) for (int n = 0; n < 2; ++n) for (int e = 0; e < 4; ++e) {
                    const int r = 128 * ai + 64 * wr + 16 * m + fr; const int c = Epi::PERM ? (128 * bj + 32 * wc + 8 * fq + 4 * n + e) : (128 * bj + 32 * wc + 16 * n + 4 * fq + e);
                    acc[ai][bj][m][n][e] = C[(size_t)r * 256 + c]; }
                if (fin) E(acc, u, wr, wc, fr, fq);
                else { if constexpr (Epi::MIDK > 0) E.mid(acc, u, sg, wr, wc, fr, fq);
                    for (int ai = 0; ai < 2; ++ai) for (int bj = 0; bj < 2; ++bj) for (int m = 0; m < 4; ++m) for (int n = 0; n < 2; ++n) for (int e = 0; e < 4; ++e) {
                        const int r = 128 * ai + 64 * wr + 16 * m + fr; const int c = Epi::PERM ? (128 * bj + 32 * wc + 8 * fq + 4 * n + e) : (128 * bj + 32 * wc + 16 * n + 4 * fq + e);
                        C[(size_t)r * 256 + c] = acc[ai][bj][m][n][e]; } } }
        }
    }
}
#endif
DI int gate_row(int sc) { const int n = sc / D, j = sc % D, jl = j & 63; return CG0 + 256 * (j >> 6) + 128 * (n >> 1) + 32 * (jl >> 4) + 8 * ((jl >> 2) & 3) + 4 * (n & 1) + (jl & 3); }
template <bool GATE> DI void transpose_item(const float* W, int N, bf16_t* dst, size_t ld_dst, int row_off, int col_off, LAS float* scr, int kb, int nb, int lane) {
    const int k0 = 64 * kb, n0 = 32 * nb;
#pragma unroll 8
    for (int i = 0; i < 32; ++i) { const int kk = 2 * i + (lane >> 5); scr[kk * 33 + (lane & 31)] = W[(size_t)(k0 + kk) * N + n0 + (lane & 31)]; }
    WAVE_SYNC();
    const int c = lane & 7;
#pragma unroll
    for (int j = 0; j < 4; ++j) { const int n = (lane >> 3) + 8 * j; const LAS float* s = scr + (8 * c) * 33 + n;
        u32x4 o; o.x = pk2(s[0 * 33], s[1 * 33]); o.y = pk2(s[2 * 33], s[3 * 33]); o.z = pk2(s[4 * 33], s[5 * 33]); o.w = pk2(s[6 * 33], s[7 * 33]);
        const int drow = GATE ? gate_row(n0 + n - C_MG) : (row_off + n0 + n);
        *(u32x4*)(dst + (size_t)drow * ld_dst + col_off + k0 + 8 * c) = o; }
    WAVE_SYNC();
}
__device__ const unsigned char T5_THR[15] = {19, 21, 24, 27, 31, 35, 40, 46, 52, 59, 67, 77, 87, 99, 113};
DI int t5_bucket(int n) { if (n < 16) return n; int b = 16;
#pragma unroll
    for (int i = 0; i < 15; ++i) b += (n >= (int)T5_THR[i]) ? 1 : 0;
    return b; }

DI void phase_prologue(KP p, lptr lds) {
    const int tid = TID(), lane = tid & 63, wave = tid >> 6;
    const int gw = blockIdx.x * 8 + wave, NGW = gridDim.x * 8;
    const size_t gt = (size_t)blockIdx.x * 512 + tid, NGT = (size_t)gridDim.x * 512;
    LAS float* scr = (LAS float*)(lds + wave * 8704);
    bf16_t* WIN = (bf16_t*)(p->ws + WS_WIN); bf16_t* WBR = (bf16_t*)(p->ws + WS_WBR); bf16_t* WOUT = (bf16_t*)(p->ws + WS_WOUT);
    constexpr int NI_IN = (D / 64) * (IN_COLS / 32), NI_V1 = (D / 64) * 1, NI_BR = (MIX / 64) * (D / 32), NI_OUT = (D / 64) * (D / 32);
    constexpr int PER_L = NI_IN + NI_V1 + 4 * NI_BR + NI_OUT;
    for (int it = gw; it < L * PER_L; it += NGW) {
        const int l = it / PER_L; int r = it % PER_L;
        if (r < NI_IN) { const int nblk = IN_COLS / 32, nb = r % nblk; const float* src = p->in[I_WIN] + (size_t)l * D * IN_COLS; bf16_t* dstw = WIN + (size_t)l * NP * D;
            if (32 * nb >= C_MG) transpose_item<true>(src, IN_COLS, dstw, D, 0, 0, scr, r / nblk, nb, lane); else transpose_item<false>(src, IN_COLS, dstw, D, 0, 0, scr, r / nblk, nb, lane); continue; } r -= NI_IN;
        if (r < NI_V1) { if (l > 0) transpose_item<false>(p->in[I_V1] + (size_t)(l - 1) * D * 32, 32, WIN + (size_t)l * NP * D, D, C_VD, 0, scr, r, 0, lane); continue; } r -= NI_V1;
        if (r < 4 * NI_BR) { const int n = r / NI_BR, rr = r % NI_BR, nblk = D / 32;
            transpose_item<false>(p->in[I_WBR] + ((size_t)l * 4 + n) * MIX * D, D, WBR + (size_t)l * D * 4 * MIX, 4 * MIX, 0, n * MIX, scr, rr / nblk, rr % nblk, lane); continue; } r -= 4 * NI_BR;
        { const int nblk = D / 32; transpose_item<false>(p->in[I_WOUT] + (size_t)l * D * D, D, WOUT + (size_t)l * D * D, D, 0, 0, scr, r / nblk, r % nblk, lane); }
    }
    for (int l = 0; l < L; ++l) { const int r0 = (l == 0) ? C_VD : C_VD + 32; const size_t n8 = (size_t)(CG0 - r0) * D / 8; u32x4* dst = (u32x4*)(WIN + ((size_t)l * NP + r0) * D);
        for (size_t i = gt; i < n8; i += NGT) dst[i] = (u32x4){0u, 0u, 0u, 0u}; }
    { const f32x4* x4 = (const f32x4*)p->in[I_X]; u32x2* xn = (u32x2*)(p->ws + WS_XN);
      for (size_t i = gt; i < (size_t)M * D / 4; i += NGT) { const f32x4 v = x4[i]; u32x2 o; o.x = pk2(v[0], v[1]); o.y = pk2(v[2], v[3]); xn[i] = o; } }
    { bf16_t* W2T = (bf16_t*)(p->ws + SM_W2T); bf16_t* A2T = (bf16_t*)(p->ws + SM_A2T); bf16_t* V2T = (bf16_t*)(p->ws + SM_V2T);
      for (size_t i = gt; i < (size_t)L * MIX * 64; i += NGT) { const int j = (int)(i % 64); const int c = (int)((i / 64) % MIX); const int l = (int)(i / ((size_t)64 * MIX));
          W2T[i] = f2bf(p->in[I_W2][((size_t)l * 64 + j) * MIX + c]); A2T[i] = f2bf(p->in[I_A2][((size_t)l * 64 + j) * MIX + c]); }
      for (size_t i = gt; i < (size_t)L * MIX * 32; i += NGT) { const int j = (int)(i % 32); const int c = (int)((i / 32) % MIX); const int l = (int)(i / ((size_t)32 * MIX));
          V2T[i] = (l > 0) ? f2bf(p->in[I_V2][((size_t)(l - 1) * 32 + j) * MIX + c]) : (bf16_t)0; } }
    if (blockIdx.x == 0) {
        float* LAM = (float*)(p->ws + SM_LAM); float* LB = (float*)(p->ws + SM_LB); float* BT = (float*)(p->ws + SM_BT);
        if (tid < L) { const float* lm = p->in[I_LAM] + (size_t)tid * 256; float s1 = 0.f, s2 = 0.f;
            for (int i = 0; i < 64; ++i) { s1 += lm[i] * lm[64 + i]; s2 += lm[128 + i] * lm[192 + i]; }
            const float li = 0.8f - 0.6f * expf(-0.3f * (float)tid); LAM[tid] = expf(s1) - expf(s2) + li; LAM[L + tid] = li; }
        for (int c = tid; c < MIX; c += 512) { float mx = -1e30f; for (int l = 0; l < L; ++l) mx = fmaxf(mx, p->in[I_HGLOW][(size_t)l * MIX + c]);
            float den = 0.f; for (int l = 0; l < L; ++l) den += expf(p->in[I_HGLOW][(size_t)l * MIX + c] - mx);
            float cum = 0.f; for (int l = 0; l < L; ++l) { if (l > 0) cum += expf(p->in[I_HGLOW][(size_t)l * MIX + c] - mx) / den;
                LB[(size_t)l * MIX + c] = cum; LB[(size_t)(L + l) * MIX + c] = (l > 0) ? logf(cum) : -1e30f; LB[(size_t)(2 * L + l) * MIX + c] = log1pf(-cum); } }
        for (int i = tid; i < AH * 132; i += 512) { const int h = i / 132, d = i % 132; const int bk = (d >= 128) ? 31 : t5_bucket(d); BT[i] = p->in[I_REL][bk * AH + h] * LOG2E; }
    }
}
constexpr int ATT_KSTR = 272, ATT_VSTR = 320;
constexpr int ATT_K_OFF = 0, ATT_V_OFF = 64 * ATT_KSTR, ATT_BUF = ATT_V_OFF + 64 * ATT_VSTR, ATT_BT_OFF = 2 * ATT_BUF, ATT_X_OFF = 0;
struct KVRegs { u32x4 k[2], v[2]; };
DI void load_kv(KVRegs& rg, const bf16_t* Z, size_t row0, int kcol, int vcol, int tid) {
#pragma unroll
    for (int i = 0; i < 2; ++i) { const int pc = tid + 512 * i, row = pc >> 4, c16 = pc & 15;
        rg.k[i] = *(const u32x4*)(Z + (row0 + row) * ZLD + kcol + c16 * 8);
        rg.v[i] = *(const u32x4*)(Z + (row0 + row) * ZLD + vcol + c16 * 8); }
}
DI void store_kv(const KVRegs& rg, lptr lds, int tid) {
#pragma unroll
    for (int i = 0; i < 2; ++i) { const int pc = tid + 512 * i, row = pc >> 4, c16 = pc & 15;
        *(LAS u32x4*)(lds + ATT_K_OFF + row * ATT_KSTR + c16 * 16) = rg.k[i];
        *(LAS u32x4*)(lds + ATT_V_OFF + row * ATT_VSTR + c16 * 16) = rg.v[i]; }
}
DI void pv_acc(f32x16 (&o)[4], const f32x16& pt, lptr lds, int kh, int lane) {
    const int hh = lane >> 5, gsub = (lane >> 4) & 1, i16 = lane & 15, qq = i16 >> 2, pp = i16 & 3;
    bf16x8 vf[2][4];
#pragma unroll
    for (int s = 0; s < 2; ++s) { const lptr vrow = lds + ATT_V_OFF + (32 * kh + 16 * s + 4 * hh + qq) * ATT_VSTR + gsub * 32 + pp * 8;
#pragma unroll
        for (int db = 0; db < 4; ++db) vf[s][db] = cat4(TR_READ(vrow + db * 64), TR_READ(vrow + 8 * ATT_VSTR + db * 64)); }
    const bf16x8 pb0 = pack8(pt[0], pt[1], pt[2], pt[3], pt[4], pt[5], pt[6], pt[7]), pb1 = pack8(pt[8], pt[9], pt[10], pt[11], pt[12], pt[13], pt[14], pt[15]);
    SCHED_FENCE();
#pragma unroll
    for (int db = 0; db < 4; ++db) o[db] = MFMA32(vf[0][db], pb0, o[db]);
#pragma unroll
    for (int db = 0; db < 4; ++db) o[db] = MFMA32(vf[1][db], pb1, o[db]);
}
DI void phase_att_a(KP p, int layer, lptr lds, int unit) {
    const int tid = TID(), lane = tid & 63, wid = RFL(tid >> 6), r = lane & 31, hh = lane >> 5;
    constexpr int NQB = S / 128;
    const int qb = NQB - 1 - (unit / (NB * AH)), bh = unit % (NB * AH), h = bh % AH, b = bh / AH;
    const int mp = wid & 1, qs = wid >> 1, q0 = qb * 128, qw0 = q0 + 32 * qs, q = qw0 + r;
    const bf16_t* Z = (const bf16_t*)(p->ws + WS_Z); const size_t rowb = (size_t)b * S;
    const float* LAM = (const float*)(p->ws + SM_LAM); const float lam_full = LAM[layer], lam_init = LAM[L + layer];
    LAS float* BT = (LAS float*)(lds + ATT_BT_OFF);
    __syncthreads();
    if (tid < 132) BT[tid] = ((const float*)(p->ws + SM_BT))[h * 132 + tid];
    bf16x8 qf[4];
    { const bf16_t* qp = Z + (rowb + q) * ZLD + C_AQ + h * 128 + mp * 64 + 8 * hh; const float qsc = 0.125f * LOG2E;
#pragma unroll
      for (int ds = 0; ds < 4; ++ds) { const u32x4 w = *(const u32x4*)(qp + 16 * ds);
          qf[ds] = pack8(bflo(w.x) * qsc, bfhi(w.x) * qsc, bflo(w.y) * qsc, bfhi(w.y) * qsc, bflo(w.z) * qsc, bfhi(w.z) * qsc, bflo(w.w) * qsc, bfhi(w.w) * qsc); } }
    f32x16 o[4];
#pragma unroll
    for (int db = 0; db < 4; ++db)
#pragma unroll
        for (int i = 0; i < 16; ++i) o[db][i] = 0.f;
    float mrun = -INFINITY, lrun = 0.f;
    const int nkt = (q0 + 128) / 64;
    KVRegs rg; load_kv(rg, Z, rowb, C_AK + h * 128, C_AV + h * 128, tid);
    store_kv(rg, lds, tid);
    if (nkt > 1) load_kv(rg, Z, rowb + 64, C_AK + h * 128, C_AV + h * 128, tid);
    __syncthreads();
    for (int kt = 0; kt < nkt; ++kt) {
        const int k0 = kt * 64; const lptr buf = lds + (kt & 1) * ATT_BUF;
        if (kt + 1 < nkt) store_kv(rg, lds + ((kt + 1) & 1) * ATT_BUF, tid);
        if (kt + 2 < nkt) load_kv(rg, Z, rowb + k0 + 128, C_AK + h * 128, C_AV + h * 128, tid);
        if (k0 <= qw0 + 31) {
            const bool two = (k0 + 32 <= qw0 + 31);
            const bool far = (qw0 - (k0 + 63) >= 128);
            const float cinit = far ? BT[128] : 0.f;
            f32x16 sc0, sc1;
#pragma unroll
            for (int i = 0; i < 16; ++i) { sc0[i] = cinit; sc1[i] = cinit; }
            { bf16x8 kf0[4], kf1[4];
#pragma unroll
              for (int ds = 0; ds < 4; ++ds) { kf0[ds] = *(const LAS bf16x8*)(buf + ATT_K_OFF + r * ATT_KSTR + mp * 128 + ds * 32 + hh * 16); kf1[ds] = *(const LAS bf16x8*)(buf + ATT_K_OFF + (32 + r) * ATT_KSTR + mp * 128 + ds * 32 + hh * 16); }
              SCHED_FENCE();
#pragma unroll
              for (int ds = 0; ds < 4; ++ds) { sc0 = MFMA32(kf0[ds], qf[ds], sc0); if (two) sc1 = MFMA32(kf1[ds], qf[ds], sc1); } }
            if (!far) {
#pragma unroll
                for (int i = 0; i < 16; ++i) { const int d0 = q - (k0 + crow(i, hh)), d1 = d0 - 32; const int i0 = d0 < 0 ? 0 : (d0 > 128 ? 128 : d0), i1 = d1 < 0 ? 0 : (d1 > 128 ? 128 : d1);
                    sc0[i] = (d0 < 0) ? -INFINITY : sc0[i] + BT[i0]; sc1[i] = (d1 < 0 || !two) ? -INFINITY : sc1[i] + BT[i1]; }
            }
            float mx = fmaxf(sc0[0], sc1[0]);
#pragma unroll
            for (int i = 1; i < 16; ++i) mx = fmaxf(mx, fmaxf(sc0[i], sc1[i]));
            mx = fmaxf(mx, __shfl_xor(mx, 32));
            const float mnew = fmaxf(mrun, mx), alpha = ex2(mrun - mnew);
            float sum = 0.f;
#pragma unroll
            for (int i = 0; i < 16; ++i) { const float e0 = ex2(sc0[i] - mnew), e1 = ex2(sc1[i] - mnew); sc0[i] = e0; sc1[i] = e1; sum += e0 + e1; }
            sum += __shfl_xor(sum, 32);
            lrun = lrun * alpha + sum; mrun = mnew;
            if (ANY(alpha != 1.f)) {
#pragma unroll
                for (int db = 0; db < 4; ++db)
#pragma unroll
                    for (int i = 0; i < 16; ++i) o[db][i] *= alpha; }
            pv_acc(o, sc0, buf, 0, lane); if (two) pv_acc(o, sc1, buf, 1, lane);
        }
        __syncthreads();
    }
    __syncthreads();
    const float inv = 1.f / lrun;
    LAS float* X = (LAS float*)(lds + ATT_X_OFF) + (qs * 32 + r) * 132;
    if (mp == 1) {
#pragma unroll
        for (int db = 0; db < 4; ++db)
#pragma unroll
            for (int g = 0; g < 4; ++g) { f32x4 v; v[0] = o[db][4 * g] * inv * lam_full; v[1] = o[db][4 * g + 1] * inv * lam_full; v[2] = o[db][4 * g + 2] * inv * lam_full; v[3] = o[db][4 * g + 3] * inv * lam_full;
                *(LAS f32x4*)(X + 32 * db + 8 * g + 4 * hh) = v; }
    }
    __syncthreads();
    if (mp == 0) {
        float ss = 0.f;
#pragma unroll
        for (int db = 0; db < 4; ++db)
#pragma unroll
            for (int g = 0; g < 4; ++g) { const f32x4 x1 = *(const LAS f32x4*)(X + 32 * db + 8 * g + 4 * hh);
#pragma unroll
                for (int e = 0; e < 4; ++e) { const float x = o[db][4 * g + e] * inv - x1[e]; o[db][4 * g + e] = x; ss += x * x; } }
        ss += __shfl_xor(ss, 32);
        const float rinv = frsq(ss * (1.f / 128.f) + RMS_EPS) * (1.f - lam_init);
        const float* sg = p->in[I_SUBLN] + (size_t)layer * 128;
        const bf16_t* gp = Z + (rowb + q) * ZLD + C_AG + h * 128; bf16_t* yp = (bf16_t*)(p->ws + WS_Y) + (rowb + q) * (4 * MIX) + 0 * MIX + h * 128;
#pragma unroll
        for (int db = 0; db < 4; ++db)
#pragma unroll
            for (int g = 0; g < 4; ++g) { const int d = 32 * db + 8 * g + 4 * hh; const u32x2 gw = *(const u32x2*)(gp + d); const f32x4 sv = *(const f32x4*)(sg + d);
                u32x2 w; w.x = pk2(o[db][4 * g] * rinv * sv[0] * fsilu(bflo(gw.x)), o[db][4 * g + 1] * rinv * sv[1] * fsilu(bfhi(gw.x)));
                w.y = pk2(o[db][4 * g + 2] * rinv * sv[2] * fsilu(bflo(gw.y)), o[db][4 * g + 3] * rinv * sv[3] * fsilu(bfhi(gw.y)));
                *(u32x2*)(yp + d) = w; }
    }
}

constexpr float SB_CUT = -110.f;
DI void phase_att_d(KP p, int layer, lptr lds, int unit) {
    const int tid = TID(), lane = tid & 63, wid = RFL(tid >> 6), r = lane & 31, hh = lane >> 5;
    constexpr int NQB = S / 256;
    const int qb = NQB - 1 - (unit / (NB * SH)), bh = unit % (NB * SH), h = bh % SH, b = bh / SH;
    const int q0 = qb * 256, qw0 = q0 + 32 * wid, q = qw0 + r;
    const bf16_t* Z = (const bf16_t*)(p->ws + WS_Z); const size_t rowb = (size_t)b * S;
    LAS int* FLG = (LAS int*)(lds + ATT_BT_OFF);
    bf16x8 qf[8];
    { const bf16_t* qp = Z + (rowb + q) * ZLD + C_SQ + h * 128 + 8 * hh; const float qsc = 0.08838834764831845f;
#pragma unroll
      for (int ds = 0; ds < 8; ++ds) { const u32x4 w = *(const u32x4*)(qp + 16 * ds);
          qf[ds] = pack8(bflo(w.x) * qsc, bfhi(w.x) * qsc, bflo(w.y) * qsc, bfhi(w.y) * qsc, bflo(w.z) * qsc, bfhi(w.z) * qsc, bflo(w.w) * qsc, bfhi(w.w) * qsc); } }
    f32x16 o[4];
#pragma unroll
    for (int db = 0; db < 4; ++db)
#pragma unroll
        for (int i = 0; i < 16; ++i) o[db][i] = 0.f;
    float carry = 0.f;
    const int kt_hi = (q0 + 255) / 64;
    __syncthreads();
    KVRegs rg; load_kv(rg, Z, rowb + (size_t)kt_hi * 64, C_SK + h * 128, C_SV + h * 128, tid);
    store_kv(rg, lds + (kt_hi & 1) * ATT_BUF, tid);
    if (kt_hi > 0) load_kv(rg, Z, rowb + (size_t)(kt_hi - 1) * 64, C_SK + h * 128, C_SV + h * 128, tid);
    __syncthreads();
    for (int kt = kt_hi; kt >= 0; --kt) {
        const int k0 = kt * 64; const lptr buf = lds + (kt & 1) * ATT_BUF;
        if (kt > 0) store_kv(rg, lds + ((kt - 1) & 1) * ATT_BUF, tid);
        if (kt > 1) load_kv(rg, Z, rowb + k0 - 128, C_SK + h * 128, C_SV + h * 128, tid);
        if (k0 < qw0 + 31) {
#pragma unroll 1
            for (int kh = 1; kh >= 0; --kh) {
                if (k0 + 32 * kh >= qw0 + 31) continue;
                f32x16 z;
#pragma unroll
                for (int i = 0; i < 16; ++i) z[i] = 0.f;
                { bf16x8 kf[8];
#pragma unroll
                  for (int ds = 0; ds < 8; ++ds) kf[ds] = *(const LAS bf16x8*)(buf + ATT_K_OFF + (32 * kh + r) * ATT_KSTR + ds * 32 + hh * 16);
                  SCHED_FENCE();
#pragma unroll
                  for (int ds = 0; ds < 8; ++ds) z = MFMA32(kf[ds], qf[ds], z); }
                f32x16 lk; float gsum[4];
#pragma unroll
                for (int g = 0; g < 4; ++g) { gsum[g] = 0.f;
#pragma unroll
                    for (int e = 0; e < 4; ++e) { const int i = 4 * g + e; const bool valid = (k0 + 32 * kh + crow(i, hh)) < q; const float sp = fsoftplus(z[i]);
                        lk[i] = valid ? -sp : 0.f; z[i] = valid ? (z[i] - sp) : -INFINITY; gsum[g] += lk[i]; } }
                float og[4];
#pragma unroll
                for (int g = 0; g < 4; ++g) og[g] = __shfl_xor(gsum[g], 32);
                float suf[4]; float run = 0.f;
#pragma unroll
                for (int g = 3; g >= 0; --g) {
                    if (hh == 1) { suf[g] = run; run += gsum[g] + og[g]; }
                    else { suf[g] = run + og[g]; run += gsum[g] + og[g]; }
                }
#pragma unroll
                for (int g = 0; g < 4; ++g) { float inner = 0.f;
#pragma unroll
                    for (int e = 3; e >= 0; --e) { const int i = 4 * g + e; const float between = carry + suf[g] + inner; inner += lk[i]; z[i] = ex2((z[i] + between) * LOG2E); } }
                carry += run;
                pv_acc(o, z, buf, kh, lane);
            }
        }
        const int active = ANY(carry > SB_CUT) ? 1 : 0;
        if (lane == 0) FLG[(kt & 1) * 8 + wid] = active;
        __syncthreads();
        int anyact = 0;
#pragma unroll
        for (int w = 0; w < 8; ++w) anyact |= FLG[(kt & 1) * 8 + w];
        if (!anyact) break;
    }
    const bf16_t* gp = Z + (rowb + q) * ZLD + C_SG + h * 128; bf16_t* yp = (bf16_t*)(p->ws + WS_Y) + (rowb + q) * (4 * MIX) + 3 * MIX + h * 128;
#pragma unroll
    for (int db = 0; db < 4; ++db)
#pragma unroll
        for (int g = 0; g < 4; ++g) { const int d = 32 * db + 8 * g + 4 * hh; const u32x2 gw = *(const u32x2*)(gp + d);
            u32x2 w; w.x = pk2(o[db][4 * g] * fsilu(bflo(gw.x)), o[db][4 * g + 1] * fsilu(bfhi(gw.x)));
            w.y = pk2(o[db][4 * g + 2] * fsilu(bflo(gw.y)), o[db][4 * g + 3] * fsilu(bfhi(gw.y)));
            *(u32x2*)(yp + d) = w; }
}
constexpr int HG_STR = 144;
constexpr int HG_QT = 0, HG_KT = 128 * HG_STR, HG_IT = 2 * 128 * HG_STR, HG_SC = 3 * 128 * HG_STR, HG_VEC = HG_SC + 64 * HG_STR;
DI bf16x8 hg_trfrag(lptr img, int col0, int dbase, int lane) {
    const int g = lane >> 4, i16 = lane & 15, qq = i16 >> 2, pp = i16 & 3;
    const lptr a = img + (dbase + 4 * g + qq) * HG_STR + (col0 + 4 * pp) * 2;
    return cat4(TR_READ(a), TR_READ(a + 16 * HG_STR));
}
constexpr int HG_NC = S / 64, HG_NCH = NB * HH * HG_NC;
DI void phase_hg_local(KP p, int layer, lptr lds, int unit) {
    const int tid = TID(), lane = tid & 63, wid = RFL(tid >> 6), g = lane >> 4, c16 = lane & 15;
    const int c = unit % HG_NC, bh = unit / HG_NC, h = bh % HH, b = bh / HH;
    const bf16_t* Z = (const bf16_t*)(p->ws + WS_Z); const size_t row0 = (size_t)b * S + (size_t)c * 64;
    const float* LBp = (const float*)(p->ws + SM_LB);
    LAS float* EBD = (LAS float*)(lds + HG_VEC); LAS float* QTOT = EBD + 128;
    const int ch = tid & 127, tq = tid >> 7;
    const float lb = LBp[(size_t)layer * MIX + h * 128 + ch], loglb = LBp[(size_t)(L + layer) * MIX + h * 128 + ch], log1m = LBp[(size_t)(2 * L + layer) * MIX + h * 128 + ch];
    __syncthreads();
    constexpr int HG_ST = 73728, HG_STR2 = 784;
#pragma unroll
    for (int i = 0; i < 6; ++i) { const int pc = tid + 512 * i, row = pc / 48, c = pc % 48;
        *(LAS u32x4*)(lds + HG_ST + row * HG_STR2 + c * 16) = *(const u32x4*)(Z + (row0 + row) * ZLD + C_HQ + (c >> 4) * MIX + h * 128 + (c & 15) * 8); }
    __syncthreads();
    float bl[16], qv[16], kv[16], iv[16];
    { const lptr zp = lds + HG_ST + (16 * tq) * HG_STR2 + ch * 2; float run = 0.f;
#pragma unroll
      for (int t = 0; t < 16; ++t) { const float zq = bf2f(*(const LAS bf16_t*)(zp + t * HG_STR2)), zf = bf2f(*(const LAS bf16_t*)(zp + t * HG_STR2 + 256)); iv[t] = bf2f(*(const LAS bf16_t*)(zp + t * HG_STR2 + 512));
          const float ls = -fsoftplus(-zf);
          float lf; if (lb > 0.f) { const float a_ = loglb, b_ = log1m + ls, mx = fmaxf(a_, b_); lf = mx + flog(fexp(a_ - mx) + fexp(b_ - mx)); } else lf = ls;
          run += lf; bl[t] = run; qv[t] = zq; kv[t] = (1.f - lb) * fexp(ls - zf); }
      QTOT[tq * 128 + ch] = run; }
    __syncthreads();
    { const float t0 = QTOT[ch], t1 = QTOT[128 + ch], t2 = QTOT[256 + ch], t3 = QTOT[384 + ch];
      const float pre = (tq > 0 ? t0 : 0.f) + (tq > 1 ? t1 : 0.f) + (tq > 2 ? t2 : 0.f), bref = t0 + t1, blast = bref + t2 + t3;
      unsigned qw[8], kw[8], iw[8];
#pragma unroll
      for (int t = 0; t < 16; t += 2) { const float b0 = pre + bl[t] - bref, b1 = pre + bl[t + 1] - bref;
          qw[t >> 1] = pk2(qv[t] * fexp(b0), qv[t + 1] * fexp(b1)); kw[t >> 1] = pk2(kv[t] * fexp(-b0), kv[t + 1] * fexp(-b1)); iw[t >> 1] = pk2(iv[t], iv[t + 1]); }
      LAS u32x4* dq = (LAS u32x4*)(lds + HG_QT + ch * HG_STR + tq * 32); dq[0] = (u32x4){qw[0], qw[1], qw[2], qw[3]}; dq[1] = (u32x4){qw[4], qw[5], qw[6], qw[7]};
      LAS u32x4* dk = (LAS u32x4*)(lds + HG_KT + ch * HG_STR + tq * 32); dk[0] = (u32x4){kw[0], kw[1], kw[2], kw[3]}; dk[1] = (u32x4){kw[4], kw[5], kw[6], kw[7]};
      LAS u32x4* di = (LAS u32x4*)(lds + HG_IT + ch * HG_STR + tq * 32); di[0] = (u32x4){iw[0], iw[1], iw[2], iw[3]}; di[1] = (u32x4){iw[4], iw[5], iw[6], iw[7]};
      if (tq == 0) { float* VE = (float*)(p->ws + WS_HGVE) + (size_t)unit * 256; VE[ch] = fexp(bref); VE[128 + ch] = fexp(blast); EBD[ch] = fexp(blast - bref); } }
    __syncthreads();
#pragma unroll
    for (int k2 = 0; k2 < 2; ++k2) { const int ti = 2 * wid + k2, tb = ti >> 2, sb = ti & 3;
        f32x4 acc = (f32x4){0.f, 0.f, 0.f, 0.f};
        if (sb <= tb) {
#pragma unroll
            for (int dp = 0; dp < 4; ++dp) acc = MFMA16(hg_trfrag(lds + HG_QT, 16 * tb, 32 * dp, lane), hg_trfrag(lds + HG_KT, 16 * sb, 32 * dp, lane), acc); }
        const int s = 16 * sb + c16;
#pragma unroll
        for (int e = 0; e < 4; ++e) { const int t = 16 * tb + 4 * g + e; *(LAS bf16_t*)(lds + HG_SC + t * HG_STR + s * 2) = f2bf((s <= t) ? acc[e] : 0.f); }
        ((bf16x8*)(p->ws + WS_HGQF))[((size_t)unit * 16 + ti) * 64 + lane] = hg_trfrag(lds + HG_QT, 16 * (ti >> 2), 32 * (ti & 3), lane); }
    __syncthreads();
    bf16x8 ib[2];
#pragma unroll
    for (int ks = 0; ks < 2; ++ks) ib[ks] = *(const LAS bf16x8*)(lds + HG_IT + (16 * wid + c16) * HG_STR + (8 * g + 32 * ks) * 2);
    f32x4* IN = (f32x4*)(p->ws + WS_HGIN) + ((size_t)unit * 8 + wid) * 4 * 64;
#pragma unroll
    for (int tb = 0; tb < 4; ++tb) { f32x4 acc = (f32x4){0.f, 0.f, 0.f, 0.f};
#pragma unroll
        for (int ks = 0; ks < 2; ++ks) acc = MFMA16(*(const LAS bf16x8*)(lds + HG_SC + (16 * tb + c16) * HG_STR + (8 * g + 32 * ks) * 2), ib[ks], acc);
        IN[tb * 64 + lane] = acc; }
    f32x4* DS = (f32x4*)(p->ws + WS_HGDS) + ((size_t)unit * 8 + wid) * 8 * 64;
#pragma unroll
    for (int db = 0; db < 8; ++db) { f32x4 tmp = (f32x4){0.f, 0.f, 0.f, 0.f};
#pragma unroll
        for (int ks = 0; ks < 2; ++ks) tmp = MFMA16(*(const LAS bf16x8*)(lds + HG_KT + (16 * db + c16) * HG_STR + (8 * g + 32 * ks) * 2), ib[ks], tmp);
        const f32x4 ed = *(const LAS f32x4*)(EBD + 16 * db + 4 * g);
        DS[db * 64 + lane] = tmp * ed; }
}
DI void phase_hg_scan(KP p, int unit) {
    const int tid = TID(), lane = tid & 63, wid = RFL(tid >> 6), g = lane >> 4;
    f32x4 st[8];
#pragma unroll
    for (int db = 0; db < 8; ++db) st[db] = (f32x4){0.f, 0.f, 0.f, 0.f};
    const float* VE0 = (const float*)(p->ws + WS_HGVE) + (size_t)unit * HG_NC * 256;
    const f32x4* DS0 = (const f32x4*)(p->ws + WS_HGDS) + ((size_t)unit * HG_NC * 8 + wid) * 8 * 64 + lane;
    bf16x8* SF0 = (bf16x8*)(p->ws + WS_HGSF) + ((size_t)unit * HG_NC * 8 + wid) * 4 * 64 + lane;
    f32x4 ds[8], el[8], er[8];
#pragma unroll
    for (int db = 0; db < 8; ++db) { ds[db] = DS0[db * 64]; el[db] = *(const f32x4*)(VE0 + 128 + 16 * db + 4 * g); er[db] = *(const f32x4*)(VE0 + 16 * db + 4 * g); }
    for (int c = 0; c < HG_NC; ++c) {
        const int cn = (c + 1 < HG_NC) ? c + 1 : c;
        f32x4 dsn[8], eln[8], ern[8];
#pragma unroll
        for (int db = 0; db < 8; ++db) { dsn[db] = DS0[((size_t)cn * 8 * 8 + db) * 64]; eln[db] = *(const f32x4*)(VE0 + (size_t)cn * 256 + 128 + 16 * db + 4 * g); ern[db] = *(const f32x4*)(VE0 + (size_t)cn * 256 + 16 * db + 4 * g); }
#pragma unroll
        for (int dp = 0; dp < 4; ++dp) { const f32x4 a0 = st[2 * dp] * er[2 * dp], a1 = st[2 * dp + 1] * er[2 * dp + 1];
            SF0[((size_t)c * 8 * 4 + dp) * 64] = pack8(a0[0], a0[1], a0[2], a0[3], a1[0], a1[1], a1[2], a1[3]); }
#pragma unroll
        for (int db = 0; db < 8; ++db) { st[db] = el[db] * st[db] + ds[db]; ds[db] = dsn[db]; el[db] = eln[db]; er[db] = ern[db]; }
    }
}
DI void phase_hg_out(KP p, int layer, lptr lds, int unit) {
    const int tid = TID(), lane = tid & 63, wid = RFL(tid >> 6), g = lane >> 4, c16 = lane & 15;
    const int c = unit % HG_NC, bh = unit / HG_NC, h = bh % HH, b = bh / HH;
    const bf16_t* Z = (const bf16_t*)(p->ws + WS_Z); const size_t row0 = (size_t)b * S + (size_t)c * 64;
    const bf16x8* QF = (const bf16x8*)(p->ws + WS_HGQF) + (size_t)unit * 16 * 64 + lane;
    const bf16x8* SF = (const bf16x8*)(p->ws + WS_HGSF) + ((size_t)unit * 8 + wid) * 4 * 64 + lane;
    const f32x4* IN = (const f32x4*)(p->ws + WS_HGIN) + ((size_t)unit * 8 + wid) * 4 * 64 + lane;
    bf16x8 sf[4];
#pragma unroll
    for (int dp = 0; dp < 4; ++dp) sf[dp] = SF[dp * 64];
    f32x4 ot[4];
#pragma unroll
    for (int tb = 0; tb < 4; ++tb) { f32x4 acc = IN[tb * 64];
#pragma unroll
        for (int dp = 0; dp < 4; ++dp) acc = MFMA16(QF[(tb * 4 + dp) * 64], sf[dp], acc);
        ot[tb] = acc; }
    if (c == 0 && g == 0) { const float* OEX = (const float*)(p->ws + WS_OEX) + (size_t)bh * FX_T * 128 + 16 * wid + c16;
#pragma unroll
        for (int e = 0; e < FX_T; ++e) ot[0][e] = OEX[e * 128]; }
    LAS float* OT = (LAS float*)lds;
    __syncthreads();
#pragma unroll
    for (int tb = 0; tb < 4; ++tb)
#pragma unroll
        for (int e = 0; e < 4; ++e) OT[(16 * tb + 4 * g + e) * 132 + 16 * wid + c16] = ot[tb][e];
    __syncthreads();
    { const int t = tid >> 3, e0 = (tid & 7) * 16; float x[16]; float ss = 0.f;
#pragma unroll
      for (int q = 0; q < 4; ++q) { const f32x4 v = *(const LAS f32x4*)(OT + t * 132 + e0 + 4 * q); x[4 * q] = v[0]; x[4 * q + 1] = v[1]; x[4 * q + 2] = v[2]; x[4 * q + 3] = v[3]; ss += (v[0] * v[0] + v[1] * v[1]) + (v[2] * v[2] + v[3] * v[3]); }
      ss += __shfl_xor(ss, 1); ss += __shfl_xor(ss, 2); ss += __shfl_xor(ss, 4);
      const float rinv = frsq(ss * (1.f / 128.f) + RMS_EPS); const float* gn = p->in[I_HGNORM] + (size_t)layer * 128 + e0;
      const bf16_t* gp = Z + (row0 + t) * ZLD + C_HG + h * 128 + e0; bf16_t* yp = (bf16_t*)(p->ws + WS_Y) + (row0 + t) * (4 * MIX) + 1 * MIX + h * 128 + e0;
#pragma unroll
      for (int q = 0; q < 2; ++q) { const u32x4 gw = *(const u32x4*)(gp + 8 * q); const f32x4 n0 = *(const f32x4*)(gn + 8 * q), n1 = *(const f32x4*)(gn + 8 * q + 4); u32x4 w;
          w.x = pk2(x[8 * q] * rinv * n0[0] * fsilu(bflo(gw.x)), x[8 * q + 1] * rinv * n0[1] * fsilu(bfhi(gw.x))); w.y = pk2(x[8 * q + 2] * rinv * n0[2] * fsilu(bflo(gw.y)), x[8 * q + 3] * rinv * n0[3] * fsilu(bfhi(gw.y)));
          w.z = pk2(x[8 * q + 4] * rinv * n1[0] * fsilu(bflo(gw.z)), x[8 * q + 5] * rinv * n1[1] * fsilu(bfhi(gw.z))); w.w = pk2(x[8 * q + 6] * rinv * n1[2] * fsilu(bflo(gw.w)), x[8 * q + 7] * rinv * n1[3] * fsilu(bfhi(gw.w)));
          *(u32x4*)(yp + 8 * q) = w; } }
}
constexpr int RC_GT = 0, RC_SL = 8192, RC_RH = 16384, RC_OL = 18432, RC_GAM = 22528, RC_BYTES = 22784;
constexpr int RC_NSUB = S / 16;
DI bf16x8 frag4_lds(lptr p) { const u32x2 w = *(const LAS u32x2*)p; u32x4 o; o.x = w.x; o.y = w.y; o.z = 0u; o.w = 0u; return __builtin_bit_cast(bf16x8, o); }
DI bf16x8 frag4_acc(const f32x4& x) { u32x4 o; o.x = pk2(x[0], x[1]); o.y = pk2(x[2], x[3]); o.z = 0u; o.w = 0u; return __builtin_bit_cast(bf16x8, o); }
DI float gbf(const bf16_t* p) { return bf2f(*p); }
DI float ftanh(float x) { return 1.f - 2.f * frcp(1.f + fexp(2.f * x)); }
DI void rw_local_item(KP p, int layer, lptr wl, int item, int lane) {
    const int j = item % RC_NSUB, bh = item / RC_NSUB, hd = bh % RH, b = bh / RH, g = lane >> 4, c16 = lane & 15;
    const int t0 = 16 * j; const size_t m0 = (size_t)b * S + t0;
    unsigned char* rec = p->ws + WS_RC + (size_t)item * RC_BYTES;
    const bf16_t* Z = (const bf16_t*)(p->ws + WS_Z); const float* mu = p->in[I_MU] + (size_t)layer * RW_MIX;
    bf16x8 xw[2], xa[2], xv; xv = (bf16x8){0, 0, 0, 0, 0, 0, 0, 0};
    { const bf16_t* cur = Z + (m0 + c16) * ZLD; const bool hp = (t0 + c16) > 0; const bf16_t* prv = hp ? cur - ZLD : cur;
#pragma unroll
      for (int ks = 0; ks < 2; ++ks) { const int jj = 32 * ks + 8 * g;
          const u32x4 cw = *(const u32x4*)(cur + C_RM + 3 * MIX + jj), ca = *(const u32x4*)(cur + C_RM + 3 * MIX + 64 + jj); u32x4 pw = (u32x4){0u, 0u, 0u, 0u}, pa = pw;
          if (hp) { pw = *(const u32x4*)(prv + C_RM + 3 * MIX + jj); pa = *(const u32x4*)(prv + C_RM + 3 * MIX + 64 + jj); }
          const f32x4 m0v = *(const f32x4*)(mu + 3 * MIX + jj), m1v = *(const f32x4*)(mu + 3 * MIX + jj + 4), n0v = *(const f32x4*)(mu + 3 * MIX + 64 + jj), n1v = *(const f32x4*)(mu + 3 * MIX + 64 + jj + 4);
#define LRP(c, q, m) ((c) + ((q) - (c)) * (m))
          xw[ks] = pack8(ftanh(LRP(bflo(cw.x), bflo(pw.x), m0v[0])), ftanh(LRP(bfhi(cw.x), bfhi(pw.x), m0v[1])), ftanh(LRP(bflo(cw.y), bflo(pw.y), m0v[2])), ftanh(LRP(bfhi(cw.y), bfhi(pw.y), m0v[3])),
                         ftanh(LRP(bflo(cw.z), bflo(pw.z), m1v[0])), ftanh(LRP(bfhi(cw.z), bfhi(pw.z), m1v[1])), ftanh(LRP(bflo(cw.w), bflo(pw.w), m1v[2])), ftanh(LRP(bfhi(cw.w), bfhi(pw.w), m1v[3])));
          xa[ks] = pack8(LRP(bflo(ca.x), bflo(pa.x), n0v[0]), LRP(bfhi(ca.x), bfhi(pa.x), n0v[1]), LRP(bflo(ca.y), bflo(pa.y), n0v[2]), LRP(bfhi(ca.y), bfhi(pa.y), n0v[3]),
                         LRP(bflo(ca.z), bflo(pa.z), n1v[0]), LRP(bfhi(ca.z), bfhi(pa.z), n1v[1]), LRP(bflo(ca.w), bflo(pa.w), n1v[2]), LRP(bfhi(ca.w), bfhi(pa.w), n1v[3])); }
      if (layer > 0) { const float* vmu = p->in[I_VMU] + (size_t)(layer - 1) * 32 + 8 * g; const u32x4 cv = *(const u32x4*)(cur + C_VD + 8 * g); u32x4 pv = (u32x4){0u, 0u, 0u, 0u}; if (hp) pv = *(const u32x4*)(prv + C_VD + 8 * g);
          const f32x4 m0v = *(const f32x4*)vmu, m1v = *(const f32x4*)(vmu + 4);
          xv = pack8(LRP(bflo(cv.x), bflo(pv.x), m0v[0]), LRP(bfhi(cv.x), bfhi(pv.x), m0v[1]), LRP(bflo(cv.y), bflo(pv.y), m0v[2]), LRP(bfhi(cv.y), bfhi(pv.y), m0v[3]),
                     LRP(bflo(cv.z), bflo(pv.z), m1v[0]), LRP(bfhi(cv.z), bfhi(pv.z), m1v[1]), LRP(bflo(cv.w), bflo(pv.w), m1v[2]), LRP(bfhi(cv.w), bfhi(pv.w), m1v[3])); }
#undef LRP
    }
    const bf16_t* W2T = (const bf16_t*)(p->ws + SM_W2T) + (size_t)layer * MIX * 64; const bf16_t* A2T = (const bf16_t*)(p->ws + SM_A2T) + (size_t)layer * MIX * 64;
    const bf16_t* V2T = (const bf16_t*)(p->ws + SM_V2T) + (size_t)layer * MIX * 32;
    const bf16_t* zg = Z + (m0 + 4 * g) * ZLD + C_RM + hd * 64 + c16; const bool hpg = (t0 + 4 * g) > 0;
    float ssq[4] = {0.f, 0.f, 0.f, 0.f};
#pragma unroll
    for (int cb = 0; cb < 4; ++cb) { const int ch = hd * 64 + 16 * cb + c16; const float mk = mu[MIX + ch], kk0 = p->in[I_KK][(size_t)layer * MIX + ch]; float pk = hpg ? gbf(zg - ZLD + MIX + 16 * cb) : 0.f;
#pragma unroll
        for (int e = 0; e < 4; ++e) { const float ck = gbf(zg + (size_t)e * ZLD + MIX + 16 * cb), kk = (ck + (pk - ck) * mk) * kk0; ssq[e] += kk * kk; pk = ck; } }
#pragma unroll
    for (int e = 0; e < 4; ++e) { float s = ssq[e]; s += __shfl_xor(s, 1); s += __shfl_xor(s, 2); s += __shfl_xor(s, 4); s += __shfl_xor(s, 8); ssq[e] = 1.f / fmaxf(sqrtf(s), 1e-12f); }
    float bon[4] = {0.f, 0.f, 0.f, 0.f};
#pragma unroll 2
    for (int cb = 0; cb < 4; ++cb) { const int chl = 16 * cb + c16, ch = hd * 64 + chl; const f32x4 z4 = (f32x4){0.f, 0.f, 0.f, 0.f};
        f32x4 lw = z4, la = z4, lv = z4;
#pragma unroll
        for (int ks = 0; ks < 2; ++ks) { lw = MFMA16(xw[ks], *(const bf16x8*)(W2T + (size_t)ch * 64 + 32 * ks + 8 * g), lw); la = MFMA16(xa[ks], *(const bf16x8*)(A2T + (size_t)ch * 64 + 32 * ks + 8 * g), la); }
        if (layer > 0) lv = MFMA16(xv, *(const bf16x8*)(V2T + (size_t)ch * 32 + 8 * g), lv);
        const float mr = mu[ch], mk = mu[MIX + ch], mv = mu[2 * MIX + ch];
        const float w0 = p->in[I_W0][(size_t)layer * MIX + ch], a0 = p->in[I_A0][(size_t)layer * MIX + ch], kk0 = p->in[I_KK][(size_t)layer * MIX + ch], ka = p->in[I_KA][(size_t)layer * MIX + ch];
        const float rk = p->in[I_RK][(size_t)layer * MIX + ch], v0 = p->in[I_V0][(size_t)(layer > 0 ? layer - 1 : 0) * MIX + ch];
        const bf16_t* zc = zg + 16 * cb;
        float pr = 0.f, pk = 0.f, pv = 0.f; if (hpg) { pr = gbf(zc - ZLD); pk = gbf(zc - ZLD + MIX); pv = gbf(zc - ZLD + 2 * MIX); }
        float rr[4], lg[4], k2[4], vv[4], kn[4], aa[4];
#pragma unroll
        for (int e = 0; e < 4; ++e) { const int tl = 4 * g + e, tq = t0 + tl; const float cr = gbf(zc + (size_t)e * ZLD), ck = gbf(zc + (size_t)e * ZLD + MIX), cv = gbf(zc + (size_t)e * ZLD + 2 * MIX);
            rr[e] = cr + (pr - cr) * mr; const float k = ck + (pk - ck) * mk; float v = cv + (pv - cv) * mv; pr = cr; pk = ck; pv = cv;
            const float wlog = -fsoftplus(-(w0 + lw[e])) - 0.5f; aa[e] = fsigmoid(a0 + la[e]);
            float* VF = (float*)(p->ws + WS_VF) + (m0 + tl) * MIX + ch;
            if (layer == 0) { if (tq >= FX_T) *VF = v; } else { const float vf = *VF; v = v + (vf - v) * fsigmoid(v0 + lv[e]); }
            if (tq >= FX_T) ((float*)(p->ws + WS_VV))[(m0 + tl) * MIX + ch] = v;
            kn[e] = k * kk0 * ssq[e]; k2[e] = k * (1.f + (aa[e] - 1.f) * ka); vv[e] = v; lg[e] = -fexp(wlog);
            bon[e] += rr[e] * k2[e] * rk; }
        float pre[4]; pre[0] = lg[0]; pre[1] = pre[0] + lg[1]; pre[2] = pre[1] + lg[2]; pre[3] = pre[2] + lg[3];
        const float G0 = __shfl(pre[3], c16), G1 = __shfl(pre[3], 16 + c16), G2 = __shfl(pre[3], 32 + c16), G3 = __shfl(pre[3], 48 + c16);
        const float P = (g > 0 ? G0 : 0.f) + (g > 1 ? G1 : 0.f) + (g > 2 ? G2 : 0.f), tot = (G0 + G1) + (G2 + G3), gC = fexp(tot);
        if (g == 0) ((float*)(rec + RC_GAM))[chl] = gC;
        float av[4], bv[4], kv[4];
        float gprev = fexp(P);
#pragma unroll
        for (int e = 0; e < 4; ++e) { const float lwt = P + pre[e], gt = fexp(lwt), gp = gprev, gi = frcp(gt); gprev = gt; const int t = 4 * g + e;
            av[e] = -kn[e] * gp; bv[e] = kn[e] * aa[e] * gi; kv[e] = k2[e] * gi;
            *(LAS bf16_t*)(wl + t * 128 + chl * 2) = f2bf(av[e]); *(LAS bf16_t*)(wl + 2048 + t * 128 + chl * 2) = f2bf(rr[e] * gt);
            *(LAS bf16_t*)(wl + 4096 + t * 128 + chl * 2) = f2bf(bv[e]); *(LAS bf16_t*)(wl + 6144 + t * 128 + chl * 2) = f2bf(kv[e]); }
        *(LAS u32x2*)(wl + 8192 + chl * 32 + 8 * g) = (u32x2){pk2(av[0], av[1]), pk2(av[2], av[3])}; *(LAS u32x2*)(wl + 10240 + chl * 32 + 8 * g) = (u32x2){pk2(vv[0], vv[1]), pk2(vv[2], vv[3])};
        *(LAS u32x2*)(wl + 12288 + chl * 32 + 8 * g) = (u32x2){pk2(bv[0] * gC, bv[1] * gC), pk2(bv[2] * gC, bv[3] * gC)}; *(LAS u32x2*)(wl + 14336 + chl * 32 + 8 * g) = (u32x2){pk2(kv[0] * gC, kv[1] * gC), pk2(kv[2] * gC, kv[3] * gC)}; }
#pragma unroll
    for (int e = 0; e < 4; ++e) { float bs = bon[e]; bs += __shfl_xor(bs, 1); bs += __shfl_xor(bs, 2); bs += __shfl_xor(bs, 4); bs += __shfl_xor(bs, 8);
        if (c16 == 0 && t0 + 4 * g + e >= FX_T) ((float*)(p->ws + WS_BON))[(m0 + 4 * g + e) * RH + hd] = bs; }
    WAVE_SYNC();
    f32x4 nab = (f32x4){0.f, 0.f, 0.f, 0.f}, nak = nab, mrb = nab, mrk = nab;
#pragma unroll
    for (int ks = 0; ks < 2; ++ks) { const int off = c16 * 128 + (32 * ks + 8 * g) * 2;
        const bf16x8 fa = *(const LAS bf16x8*)(wl + off), fr = *(const LAS bf16x8*)(wl + 2048 + off), fb = *(const LAS bf16x8*)(wl + 4096 + off), fk = *(const LAS bf16x8*)(wl + 6144 + off);
        nab = MFMA16(fa, fb, nab); nak = MFMA16(fa, fk, nak); mrb = MFMA16(fr, fb, mrb); mrk = MFMA16(fr, fk, mrk); }
    f32x4 rt[4];
#pragma unroll
    for (int cb = 0; cb < 4; ++cb)
#pragma unroll
        for (int e = 0; e < 4; ++e) rt[cb][e] = bf2f(*(const LAS bf16_t*)(wl + 2048 + (4 * g + e) * 128 + (16 * cb + c16) * 2));
    WAVE_SYNC();
#pragma unroll
    for (int e = 0; e < 4; ++e) { const int t = 4 * g + e, i = c16;
        *(LAS float*)(wl + (t * 16 + i) * 4) = (i < t) ? nab[e] : 0.f;
        *(LAS bf16_t*)(wl + 1024 + (t * 16 + i) * 2) = f2bf((i < t) ? nak[e] : 0.f);
        *(LAS bf16_t*)(wl + 1536 + (t * 16 + i) * 2) = f2bf((i <= t) ? mrb[e] : 0.f);
        *(LAS bf16_t*)(wl + 2048 + (t * 16 + i) * 2) = f2bf((i <= t) ? mrk[e] : 0.f); }
    WAVE_SYNC();
    { float tr[16];
#pragma unroll
      for (int t = 0; t < 16; ++t) { float acc = (c16 == t) ? 1.f : 0.f;
#pragma unroll
          for (int s = 0; s < t; ++s) acc += *(const LAS float*)(wl + (t * 16 + s) * 4) * tr[s];
          tr[t] = acc; if (g == 0) *(LAS bf16_t*)(wl + 2560 + (t * 16 + c16) * 2) = f2bf(acc); } }
    WAVE_SYNC();
    const bf16x8 tf = frag4_lds(wl + 2560 + c16 * 32 + 8 * g), nakf = frag4_lds(wl + 1024 + c16 * 32 + 8 * g), mrbf = frag4_lds(wl + 1536 + c16 * 32 + 8 * g), mrkf = frag4_lds(wl + 2048 + c16 * 32 + 8 * g);
    const f32x4 z4 = (f32x4){0.f, 0.f, 0.f, 0.f};
    bf16x8 ahf[4], plf[4];
#pragma unroll
    for (int cb = 0; cb < 4; ++cb) { const f32x4 ah = MFMA16(tf, frag4_lds(wl + 8192 + (16 * cb + c16) * 32 + 8 * g), z4); ahf[cb] = frag4_acc(ah);
        const f32x4 rh = MFMA16(mrbf, ahf[cb], rt[cb]);
#pragma unroll
        for (int e = 0; e < 4; ++e) ((bf16_t*)(rec + RC_RH))[(4 * g + e) * 64 + 16 * cb + c16] = f2bf(rh[e]); }
#pragma unroll
    for (int vb = 0; vb < 4; ++vb) { const bf16x8 vf = frag4_lds(wl + 10240 + (16 * vb + c16) * 32 + 8 * g);
        const f32x4 q = MFMA16(nakf, vf, z4); const f32x4 pl = MFMA16(tf, frag4_acc(q), z4); plf[vb] = frag4_acc(pl);
        f32x4 ol = MFMA16(mrbf, plf[vb], z4); ol = MFMA16(mrkf, vf, ol);
        ((f32x4*)(rec + RC_OL))[vb * 64 + lane] = ol; }
#pragma unroll
    for (int kb2 = 0; kb2 < 4; ++kb2) { const bf16x8 bbf = frag4_lds(wl + 12288 + (16 * kb2 + c16) * 32 + 8 * g), kkf = frag4_lds(wl + 14336 + (16 * kb2 + c16) * 32 + 8 * g);
#pragma unroll
        for (int kb = 0; kb < 4; ++kb) { const f32x4 gp4 = MFMA16(ahf[kb], bbf, z4);
            u32x2 w; w.x = pk2(gp4[0], gp4[1]); w.y = pk2(gp4[2], gp4[3]); *(u32x2*)((bf16_t*)(rec + RC_GT) + (16 * kb2 + c16) * 64 + 16 * kb + 4 * g) = w; }
#pragma unroll
        for (int vb = 0; vb < 4; ++vb) { f32x4 sl = MFMA16(plf[vb], bbf, z4); sl = MFMA16(frag4_lds(wl + 10240 + (16 * vb + c16) * 32 + 8 * g), kkf, sl);
            u32x2 w; w.x = pk2(sl[0], sl[1]); w.y = pk2(sl[2], sl[3]); ((u32x2*)(rec + RC_SL))[(vb * 4 + kb2) * 64 + lane] = w; } }
    WAVE_SYNC();
}
DI void phase_rw_local(KP p, int layer, lptr lds) {
    const int tid = TID(), lane = tid & 63, wave = RFL(tid >> 6);
    constexpr int NITEM = NB * RH * RC_NSUB;
    for (int it = blockIdx.x * 8 + wave; it < NITEM; it += gridDim.x * 8) rw_local_item(p, layer, lds + wave * 16384, it, lane);
}
constexpr int RS_STR = 144;
DI void phase_rw_scan(KP p, lptr lds, int unit) {
    const int tid = TID(), lane = tid & 63, wid = RFL(tid >> 6), g = lane >> 4, c16 = lane & 15;
    const int vb = wid >> 1, kb0 = 2 * (wid & 1), hd = unit % RH, b = unit / RH;
    const unsigned char* rec0 = p->ws + WS_RC + (size_t)unit * RC_NSUB * RC_BYTES;
    float* SCO = (float*)(p->ws + WS_SCO) + (size_t)b * S * MIX + hd * 64;
    f32x4 st[2]; st[0] = (f32x4){0.f, 0.f, 0.f, 0.f}; st[1] = st[0];
    __syncthreads();
    for (int j = 0; j < RC_NSUB; ++j) { const unsigned char* rec = rec0 + (size_t)j * RC_BYTES; const lptr img = lds + (j & 1) * (64 * RS_STR);
        bf16x8 gt[2][2]; u32x2 slw[2]; float gam[2];
#pragma unroll
        for (int tl = 0; tl < 2; ++tl) { const int kcol = 16 * (kb0 + tl) + c16;
#pragma unroll
            for (int ks = 0; ks < 2; ++ks) gt[tl][ks] = *(const bf16x8*)((const bf16_t*)(rec + RC_GT) + kcol * 64 + 32 * ks + 8 * g);
            slw[tl] = ((const u32x2*)(rec + RC_SL))[(vb * 4 + kb0 + tl) * 64 + lane]; gam[tl] = ((const float*)(rec + RC_GAM))[kcol]; }
        bf16x8 rh[2]; f32x4 ol = (f32x4){0.f, 0.f, 0.f, 0.f};
        if (wid < 4) {
#pragma unroll
            for (int ks = 0; ks < 2; ++ks) rh[ks] = *(const bf16x8*)((const bf16_t*)(rec + RC_RH) + c16 * 64 + 32 * ks + 8 * g);
            ol = ((const f32x4*)(rec + RC_OL))[wid * 64 + lane]; }
#pragma unroll
        for (int tl = 0; tl < 2; ++tl)
#pragma unroll
            for (int e = 0; e < 4; ++e) *(LAS bf16_t*)(img + (16 * vb + 4 * g + e) * RS_STR + (16 * (kb0 + tl) + c16) * 2) = f2bf(st[tl][e]);
        __syncthreads();
        bf16x8 af[2];
#pragma unroll
        for (int ks = 0; ks < 2; ++ks) af[ks] = *(const LAS bf16x8*)(img + (16 * vb + c16) * RS_STR + (32 * ks + 8 * g) * 2);
        if (wid < 4) {
            f32x4 o = ol;
#pragma unroll
            for (int ks = 0; ks < 2; ++ks) o = MFMA16(rh[ks], *(const LAS bf16x8*)(img + (16 * wid + c16) * RS_STR + (32 * ks + 8 * g) * 2), o);
#pragma unroll
            for (int e = 0; e < 4; ++e) SCO[(size_t)(16 * j + 4 * g + e) * MIX + 16 * wid + c16] = o[e]; }
#pragma unroll
        for (int tl = 0; tl < 2; ++tl) { f32x4 nw = (f32x4){0.f, 0.f, 0.f, 0.f};
#pragma unroll
            for (int ks = 0; ks < 2; ++ks) nw = MFMA16(af[ks], gt[tl][ks], nw);
            st[tl][0] = st[tl][0] * gam[tl] + nw[0] + bflo(slw[tl].x); st[tl][1] = st[tl][1] * gam[tl] + nw[1] + bfhi(slw[tl].x);
            st[tl][2] = st[tl][2] * gam[tl] + nw[2] + bflo(slw[tl].y); st[tl][3] = st[tl][3] * gam[tl] + nw[3] + bfhi(slw[tl].y); }
    }
}

DI void phase_rw_post(KP p, int layer) {
    const size_t gt = (size_t)blockIdx.x * 512 + TID(), NGT = (size_t)gridDim.x * 512;
    const bf16_t* Z = (const bf16_t*)(p->ws + WS_Z); const float* SCO = (const float*)(p->ws + WS_SCO); const float* BON = (const float*)(p->ws + WS_BON);
    const float* lg = p->in[I_LNXG] + (size_t)layer * MIX; const float* lbv = p->in[I_LNXB] + (size_t)layer * MIX;
    for (size_t i = gt; i < (size_t)M * (MIX / 16); i += NGT) { const size_t m = i / (MIX / 16); const int c0 = (int)(i % (MIX / 16)) * 16, hd = c0 >> 6; const int t = (int)(m % S), b = (int)(m / S);
        float o[16]; float s1 = 0.f; const float* osrc = (t < FX_T) ? (const float*)(p->ws + WS_OEXC) + ((size_t)b * FX_T + t) * MIX + c0 : SCO + m * MIX + c0;
#pragma unroll
        for (int j = 0; j < 4; ++j) { const f32x4 v = *(const f32x4*)(osrc + 4 * j); o[4 * j] = v[0]; o[4 * j + 1] = v[1]; o[4 * j + 2] = v[2]; o[4 * j + 3] = v[3]; s1 += (v[0] + v[1]) + (v[2] + v[3]); }
        s1 += __shfl_xor(s1, 1); s1 += __shfl_xor(s1, 2); const float mean = s1 * (1.f / 64.f); float s2 = 0.f;
#pragma unroll
        for (int j = 0; j < 16; ++j) { o[j] -= mean; s2 += o[j] * o[j]; }
        s2 += __shfl_xor(s2, 1); s2 += __shfl_xor(s2, 2); const float rstd = frsq(s2 * (1.f / 64.f) + RW_LN_EPS);
        const float bon = BON[m * RH + hd]; const float* vsrc = (const float*)(p->ws + WS_VV) + m * MIX + c0;
        const bf16_t* gp = Z + m * ZLD + C_RG + c0; bf16_t* yp = (bf16_t*)(p->ws + WS_Y) + m * (4 * MIX) + 2 * MIX + c0;
        unsigned w[8];
#pragma unroll
        for (int j = 0; j < 16; j += 2) { const float y0 = (o[j] * rstd * lg[c0 + j] + lbv[c0 + j] + bon * vsrc[j]) * fsilu(bf2f(gp[j])), y1 = (o[j + 1] * rstd * lg[c0 + j + 1] + lbv[c0 + j + 1] + bon * vsrc[j + 1]) * fsilu(bf2f(gp[j + 1]));
            w[j >> 1] = pk2(y0, y1); }
        *(u32x4*)(yp) = (u32x4){w[0], w[1], w[2], w[3]}; *(u32x4*)(yp + 8) = (u32x4){w[4], w[5], w[6], w[7]}; }
}

DI void phase_ln(KP p, int layer) {
    const int tid = TID(), lane = tid & 63, wave = tid >> 6;
    const float alpha = sqrtf(sqrtf(2.f * (float)L));
    const float* hprev = (layer == 0) ? p->in[I_X] : (const float*)(p->ws + WS_H); const float* outf = (const float*)(p->ws + WS_OUTF);
    float* hnew = (layer == L - 1) ? p->out : (float*)(p->ws + WS_H); bf16_t* xn = (bf16_t*)(p->ws + WS_XN);
    const float* lg = p->in[I_LNG] + (size_t)layer * D; const float* lbv = p->in[I_LNB] + (size_t)layer * D;
    constexpr int NV = D / 256;
    for (size_t m = (size_t)blockIdx.x * 8 + wave; m < (size_t)M; m += (size_t)gridDim.x * 8) {
        f32x4 v[NV]; float s = 0.f;
#pragma unroll
        for (int j = 0; j < NV; ++j) { const f32x4 a = *(const f32x4*)(hprev + m * D + 256 * j + 4 * lane), o = *(const f32x4*)(outf + m * D + 256 * j + 4 * lane); v[j] = a * alpha + o; s += (v[j][0] + v[j][1]) + (v[j][2] + v[j][3]); }
#pragma unroll
        for (int o = 1; o < 64; o <<= 1) s += __shfl_xor(s, o);
        const float mean = s * (1.f / D); float s2 = 0.f;
#pragma unroll
        for (int j = 0; j < NV; ++j) { v[j] = v[j] - mean; s2 += (v[j][0] * v[j][0] + v[j][1] * v[j][1]) + (v[j][2] * v[j][2] + v[j][3] * v[j][3]); }
#pragma unroll
        for (int o = 1; o < 64; o <<= 1) s2 += __shfl_xor(s2, o);
        const float rstd = 1.f / sqrtf(s2 * (1.f / D) + LN_EPS);
#pragma unroll
        for (int j = 0; j < NV; ++j) { const f32x4 g4 = *(const f32x4*)(lg + 256 * j + 4 * lane), b4 = *(const f32x4*)(lbv + 256 * j + 4 * lane); const f32x4 y = v[j] * rstd * g4 + b4;
            *(f32x4*)(hnew + m * D + 256 * j + 4 * lane) = y; u32x2 w; w.x = pk2(y[0], y[1]); w.y = pk2(y[2], y[3]); *(u32x2*)(xn + m * D + 256 * j + 4 * lane) = w; }
    }
}
constexpr int FX_NS_HG = 3 * MIX / 64, FX_NS_RW = RW_MIX / 64, FX_NSTRIP = FX_NS_HG + FX_NS_RW + 1;
DI void phase_fx_project(KP p, int layer, lptr lds, int strip) {
    const int tid = TID(), c = tid & 63, kg = tid >> 6;
    const float* hsrc = (layer == 0) ? p->in[I_X] : (const float*)(p->ws + WS_H);
    LAS float* HR = (LAS float*)lds;
    __syncthreads();
    for (int i = tid; i < FX_ROWS * D / 4; i += 512) { const int r = i / (D / 4), k4 = i % (D / 4); const size_t m = (size_t)(r / FX_T) * S + (r % FX_T);
        *(LAS f32x4*)(HR + r * D + 4 * k4) = *(const f32x4*)(hsrc + m * D + 4 * k4); }
    __syncthreads();
    int col0, ncol, ldw; const float* W;
    if (strip < FX_NS_HG) { col0 = C_HQ + 64 * strip; ncol = 64; ldw = IN_COLS; W = p->in[I_WIN] + (size_t)layer * D * IN_COLS + col0; }
    else if (strip < FX_NS_HG + FX_NS_RW) { col0 = C_RM + 64 * (strip - FX_NS_HG); ncol = 64; ldw = IN_COLS; W = p->in[I_WIN] + (size_t)layer * D * IN_COLS + col0; }
    else { col0 = C_VD; ncol = 32; ldw = 32; W = p->in[I_V1] + (size_t)(layer > 0 ? layer - 1 : 0) * D * 32; if (layer == 0) ncol = 0; }
    float acc[FX_ROWS];
#pragma unroll
    for (int r = 0; r < FX_ROWS; ++r) acc[r] = 0.f;
    if (c < ncol) {
        for (int k = kg * (D / 8); k < (kg + 1) * (D / 8); ++k) { const float w = W[(size_t)k * ldw + c];
#pragma unroll
            for (int r = 0; r < FX_ROWS; ++r) acc[r] += HR[r * D + k] * w; } }
    __syncthreads();
    LAS float* RED = (LAS float*)lds;
#pragma unroll
    for (int r = 0; r < FX_ROWS; ++r) RED[(kg * FX_ROWS + r) * 64 + c] = acc[r];
    __syncthreads();
    for (int i = tid; i < FX_ROWS * 64; i += 512) { const int r = i >> 6, cc = i & 63; float s = 0.f;
#pragma unroll
        for (int g = 0; g < 8; ++g) s += RED[(g * FX_ROWS + r) * 64 + cc];
        if (cc < ncol) ((float*)(p->ws + WS_ZF))[(size_t)r * ZLD + col0 + cc] = s; }
}
DI float wave_sum64(float v) {
#pragma unroll
    for (int o = 1; o < 64; o <<= 1) v += __shfl_xor(v, o);
    return v; }
DI void fx_rwkv(KP p, int layer, int item, int lane) {
    const int hd = item % RH, b = item / RH, ch = hd * 64 + lane;
    const float* ZF = (const float*)(p->ws + WS_ZF) + (size_t)b * FX_T * ZLD;
    const float* mu = p->in[I_MU] + (size_t)layer * RW_MIX;
    const float mur = mu[ch], muk = mu[MIX + ch], muv = mu[2 * MIX + ch], muw = mu[3 * MIX + lane], mua = mu[3 * MIX + 64 + lane];
    const float muvd = (layer > 0 && lane < 32) ? p->in[I_VMU][(size_t)(layer - 1) * 32 + lane] : 0.f;
    const float* w2 = p->in[I_W2] + (size_t)layer * 64 * MIX + ch; const float* a2 = p->in[I_A2] + (size_t)layer * 64 * MIX + ch;
    const float* v2 = p->in[I_V2] + (size_t)(layer > 0 ? layer - 1 : 0) * 32 * MIX + ch;
    const float w0 = p->in[I_W0][(size_t)layer * MIX + ch], a0 = p->in[I_A0][(size_t)layer * MIX + ch], kq = p->in[I_KK][(size_t)layer * MIX + ch], ka = p->in[I_KA][(size_t)layer * MIX + ch], rk = p->in[I_RK][(size_t)layer * MIX + ch];
    const float v0 = p->in[I_V0][(size_t)(layer > 0 ? layer - 1 : 0) * MIX + ch];
    float rv[FX_T], kv[FX_T], vv[FX_T], tw[FX_T], ad[FX_T], vd[FX_T];
    { float pr = 0.f, pk = 0.f, pv = 0.f, pw = 0.f, pa = 0.f, pvd = 0.f;
#pragma unroll
      for (int t = 0; t < FX_T; ++t) { const float* z = ZF + (size_t)t * ZLD;
          const float cr = z[C_RM + ch], ck = z[C_RM + MIX + ch], cv = z[C_RM + 2 * MIX + ch], cw = z[C_RM + 3 * MIX + lane], ca = z[C_RM + 3 * MIX + 64 + lane], cvd = (layer > 0 && lane < 32) ? z[C_VD + lane] : 0.f;
          rv[t] = cr + (pr - cr) * mur; kv[t] = ck + (pk - ck) * muk; vv[t] = cv + (pv - cv) * muv;
          tw[t] = tanhf(cw + (pw - cw) * muw); ad[t] = ca + (pa - ca) * mua; vd[t] = cvd + (pvd - cvd) * muvd;
          pr = cr; pk = ck; pv = cv; pw = cw; pa = ca; pvd = cvd; } }
    float lwv[FX_T], lav[FX_T], lvv[FX_T];
#pragma unroll
    for (int t = 0; t < FX_T; ++t) { lwv[t] = 0.f; lav[t] = 0.f; lvv[t] = 0.f; }
#pragma unroll 8
    for (int j = 0; j < 64; ++j) { const float w2j = w2[(size_t)j * MIX], a2j = a2[(size_t)j * MIX];
#pragma unroll
        for (int t = 0; t < FX_T; ++t) { lwv[t] += __shfl(tw[t], j) * w2j; lav[t] += __shfl(ad[t], j) * a2j; } }
    if (layer > 0) {
#pragma unroll 8
        for (int j = 0; j < 32; ++j) { const float v2j = v2[(size_t)j * MIX];
#pragma unroll
            for (int t = 0; t < FX_T; ++t) lvv[t] += __shfl(vd[t], j) * v2j; } }
    float xs[2 * FX_T - 1], ys[2 * FX_T - 1];
#pragma unroll
    for (int t = 0; t < FX_T; ++t) { const float r = rv[t], k = kv[t], lw = lwv[t], la = lav[t], lv = lvv[t]; float v = vv[t];
        const float wlog = -(fmaxf(-(w0 + lw), 0.f) + log1pf(expf(-fabsf(w0 + lw)))) - 0.5f, decay = expf(-expf(wlog));
        const float a = 1.f / (1.f + expf(-(a0 + la)));
        const size_t m = (size_t)b * S + t; float* VF = (float*)(p->ws + WS_VF) + m * MIX;
        if (layer == 0) VF[ch] = v; else { const float vf = VF[ch]; v = v + (vf - v) / (1.f + expf(-(v0 + lv))); }
        float kk = k * kq; const float nrm = sqrtf(wave_sum64(kk * kk)); kk = kk / fmaxf(nrm, 1e-12f);
        const float k2 = k * (1.f + (a - 1.f) * ka);
        const float bon = wave_sum64(r * k2 * rk);
        ((float*)(p->ws + WS_VV))[m * MIX + ch] = v;
        if (lane == 0) ((float*)(p->ws + WS_BON))[m * RH + hd] = bon;
        { const float an = -kk, bn = kk * a; float sa = 0.f, ov = 0.f;
          const int nt = (t == 0) ? 0 : 2 * t - 1;
#pragma unroll
          for (int i = 0; i < 2 * FX_T - 1; ++i) if (i < nt) { sa += xs[i] * wave_sum64(ys[i] * an); ys[i] *= decay; ov += xs[i] * wave_sum64(ys[i] * r); }
          if (t > 0) { ov += sa * wave_sum64(bn * r); }
          ov += v * wave_sum64(k2 * r);
#pragma unroll
          for (int i = 0; i < 2 * FX_T - 1; ++i) { if (t > 0 && i == nt) { xs[i] = sa; ys[i] = bn; } if (i == ((t == 0) ? 0 : nt + 1)) { xs[i] = v; ys[i] = k2; } }
          ((float*)(p->ws + WS_OEXC))[((size_t)b * FX_T + t) * MIX + ch] = ov; } }
}
DI void fx_hgrn(KP p, int layer, int item, int lane) {
    const int h = item % HH, b = item / HH;
    const float* ZF = (const float*)(p->ws + WS_ZF) + (size_t)b * FX_T * ZLD; const float* LBp = (const float*)(p->ws + SM_LB);
    float q[FX_T][2], kx[FX_T][2], Bc[FX_T][2], iv[FX_T][2];
#pragma unroll
    for (int u = 0; u < 2; ++u) { const int d = h * 128 + lane + 64 * u; const float lb = LBp[(size_t)layer * MIX + d]; float run = 0.f;
#pragma unroll
        for (int t = 0; t < FX_T; ++t) { const float* z = ZF + (size_t)t * ZLD; const float zf = z[C_HF + d]; q[t][u] = z[C_HQ + d]; iv[t][u] = z[C_HI + d];
            const float sg = 1.f / (1.f + expf(-zf)); run += logf(lb + (1.f - lb) * sg); Bc[t][u] = run; kx[t][u] = (1.f - lb) * (1.f - sg); } }
    float* OEX = (float*)(p->ws + WS_OEX) + (size_t)item * FX_T * 128;
#pragma unroll
    for (int t = 0; t < FX_T; ++t) { float o0 = 0.f, o1 = 0.f;
#pragma unroll
        for (int s = 0; s <= t; ++s) { const float c = wave_sum64(q[t][0] * kx[s][0] * expf(Bc[t][0] - Bc[s][0]) + q[t][1] * kx[s][1] * expf(Bc[t][1] - Bc[s][1])); o0 += c * iv[s][0]; o1 += c * iv[s][1]; }
        OEX[t * 128 + lane] = o0; OEX[t * 128 + 64 + lane] = o1; }
}
DI void phase_fx_fix(KP p, int layer) {
    const int tid = TID(), lane = tid & 63, gw = blockIdx.x * 8 + (tid >> 6), NGW = gridDim.x * 8;
    for (int it = gw; it < NB * RH + NB * HH; it += NGW) { if (it < NB * RH) fx_rwkv(p, layer, it, lane); else fx_hgrn(p, layer, it - NB * RH, lane); }
}
constexpr int NWAVES = 8, LDS_RING = 131072, MISC_OFF = LDS_RING + 320, LDS_BYTES = 147456;
constexpr int CW_BAR = 4096, CW_WQ = 16384;
enum { PH_INPROJ = 0, PH_RWPREP, PH_RWLOC, PH_MIX, PH_RWPOST, PH_BRANCH, PH_SUM, PH_OUT, PH_LN, PH_COUNT };
constexpr int U_SCAN = NB * RH, U_HG = NB * HH, U_HGC = NB * HH * (S / 64), U_AA = NB * AH * (S / 128), U_AD = NB * SH * (S / 256), U_MIX = U_SCAN + U_HG + U_AA + U_AD;

struct Args { Params p; int do_pro, l_lo, l_hi, ph_lo, ph_hi, mega, pad0, pad1; };

#ifndef EMU
#define XB_TMO      128
#define XB_XCNT(j)  (256  + 64 * (j))
#define XB_XSUB(j)  (1280 + 64 * (j))
#define XB_XGEN(j)  (2304 + 64 * (j))
#define XB_TOP      3328
#define XB_TOPGEN   3392
#define XCD_BAR_WORDS 3456
#define XB_SPIN_CAP (1u << 18)
__device__ __forceinline__ unsigned xb_ld(unsigned* p)              { return __hip_atomic_load(p, __ATOMIC_RELAXED, __HIP_MEMORY_SCOPE_AGENT); }
__device__ __forceinline__ unsigned xb_add(unsigned* p, unsigned v) { return __hip_atomic_fetch_add(p, v, __ATOMIC_RELAXED, __HIP_MEMORY_SCOPE_AGENT); }
__device__ __forceinline__ unsigned xb_xcc_id() { return (unsigned)__builtin_amdgcn_s_getreg((3 << 11) | 20) & 0xFu; }
#define XB_SPIN(cond, bar) do { unsigned _sp = 0; while (cond) { __builtin_amdgcn_s_sleep(1); \
    if ((++_sp & 255u) == 0u) { if (xb_ld(&(bar)[XB_TMO])) break; if (_sp > XB_SPIN_CAP) { atomicAdd(&(bar)[XB_TMO], 1u); break; } } } } while (0)
struct XcdBarrier { unsigned* bar; unsigned x; volatile LAS unsigned* st; };
__device__ __forceinline__ XcdBarrier xcd_barrier_post(unsigned* bar, volatile LAS unsigned* st) {
    XcdBarrier b; b.bar = bar; b.x = xb_xcc_id(); b.st = st;
    if (threadIdx.x == 0) (void)xb_add(&bar[XB_XCNT(b.x)], 1u);
    return b;
}
__device__ __forceinline__ void xcd_barrier_complete(unsigned* bar, unsigned x, unsigned& nloc, unsigned& nx) {
    const unsigned G = gridDim.x * gridDim.y * gridDim.z;
    unsigned sum, cnt, mine, sp = 0u;
    for (;;) {
        sum = 0u; cnt = 0u; mine = 0u;
#pragma unroll
        for (unsigned j = 0; j < 16; ++j) { const unsigned c = xb_ld(&bar[XB_XCNT(j)]); sum += c; cnt += (c > 0u) ? 1u : 0u; mine = (j == x) ? c : mine; }
        if (sum == G) break;
        __builtin_amdgcn_s_sleep(1);
        if ((++sp & 255u) == 0u) { if (xb_ld(&bar[XB_TMO])) break; if (sp > XB_SPIN_CAP) { atomicAdd(&bar[XB_TMO], 1u); break; } }
    }
    nloc = mine > 0u ? mine : 1u; nx = cnt > 0u ? cnt : 1u;
}
__device__ __forceinline__ void xcd_barrier(const XcdBarrier& b) {
    asm volatile("s_waitcnt vmcnt(0)" ::: "memory");
    __syncthreads();
    if (threadIdx.x == 0) {
        unsigned* bar = b.bar;
        __builtin_amdgcn_s_waitcnt(0);
        unsigned nloc = b.st[0], nx = b.st[1];
        if (nloc == 0u) { xcd_barrier_complete(bar, b.x, nloc, nx); b.st[0] = nloc; b.st[1] = nx; }
        const unsigned old = xb_add(&bar[XB_XSUB(b.x)], 1u);
        const unsigned gen = old / nloc;
        if (old + 1u == (gen + 1u) * nloc) {
            __builtin_amdgcn_fence(__ATOMIC_RELEASE, "agent");
            asm volatile("s_waitcnt vmcnt(0)" ::: "memory");
            const unsigned og = xb_add(&bar[XB_TOP], 1u);
            const unsigned tg = og / nx;
            if (og + 1u == (tg + 1u) * nx) xb_add(&bar[XB_TOPGEN], 1u);
            else XB_SPIN(xb_ld(&bar[XB_TOPGEN]) == tg, bar);
            __builtin_amdgcn_fence(__ATOMIC_ACQUIRE, "agent");
            xb_add(&bar[XB_XGEN(b.x)], 1u);
            asm volatile("s_waitcnt vmcnt(0)" ::: "memory");
        } else {
            XB_SPIN(xb_ld(&bar[XB_XGEN(b.x)]) == gen, bar);
            __builtin_amdgcn_fence(__ATOMIC_ACQUIRE, "agent");
            asm volatile("s_waitcnt vmcnt(0)" ::: "memory");
        }
    }
    __syncthreads();
}
#endif

DI int next_unit(unsigned* head, lptr lds) {
    LAS int* slot = (LAS int*)(lds + MISC_OFF + 64);
    __syncthreads();
#ifdef EMU
    if (threadIdx.x == 0) { *slot = (int)(*head); *head += 1; }
#else
    if (threadIdx.x == 0) *slot = (int)__hip_atomic_fetch_add(head, 1u, __ATOMIC_RELAXED, __HIP_MEMORY_SCOPE_AGENT);
#endif
    __syncthreads();
    return *slot;
}

#ifndef DBG_PHMASK
#define DBG_PHMASK 0xffff
#endif
struct BranchOrder {
    pg8::StaticOrder so;
    DM bool next(int i, pg8::Unit& u) const { if (!so.next(i, u)) return false; u.ka = (u.pn / (D / 256)) * MIX; return true; }
    DM void a_ready(const pg8::Unit&) const {}
    DM void done(const pg8::Unit&) const {}
};
#ifndef PROBE_REP
#define PROBE_REP 0
#endif
#ifndef PROBE_PREPSEL
#define PROBE_PREPSEL 7
#endif
#ifndef PROBE_MIXREP
#define PROBE_MIXREP 15
#endif
#ifndef DBG_MIXMASK
#define DBG_MIXMASK 15
#endif
DI void run_phase(KP p, int rep, int l, int ph, lptr lds) {
    unsigned char* ws = p->ws;
    if (!((DBG_PHMASK >> ph) & 1)) return;
    if (ph == PH_INPROJ) {
        pg8::Gemm g{(const bf16_t*)(ws + WS_XN), (const bf16_t*)(ws + WS_WIN) + (size_t)l * NP * D, M, NP, D, D, D};
        EpiInproj E{(bf16_t*)(ws + WS_Z), ZLD, (bf16_t*)(ws + WS_RHO), CG0 / 256};
#ifndef EMU
        pg8::StaticOrder so; so.init(M, NP, gridDim.x, blockIdx.x);
        pg8::gemm_phase<EpiInproj, pg8::StaticOrder, true, true, D, D, D>((LAS unsigned char*)lds, g, so, E);
#endif
        { const int first = (M / 256) * (NP / 256) % (int)gridDim.x;
          for (int s = ((int)blockIdx.x - first + (int)gridDim.x) % (int)gridDim.x; s < FX_NSTRIP; s += gridDim.x) phase_fx_project(p, l, lds, s); }
    } else if (ph == PH_RWPREP) {
        const int psel = rep ? PROBE_PREPSEL : 7;
        if (psel & 1) phase_rw_local(p, l, lds);
        if (psel & 2) phase_fx_fix(p, l);
        if (psel & 4) for (int u = blockIdx.x; u < U_HGC; u += gridDim.x) phase_hg_local(p, l, lds, u);
    } else if (ph == PH_RWLOC) {
    } else if (ph == PH_MIX) {
        unsigned* head = (unsigned*)(ws + WS_CTL) + CW_WQ + 64 * l + (rep ? 32 * 64 : 0);
        for (;;) { int u = next_unit(head, lds); if (u >= U_MIX) break;
            const int mm = rep ? PROBE_MIXREP : DBG_MIXMASK;
            if (u < U_SCAN) { if (mm & 1) phase_rw_scan(p, lds, u); continue; } u -= U_SCAN;
            if (u < U_HG) { if (mm & 2) phase_hg_scan(p, u); continue; } u -= U_HG;
            if (u < U_AA) { if (mm & 4) phase_att_a(p, l, lds, u); continue; } u -= U_AA;
            if (mm & 8) phase_att_d(p, l, lds, u); }
    } else if (ph == PH_RWPOST) {
        phase_rw_post(p, l);
        for (int u = blockIdx.x; u < U_HGC; u += gridDim.x) phase_hg_out(p, l, lds, u);
    } else if (ph == PH_BRANCH) {
        pg8::Gemm g{(const bf16_t*)(ws + WS_Y), (const bf16_t*)(ws + WS_WBR) + (size_t)l * D * 4 * MIX, M, D, 4 * MIX, 4 * MIX, 4 * MIX};
        EpiMerged E{(bf16_t*)(ws + WS_MG), D, (const bf16_t*)(ws + WS_RHO)};
#ifndef EMU
        pg8::StaticOrder so; so.init(M, D, gridDim.x, blockIdx.x);
        pg8::gemm_phase<EpiMerged, pg8::StaticOrder, true, true, 4 * MIX, 4 * MIX, 4 * MIX>((LAS unsigned char*)lds, g, so, E);
#endif
    } else if (ph == PH_SUM) {
    } else if (ph == PH_OUT) {
        pg8::Gemm g{(const bf16_t*)(ws + WS_MG), (const bf16_t*)(ws + WS_WOUT) + (size_t)l * D * D, M, D, D, D, D};
        EpiF32 E{(float*)(ws + WS_OUTF), D};
#ifndef EMU
        pg8::StaticOrder so; so.init(M, D, gridDim.x, blockIdx.x);
        pg8::gemm_phase<EpiF32, pg8::StaticOrder, true, true, D, D, D>((LAS unsigned char*)lds, g, so, E);
#endif
    } else if (ph == PH_LN) {
        phase_ln(p, l);
    }
}

#ifndef EMU
__global__ void __launch_bounds__(NWAVES * 64, 2) fwd(Args a) {
    extern __shared__ __attribute__((aligned(16))) unsigned char lds_raw[];
    lptr lds = (lptr)lds_raw;
    volatile LAS unsigned* MISC = (volatile LAS unsigned*)(lds + MISC_OFF);
    for (int u = threadIdx.x; u < (LDS_BYTES - LDS_RING) / 4; u += NWAVES * 64) ((LAS unsigned*)(lds + LDS_RING))[u] = 0u;
    __syncthreads();
    typedef const __attribute__((address_space(4))) Args* KA;
    KA ka = (KA)__builtin_amdgcn_kernarg_segment_ptr();
    const int mega = ka->mega, do_pro = ka->do_pro, l_lo = ka->l_lo, l_hi = ka->l_hi, ph_lo = ka->ph_lo, ph_hi = ka->ph_hi;
    auto kp = [&]() -> KP { KA k2 = ka; asm volatile("" : "+s"(k2)); return &k2->p; };
    XcdBarrier bar; bar.bar = (unsigned*)(ka->p.ws + WS_CTL) + CW_BAR; bar.x = 0; bar.st = nullptr;
    if (mega) bar = xcd_barrier_post((unsigned*)(ka->p.ws + WS_CTL) + CW_BAR, MISC + 8);
#define SEAM() do { if (mega) xcd_barrier(bar); } while (0)
    if (do_pro != 0 && ((DBG_PHMASK >> 8) & 1) != 0) { phase_prologue(kp(), lds); SEAM(); }
    for (int l = l_lo; l < l_hi; ++l) {
        if (ph_lo <= PH_INPROJ && PH_INPROJ < ph_hi) { run_phase(kp(), 0, l, PH_INPROJ, lds); SEAM(); if ((PROBE_REP >> PH_INPROJ) & 1) { run_phase(kp(), 1, l, PH_INPROJ, lds); SEAM(); } }
        if (ph_lo <= PH_RWPREP && PH_RWPREP < ph_hi) { run_phase(kp(), 0, l, PH_RWPREP, lds); SEAM(); if ((PROBE_REP >> PH_RWPREP) & 1) { run_phase(kp(), 1, l, PH_RWPREP, lds); SEAM(); } }
        if (ph_lo <= PH_MIX && PH_MIX < ph_hi) { run_phase(kp(), 0, l, PH_MIX, lds); SEAM(); if ((PROBE_REP >> PH_MIX) & 1) { run_phase(kp(), 1, l, PH_MIX, lds); SEAM(); } }
        if (ph_lo <= PH_RWPOST && PH_RWPOST < ph_hi) { run_phase(kp(), 0, l, PH_RWPOST, lds); SEAM(); if ((PROBE_REP >> PH_RWPOST) & 1) { run_phase(kp(), 1, l, PH_RWPOST, lds); SEAM(); } }
        if (ph_lo <= PH_BRANCH && PH_BRANCH < ph_hi) { run_phase(kp(), 0, l, PH_BRANCH, lds); SEAM(); if ((PROBE_REP >> PH_BRANCH) & 1) { run_phase(kp(), 1, l, PH_BRANCH, lds); SEAM(); } }
        if (ph_lo <= PH_OUT && PH_OUT < ph_hi) { run_phase(kp(), 0, l, PH_OUT, lds); SEAM(); if ((PROBE_REP >> PH_OUT) & 1) { run_phase(kp(), 1, l, PH_OUT, lds); SEAM(); } }
        if (ph_lo <= PH_LN && PH_LN < ph_hi) { run_phase(kp(), 0, l, PH_LN, lds); SEAM(); }
    }
#undef SEAM
}

#ifndef MK_MEGA
#define MK_MEGA 1
#endif
extern "C" void kernel_launch(void* const* d_in, const int* in_sizes, int n_in, void* d_out, int out_size, void* d_ws, size_t ws_size, hipStream_t stream) {
    static int grid = 0;
    if (grid == 0) {
        if (n_in != 25 || in_sizes[0] != M * D || out_size != M * D || ws_size < WS_END) { fprintf(stderr, "kernel_launch: shape/workspace mismatch (n_in %d, in0 %d, out %d, ws %zu need %zu)\n", n_in, n_in > 0 ? in_sizes[0] : -1, out_size, ws_size, (size_t)WS_END); grid = -1; return; }
        int dev = 0, cus = 0, per_cu = 0;
        if (hipGetDevice(&dev) != hipSuccess || hipDeviceGetAttribute(&cus, hipDeviceAttributeMultiprocessorCount, dev) != hipSuccess) { grid = -1; return; }
        if (hipFuncSetAttribute((const void*)fwd, hipFuncAttributeMaxDynamicSharedMemorySize, LDS_BYTES) != hipSuccess) { fprintf(stderr, "kernel_launch: hipFuncSetAttribute failed\n"); grid = -1; return; }
        if (hipOccupancyMaxActiveBlocksPerMultiprocessor(&per_cu, (const void*)fwd, NWAVES * 64, LDS_BYTES) != hipSuccess || per_cu < 1) fprintf(stderr, "kernel_launch: occupancy query says %d\n", per_cu);
        (void)hipGetLastError();
        grid = cus;
    }
    if (grid < 0) return;
    (void)hipMemsetAsync((char*)d_ws + WS_CTL, 0, CTL_BYTES, stream);
    Args a{};
    for (int i = 0; i < 25; ++i) a.p.in[i] = (const float*)d_in[i];
    a.p.out = (float*)d_out; a.p.ws = (unsigned char*)d_ws;
    if (MK_MEGA) {
        a.do_pro = 1; a.l_lo = 0; a.l_hi = L; a.ph_lo = 0; a.ph_hi = PH_COUNT; a.mega = 1;
        hipLaunchKernelGGL(fwd, dim3(grid), dim3(NWAVES * 64), LDS_BYTES, stream, a);
    } else {
        a.mega = 0; a.do_pro = 1; a.l_lo = 0; a.l_hi = 0; a.ph_lo = 0; a.ph_hi = 0;
        hipLaunchKernelGGL(fwd, dim3(grid), dim3(NWAVES * 64), LDS_BYTES, stream, a);
        a.do_pro = 0;
        for (int l = 0; l < L; ++l) for (int ph = 0; ph < PH_COUNT; ++ph) { a.l_lo = l; a.l_hi = l + 1; a.ph_lo = ph; a.ph_hi = ph + 1;
            hipLaunchKernelGGL(fwd, dim3(grid), dim3(NWAVES * 64), LDS_BYTES, stream, a); }
    }
}
#endif
```

```cpp
#ifdef EMU
#include "emu.h"
#else
#include <hip/hip_runtime.h>
#include <cstdio>
#include <cstdint>
#endif

#ifndef CFG_D_MODEL
#define CFG_D_MODEL 2048
#endif
#ifndef CFG_BATCH
#define CFG_BATCH 4
#endif
#ifndef CFG_SEQ
#define CFG_SEQ 4096
#endif
#ifndef CFG_DEPTH
#define CFG_DEPTH 4
#endif
constexpr int D = CFG_D_MODEL, NB = CFG_BATCH, S = CFG_SEQ, L = CFG_DEPTH, MIX = D / 2, M = NB * S;
constexpr int AH = MIX / 128, HH = MIX / 128, RH = MIX / 64, SH = MIX / 128;
constexpr int RW_MIX = 3 * MIX + 128;
constexpr int C_AQ = 0, C_AK = MIX, C_AV = 2 * MIX, C_AG = 3 * MIX, C_HQ = 4 * MIX, C_HF = 5 * MIX, C_HI = 6 * MIX, C_HG = 7 * MIX;
constexpr int C_RM = 8 * MIX, C_RG = C_RM + RW_MIX, C_SQ = C_RG + MIX, C_SK = C_SQ + MIX, C_SV = C_SK + MIX, C_SG = C_SV + MIX, C_MG = C_SG + MIX;
constexpr int IN_COLS = C_MG + 4 * D;
constexpr int C_VD = C_MG, CG0 = ((C_MG + 32 + 255) / 256) * 256, NP = CG0 + 4 * D, ZLD = CG0;
constexpr float LN_EPS = 1e-5f, RMS_EPS = 1e-6f, RW_LN_EPS = 64e-5f;
constexpr float LOG2E = 1.4426950408889634f, LN2 = 0.6931471805599453f;

constexpr size_t al256(size_t x) { return (x + 255) & ~(size_t)255; }
constexpr size_t WS_CTL = 0, CTL_BYTES = 1u << 20;
constexpr size_t SM_LAM = CTL_BYTES;
constexpr size_t SM_LB = SM_LAM + 256;
constexpr size_t SM_BT = al256(SM_LB + (size_t)3 * L * MIX * 4);
constexpr size_t SM_W2T = al256(SM_BT + (size_t)AH * 132 * 4);
constexpr size_t SM_A2T = al256(SM_W2T + (size_t)L * MIX * 64 * 2);
constexpr size_t SM_V2T = al256(SM_A2T + (size_t)L * MIX * 64 * 2);
constexpr size_t WS_WIN = al256(SM_V2T + (size_t)L * MIX * 32 * 2);
constexpr size_t WS_WBR = al256(WS_WIN + (size_t)L * NP * D * 2);
constexpr size_t WS_WOUT = al256(WS_WBR + (size_t)L * D * 4 * MIX * 2);
constexpr size_t WS_XN = al256(WS_WOUT + (size_t)L * D * D * 2);
constexpr size_t WS_H = al256(WS_XN + (size_t)M * D * 2);
constexpr size_t WS_Z = al256(WS_H + (size_t)M * D * 4);
constexpr size_t WS_Y = al256(WS_Z + (size_t)M * ZLD * 2);
constexpr size_t WS_RHO = al256(WS_Y + (size_t)M * 4 * MIX * 2);
constexpr size_t WS_P = al256(WS_RHO + (size_t)M * 4 * D * 2);
constexpr size_t WS_MG = al256(WS_P + (size_t)M * 4 * D * 2);
constexpr size_t WS_OUTF = al256(WS_MG + (size_t)M * D * 2);
constexpr size_t WS_VF = al256(WS_OUTF + (size_t)M * D * 4);
constexpr size_t WS_VV = al256(WS_VF + (size_t)M * MIX * 4);
constexpr size_t WS_SCO = al256(WS_VV + (size_t)M * MIX * 4);
constexpr size_t WS_BON = al256(WS_SCO + (size_t)M * MIX * 4);
constexpr size_t HG_CHUNKS = (size_t)NB * (MIX / 128) * (S / 64);
constexpr size_t WS_HGQF = al256(WS_BON + (size_t)M * RH * 4);
constexpr size_t WS_HGIN = al256(WS_HGQF + HG_CHUNKS * 16 * 64 * 16);
constexpr size_t WS_HGDS = al256(WS_HGIN + HG_CHUNKS * 8 * 4 * 64 * 16);
constexpr size_t WS_HGVE = al256(WS_HGDS + HG_CHUNKS * 8 * 8 * 64 * 16);
constexpr size_t WS_HGSF = al256(WS_HGVE + HG_CHUNKS * 256 * 4);
constexpr int FX_T = 4, FX_ROWS = NB * FX_T;
constexpr size_t WS_ZF = al256(WS_HGSF + HG_CHUNKS * 8 * 4 * 64 * 16);
constexpr size_t WS_OEX = al256(WS_ZF + (size_t)FX_ROWS * ZLD * 4);
constexpr size_t WS_OEXC = al256(WS_OEX + (size_t)NB * (MIX / 128) * FX_T * 128 * 4);
constexpr size_t WS_END = al256(WS_OEXC + (size_t)NB * FX_T * MIX * 4);
constexpr size_t WS_RC = WS_P;
static_assert((size_t)NB * (MIX / 64) * (S / 16) * 22784 <= WS_VF - WS_P, "RWKV records fit the aliased region");

typedef unsigned short bf16_t;
typedef short bf16x8 __attribute__((ext_vector_type(8)));
typedef short s16x4 __attribute__((ext_vector_type(4)));
typedef float f32x16 __attribute__((ext_vector_type(16)));
typedef float f32x4 __attribute__((ext_vector_type(4)));
typedef float f32x2 __attribute__((ext_vector_type(2)));
typedef unsigned u32x4 __attribute__((ext_vector_type(4)));
typedef unsigned u32x2 __attribute__((ext_vector_type(2)));
#ifdef EMU
#define DI static inline
#define DM inline
#define LAS
#define GAS
#define WAVE_SYNC() emu_wave_barrier()
#define MFMA32(a, b, c) emu_mfma32(a, b, c)
#define MFMA16(a, b, c) emu_mfma16(a, b, c)
#define TR_READ(p) emu_tr_read((const void*)(p))
#define ROW_ROR(x, n) emu_row_ror(x, n)
#define ANY(p) emu_any(p)
#define RFL(x) (x)
DI float ex2(float x) { return exp2f(x); }
DI float lg2(float x) { return log2f(x); }
DI float frcp(float x) { return 1.f / x; }
DI float frsq(float x) { return 1.f / sqrtf(x); }
DI float u2f(unsigned u) { float f; memcpy(&f, &u, 4); return f; }
DI unsigned f2u(float f) { unsigned u; memcpy(&u, &f, 4); return u; }
#else
#define DI __device__ __forceinline__
#define DM __device__ __forceinline__
#define LAS __attribute__((address_space(3)))
#define GAS __attribute__((address_space(1)))
#define WAVE_SYNC() do { __builtin_amdgcn_fence(__ATOMIC_RELEASE, "wavefront"); __builtin_amdgcn_wave_barrier(); __builtin_amdgcn_fence(__ATOMIC_ACQUIRE, "wavefront"); } while (0)
#define MFMA32(a, b, c) __builtin_amdgcn_mfma_f32_32x32x16_bf16((a), (b), (c), 0, 0, 0)
#define MFMA16(a, b, c) __builtin_amdgcn_mfma_f32_16x16x32_bf16((a), (b), (c), 0, 0, 0)
typedef short v4i16_t __attribute__((ext_vector_type(4)));
#define TR_READ(p) __builtin_bit_cast(s16x4, __builtin_amdgcn_ds_read_tr16_b64_v4i16((LAS v4i16_t*)(p)))
#define ROW_ROR(x, n) __builtin_bit_cast(float, __builtin_amdgcn_update_dpp(0, __builtin_bit_cast(int, (x)), 0x120 + (n), 0xf, 0xf, false))
#define ANY(p) __any(p)
#define RFL(x) __builtin_amdgcn_readfirstlane(x)
DI float ex2(float x) { return __builtin_amdgcn_exp2f(x); }
DI float lg2(float x) { return __builtin_amdgcn_logf(x); }
DI float frcp(float x) { return __builtin_amdgcn_rcpf(x); }
DI float frsq(float x) { return __builtin_amdgcn_rsqf(x); }
DI float u2f(unsigned u) { return __builtin_bit_cast(float, u); }
DI unsigned f2u(float f) { return __builtin_bit_cast(unsigned, f); }
#endif
#ifdef EMU
#define SCHED_FENCE()
#else
#define SCHED_FENCE() __builtin_amdgcn_sched_barrier(0)
#endif
typedef LAS char* lptr;
#ifdef EMU
DI int TID() { return (int)threadIdx.x; }
#else
DI int TID() { int t = (int)threadIdx.x; asm volatile("" : "+v"(t)); return t; }
#endif
DI float bf2f(bf16_t v) { return u2f(((unsigned)v) << 16); }
DI bf16_t f2bf(float f) { unsigned u = f2u(f); return (bf16_t)((u + 0x7fffu + ((u >> 16) & 1u)) >> 16); }
#ifdef EMU
DI unsigned pk2(float lo, float hi) { return (unsigned)f2bf(lo) | ((unsigned)f2bf(hi) << 16); }
#else
typedef __bf16 bf16x2_hw __attribute__((ext_vector_type(2)));
DI unsigned pk2(float lo, float hi) { const f32x2 v = {lo, hi}; return __builtin_bit_cast(unsigned, __builtin_convertvector(v, bf16x2_hw)); }
#endif
DI float bflo(unsigned w) { return u2f(w << 16); }
DI float bfhi(unsigned w) { return u2f(w & 0xffff0000u); }
DI float fexp(float x) { return ex2(x * LOG2E); }
DI float flog(float x) { return lg2(x) * LN2; }
DI float fsigmoid(float x) { return frcp(1.f + fexp(-x)); }
DI float fsilu(float x) { return x * fsigmoid(x); }
DI float fsoftplus(float x) { return fmaxf(x, 0.f) + flog(1.f + fexp(-fabsf(x))); }
DI int crow(int i, int h) { return (i & 3) + 8 * (i >> 2) + 4 * h; }
DI bf16x8 pack8(float a0, float a1, float a2, float a3, float a4, float a5, float a6, float a7) {
    u32x4 w; w.x = pk2(a0, a1); w.y = pk2(a2, a3); w.z = pk2(a4, a5); w.w = pk2(a6, a7); return __builtin_bit_cast(bf16x8, w);
}
DI bf16x8 cat4(s16x4 lo, s16x4 hi) { return __builtin_shufflevector(lo, hi, 0, 1, 2, 3, 4, 5, 6, 7); }

struct Params {
    const float* in[25];
    float* out;
    unsigned char* ws;
};
#ifdef EMU
typedef const Params* KP;
#else
typedef const __attribute__((address_space(4))) Params* KP;
#endif
enum { I_X = 0, I_WIN, I_REL, I_LAM, I_SUBLN, I_HGLOW, I_HGNORM, I_MU, I_W0, I_W2, I_A0, I_A2, I_V1, I_VMU, I_V0, I_V2, I_KK, I_KA, I_RK, I_LNXG, I_LNXB, I_WBR, I_WOUT, I_LNG, I_LNB };
namespace pg8 {
#ifdef EMU
#define PG8_LAS
#else
#define PG8_LAS __attribute__((address_space(3)))
#endif
typedef unsigned short bf16_t;
typedef short bf16x8 __attribute__((ext_vector_type(8)));
typedef float f32x4 __attribute__((ext_vector_type(4)));
typedef unsigned u32x4 __attribute__((ext_vector_type(4)));
constexpr int BM = 256, BK = 64, HALF = 128, HTB = HALF * BK * 2  , STAGE_BYTES = 8 * HTB, NXCD = 8, WGM = 8;

__host__ __device__ __forceinline__ int lds_byte(int r, int c) { const int st = (r >> 4) * 2 + (c >> 5), rr = r & 15, cc = c & 31, ob = rr * 64 + cc * 2; return st * 1024 + (ob ^ (((ob >> 9) & 1) << 5)); }
__host__ __device__ __forceinline__ void stage_rc(int b, int& R, int& C) { const int st = b / 1024, sb = b % 1024, swz = sb ^ (((sb >> 9) & 1) << 5); R = (st >> 1) * 16 + swz / 64; C = (st & 1) * 32 + (swz % 64) / 2; }
__host__ __device__ __forceinline__ int perm32(int rho) { const int n = rho >> 4, i = rho & 15; return 8 * (i >> 2) + 4 * n + (i & 3); }

struct Unit { int pm, pn, ka; };
struct Gemm { const bf16_t* A; const bf16_t* Bt; int M, N, K, lda, ldb; };

struct StaticOrder {
    int nM, nN, nwg, G, c;
    __host__ __device__ void init(int M, int N, int G_, int c_) { nM = M / BM; nN = N / BM; nwg = nM * nN; G = G_; c = c_; }
    __host__ __device__ bool next(int i, Unit& u) const {
        const long L = (long)i * G + c; if (L >= nwg) return false;
        int wgid = (int)L; { const int q = nwg / NXCD, r = nwg % NXCD, xcd = wgid % NXCD, off = wgid / NXCD; wgid = (xcd < r ? xcd * (q + 1) : r * (q + 1) + (xcd - r) * q) + off; }
        const int nig = WGM * nN, gid = wgid / nig, fm = gid * WGM, gsz = (nM - fm) < WGM ? (nM - fm) : WGM;
        u.pm = fm + ((wgid % nig) % gsz); u.pn = (wgid % nig) / gsz; u.ka = 0; return true;
    }
    __device__ __forceinline__ void a_ready(const Unit&) const {}
    __device__ __forceinline__ void done(const Unit&) const {}
};
#ifndef EMU
template <class Epi, class Sched, bool ALIGN_EPI, bool SP2, int LDA, int LDB, int KDIM>
__device__ __forceinline__ void gemm_phase(PG8_LAS unsigned char* lds, const Gemm g, const Sched& S, const Epi& E) {
    const int tid = TID(), wid = __builtin_amdgcn_readfirstlane(tid >> 6), lane = tid & 63, wr = wid >> 2, wc = wid & 3, fr = lane & 15, fq = lane >> 4;
    constexpr int K = KDIM, nt = K / BK;
    unsigned voffA, voffB;
    { int R, C; stage_rc(tid * 16, R, C); const int Rb = Epi::PERM ? ((R & ~31) + perm32(R & 31)) : R;
      voffA = (unsigned)(R * LDA + C) * 2u; voffB = (unsigned)(Rb * LDB + C) * 2u; }
    const size_t qA = (size_t)64 * LDA * 2, qB = (size_t)64 * LDB * 2;
    const size_t kstep = (size_t)(BK * 2);
    const size_t hstepA = (size_t)HALF * LDA * 2, hstepB = (size_t)HALF * LDB * 2;
    const size_t tstepA = 2 * hstepA, tstepB = 2 * hstepB;
    const unsigned ldsw = (unsigned)wid * 1024u;
    const int aoff = lds_byte(wr * 64 + fr, fq * 8), boff = lds_byte(wc * 32 + fr, fq * 8);
#define PG8_SA(b, h) (((b) * 2 + (h)) * HTB)
#define PG8_SB(b, h) ((4 + (b) * 2 + (h)) * HTB)
#define PG8_STAGE_X(bufoff, gbase, voff, q) do { _Pragma("unroll") for (int _i = 0; _i < 2; ++_i) \
        __builtin_amdgcn_global_load_lds((const unsigned*)((const char*)(gbase) + (size_t)_i * (q) + (voff)), (PG8_LAS unsigned*)(lds + (bufoff) + ldsw + _i * 8192), 16, 0, 0); } while (0)
#define PG8_STAGE_A(bufoff, gbase) PG8_STAGE_X(bufoff, gbase, voffA, qA)
#define PG8_STAGE_B(bufoff, gbase) PG8_STAGE_X(bufoff, gbase, voffB, qB)
#define PG8_LDA(dst, b, h) do { _Pragma("unroll") for (int m = 0; m < 4; ++m) _Pragma("unroll") for (int k = 0; k < 2; ++k) dst[m][k] = *(const PG8_LAS bf16x8*)(lds + PG8_SA(b, h) + aoff + m * 2048 + k * 1024); } while (0)
#define PG8_LDB(dst, b, h) do { _Pragma("unroll") for (int n = 0; n < 2; ++n) _Pragma("unroll") for (int k = 0; k < 2; ++k) dst[n][k] = *(const PG8_LAS bf16x8*)(lds + PG8_SB(b, h) + boff + n * 2048 + k * 1024); } while (0)
#define PG8_MMA(ai, bj, At, Bt) do { __builtin_amdgcn_s_setprio(1); _Pragma("unroll") for (int m = 0; m < 4; ++m) _Pragma("unroll") for (int n = 0; n < 2; ++n) _Pragma("unroll") for (int k = 0; k < 2; ++k) \
        acc[ai][bj][m][n] = __builtin_amdgcn_mfma_f32_16x16x32_bf16(Bt[n][k], At[m][k], acc[ai][bj][m][n], 0, 0, 0); __builtin_amdgcn_s_setprio(0); } while (0)
#define PG8_WAIT_V(n) asm volatile("s_waitcnt vmcnt(" #n ")" ::: "memory")
#define PG8_WAIT_L(n) asm volatile("s_waitcnt lgkmcnt(" #n ")" ::: "memory")
#define PG8_BAR __builtin_amdgcn_s_barrier()
#define PG8_SCHED __builtin_amdgcn_sched_barrier(0)
    Unit cur, nxt; int ui = 0;
    if (!S.next(0, cur)) return;
    f32x4 acc[2][2][4][2];
#pragma unroll
    for (int a = 0; a < 2; ++a)
#pragma unroll
        for (int b = 0; b < 2; ++b)
#pragma unroll
            for (int m = 0; m < 4; ++m)
#pragma unroll
                for (int n = 0; n < 2; ++n) acc[a][b][m][n] = (f32x4){0.f, 0.f, 0.f, 0.f};
    bf16x8 At[4][2], B0[2][2], B1[2][2];
    const char* cA = (const char*)g.A + (size_t)cur.pm * tstepA + (size_t)cur.ka * 2; const char* cB = (const char*)g.Bt + (size_t)cur.pn * tstepB;
    S.a_ready(cur);
    if constexpr (SP2) {
        PG8_STAGE_B(PG8_SB(0, 0), cB); PG8_STAGE_B(PG8_SB(0, 1), cB + hstepB); PG8_STAGE_A(PG8_SA(0, 0), cA); PG8_STAGE_A(PG8_SA(0, 1), cA + hstepA);
        if (wr == 1) PG8_BAR;
        PG8_WAIT_V(2); PG8_BAR;
        PG8_STAGE_B(PG8_SB(1, 0), cB + kstep); PG8_STAGE_A(PG8_SA(1, 0), cA + kstep); PG8_STAGE_B(PG8_SB(1, 1), cB + hstepB + kstep);
        PG8_WAIT_V(6); PG8_BAR;
    } else {
        PG8_STAGE_B(PG8_SB(0, 0), cB); PG8_STAGE_A(PG8_SA(0, 0), cA); PG8_STAGE_B(PG8_SB(0, 1), cB + hstepB); PG8_STAGE_A(PG8_SA(0, 1), cA + hstepA);
        if (wr == 1) PG8_BAR;
        PG8_WAIT_V(4); PG8_BAR;
        PG8_STAGE_B(PG8_SB(1, 0), cB + kstep); PG8_STAGE_A(PG8_SA(1, 0), cA + kstep); PG8_STAGE_B(PG8_SB(1, 1), cB + hstepB + kstep);
        PG8_WAIT_V(6); PG8_BAR;
    }
    for (;;) {
        const bool has_next = S.next(ui + 1, nxt);
        const char* nA = has_next ? (const char*)g.A + (size_t)nxt.pm * tstepA + (size_t)nxt.ka * 2 : cA; const char* nB = has_next ? (const char*)g.Bt + (size_t)nxt.pn * tstepB : cB;
        auto kbody = [&](const int t) __attribute__((always_inline)) {
            const bool last = (t == nt - 2);
            const char* a1 = cA + (size_t)(t + 1) * kstep;
            const char* a2 = last ? nA : cA + (size_t)(t + 2) * kstep; const char* b2 = last ? nB : cB + (size_t)(t + 2) * kstep;
            const char* a3 = a2 + kstep; const char* b3 = b2 + kstep;
            if (last && has_next) S.a_ready(nxt);
            if constexpr (SP2) {
            PG8_LDB(B0, 0, 0); PG8_LDB(B1, 0, 1); PG8_SCHED; PG8_LDA(At, 0, 0); PG8_STAGE_A(PG8_SA(1, 1), a1 + hstepA);
            PG8_WAIT_V(8); PG8_WAIT_L(0); PG8_BAR; PG8_MMA(0, 0, At, B0); PG8_MMA(0, 1, At, B1); PG8_BAR; PG8_SCHED;
            PG8_LDA(At, 0, 1); PG8_STAGE_B(PG8_SB(0, 0), b2); PG8_STAGE_B(PG8_SB(0, 1), b2 + hstepB); PG8_STAGE_A(PG8_SA(0, 0), a2);
            PG8_WAIT_V(8); PG8_WAIT_L(0); PG8_BAR; PG8_MMA(1, 0, At, B0); PG8_MMA(1, 1, At, B1); PG8_BAR; PG8_SCHED;
            PG8_LDB(B0, 1, 0); PG8_LDB(B1, 1, 1); PG8_SCHED; PG8_LDA(At, 1, 0); PG8_STAGE_A(PG8_SA(0, 1), a2 + hstepA);
            PG8_WAIT_V(8); PG8_WAIT_L(0); PG8_BAR; PG8_MMA(0, 0, At, B0); PG8_MMA(0, 1, At, B1); PG8_BAR; PG8_SCHED;
            PG8_LDA(At, 1, 1); PG8_STAGE_B(PG8_SB(1, 0), b3); PG8_STAGE_B(PG8_SB(1, 1), b3 + hstepB); PG8_STAGE_A(PG8_SA(1, 0), a3);
            PG8_WAIT_V(8); PG8_WAIT_L(0); PG8_BAR; PG8_MMA(1, 0, At, B0); PG8_MMA(1, 1, At, B1); PG8_BAR; PG8_SCHED;
            } else {
            PG8_LDB(B0, 0, 0); PG8_SCHED; PG8_LDA(At, 0, 0); PG8_STAGE_A(PG8_SA(1, 1), a1 + hstepA);
            PG8_WAIT_L(8); PG8_BAR; PG8_WAIT_L(0); PG8_MMA(0, 0, At, B0); PG8_BAR; PG8_SCHED;
            PG8_LDB(B1, 0, 1); PG8_STAGE_B(PG8_SB(0, 0), b2);
            PG8_BAR; PG8_WAIT_L(0); PG8_MMA(0, 1, At, B1); PG8_BAR;
            PG8_LDA(At, 0, 1); PG8_STAGE_A(PG8_SA(0, 0), a2);
            PG8_BAR; PG8_WAIT_L(0); PG8_MMA(1, 0, At, B0); PG8_BAR; PG8_SCHED;
            PG8_STAGE_B(PG8_SB(0, 1), b2 + hstepB);
            PG8_WAIT_V(6); PG8_BAR; PG8_MMA(1, 1, At, B1); PG8_BAR;
            PG8_LDB(B0, 1, 0); PG8_SCHED; PG8_LDA(At, 1, 0); PG8_STAGE_A(PG8_SA(0, 1), a2 + hstepA);
            PG8_WAIT_L(8); PG8_BAR; PG8_WAIT_L(0); PG8_MMA(0, 0, At, B0); PG8_BAR; PG8_SCHED;
            PG8_LDB(B1, 1, 1); PG8_STAGE_B(PG8_SB(1, 0), b3);
            PG8_BAR; PG8_WAIT_L(0); PG8_MMA(0, 1, At, B1); PG8_BAR;
            PG8_LDA(At, 1, 1); PG8_STAGE_A(PG8_SA(1, 0), a3);
            PG8_BAR; PG8_WAIT_L(0); PG8_MMA(1, 0, At, B0); PG8_BAR; PG8_SCHED;
            PG8_STAGE_B(PG8_SB(1, 1), b3 + hstepB);
            PG8_WAIT_V(6); PG8_BAR; PG8_MMA(1, 1, At, B1); PG8_BAR;
            }
        };
        if constexpr (Epi::MIDK > 0) {
#pragma unroll 1
            for (int t0 = 0; t0 < nt; t0 += Epi::MIDK) { if (t0 > 0) E.mid(acc, cur, t0 / Epi::MIDK - 1, wr, wc, fr, fq);
#pragma unroll 1
                for (int t = t0; t < t0 + Epi::MIDK; t += 2) kbody(t); }
        } else {
            for (int t = 0; t < nt; t += 2) kbody(t);
        }
        if constexpr (ALIGN_EPI) { if (wr == 0) PG8_BAR; }
        if constexpr (!Epi::AFTER_DRAIN) { E(acc, cur, wr, wc, fr, fq); S.done(cur); }
        if (!has_next) break;
#pragma unroll
        for (int a = 0; a < 2; ++a)
#pragma unroll
            for (int b = 0; b < 2; ++b)
#pragma unroll
                for (int m = 0; m < 4; ++m)
#pragma unroll
                    for (int n = 0; n < 2; ++n) acc[a][b][m][n] = (f32x4){0.f, 0.f, 0.f, 0.f};
        cur = nxt; cA = nA; cB = nB; ++ui;
        if constexpr (ALIGN_EPI) { if (wr == 1) PG8_BAR; }
    }
    PG8_WAIT_V(0);
    if constexpr (!ALIGN_EPI) { if (wr == 0) PG8_BAR; }
    PG8_BAR;
    if constexpr (Epi::AFTER_DRAIN) { E.fused(acc, cur, wr, wc, fr, fq, lds, wid, lane); S.done(cur); }
#undef PG8_SA
#undef PG8_SB
#undef PG8_STAGE_X
#undef PG8_STAGE_A
#undef PG8_STAGE_B
#undef PG8_LDA
#undef PG8_LDB
#undef PG8_MMA
#undef PG8_WAIT_V
#undef PG8_WAIT_L
#undef PG8_BAR
#undef PG8_SCHED
}
#endif
}
#ifdef EMU
#define EPI_COORDS()
#else
#define EPI_COORDS() { const int t_ = TID(); const int w_ = RFL(t_ >> 6), l_ = t_ & 63; wr = w_ >> 2; wc = w_ & 3; fr = l_ & 15; fq = l_ >> 4; }
#endif
struct EpiInproj {
    static constexpr bool PERM = true, AFTER_DRAIN = false; static constexpr int MIDK = 0;
    bf16_t* O; int ldc; bf16_t* RHO; int gate_pn0;
    DM void operator()(const f32x4 (&acc)[2][2][4][2], const pg8::Unit& u, int wr, int wc, int fr, int fq) const {
        const int row0 = u.pm * 256 + wr * 64 + fr;
        if (u.pn < gate_pn0) { const int col0 = u.pn * 256 + wc * 32 + 8 * fq;
#pragma unroll
            for (int ai = 0; ai < 2; ++ai)
#pragma unroll
                for (int m = 0; m < 4; ++m) { bf16_t* rowp = O + (size_t)(row0 + ai * 128 + m * 16) * ldc + col0;
#pragma unroll
                    for (int bj = 0; bj < 2; ++bj) { const f32x4 v0 = acc[ai][bj][m][0], v1 = acc[ai][bj][m][1];
                        u32x4 w; w.x = pk2(v0[0], v0[1]); w.y = pk2(v0[2], v0[3]); w.z = pk2(v1[0], v1[1]); w.w = pk2(v1[2], v1[3]);
                        *(u32x4*)(rowp + bj * 128) = w; } }
        } else {
            const int T = u.pn - gate_pn0, pnc = T >> 2, bjc = (T & 3) >> 1, wcc = 2 * (T & 1) + (wc >> 1), fqc = fq, nc = wc & 1;
            bf16_t* base = RHO + ((((size_t)u.pm * (D / 256) + pnc) * 4) * 8 + (wr * 4 + wcc)) * (size_t)(16 * 64 * 8) + bjc * 512 + (fqc * 16 + fr) * 8 + nc * 4;
            constexpr size_t SEG_STRIDE = (size_t)8 * 16 * 64 * 8;
#pragma unroll
            for (int ai = 0; ai < 2; ++ai)
#pragma unroll
                for (int m = 0; m < 4; ++m) { bf16_t* rp = base + (ai * 4 + m) * 1024; float r0[4], r1[4], r2[4], r3[4];
#pragma unroll
                    for (int e = 0; e < 4; ++e) { const float d0 = 1.f + fexp(-acc[ai][0][m][0][e]), d1 = 1.f + fexp(-acc[ai][0][m][1][e]), d2 = 1.f + fexp(-acc[ai][1][m][0][e]), d3 = 1.f + fexp(-acc[ai][1][m][1][e]);
                        const float i0 = frcp(d0), i1 = frcp(d1), i2 = frcp(d2), i3 = frcp(d3);
                        r0[e] = d1 * i0; r1[e] = d2 * i1; r2[e] = d3 * i2; r3[e] = i3; }
                    u32x2 w; w.x = pk2(r0[0], r0[1]); w.y = pk2(r0[2], r0[3]); *(u32x2*)(rp) = w; w.x = pk2(r1[0], r1[1]); w.y = pk2(r1[2], r1[3]); *(u32x2*)(rp + SEG_STRIDE) = w;
                    w.x = pk2(r2[0], r2[1]); w.y = pk2(r2[2], r2[3]); *(u32x2*)(rp + 2 * SEG_STRIDE) = w; w.x = pk2(r3[0], r3[1]); w.y = pk2(r3[2], r3[3]); *(u32x2*)(rp + 3 * SEG_STRIDE) = w; } }
    }
};
struct EpiGateP {
    static constexpr bool PERM = false, AFTER_DRAIN = false; static constexpr int MIDK = 0;
    bf16_t* O; int ldc; const bf16_t* SG;
    DM void operator()(const f32x4 (&acc)[2][2][4][2], const pg8::Unit& u, int wr, int wc, int fr, int fq) const {
        const int n = u.pn / (D / 256), pnc = u.pn % (D / 256);
        const u32x4* base = (const u32x4*)(SG + ((((size_t)u.pm * (D / 256) + pnc) * 4 + n) * 8 + (wr * 4 + wc)) * (size_t)(16 * 64 * 8)) + (fq * 16 + fr);
        const int row0 = u.pm * 256 + wr * 64 + fr, col0 = u.pn * 256 + wc * 32 + 4 * fq;
#pragma unroll
        for (int ai = 0; ai < 2; ++ai)
#pragma unroll
            for (int m = 0; m < 4; ++m) { bf16_t* rowp = O + (size_t)(row0 + ai * 128 + m * 16) * ldc + col0;
#pragma unroll
                for (int bj = 0; bj < 2; ++bj) { const u32x4 g = base[((ai * 4 + m) * 2 + bj) * 64]; const f32x4 v0 = acc[ai][bj][m][0], v1 = acc[ai][bj][m][1];
                    u32x2 w0, w1; w0.x = pk2(v0[0] * bflo(g.x), v0[1] * bfhi(g.x)); w0.y = pk2(v0[2] * bflo(g.y), v0[3] * bfhi(g.y)); w1.x = pk2(v1[0] * bflo(g.z), v1[1] * bfhi(g.z)); w1.y = pk2(v1[2] * bflo(g.w), v1[3] * bfhi(g.w));
                    *(u32x2*)(rowp + bj * 128) = w0; *(u32x2*)(rowp + bj * 128 + 16) = w1; } }
    }
};
struct EpiMerged {
    static constexpr bool PERM = false, AFTER_DRAIN = false; static constexpr int MIDK = MIX / 64;
    bf16_t* O; int ldc; const bf16_t* RHO;
    DM void mid(f32x4 (&acc)[2][2][4][2], const pg8::Unit& u, int seg, int wr, int wc, int fr, int fq) const {
        EPI_COORDS();
        const u32x4* base = (const u32x4*)(RHO + ((((size_t)u.pm * (D / 256) + u.pn) * 4 + seg) * 8 + (wr * 4 + wc)) * (size_t)(16 * 64 * 8)) + (fq * 16 + fr);
#pragma unroll
        for (int q = 0; q < 2; ++q) { u32x4 gv[8];
#pragma unroll
            for (int i = 0; i < 8; ++i) gv[i] = base[(q * 8 + i) * 64];
#pragma unroll
            for (int i = 0; i < 8; ++i) { const int idx = q * 8 + i, ai = idx >> 3, m = (idx >> 1) & 3, bj = idx & 1; const u32x4 g = gv[i];
                acc[ai][bj][m][0] = acc[ai][bj][m][0] * (f32x4){bflo(g.x), bfhi(g.x), bflo(g.y), bfhi(g.y)}; acc[ai][bj][m][1] = acc[ai][bj][m][1] * (f32x4){bflo(g.z), bfhi(g.z), bflo(g.w), bfhi(g.w)}; }
            SCHED_FENCE(); }
    }
    DM void operator()(const f32x4 (&acc)[2][2][4][2], const pg8::Unit& u, int wr, int wc, int fr, int fq) const {
        EPI_COORDS();
        const u32x4* base = (const u32x4*)(RHO + ((((size_t)u.pm * (D / 256) + u.pn) * 4 + 3) * 8 + (wr * 4 + wc)) * (size_t)(16 * 64 * 8)) + (fq * 16 + fr);
        const int row0 = u.pm * 256 + wr * 64 + fr, col0 = u.pn * 256 + wc * 32 + 4 * fq;
#pragma unroll
        for (int ai = 0; ai < 2; ++ai)
#pragma unroll
            for (int m = 0; m < 4; ++m) { bf16_t* rowp = O + (size_t)(row0 + ai * 128 + m * 16) * ldc + col0;
#pragma unroll
                for (int bj = 0; bj < 2; ++bj) { const u32x4 g = base[((ai * 4 + m) * 2 + bj) * 64]; const f32x4 v0 = acc[ai][bj][m][0], v1 = acc[ai][bj][m][1];
                    u32x2 w0, w1; w0.x = pk2(v0[0] * bflo(g.x), v0[1] * bfhi(g.x)); w0.y = pk2(v0[2] * bflo(g.y), v0[3] * bfhi(g.y)); w1.x = pk2(v1[0] * bflo(g.z), v1[1] * bfhi(g.z)); w1.y = pk2(v1[2] * bflo(g.w), v1[3] * bfhi(g.w));
                    *(u32x2*)(rowp + bj * 128) = w0; *(u32x2*)(rowp + bj * 128 + 16) = w1; } }
    }
};
struct EpiF32 {
    static constexpr bool PERM = false, AFTER_DRAIN = false; static constexpr int MIDK = 0;
    float* O; int ldc;
    DM void operator()(const f32x4 (&acc)[2][2][4][2], const pg8::Unit& u, int wr, int wc, int fr, int fq) const {
        const int row0 = u.pm * 256 + wr * 64 + fr, col0 = u.pn * 256 + wc * 32 + 4 * fq;
#pragma unroll
        for (int ai = 0; ai < 2; ++ai)
#pragma unroll
            for (int m = 0; m < 4; ++m) { float* rowp = O + (size_t)(row0 + ai * 128 + m * 16) * ldc + col0;
#pragma unroll
                for (int bj = 0; bj < 2; ++bj)
#pragma unroll
                    for (int n = 0; n < 2; ++n) *(f32x4*)(rowp + bj * 128 + n * 16) = acc[ai][bj][m][n]; }
    }
};

#ifdef EMU
template <class Epi> static void emu_gemm(const pg8::Gemm g, const Epi& E, int ka_div = 0, int ka_mul = 0) {
    if (g.M % 256 || g.N % 256) { printf("emu_gemm: M %d N %d not multiples of 256\n", g.M, g.N); exit(1); }
    std::vector<float> C((size_t)256 * 256);
    const int seglen = (Epi::MIDK > 0) ? Epi::MIDK * 64 : g.K, nseg = g.K / seglen;
    for (int pm = 0; pm < g.M / 256; ++pm) for (int pn = 0; pn < g.N / 256; ++pn) {
        pg8::Unit u{pm, pn, 0};
        std::fill(C.begin(), C.end(), 0.f);
        for (int sg = 0; sg < nseg; ++sg) {
            for (int i = 0; i < 256; ++i) for (int j = 0; j < 256; ++j) { float a = 0.f; const bf16_t* ar = g.A + (size_t)(pm * 256 + i) * g.lda + sg * seglen + (ka_div ? (pn / ka_div) * ka_mul : 0); const bf16_t* br = g.Bt + (size_t)(pn * 256 + j) * g.ldb + sg * seglen;
                for (int k = 0; k < seglen; ++k) a += bf2f(ar[k]) * bf2f(br[k]); C[(size_t)i * 256 + j] += a; }
            const bool fin = (sg == nseg - 1);
            for (int wid = 0; wid < 8; ++wid) for (int lane = 0; lane < 64; ++lane) { const int wr = wid >> 2, wc = wid & 3, fr = lane & 15, fq = lane >> 4;
                f32x4 acc[2][2][4][2];
                for (int ai = 0; ai < 2; ++ai) for (int bj = 0; bj < 2; ++bj) for (int m = 0; m < 4; ++m) for (int n = 0; n < 2; ++n) for (int e = 0; e < 4; ++e) {
                    const int r = 128 * ai + 64 * wr + 16 * m + fr; const int c = Epi::PERM ? (128 * bj + 32 * wc + 8 * fq + 4 * n + e) : (128 * bj + 32 * wc + 16 * n + 4 * fq + e);
                    acc[ai][bj][m][n][e] = C[(size_t)r * 256 + c]; }
                if (fin) E(acc, u, wr, wc, fr, fq);
                else { if constexpr (Epi::MIDK > 0) E.mid(acc, u, sg, wr, wc, fr, fq);
                    for (int ai = 0; ai < 2; ++ai) for (int bj = 0; bj < 2; ++bj) for (int m = 0; m < 4; ++m) for (int n = 0; n < 2; ++n) for (int e = 0; e < 4; ++e) {
                        const int r = 128 * ai + 64 * wr + 16 * m + fr; const int c = Epi::PERM ? (128 * bj + 32 * wc + 8 * fq + 4 * n + e) : (128 * bj + 32 * wc + 16 * n + 4 * fq + e);
                        C[(size_t)r * 256 + c] = acc[ai][bj][m][n][e]; } } }
        }
    }
}
#endif
DI int gate_row(int sc) { const int n = sc / D, j = sc % D, jl = j & 63; return CG0 + 256 * (j >> 6) + 128 * (n >> 1) + 32 * (jl >> 4) + 8 * ((jl >> 2) & 3) + 4 * (n & 1) + (jl & 3); }
template <bool GATE> DI void transpose_item(const float* W, int N, bf16_t* dst, size_t ld_dst, int row_off, int col_off, LAS float* scr, int kb, int nb, int lane) {
    const int k0 = 64 * kb, n0 = 32 * nb;
#pragma unroll 8
    for (int i = 0; i < 32; ++i) { const int kk = 2 * i + (lane >> 5); scr[kk * 33 + (lane & 31)] = W[(size_t)(k0 + kk) * N + n0 + (lane & 31)]; }
    WAVE_SYNC();
    const int c = lane & 7;
#pragma unroll
    for (int j = 0; j < 4; ++j) { const int n = (lane >> 3) + 8 * j; const LAS float* s = scr + (8 * c) * 33 + n;
        u32x4 o; o.x = pk2(s[0 * 33], s[1 * 33]); o.y = pk2(s[2 * 33], s[3 * 33]); o.z = pk2(s[4 * 33], s[5 * 33]); o.w = pk2(s[6 * 33], s[7 * 33]);
        const int drow = GATE ? gate_row(n0 + n - C_MG) : (row_off + n0 + n);
        *(u32x4*)(dst + (size_t)drow * ld_dst + col_off + k0 + 8 * c) = o; }
    WAVE_SYNC();
}
__device__ const unsigned char T5_THR[15] = {19, 21, 24, 27, 31, 35, 40, 46, 52, 59, 67, 77, 87, 99, 113};
DI int t5_bucket(int n) { if (n < 16) return n; int b = 16;
#pragma unroll
    for (int i = 0; i < 15; ++i) b += (n >= (int)T5_THR[i]) ? 1 : 0;
    return b; }

DI void phase_prologue(KP p, lptr lds) {
    const int tid = TID(), lane = tid & 63, wave = tid >> 6;
    const int gw = blockIdx.x * 8 + wave, NGW = gridDim.x * 8;
    const size_t gt = (size_t)blockIdx.x * 512 + tid, NGT = (size_t)gridDim.x * 512;
    LAS float* scr = (LAS float*)(lds + wave * 8704);
    bf16_t* WIN = (bf16_t*)(p->ws + WS_WIN); bf16_t* WBR = (bf16_t*)(p->ws + WS_WBR); bf16_t* WOUT = (bf16_t*)(p->ws + WS_WOUT);
    constexpr int NI_IN = (D / 64) * (IN_COLS / 32), NI_V1 = (D / 64) * 1, NI_BR = (MIX / 64) * (D / 32), NI_OUT = (D / 64) * (D / 32);
    constexpr int PER_L = NI_IN + NI_V1 + 4 * NI_BR + NI_OUT;
    for (int it = gw; it < L * PER_L; it += NGW) {
        const int l = it / PER_L; int r = it % PER_L;
        if (r < NI_IN) { const int nblk = IN_COLS / 32, nb = r % nblk; const float* src = p->in[I_WIN] + (size_t)l * D * IN_COLS; bf16_t* dstw = WIN + (size_t)l * NP * D;
            if (32 * nb >= C_MG) transpose_item<true>(src, IN_COLS, dstw, D, 0, 0, scr, r / nblk, nb, lane); else transpose_item<false>(src, IN_COLS, dstw, D, 0, 0, scr, r / nblk, nb, lane); continue; } r -= NI_IN;
        if (r < NI_V1) { if (l > 0) transpose_item<false>(p->in[I_V1] + (size_t)(l - 1) * D * 32, 32, WIN + (size_t)l * NP * D, D, C_VD, 0, scr, r, 0, lane); continue; } r -= NI_V1;
        if (r < 4 * NI_BR) { const int n = r / NI_BR, rr = r % NI_BR, nblk = D / 32;
            transpose_item<false>(p->in[I_WBR] + ((size_t)l * 4 + n) * MIX * D, D, WBR + (size_t)l * D * 4 * MIX, 4 * MIX, 0, n * MIX, scr, rr / nblk, rr % nblk, lane); continue; } r -= 4 * NI_BR;
        { const int nblk = D / 32; transpose_item<false>(p->in[I_WOUT] + (size_t)l * D * D, D, WOUT + (size_t)l * D * D, D, 0, 0, scr, r / nblk, r % nblk, lane); }
    }
    for (int l = 0; l < L; ++l) { const int r0 = (l == 0) ? C_VD : C_VD + 32; const size_t n8 = (size_t)(CG0 - r0) * D / 8; u32x4* dst = (u32x4*)(WIN + ((size_t)l * NP + r0) * D);
        for (size_t i = gt; i < n8; i += NGT) dst[i] = (u32x4){0u, 0u, 0u, 0u}; }
    { const f32x4* x4 = (const f32x4*)p->in[I_X]; u32x2* xn = (u32x2*)(p->ws + WS_XN);
      for (size_t i = gt; i < (size_t)M * D / 4; i += NGT) { const f32x4 v = x4[i]; u32x2 o; o.x = pk2(v[0], v[1]); o.y = pk2(v[2], v[3]); xn[i] = o; } }
    { bf16_t* W2T = (bf16_t*)(p->ws + SM_W2T); bf16_t* A2T = (bf16_t*)(p->ws + SM_A2T); bf16_t* V2T = (bf16_t*)(p->ws + SM_V2T);
      for (size_t i = gt; i < (size_t)L * MIX * 64; i += NGT) { const int j = (int)(i % 64); const int c = (int)((i / 64) % MIX); const int l = (int)(i / ((size_t)64 * MIX));
          W2T[i] = f2bf(p->in[I_W2][((size_t)l * 64 + j) * MIX + c]); A2T[i] = f2bf(p->in[I_A2][((size_t)l * 64 + j) * MIX + c]); }
      for (size_t i = gt; i < (size_t)L * MIX * 32; i += NGT) { const int j = (int)(i % 32); const int c = (int)((i / 32) % MIX); const int l = (int)(i / ((size_t)32 * MIX));
          V2T[i] = (l > 0) ? f2bf(p->in[I_V2][((size_t)(l - 1) * 32 + j) * MIX + c]) : (bf16_t)0; } }
    if (blockIdx.x == 0) {
        float* LAM = (float*)(p->ws + SM_LAM); float* LB = (float*)(p->ws + SM_LB); float* BT = (float*)(p->ws + SM_BT);
        if (tid < L) { const float* lm = p->in[I_LAM] + (size_t)tid * 256; float s1 = 0.f, s2 = 0.f;
            for (int i = 0; i < 64; ++i) { s1 += lm[i] * lm[64 + i]; s2 += lm[128 + i] * lm[192 + i]; }
            const float li = 0.8f - 0.6f * expf(-0.3f * (float)tid); LAM[tid] = expf(s1) - expf(s2) + li; LAM[L + tid] = li; }
        for (int c = tid; c < MIX; c += 512) { float mx = -1e30f; for (int l = 0; l < L; ++l) mx = fmaxf(mx, p->in[I_HGLOW][(size_t)l * MIX + c]);
            float den = 0.f; for (int l = 0; l < L; ++l) den += expf(p->in[I_HGLOW][(size_t)l * MIX + c] - mx);
            float cum = 0.f; for (int l = 0; l < L; ++l) { if (l > 0) cum += expf(p->in[I_HGLOW][(size_t)l * MIX + c] - mx) / den;
                LB[(size_t)l * MIX + c] = cum; LB[(size_t)(L + l) * MIX + c] = (l > 0) ? logf(cum) : -1e30f; LB[(size_t)(2 * L + l) * MIX + c] = log1pf(-cum); } }
        for (int i = tid; i < AH * 132; i += 512) { const int h = i / 132, d = i % 132; const int bk = (d >= 128) ? 31 : t5_bucket(d); BT[i] = p->in[I_REL][bk * AH + h] * LOG2E; }
    }
}
constexpr int ATT_KSTR = 272, ATT_VSTR = 320;
constexpr int ATT_K_OFF = 0, ATT_V_OFF = 64 * ATT_KSTR, ATT_BUF = ATT_V_OFF + 64 * ATT_VSTR, ATT_BT_OFF = 2 * ATT_BUF, ATT_X_OFF = 0;
struct KVRegs { u32x4 k[2], v[2]; };
DI void load_kv(KVRegs& rg, const bf16_t* Z, size_t row0, int kcol, int vcol, int tid) {
#pragma unroll
    for (int i = 0; i < 2; ++i) { const int pc = tid + 512 * i, row = pc >> 4, c16 = pc & 15;
        rg.k[i] = *(const u32x4*)(Z + (row0 + row) * ZLD + kcol + c16 * 8);
        rg.v[i] = *(const u32x4*)(Z + (row0 + row) * ZLD + vcol + c16 * 8); }
}
DI void store_kv(const KVRegs& rg, lptr lds, int tid) {
#pragma unroll
    for (int i = 0; i < 2; ++i) { const int pc = tid + 512 * i, row = pc >> 4, c16 = pc & 15;
        *(LAS u32x4*)(lds + ATT_K_OFF + row * ATT_KSTR + c16 * 16) = rg.k[i];
        *(LAS u32x4*)(lds + ATT_V_OFF + row * ATT_VSTR + c16 * 16) = rg.v[i]; }
}
DI void pv_acc(f32x16 (&o)[4], const f32x16& pt, lptr lds, int kh, int lane) {
    const int hh = lane >> 5, gsub = (lane >> 4) & 1, i16 = lane & 15, qq = i16 >> 2, pp = i16 & 3;
    bf16x8 vf[2][4];
#pragma unroll
    for (int s = 0; s < 2; ++s) { const lptr vrow = lds + ATT_V_OFF + (32 * kh + 16 * s + 4 * hh + qq) * ATT_VSTR + gsub * 32 + pp * 8;
#pragma unroll
        for (int db = 0; db < 4; ++db) vf[s][db] = cat4(TR_READ(vrow + db * 64), TR_READ(vrow + 8 * ATT_VSTR + db * 64)); }
    const bf16x8 pb0 = pack8(pt[0], pt[1], pt[2], pt[3], pt[4], pt[5], pt[6], pt[7]), pb1 = pack8(pt[8], pt[9], pt[10], pt[11], pt[12], pt[13], pt[14], pt[15]);
    SCHED_FENCE();
#pragma unroll
    for (int db = 0; db < 4; ++db) o[db] = MFMA32(vf[0][db], pb0, o[db]);
#pragma unroll
    for (int db = 0; db < 4; ++db) o[db] = MFMA32(vf[1][db], pb1, o[db]);
}
DI void phase_att_a(KP p, int layer, lptr lds, int unit) {
    const int tid = TID(), lane = tid & 63, wid = RFL(tid >> 6), r = lane & 31, hh = lane >> 5;
    constexpr int NQB = S / 128;
    const int qb = NQB - 1 - (unit / (NB * AH)), bh = unit % (NB * AH), h = bh % AH, b = bh / AH;
    const int mp = wid & 1, qs = wid >> 1, q0 = qb * 128, qw0 = q0 + 32 * qs, q = qw0 + r;
    const bf16_t* Z = (const bf16_t*)(p->ws + WS_Z); const size_t rowb = (size_t)b * S;
    const float* LAM = (const float*)(p->ws + SM_LAM); const float lam_full = LAM[layer], lam_init = LAM[L + layer];
    LAS float* BT = (LAS float*)(lds + ATT_BT_OFF);
    __syncthreads();
    if (tid < 132) BT[tid] = ((const float*)(p->ws + SM_BT))[h * 132 + tid];
    bf16x8 qf[4];
    { const bf16_t* qp = Z + (rowb + q) * ZLD + C_AQ + h * 128 + mp * 64 + 8 * hh; const float qsc = 0.125f * LOG2E;
#pragma unroll
      for (int ds = 0; ds < 4; ++ds) { const u32x4 w = *(const u32x4*)(qp + 16 * ds);
          qf[ds] = pack8(bflo(w.x) * qsc, bfhi(w.x) * qsc, bflo(w.y) * qsc, bfhi(w.y) * qsc, bflo(w.z) * qsc, bfhi(w.z) * qsc, bflo(w.w) * qsc, bfhi(w.w) * qsc); } }
    f32x16 o[4];
#pragma unroll
    for (int db = 0; db < 4; ++db)
#pragma unroll
        for (int i = 0; i < 16; ++i) o[db][i] = 0.f;
    float mrun = -INFINITY, lrun = 0.f;
    const int nkt = (q0 + 128) / 64;
    KVRegs rg; load_kv(rg, Z, rowb, C_AK + h * 128, C_AV + h * 128, tid);
    store_kv(rg, lds, tid);
    if (nkt > 1) load_kv(rg, Z, rowb + 64, C_AK + h * 128, C_AV + h * 128, tid);
    __syncthreads();
    for (int kt = 0; kt < nkt; ++kt) {
        const int k0 = kt * 64; const lptr buf = lds + (kt & 1) * ATT_BUF;
        if (kt + 1 < nkt) store_kv(rg, lds + ((kt + 1) & 1) * ATT_BUF, tid);
        if (kt + 2 < nkt) load_kv(rg, Z, rowb + k0 + 128, C_AK + h * 128, C_AV + h * 128, tid);
        if (k0 <= qw0 + 31) {
            const bool two = (k0 + 32 <= qw0 + 31);
            const bool far = (qw0 - (k0 + 63) >= 128);
            const float cinit = far ? BT[128] : 0.f;
            f32x16 sc0, sc1;
#pragma unroll
            for (int i = 0; i < 16; ++i) { sc0[i] = cinit; sc1[i] = cinit; }
            { bf16x8 kf0[4], kf1[4];
#pragma unroll
              for (int ds = 0; ds < 4; ++ds) { kf0[ds] = *(const LAS bf16x8*)(buf + ATT_K_OFF + r * ATT_KSTR + mp * 128 + ds * 32 + hh * 16); kf1[ds] = *(const LAS bf16x8*)(buf + ATT_K_OFF + (32 + r) * ATT_KSTR + mp * 128 + ds * 32 + hh * 16); }
              SCHED_FENCE();
#pragma unroll
              for (int ds = 0; ds < 4; ++ds) { sc0 = MFMA32(kf0[ds], qf[ds], sc0); if (two) sc1 = MFMA32(kf1[ds], qf[ds], sc1); } }
            if (!far) {
#pragma unroll
                for (int i = 0; i < 16; ++i) { const int d0 = q - (k0 + crow(i, hh)), d1 = d0 - 32; const int i0 = d0 < 0 ? 0 : (d0 > 128 ? 128 : d0), i1 = d1 < 0 ? 0 : (d1 > 128 ? 128 : d1);
                    sc0[i] = (d0 < 0) ? -INFINITY : sc0[i] + BT[i0]; sc1[i] = (d1 < 0 || !two) ? -INFINITY : sc1[i] + BT[i1]; }
            }
            float mx = fmaxf(sc0[0], sc1[0]);
#pragma unroll
            for (int i = 1; i < 16; ++i) mx = fmaxf(mx, fmaxf(sc0[i], sc1[i]));
            mx = fmaxf(mx, __shfl_xor(mx, 32));
            if (ANY(mx > mrun + 6.f)) { const float mnew = fmaxf(mrun, mx), alpha = ex2(mrun - mnew); lrun *= alpha; mrun = mnew;
#pragma unroll
                for (int db = 0; db < 4; ++db)
#pragma unroll
                    for (int i = 0; i < 16; ++i) o[db][i] *= alpha; }
            float sum = 0.f;
#pragma unroll
            for (int i = 0; i < 16; ++i) { const float e0 = ex2(sc0[i] - mrun), e1 = ex2(sc1[i] - mrun); sc0[i] = e0; sc1[i] = e1; sum += e0 + e1; }
            sum += __shfl_xor(sum, 32);
            lrun += sum;
            pv_acc(o, sc0, buf, 0, lane); if (two) pv_acc(o, sc1, buf, 1, lane);
        }
        __syncthreads();
    }
    __syncthreads();
    const float inv = 1.f / lrun;
    LAS float* X = (LAS float*)(lds + ATT_X_OFF) + (qs * 32 + r) * 132;
    if (mp == 1) {
#pragma unroll
        for (int db = 0; db < 4; ++db)
#pragma unroll
            for (int g = 0; g < 4; ++g) { f32x4 v; v[0] = o[db][4 * g] * inv * lam_full; v[1] = o[db][4 * g + 1] * inv * lam_full; v[2] = o[db][4 * g + 2] * inv * lam_full; v[3] = o[db][4 * g + 3] * inv * lam_full;
                *(LAS f32x4*)(X + 32 * db + 8 * g + 4 * hh) = v; }
    }
    __syncthreads();
    if (mp == 0) {
        float ss = 0.f;
#pragma unroll
        for (int db = 0; db < 4; ++db)
#pragma unroll
            for (int g = 0; g < 4; ++g) { const f32x4 x1 = *(const LAS f32x4*)(X + 32 * db + 8 * g + 4 * hh);
#pragma unroll
                for (int e = 0; e < 4; ++e) { const float x = o[db][4 * g + e] * inv - x1[e]; o[db][4 * g + e] = x; ss += x * x; } }
        ss += __shfl_xor(ss, 32);
        const float rinv = frsq(ss * (1.f / 128.f) + RMS_EPS) * (1.f - lam_init);
        const float* sg = p->in[I_SUBLN] + (size_t)layer * 128;
        const bf16_t* gp = Z + (rowb + q) * ZLD + C_AG + h * 128; bf16_t* yp = (bf16_t*)(p->ws + WS_Y) + (rowb + q) * (4 * MIX) + 0 * MIX + h * 128;
#pragma unroll
        for (int db = 0; db < 4; ++db)
#pragma unroll
            for (int g = 0; g < 4; ++g) { const int d = 32 * db + 8 * g + 4 * hh; const u32x2 gw = *(const u32x2*)(gp + d); const f32x4 sv = *(const f32x4*)(sg + d);
                u32x2 w; w.x = pk2(o[db][4 * g] * rinv * sv[0] * fsilu(bflo(gw.x)), o[db][4 * g + 1] * rinv * sv[1] * fsilu(bfhi(gw.x)));
                w.y = pk2(o[db][4 * g + 2] * rinv * sv[2] * fsilu(bflo(gw.y)), o[db][4 * g + 3] * rinv * sv[3] * fsilu(bfhi(gw.y)));
                *(u32x2*)(yp + d) = w; }
    }
}

constexpr float SB_CUT = -110.f;
DI void phase_att_d(KP p, int layer, lptr lds, int unit) {
    const int tid = TID(), lane = tid & 63, wid = RFL(tid >> 6), r = lane & 31, hh = lane >> 5;
    constexpr int NQB = S / 256;
    const int qb = NQB - 1 - (unit / (NB * SH)), bh = unit % (NB * SH), h = bh % SH, b = bh / SH;
    const int q0 = qb * 256, qw0 = q0 + 32 * wid, q = qw0 + r;
    const bf16_t* Z = (const bf16_t*)(p->ws + WS_Z); const size_t rowb = (size_t)b * S;
    LAS int* FLG = (LAS int*)(lds + ATT_BT_OFF);
    bf16x8 qf[8];
    { const bf16_t* qp = Z + (rowb + q) * ZLD + C_SQ + h * 128 + 8 * hh; const float qsc = 0.08838834764831845f;
#pragma unroll
      for (int ds = 0; ds < 8; ++ds) { const u32x4 w = *(const u32x4*)(qp + 16 * ds);
          qf[ds] = pack8(bflo(w.x) * qsc, bfhi(w.x) * qsc, bflo(w.y) * qsc, bfhi(w.y) * qsc, bflo(w.z) * qsc, bfhi(w.z) * qsc, bflo(w.w) * qsc, bfhi(w.w) * qsc); } }
    f32x16 o[4];
#pragma unroll
    for (int db = 0; db < 4; ++db)
#pragma unroll
        for (int i = 0; i < 16; ++i) o[db][i] = 0.f;
    float carry = 0.f;
    const int kt_hi = (q0 + 255) / 64;
    __syncthreads();
    KVRegs rg; load_kv(rg, Z, rowb + (size_t)kt_hi * 64, C_SK + h * 128, C_SV + h * 128, tid);
    store_kv(rg, lds + (kt_hi & 1) * ATT_BUF, tid);
    if (kt_hi > 0) load_kv(rg, Z, rowb + (size_t)(kt_hi - 1) * 64, C_SK + h * 128, C_SV + h * 128, tid);
    __syncthreads();
    for (int kt = kt_hi; kt >= 0; --kt) {
        const int k0 = kt * 64; const lptr buf = lds + (kt & 1) * ATT_BUF;
        if (kt > 0) store_kv(rg, lds + ((kt - 1) & 1) * ATT_BUF, tid);
        if (kt > 1) load_kv(rg, Z, rowb + k0 - 128, C_SK + h * 128, C_SV + h * 128, tid);
        if (k0 < qw0 + 31) {
#pragma unroll 1
            for (int kh = 1; kh >= 0; --kh) {
                if (k0 + 32 * kh >= qw0 + 31) continue;
                f32x16 z;
#pragma unroll
                for (int i = 0; i < 16; ++i) z[i] = 0.f;
                { bf16x8 kf[8];
#pragma unroll
                  for (int ds = 0; ds < 8; ++ds) kf[ds] = *(const LAS bf16x8*)(buf + ATT_K_OFF + (32 * kh + r) * ATT_KSTR + ds * 32 + hh * 16);
                  SCHED_FENCE();
#pragma unroll
                  for (int ds = 0; ds < 8; ++ds) z = MFMA32(kf[ds], qf[ds], z); }
                f32x16 lk; float gsum[4];
#pragma unroll
                for (int g = 0; g < 4; ++g) { gsum[g] = 0.f;
#pragma unroll
                    for (int e = 0; e < 4; ++e) { const int i = 4 * g + e; const bool valid = (k0 + 32 * kh + crow(i, hh)) < q; const float sp = fsoftplus(z[i]);
                        lk[i] = valid ? -sp : 0.f; z[i] = valid ? (z[i] - sp) : -INFINITY; gsum[g] += lk[i]; } }
                float og[4];
#pragma unroll
                for (int g = 0; g < 4; ++g) og[g] = __shfl_xor(gsum[g], 32);
                float suf[4]; float run = 0.f;
#pragma unroll
                for (int g = 3; g >= 0; --g) {
                    if (hh == 1) { suf[g] = run; run += gsum[g] + og[g]; }
                    else { suf[g] = run + og[g]; run += gsum[g] + og[g]; }
                }
#pragma unroll
                for (int g = 0; g < 4; ++g) { float inner = 0.f;
#pragma unroll
                    for (int e = 3; e >= 0; --e) { const int i = 4 * g + e; const float between = carry + suf[g] + inner; inner += lk[i]; z[i] = ex2((z[i] + between) * LOG2E); } }
                carry += run;
                pv_acc(o, z, buf, kh, lane);
            }
        }
        const int active = ANY(carry > SB_CUT) ? 1 : 0;
        if (lane == 0) FLG[(kt & 1) * 8 + wid] = active;
        __syncthreads();
        int anyact = 0;
#pragma unroll
        for (int w = 0; w < 8; ++w) anyact |= FLG[(kt & 1) * 8 + w];
        if (!anyact) break;
    }
    const bf16_t* gp = Z + (rowb + q) * ZLD + C_SG + h * 128; bf16_t* yp = (bf16_t*)(p->ws + WS_Y) + (rowb + q) * (4 * MIX) + 3 * MIX + h * 128;
#pragma unroll
    for (int db = 0; db < 4; ++db)
#pragma unroll
        for (int g = 0; g < 4; ++g) { const int d = 32 * db + 8 * g + 4 * hh; const u32x2 gw = *(const u32x2*)(gp + d);
            u32x2 w; w.x = pk2(o[db][4 * g] * fsilu(bflo(gw.x)), o[db][4 * g + 1] * fsilu(bfhi(gw.x)));
            w.y = pk2(o[db][4 * g + 2] * fsilu(bflo(gw.y)), o[db][4 * g + 3] * fsilu(bfhi(gw.y)));
            *(u32x2*)(yp + d) = w; }
}
constexpr int HG_STR = 144;
constexpr int HG_QT = 0, HG_KT = 128 * HG_STR, HG_IT = 2 * 128 * HG_STR, HG_SC = 3 * 128 * HG_STR, HG_VEC = HG_SC + 64 * HG_STR;
DI bf16x8 hg_trfrag(lptr img, int col0, int dbase, int lane) {
    const int g = lane >> 4, i16 = lane & 15, qq = i16 >> 2, pp = i16 & 3;
    const lptr a = img + (dbase + 4 * g + qq) * HG_STR + (col0 + 4 * pp) * 2;
    return cat4(TR_READ(a), TR_READ(a + 16 * HG_STR));
}
constexpr int HG_NC = S / 64, HG_NCH = NB * HH * HG_NC;
DI void phase_hg_local(KP p, int layer, lptr lds, int unit) {
    const int tid = TID(), lane = tid & 63, wid = RFL(tid >> 6), g = lane >> 4, c16 = lane & 15;
    const int c = unit % HG_NC, bh = unit / HG_NC, h = bh % HH, b = bh / HH;
    const bf16_t* Z = (const bf16_t*)(p->ws + WS_Z); const size_t row0 = (size_t)b * S + (size_t)c * 64;
    const float* LBp = (const float*)(p->ws + SM_LB);
    LAS float* EBD = (LAS float*)(lds + HG_VEC); LAS float* QTOT = EBD + 128;
    const int ch = tid & 127, tq = tid >> 7;
    const float lb = LBp[(size_t)layer * MIX + h * 128 + ch], loglb = LBp[(size_t)(L + layer) * MIX + h * 128 + ch], log1m = LBp[(size_t)(2 * L + layer) * MIX + h * 128 + ch];
    __syncthreads();
    constexpr int HG_ST = 73728, HG_STR2 = 784;
#pragma unroll
    for (int i = 0; i < 6; ++i) { const int pc = tid + 512 * i, row = pc / 48, c = pc % 48;
        *(LAS u32x4*)(lds + HG_ST + row * HG_STR2 + c * 16) = *(const u32x4*)(Z + (row0 + row) * ZLD + C_HQ + (c >> 4) * MIX + h * 128 + (c & 15) * 8); }
    __syncthreads();
    float bl[16], qv[16], kv[16], iv[16];
    { const lptr zp = lds + HG_ST + (16 * tq) * HG_STR2 + ch * 2; float run = 0.f;
#pragma unroll
      for (int t = 0; t < 16; ++t) { const float zq = bf2f(*(const LAS bf16_t*)(zp + t * HG_STR2)), zf = bf2f(*(const LAS bf16_t*)(zp + t * HG_STR2 + 256)); iv[t] = bf2f(*(const LAS bf16_t*)(zp + t * HG_STR2 + 512));
          const float ls = -fsoftplus(-zf);
          float lf; if (lb > 0.f) { const float a_ = loglb, b_ = log1m + ls, mx = fmaxf(a_, b_); lf = mx + flog(fexp(a_ - mx) + fexp(b_ - mx)); } else lf = ls;
          run += lf; bl[t] = run; qv[t] = zq; kv[t] = (1.f - lb) * fexp(ls - zf); }
      QTOT[tq * 128 + ch] = run; }
    __syncthreads();
    { const float t0 = QTOT[ch], t1 = QTOT[128 + ch], t2 = QTOT[256 + ch], t3 = QTOT[384 + ch];
      const float pre = (tq > 0 ? t0 : 0.f) + (tq > 1 ? t1 : 0.f) + (tq > 2 ? t2 : 0.f), bref = t0 + t1, blast = bref + t2 + t3;
      unsigned qw[8], kw[8], iw[8];
#pragma unroll
      for (int t = 0; t < 16; t += 2) { const float b0 = pre + bl[t] - bref, b1 = pre + bl[t + 1] - bref;
          const float c0 = fminf(fmaxf(b0, -80.f), 80.f), c1 = fminf(fmaxf(b1, -80.f), 80.f);
          qw[t >> 1] = pk2(qv[t] * fexp(c0), qv[t + 1] * fexp(c1)); kw[t >> 1] = pk2(kv[t] * fexp(-c0), kv[t + 1] * fexp(-c1)); iw[t >> 1] = pk2(iv[t], iv[t + 1]); }
      LAS u32x4* dq = (LAS u32x4*)(lds + HG_QT + ch * HG_STR + tq * 32); dq[0] = (u32x4){qw[0], qw[1], qw[2], qw[3]}; dq[1] = (u32x4){qw[4], qw[5], qw[6], qw[7]};
      LAS u32x4* dk = (LAS u32x4*)(lds + HG_KT + ch * HG_STR + tq * 32); dk[0] = (u32x4){kw[0], kw[1], kw[2], kw[3]}; dk[1] = (u32x4){kw[4], kw[5], kw[6], kw[7]};
      LAS u32x4* di = (LAS u32x4*)(lds + HG_IT + ch * HG_STR + tq * 32); di[0] = (u32x4){iw[0], iw[1], iw[2], iw[3]}; di[1] = (u32x4){iw[4], iw[5], iw[6], iw[7]};
      if (tq == 0) { float* VE = (float*)(p->ws + WS_HGVE) + (size_t)unit * 256; VE[ch] = fexp(fmaxf(bref, -80.f)); VE[128 + ch] = fexp(blast); EBD[ch] = fexp(fmaxf(blast - bref, -80.f)); } }
    __syncthreads();
#pragma unroll
    for (int k2 = 0; k2 < 2; ++k2) { const int ti = 2 * wid + k2, tb = ti >> 2, sb = ti & 3;
        f32x4 acc = (f32x4){0.f, 0.f, 0.f, 0.f};
        if (sb <= tb) {
#pragma unroll
            for (int dp = 0; dp < 4; ++dp) acc = MFMA16(hg_trfrag(lds + HG_QT, 16 * tb, 32 * dp, lane), hg_trfrag(lds + HG_KT, 16 * sb, 32 * dp, lane), acc); }
        const int s = 16 * sb + c16;
#pragma unroll
        for (int e = 0; e < 4; ++e) { const int t = 16 * tb + 4 * g + e; *(LAS bf16_t*)(lds + HG_SC + t * HG_STR + s * 2) = f2bf((s <= t) ? acc[e] : 0.f); }
        ((bf16x8*)(p->ws + WS_HGQF))[((size_t)unit * 16 + ti) * 64 + lane] = hg_trfrag(lds + HG_QT, 16 * (ti >> 2), 32 * (ti & 3), lane); }
    __syncthreads();
    bf16x8 ib[2];
#pragma unroll
    for (int ks = 0; ks < 2; ++ks) ib[ks] = *(const LAS bf16x8*)(lds + HG_IT + (16 * wid + c16) * HG_STR + (8 * g + 32 * ks) * 2);
    f32x4* IN = (f32x4*)(p->ws + WS_HGIN) + ((size_t)unit * 8 + wid) * 4 * 64;
#pragma unroll
    for (int tb = 0; tb < 4; ++tb) { f32x4 acc = (f32x4){0.f, 0.f, 0.f, 0.f};
#pragma unroll
        for (int ks = 0; ks < 2; ++ks) acc = MFMA16(*(const LAS bf16x8*)(lds + HG_SC + (16 * tb + c16) * HG_STR + (8 * g + 32 * ks) * 2), ib[ks], acc);
        IN[tb * 64 + lane] = acc; }
    f32x4* DS = (f32x4*)(p->ws + WS_HGDS) + ((size_t)unit * 8 + wid) * 8 * 64;
#pragma unroll
    for (int db = 0; db < 8; ++db) { f32x4 tmp = (f32x4){0.f, 0.f, 0.f, 0.f};
#pragma unroll
        for (int ks = 0; ks < 2; ++ks) tmp = MFMA16(*(const LAS bf16x8*)(lds + HG_KT + (16 * db + c16) * HG_STR + (8 * g + 32 * ks) * 2), ib[ks], tmp);
        const f32x4 ed = *(const LAS f32x4*)(EBD + 16 * db + 4 * g);
        DS[db * 64 + lane] = tmp * ed; }
}
DI void phase_hg_scan(KP p, int unit) {
    const int tid = TID(), lane = tid & 63, wid = RFL(tid >> 6), g = lane >> 4;
    f32x4 st[8];
#pragma unroll
    for (int db = 0; db < 8; ++db) st[db] = (f32x4){0.f, 0.f, 0.f, 0.f};
    const float* VE0 = (const float*)(p->ws + WS_HGVE) + (size_t)unit * HG_NC * 256;
    const f32x4* DS0 = (const f32x4*)(p->ws + WS_HGDS) + ((size_t)unit * HG_NC * 8 + wid) * 8 * 64 + lane;
    bf16x8* SF0 = (bf16x8*)(p->ws + WS_HGSF) + ((size_t)unit * HG_NC * 8 + wid) * 4 * 64 + lane;
    f32x4 ds[8], el[8], er[8];
#pragma unroll
    for (int db = 0; db < 8; ++db) { ds[db] = DS0[db * 64]; el[db] = *(const f32x4*)(VE0 + 128 + 16 * db + 4 * g); er[db] = *(const f32x4*)(VE0 + 16 * db + 4 * g); }
    for (int c = 0; c < HG_NC; ++c) {
        const int cn = (c + 1 < HG_NC) ? c + 1 : c;
        f32x4 dsn[8], eln[8], ern[8];
#pragma unroll
        for (int db = 0; db < 8; ++db) { dsn[db] = DS0[((size_t)cn * 8 * 8 + db) * 64]; eln[db] = *(const f32x4*)(VE0 + (size_t)cn * 256 + 128 + 16 * db + 4 * g); ern[db] = *(const f32x4*)(VE0 + (size_t)cn * 256 + 16 * db + 4 * g); }
#pragma unroll
        for (int dp = 0; dp < 4; ++dp) { const f32x4 a0 = st[2 * dp] * er[2 * dp], a1 = st[2 * dp + 1] * er[2 * dp + 1];
            SF0[((size_t)c * 8 * 4 + dp) * 64] = pack8(a0[0], a0[1], a0[2], a0[3], a1[0], a1[1], a1[2], a1[3]); }
#pragma unroll
        for (int db = 0; db < 8; ++db) { st[db] = el[db] * st[db] + ds[db]; ds[db] = dsn[db]; el[db] = eln[db]; er[db] = ern[db]; }
    }
}
DI void phase_hg_out(KP p, int layer, lptr lds, int unit) {
    const int tid = TID(), lane = tid & 63, wid = RFL(tid >> 6), g = lane >> 4, c16 = lane & 15;
    const int c = unit % HG_NC, bh = unit / HG_NC, h = bh % HH, b = bh / HH;
    const bf16_t* Z = (const bf16_t*)(p->ws + WS_Z); const size_t row0 = (size_t)b * S + (size_t)c * 64;
    const bf16x8* QF = (const bf16x8*)(p->ws + WS_HGQF) + (size_t)unit * 16 * 64 + lane;
    const bf16x8* SF = (const bf16x8*)(p->ws + WS_HGSF) + ((size_t)unit * 8 + wid) * 4 * 64 + lane;
    const f32x4* IN = (const f32x4*)(p->ws + WS_HGIN) + ((size_t)unit * 8 + wid) * 4 * 64 + lane;
    bf16x8 sf[4];
#pragma unroll
    for (int dp = 0; dp < 4; ++dp) sf[dp] = SF[dp * 64];
    f32x4 ot[4];
#pragma unroll
    for (int tb = 0; tb < 4; ++tb) { f32x4 acc = IN[tb * 64];
#pragma unroll
        for (int dp = 0; dp < 4; ++dp) acc = MFMA16(QF[(tb * 4 + dp) * 64], sf[dp], acc);
        ot[tb] = acc; }
    if (c == 0 && g == 0) { const float* OEX = (const float*)(p->ws + WS_OEX) + (size_t)bh * FX_T * 128 + 16 * wid + c16;
#pragma unroll
        for (int e = 0; e < FX_T; ++e) ot[0][e] = OEX[e * 128]; }
    LAS float* OT = (LAS float*)lds;
    __syncthreads();
#pragma unroll
    for (int tb = 0; tb < 4; ++tb)
#pragma unroll
        for (int e = 0; e < 4; ++e) OT[(16 * tb + 4 * g + e) * 132 + 16 * wid + c16] = ot[tb][e];
    __syncthreads();
    { const int t = tid >> 3, e0 = (tid & 7) * 16; float x[16]; float ss = 0.f;
#pragma unroll
      for (int q = 0; q < 4; ++q) { const f32x4 v = *(const LAS f32x4*)(OT + t * 132 + e0 + 4 * q); x[4 * q] = v[0]; x[4 * q + 1] = v[1]; x[4 * q + 2] = v[2]; x[4 * q + 3] = v[3]; ss += (v[0] * v[0] + v[1] * v[1]) + (v[2] * v[2] + v[3] * v[3]); }
      ss += __shfl_xor(ss, 1); ss += __shfl_xor(ss, 2); ss += __shfl_xor(ss, 4);
      const float rinv = frsq(ss * (1.f / 128.f) + RMS_EPS); const float* gn = p->in[I_HGNORM] + (size_t)layer * 128 + e0;
      const bf16_t* gp = Z + (row0 + t) * ZLD + C_HG + h * 128 + e0; bf16_t* yp = (bf16_t*)(p->ws + WS_Y) + (row0 + t) * (4 * MIX) + 1 * MIX + h * 128 + e0;
#pragma unroll
      for (int q = 0; q < 2; ++q) { const u32x4 gw = *(const u32x4*)(gp + 8 * q); const f32x4 n0 = *(const f32x4*)(gn + 8 * q), n1 = *(const f32x4*)(gn + 8 * q + 4); u32x4 w;
          w.x = pk2(x[8 * q] * rinv * n0[0] * fsilu(bflo(gw.x)), x[8 * q + 1] * rinv * n0[1] * fsilu(bfhi(gw.x))); w.y = pk2(x[8 * q + 2] * rinv * n0[2] * fsilu(bflo(gw.y)), x[8 * q + 3] * rinv * n0[3] * fsilu(bfhi(gw.y)));
          w.z = pk2(x[8 * q + 4] * rinv * n1[0] * fsilu(bflo(gw.z)), x[8 * q + 5] * rinv * n1[1] * fsilu(bfhi(gw.z))); w.w = pk2(x[8 * q + 6] * rinv * n1[2] * fsilu(bflo(gw.w)), x[8 * q + 7] * rinv * n1[3] * fsilu(bfhi(gw.w)));
          *(u32x4*)(yp + 8 * q) = w; } }
}
constexpr int RC_GT = 0, RC_SL = 8192, RC_RH = 16384, RC_OL = 18432, RC_GAM = 22528, RC_BYTES = 22784;
constexpr int RC_NSUB = S / 16;
DI bf16x8 frag4_lds(lptr p) { const u32x2 w = *(const LAS u32x2*)p; u32x4 o; o.x = w.x; o.y = w.y; o.z = 0u; o.w = 0u; return __builtin_bit_cast(bf16x8, o); }
DI bf16x8 frag4_acc(const f32x4& x) { u32x4 o; o.x = pk2(x[0], x[1]); o.y = pk2(x[2], x[3]); o.z = 0u; o.w = 0u; return __builtin_bit_cast(bf16x8, o); }
DI float gbf(const bf16_t* p) { return bf2f(*p); }
DI float ftanh(float x) { return 1.f - 2.f * frcp(1.f + fexp(2.f * x)); }
DI void rw_local_item(KP p, int layer, lptr wl, int item, int lane) {
    const int j = item % RC_NSUB, bh = item / RC_NSUB, hd = bh % RH, b = bh / RH, g = lane >> 4, c16 = lane & 15;
    const int t0 = 16 * j; const size_t m0 = (size_t)b * S + t0;
    unsigned char* rec = p->ws + WS_RC + (size_t)item * RC_BYTES;
    const bf16_t* Z = (const bf16_t*)(p->ws + WS_Z); const float* mu = p->in[I_MU] + (size_t)layer * RW_MIX;
    bf16x8 xw[2], xa[2], xv; xv = (bf16x8){0, 0, 0, 0, 0, 0, 0, 0};
    { const bf16_t* cur = Z + (m0 + c16) * ZLD; const bool hp = (t0 + c16) > 0; const bf16_t* prv = hp ? cur - ZLD : cur;
#pragma unroll
      for (int ks = 0; ks < 2; ++ks) { const int jj = 32 * ks + 8 * g;
          const u32x4 cw = *(const u32x4*)(cur + C_RM + 3 * MIX + jj), ca = *(const u32x4*)(cur + C_RM + 3 * MIX + 64 + jj); u32x4 pw = (u32x4){0u, 0u, 0u, 0u}, pa = pw;
          if (hp) { pw = *(const u32x4*)(prv + C_RM + 3 * MIX + jj); pa = *(const u32x4*)(prv + C_RM + 3 * MIX + 64 + jj); }
          const f32x4 m0v = *(const f32x4*)(mu + 3 * MIX + jj), m1v = *(const f32x4*)(mu + 3 * MIX + jj + 4), n0v = *(const f32x4*)(mu + 3 * MIX + 64 + jj), n1v = *(const f32x4*)(mu + 3 * MIX + 64 + jj + 4);
#define LRP(c, q, m) ((c) + ((q) - (c)) * (m))
          xw[ks] = pack8(ftanh(LRP(bflo(cw.x), bflo(pw.x), m0v[0])), ftanh(LRP(bfhi(cw.x), bfhi(pw.x), m0v[1])), ftanh(LRP(bflo(cw.y), bflo(pw.y), m0v[2])), ftanh(LRP(bfhi(cw.y), bfhi(pw.y), m0v[3])),
                         ftanh(LRP(bflo(cw.z), bflo(pw.z), m1v[0])), ftanh(LRP(bfhi(cw.z), bfhi(pw.z), m1v[1])), ftanh(LRP(bflo(cw.w), bflo(pw.w), m1v[2])), ftanh(LRP(bfhi(cw.w), bfhi(pw.w), m1v[3])));
          xa[ks] = pack8(LRP(bflo(ca.x), bflo(pa.x), n0v[0]), LRP(bfhi(ca.x), bfhi(pa.x), n0v[1]), LRP(bflo(ca.y), bflo(pa.y), n0v[2]), LRP(bfhi(ca.y), bfhi(pa.y), n0v[3]),
                         LRP(bflo(ca.z), bflo(pa.z), n1v[0]), LRP(bfhi(ca.z), bfhi(pa.z), n1v[1]), LRP(bflo(ca.w), bflo(pa.w), n1v[2]), LRP(bfhi(ca.w), bfhi(pa.w), n1v[3])); }
      if (layer > 0) { const float* vmu = p->in[I_VMU] + (size_t)(layer - 1) * 32 + 8 * g; const u32x4 cv = *(const u32x4*)(cur + C_VD + 8 * g); u32x4 pv = (u32x4){0u, 0u, 0u, 0u}; if (hp) pv = *(const u32x4*)(prv + C_VD + 8 * g);
          const f32x4 m0v = *(const f32x4*)vmu, m1v = *(const f32x4*)(vmu + 4);
          xv = pack8(LRP(bflo(cv.x), bflo(pv.x), m0v[0]), LRP(bfhi(cv.x), bfhi(pv.x), m0v[1]), LRP(bflo(cv.y), bflo(pv.y), m0v[2]), LRP(bfhi(cv.y), bfhi(pv.y), m0v[3]),
                     LRP(bflo(cv.z), bflo(pv.z), m1v[0]), LRP(bfhi(cv.z), bfhi(pv.z), m1v[1]), LRP(bflo(cv.w), bflo(pv.w), m1v[2]), LRP(bfhi(cv.w), bfhi(pv.w), m1v[3])); }
#undef LRP
    }
    const bf16_t* W2T = (const bf16_t*)(p->ws + SM_W2T) + (size_t)layer * MIX * 64; const bf16_t* A2T = (const bf16_t*)(p->ws + SM_A2T) + (size_t)layer * MIX * 64;
    const bf16_t* V2T = (const bf16_t*)(p->ws + SM_V2T) + (size_t)layer * MIX * 32;
    const bf16_t* zg = Z + (m0 + 4 * g) * ZLD + C_RM + hd * 64 + c16; const bool hpg = (t0 + 4 * g) > 0;
    float ssq[4] = {0.f, 0.f, 0.f, 0.f};
#pragma unroll
    for (int cb = 0; cb < 4; ++cb) { const int ch = hd * 64 + 16 * cb + c16; const float mk = mu[MIX + ch], kk0 = p->in[I_KK][(size_t)layer * MIX + ch]; float pk = hpg ? gbf(zg - ZLD + MIX + 16 * cb) : 0.f;
#pragma unroll
        for (int e = 0; e < 4; ++e) { const float ck = gbf(zg + (size_t)e * ZLD + MIX + 16 * cb), kk = (ck + (pk - ck) * mk) * kk0; ssq[e] += kk * kk; pk = ck; } }
#pragma unroll
    for (int e = 0; e < 4; ++e) { float s = ssq[e]; s += __shfl_xor(s, 1); s += __shfl_xor(s, 2); s += __shfl_xor(s, 4); s += __shfl_xor(s, 8); ssq[e] = 1.f / fmaxf(sqrtf(s), 1e-12f); }
    float bon[4] = {0.f, 0.f, 0.f, 0.f};
#pragma unroll
    for (int cb = 0; cb < 4; ++cb) { const int chl = 16 * cb + c16, ch = hd * 64 + chl; const f32x4 z4 = (f32x4){0.f, 0.f, 0.f, 0.f};
        f32x4 lw = z4, la = z4, lv = z4;
#pragma unroll
        for (int ks = 0; ks < 2; ++ks) { lw = MFMA16(xw[ks], *(const bf16x8*)(W2T + (size_t)ch * 64 + 32 * ks + 8 * g), lw); la = MFMA16(xa[ks], *(const bf16x8*)(A2T + (size_t)ch * 64 + 32 * ks + 8 * g), la); }
        if (layer > 0) lv = MFMA16(xv, *(const bf16x8*)(V2T + (size_t)ch * 32 + 8 * g), lv);
        const float mr = mu[ch], mk = mu[MIX + ch], mv = mu[2 * MIX + ch];
        const float w0 = p->in[I_W0][(size_t)layer * MIX + ch], a0 = p->in[I_A0][(size_t)layer * MIX + ch], kk0 = p->in[I_KK][(size_t)layer * MIX + ch], ka = p->in[I_KA][(size_t)layer * MIX + ch];
        const float rk = p->in[I_RK][(size_t)layer * MIX + ch], v0 = p->in[I_V0][(size_t)(layer > 0 ? layer - 1 : 0) * MIX + ch];
        const bf16_t* zc = zg + 16 * cb;
        float pr = 0.f, pk = 0.f, pv = 0.f; if (hpg) { pr = gbf(zc - ZLD); pk = gbf(zc - ZLD + MIX); pv = gbf(zc - ZLD + 2 * MIX); }
        float rr[4], lg[4], k2[4], vv[4], kn[4], aa[4];
#pragma unroll
        for (int e = 0; e < 4; ++e) { const int tl = 4 * g + e, tq = t0 + tl; const float cr = gbf(zc + (size_t)e * ZLD), ck = gbf(zc + (size_t)e * ZLD + MIX), cv = gbf(zc + (size_t)e * ZLD + 2 * MIX);
            rr[e] = cr + (pr - cr) * mr; const float k = ck + (pk - ck) * mk; float v = cv + (pv - cv) * mv; pr = cr; pk = ck; pv = cv;
            const float wlog = -fsoftplus(-(w0 + lw[e])) - 0.5f; aa[e] = fsigmoid(a0 + la[e]);
            float* VF = (float*)(p->ws + WS_VF) + (m0 + tl) * MIX + ch;
            if (layer == 0) { if (tq >= FX_T) *VF = v; } else { const float vf = *VF; v = v + (vf - v) * fsigmoid(v0 + lv[e]); }
            if (tq >= FX_T) ((float*)(p->ws + WS_VV))[(m0 + tl) * MIX + ch] = v;
            kn[e] = k * kk0 * ssq[e]; k2[e] = k * (1.f + (aa[e] - 1.f) * ka); vv[e] = v; lg[e] = -fexp(wlog);
            bon[e] += rr[e] * k2[e] * rk; }
        float pre[4]; pre[0] = lg[0]; pre[1] = pre[0] + lg[1]; pre[2] = pre[1] + lg[2]; pre[3] = pre[2] + lg[3];
        const float G0 = __shfl(pre[3], c16), G1 = __shfl(pre[3], 16 + c16), G2 = __shfl(pre[3], 32 + c16), G3 = __shfl(pre[3], 48 + c16);
        const float P = (g > 0 ? G0 : 0.f) + (g > 1 ? G1 : 0.f) + (g > 2 ? G2 : 0.f), tot = (G0 + G1) + (G2 + G3), gC = fexp(tot);
        if (g == 0) ((float*)(rec + RC_GAM))[chl] = gC;
        float av[4], bv[4], kv[4];
        float gprev = fexp(P);
#pragma unroll
        for (int e = 0; e < 4; ++e) { const float lwt = P + pre[e], gt = fexp(lwt), gp = gprev, gi = frcp(gt); gprev = gt; const int t = 4 * g + e;
            av[e] = -kn[e] * gp; bv[e] = kn[e] * aa[e] * gi; kv[e] = k2[e] * gi;
            *(LAS bf16_t*)(wl + t * 128 + chl * 2) = f2bf(av[e]); *(LAS bf16_t*)(wl + 2048 + t * 128 + chl * 2) = f2bf(rr[e] * gt);
            *(LAS bf16_t*)(wl + 4096 + t * 128 + chl * 2) = f2bf(bv[e]); *(LAS bf16_t*)(wl + 6144 + t * 128 + chl * 2) = f2bf(kv[e]); }
        *(LAS u32x2*)(wl + 8192 + chl * 32 + 8 * g) = (u32x2){pk2(av[0], av[1]), pk2(av[2], av[3])}; *(LAS u32x2*)(wl + 10240 + chl * 32 + 8 * g) = (u32x2){pk2(vv[0], vv[1]), pk2(vv[2], vv[3])};
        *(LAS u32x2*)(wl + 12288 + chl * 32 + 8 * g) = (u32x2){pk2(bv[0] * gC, bv[1] * gC), pk2(bv[2] * gC, bv[3] * gC)}; *(LAS u32x2*)(wl + 14336 + chl * 32 + 8 * g) = (u32x2){pk2(kv[0] * gC, kv[1] * gC), pk2(kv[2] * gC, kv[3] * gC)}; }
#pragma unroll
    for (int e = 0; e < 4; ++e) { float bs = bon[e]; bs += __shfl_xor(bs, 1); bs += __shfl_xor(bs, 2); bs += __shfl_xor(bs, 4); bs += __shfl_xor(bs, 8);
        if (c16 == 0 && t0 + 4 * g + e >= FX_T) ((float*)(p->ws + WS_BON))[(m0 + 4 * g + e) * RH + hd] = bs; }
    WAVE_SYNC();
    f32x4 nab = (f32x4){0.f, 0.f, 0.f, 0.f}, nak = nab, mrb = nab, mrk = nab;
#pragma unroll
    for (int ks = 0; ks < 2; ++ks) { const int off = c16 * 128 + (32 * ks + 8 * g) * 2;
        const bf16x8 fa = *(const LAS bf16x8*)(wl + off), fr = *(const LAS bf16x8*)(wl + 2048 + off), fb = *(const LAS bf16x8*)(wl + 4096 + off), fk = *(const LAS bf16x8*)(wl + 6144 + off);
        nab = MFMA16(fa, fb, nab); nak = MFMA16(fa, fk, nak); mrb = MFMA16(fr, fb, mrb); mrk = MFMA16(fr, fk, mrk); }
    f32x4 rt[4];
#pragma unroll
    for (int cb = 0; cb < 4; ++cb)
#pragma unroll
        for (int e = 0; e < 4; ++e) rt[cb][e] = bf2f(*(const LAS bf16_t*)(wl + 2048 + (4 * g + e) * 128 + (16 * cb + c16) * 2));
    WAVE_SYNC();
#pragma unroll
    for (int e = 0; e < 4; ++e) { const int t = 4 * g + e, i = c16;
        *(LAS float*)(wl + (t * 16 + i) * 4) = (i < t) ? nab[e] : 0.f;
        *(LAS bf16_t*)(wl + 1024 + (t * 16 + i) * 2) = f2bf((i < t) ? nak[e] : 0.f);
        *(LAS bf16_t*)(wl + 1536 + (t * 16 + i) * 2) = f2bf((i <= t) ? mrb[e] : 0.f);
        *(LAS bf16_t*)(wl + 2048 + (t * 16 + i) * 2) = f2bf((i <= t) ? mrk[e] : 0.f); }
    WAVE_SYNC();
    { float tr[16];
#pragma unroll
      for (int t = 0; t < 16; ++t) { float acc = (c16 == t) ? 1.f : 0.f;
#pragma unroll
          for (int s = 0; s < t; ++s) acc += *(const LAS float*)(wl + (t * 16 + s) * 4) * tr[s];
          tr[t] = acc; if (g == 0) *(LAS bf16_t*)(wl + 2560 + (t * 16 + c16) * 2) = f2bf(acc); } }
    WAVE_SYNC();
    const bf16x8 tf = frag4_lds(wl + 2560 + c16 * 32 + 8 * g), nakf = frag4_lds(wl + 1024 + c16 * 32 + 8 * g), mrbf = frag4_lds(wl + 1536 + c16 * 32 + 8 * g), mrkf = frag4_lds(wl + 2048 + c16 * 32 + 8 * g);
    const f32x4 z4 = (f32x4){0.f, 0.f, 0.f, 0.f};
    bf16x8 ahf[4], plf[4];
#pragma unroll
    for (int cb = 0; cb < 4; ++cb) { const f32x4 ah = MFMA16(tf, frag4_lds(wl + 8192 + (16 * cb + c16) * 32 + 8 * g), z4); ahf[cb] = frag4_acc(ah);
        const f32x4 rh = MFMA16(mrbf, ahf[cb], rt[cb]);
#pragma unroll
        for (int e = 0; e < 4; ++e) ((bf16_t*)(rec + RC_RH))[(4 * g + e) * 64 + 16 * cb + c16] = f2bf(rh[e]); }
#pragma unroll
    for (int vb = 0; vb < 4; ++vb) { const bf16x8 vf = frag4_lds(wl + 10240 + (16 * vb + c16) * 32 + 8 * g);
        const f32x4 q = MFMA16(nakf, vf, z4); const f32x4 pl = MFMA16(tf, frag4_acc(q), z4); plf[vb] = frag4_acc(pl);
        f32x4 ol = MFMA16(mrbf, plf[vb], z4); ol = MFMA16(mrkf, vf, ol);
        ((f32x4*)(rec + RC_OL))[vb * 64 + lane] = ol; }
#pragma unroll
    for (int kb2 = 0; kb2 < 4; ++kb2) { const bf16x8 bbf = frag4_lds(wl + 12288 + (16 * kb2 + c16) * 32 + 8 * g), kkf = frag4_lds(wl + 14336 + (16 * kb2 + c16) * 32 + 8 * g);
#pragma unroll
        for (int kb = 0; kb < 4; ++kb) { const f32x4 gp4 = MFMA16(ahf[kb], bbf, z4);
            u32x2 w; w.x = pk2(gp4[0], gp4[1]); w.y = pk2(gp4[2], gp4[3]); *(u32x2*)((bf16_t*)(rec + RC_GT) + (16 * kb2 + c16) * 64 + 16 * kb + 4 * g) = w; }
#pragma unroll
        for (int vb = 0; vb < 4; ++vb) { f32x4 sl = MFMA16(plf[vb], bbf, z4); sl = MFMA16(frag4_lds(wl + 10240 + (16 * vb + c16) * 32 + 8 * g), kkf, sl);
            u32x2 w; w.x = pk2(sl[0], sl[1]); w.y = pk2(sl[2], sl[3]); ((u32x2*)(rec + RC_SL))[(vb * 4 + kb2) * 64 + lane] = w; } }
    WAVE_SYNC();
}
DI void phase_rw_local(KP p, int layer, lptr lds) {
    const int tid = TID(), lane = tid & 63, wave = RFL(tid >> 6);
    constexpr int NITEM = NB * RH * RC_NSUB;
    for (int it = blockIdx.x * 8 + wave; it < NITEM; it += gridDim.x * 8) rw_local_item(p, layer, lds + wave * 16384, it, lane);
}
constexpr int RS_STR = 144;
DI void phase_rw_scan(KP p, lptr lds, int unit) {
    const int tid = TID(), lane = tid & 63, wid = RFL(tid >> 6), g = lane >> 4, c16 = lane & 15;
    const int vb = wid >> 1, kb0 = 2 * (wid & 1), hd = unit % RH, b = unit / RH;
    const unsigned char* rec0 = p->ws + WS_RC + (size_t)unit * RC_NSUB * RC_BYTES;
    float* SCO = (float*)(p->ws + WS_SCO) + (size_t)b * S * MIX + hd * 64;
    f32x4 st[2]; st[0] = (f32x4){0.f, 0.f, 0.f, 0.f}; st[1] = st[0];
    __syncthreads();
    for (int j = 0; j < RC_NSUB; ++j) { const unsigned char* rec = rec0 + (size_t)j * RC_BYTES; const lptr img = lds + (j & 1) * (64 * RS_STR);
        bf16x8 gt[2][2]; u32x2 slw[2]; float gam[2];
#pragma unroll
        for (int tl = 0; tl < 2; ++tl) { const int kcol = 16 * (kb0 + tl) + c16;
#pragma unroll
            for (int ks = 0; ks < 2; ++ks) gt[tl][ks] = *(const bf16x8*)((const bf16_t*)(rec + RC_GT) + kcol * 64 + 32 * ks + 8 * g);
            slw[tl] = ((const u32x2*)(rec + RC_SL))[(vb * 4 + kb0 + tl) * 64 + lane]; gam[tl] = ((const float*)(rec + RC_GAM))[kcol]; }
        bf16x8 rh[2]; f32x4 ol = (f32x4){0.f, 0.f, 0.f, 0.f};
        if (wid < 4) {
#pragma unroll
            for (int ks = 0; ks < 2; ++ks) rh[ks] = *(const bf16x8*)((const bf16_t*)(rec + RC_RH) + c16 * 64 + 32 * ks + 8 * g);
            ol = ((const f32x4*)(rec + RC_OL))[wid * 64 + lane]; }
#pragma unroll
        for (int tl = 0; tl < 2; ++tl)
#pragma unroll
            for (int e = 0; e < 4; ++e) *(LAS bf16_t*)(img + (16 * vb + 4 * g + e) * RS_STR + (16 * (kb0 + tl) + c16) * 2) = f2bf(st[tl][e]);
        __syncthreads();
        bf16x8 af[2];
#pragma unroll
        for (int ks = 0; ks < 2; ++ks) af[ks] = *(const LAS bf16x8*)(img + (16 * vb + c16) * RS_STR + (32 * ks + 8 * g) * 2);
        if (wid < 4) {
            f32x4 o = ol;
#pragma unroll
            for (int ks = 0; ks < 2; ++ks) o = MFMA16(rh[ks], *(const LAS bf16x8*)(img + (16 * wid + c16) * RS_STR + (32 * ks + 8 * g) * 2), o);
#pragma unroll
            for (int e = 0; e < 4; ++e) SCO[(size_t)(16 * j + 4 * g + e) * MIX + 16 * wid + c16] = o[e]; }
#pragma unroll
        for (int tl = 0; tl < 2; ++tl) { f32x4 nw = (f32x4){0.f, 0.f, 0.f, 0.f};
#pragma unroll
            for (int ks = 0; ks < 2; ++ks) nw = MFMA16(af[ks], gt[tl][ks], nw);
            st[tl][0] = st[tl][0] * gam[tl] + nw[0] + bflo(slw[tl].x); st[tl][1] = st[tl][1] * gam[tl] + nw[1] + bfhi(slw[tl].x);
            st[tl][2] = st[tl][2] * gam[tl] + nw[2] + bflo(slw[tl].y); st[tl][3] = st[tl][3] * gam[tl] + nw[3] + bfhi(slw[tl].y); }
    }
}

DI void phase_rw_post(KP p, int layer) {
    const size_t gt = (size_t)blockIdx.x * 512 + TID(), NGT = (size_t)gridDim.x * 512;
    const bf16_t* Z = (const bf16_t*)(p->ws + WS_Z); const float* SCO = (const float*)(p->ws + WS_SCO); const float* BON = (const float*)(p->ws + WS_BON);
    const float* lg = p->in[I_LNXG] + (size_t)layer * MIX; const float* lbv = p->in[I_LNXB] + (size_t)layer * MIX;
    for (size_t i = gt; i < (size_t)M * (MIX / 16); i += NGT) { const size_t m = i / (MIX / 16); const int c0 = (int)(i % (MIX / 16)) * 16, hd = c0 >> 6; const int t = (int)(m % S), b = (int)(m / S);
        float o[16]; float s1 = 0.f; const float* osrc = (t < FX_T) ? (const float*)(p->ws + WS_OEXC) + ((size_t)b * FX_T + t) * MIX + c0 : SCO + m * MIX + c0;
#pragma unroll
        for (int j = 0; j < 4; ++j) { const f32x4 v = *(const f32x4*)(osrc + 4 * j); o[4 * j] = v[0]; o[4 * j + 1] = v[1]; o[4 * j + 2] = v[2]; o[4 * j + 3] = v[3]; s1 += (v[0] + v[1]) + (v[2] + v[3]); }
        s1 += __shfl_xor(s1, 1); s1 += __shfl_xor(s1, 2); const float mean = s1 * (1.f / 64.f); float s2 = 0.f;
#pragma unroll
        for (int j = 0; j < 16; ++j) { o[j] -= mean; s2 += o[j] * o[j]; }
        s2 += __shfl_xor(s2, 1); s2 += __shfl_xor(s2, 2); const float rstd = frsq(s2 * (1.f / 64.f) + RW_LN_EPS);
        const float bon = BON[m * RH + hd]; const float* vsrc = (const float*)(p->ws + WS_VV) + m * MIX + c0;
        const bf16_t* gp = Z + m * ZLD + C_RG + c0; bf16_t* yp = (bf16_t*)(p->ws + WS_Y) + m * (4 * MIX) + 2 * MIX + c0;
        unsigned w[8];
#pragma unroll
        for (int j = 0; j < 16; j += 2) { const float y0 = (o[j] * rstd * lg[c0 + j] + lbv[c0 + j] + bon * vsrc[j]) * fsilu(bf2f(gp[j])), y1 = (o[j + 1] * rstd * lg[c0 + j + 1] + lbv[c0 + j + 1] + bon * vsrc[j + 1]) * fsilu(bf2f(gp[j + 1]));
            w[j >> 1] = pk2(y0, y1); }
        *(u32x4*)(yp) = (u32x4){w[0], w[1], w[2], w[3]}; *(u32x4*)(yp + 8) = (u32x4){w[4], w[5], w[6], w[7]}; }
}

DI void phase_ln(KP p, int layer) {
    const int tid = TID(), lane = tid & 63, wave = tid >> 6;
    const float alpha = sqrtf(sqrtf(2.f * (float)L));
    const float* hprev = (layer == 0) ? p->in[I_X] : (const float*)(p->ws + WS_H); const float* outf = (const float*)(p->ws + WS_OUTF);
    float* hnew = (layer == L - 1) ? p->out : (float*)(p->ws + WS_H); bf16_t* xn = (bf16_t*)(p->ws + WS_XN);
    const float* lg = p->in[I_LNG] + (size_t)layer * D; const float* lbv = p->in[I_LNB] + (size_t)layer * D;
    constexpr int NV = D / 256;
    for (size_t m = (size_t)blockIdx.x * 8 + wave; m < (size_t)M; m += (size_t)gridDim.x * 8) {
        f32x4 v[NV]; float s = 0.f;
#pragma unroll
        for (int j = 0; j < NV; ++j) { const f32x4 a = *(const f32x4*)(hprev + m * D + 256 * j + 4 * lane), o = *(const f32x4*)(outf + m * D + 256 * j + 4 * lane); v[j] = a * alpha + o; s += (v[j][0] + v[j][1]) + (v[j][2] + v[j][3]); }
#pragma unroll
        for (int o = 1; o < 64; o <<= 1) s += __shfl_xor(s, o);
        const float mean = s * (1.f / D); float s2 = 0.f;
#pragma unroll
        for (int j = 0; j < NV; ++j) { v[j] = v[j] - mean; s2 += (v[j][0] * v[j][0] + v[j][1] * v[j][1]) + (v[j][2] * v[j][2] + v[j][3] * v[j][3]); }
#pragma unroll
        for (int o = 1; o < 64; o <<= 1) s2 += __shfl_xor(s2, o);
        const float rstd = 1.f / sqrtf(s2 * (1.f / D) + LN_EPS);
#pragma unroll
        for (int j = 0; j < NV; ++j) { const f32x4 g4 = *(const f32x4*)(lg + 256 * j + 4 * lane), b4 = *(const f32x4*)(lbv + 256 * j + 4 * lane); const f32x4 y = v[j] * rstd * g4 + b4;
            *(f32x4*)(hnew + m * D + 256 * j + 4 * lane) = y; u32x2 w; w.x = pk2(y[0], y[1]); w.y = pk2(y[2], y[3]); *(u32x2*)(xn + m * D + 256 * j + 4 * lane) = w; }
    }
}
constexpr int FX_NS_HG = 3 * MIX / 64, FX_NS_RW = RW_MIX / 64, FX_NSTRIP = FX_NS_HG + FX_NS_RW + 1;
DI void phase_fx_project(KP p, int layer, lptr lds, int strip) {
    const int tid = TID(), c = tid & 63, kg = tid >> 6;
    const float* hsrc = (layer == 0) ? p->in[I_X] : (const float*)(p->ws + WS_H);
    LAS float* HR = (LAS float*)lds;
    __syncthreads();
    for (int i = tid; i < FX_ROWS * D / 4; i += 512) { const int r = i / (D / 4), k4 = i % (D / 4); const size_t m = (size_t)(r / FX_T) * S + (r % FX_T);
        *(LAS f32x4*)(HR + r * D + 4 * k4) = *(const f32x4*)(hsrc + m * D + 4 * k4); }
    __syncthreads();
    int col0, ncol, ldw; const float* W;
    if (strip < FX_NS_HG) { col0 = C_HQ + 64 * strip; ncol = 64; ldw = IN_COLS; W = p->in[I_WIN] + (size_t)layer * D * IN_COLS + col0; }
    else if (strip < FX_NS_HG + FX_NS_RW) { col0 = C_RM + 64 * (strip - FX_NS_HG); ncol = 64; ldw = IN_COLS; W = p->in[I_WIN] + (size_t)layer * D * IN_COLS + col0; }
    else { col0 = C_VD; ncol = 32; ldw = 32; W = p->in[I_V1] + (size_t)(layer > 0 ? layer - 1 : 0) * D * 32; if (layer == 0) ncol = 0; }
    float acc[FX_ROWS];
#pragma unroll
    for (int r = 0; r < FX_ROWS; ++r) acc[r] = 0.f;
    if (c < ncol) {
        for (int k = kg * (D / 8); k < (kg + 1) * (D / 8); ++k) { const float w = W[(size_t)k * ldw + c];
#pragma unroll
            for (int r = 0; r < FX_ROWS; ++r) acc[r] += HR[r * D + k] * w; } }
    __syncthreads();
    LAS float* RED = (LAS float*)lds;
#pragma unroll
    for (int r = 0; r < FX_ROWS; ++r) RED[(kg * FX_ROWS + r) * 64 + c] = acc[r];
    __syncthreads();
    for (int i = tid; i < FX_ROWS * 64; i += 512) { const int r = i >> 6, cc = i & 63; float s = 0.f;
#pragma unroll
        for (int g = 0; g < 8; ++g) s += RED[(g * FX_ROWS + r) * 64 + cc];
        if (cc < ncol) ((float*)(p->ws + WS_ZF))[(size_t)r * ZLD + col0 + cc] = s; }
}
DI float wave_sum64(float v) {
#pragma unroll
    for (int o = 1; o < 64; o <<= 1) v += __shfl_xor(v, o);
    return v; }
DI void fx_rwkv(KP p, int layer, int item, int lane) {
    const int hd = item % RH, b = item / RH, ch = hd * 64 + lane;
    const float* ZF = (const float*)(p->ws + WS_ZF) + (size_t)b * FX_T * ZLD;
    const float* mu = p->in[I_MU] + (size_t)layer * RW_MIX;
    const float mur = mu[ch], muk = mu[MIX + ch], muv = mu[2 * MIX + ch], muw = mu[3 * MIX + lane], mua = mu[3 * MIX + 64 + lane];
    const float muvd = (layer > 0 && lane < 32) ? p->in[I_VMU][(size_t)(layer - 1) * 32 + lane] : 0.f;
    const float* w2 = p->in[I_W2] + (size_t)layer * 64 * MIX + ch; const float* a2 = p->in[I_A2] + (size_t)layer * 64 * MIX + ch;
    const float* v2 = p->in[I_V2] + (size_t)(layer > 0 ? layer - 1 : 0) * 32 * MIX + ch;
    const float w0 = p->in[I_W0][(size_t)layer * MIX + ch], a0 = p->in[I_A0][(size_t)layer * MIX + ch], kq = p->in[I_KK][(size_t)layer * MIX + ch], ka = p->in[I_KA][(size_t)layer * MIX + ch], rk = p->in[I_RK][(size_t)layer * MIX + ch];
    const float v0 = p->in[I_V0][(size_t)(layer > 0 ? layer - 1 : 0) * MIX + ch];
    float rv[FX_T], kv[FX_T], vv[FX_T], tw[FX_T], ad[FX_T], vd[FX_T];
    { float pr = 0.f, pk = 0.f, pv = 0.f, pw = 0.f, pa = 0.f, pvd = 0.f;
#pragma unroll
      for (int t = 0; t < FX_T; ++t) { const float* z = ZF + (size_t)t * ZLD;
          const float cr = z[C_RM + ch], ck = z[C_RM + MIX + ch], cv = z[C_RM + 2 * MIX + ch], cw = z[C_RM + 3 * MIX + lane], ca = z[C_RM + 3 * MIX + 64 + lane], cvd = (layer > 0 && lane < 32) ? z[C_VD + lane] : 0.f;
          rv[t] = cr + (pr - cr) * mur; kv[t] = ck + (pk - ck) * muk; vv[t] = cv + (pv - cv) * muv;
          tw[t] = tanhf(cw + (pw - cw) * muw); ad[t] = ca + (pa - ca) * mua; vd[t] = cvd + (pvd - cvd) * muvd;
          pr = cr; pk = ck; pv = cv; pw = cw; pa = ca; pvd = cvd; } }
    float lwv[FX_T], lav[FX_T], lvv[FX_T];
#pragma unroll
    for (int t = 0; t < FX_T; ++t) { lwv[t] = 0.f; lav[t] = 0.f; lvv[t] = 0.f; }
#pragma unroll 8
    for (int j = 0; j < 64; ++j) { const float w2j = w2[(size_t)j * MIX], a2j = a2[(size_t)j * MIX];
#pragma unroll
        for (int t = 0; t < FX_T; ++t) { lwv[t] += __shfl(tw[t], j) * w2j; lav[t] += __shfl(ad[t], j) * a2j; } }
    if (layer > 0) {
#pragma unroll 8
        for (int j = 0; j < 32; ++j) { const float v2j = v2[(size_t)j * MIX];
#pragma unroll
            for (int t = 0; t < FX_T; ++t) lvv[t] += __shfl(vd[t], j) * v2j; } }
    float xs[2 * FX_T - 1], ys[2 * FX_T - 1];
#pragma unroll
    for (int t = 0; t < FX_T; ++t) { const float r = rv[t], k = kv[t], lw = lwv[t], la = lav[t], lv = lvv[t]; float v = vv[t];
        const float wlog = -(fmaxf(-(w0 + lw), 0.f) + log1pf(expf(-fabsf(w0 + lw)))) - 0.5f, decay = expf(-expf(wlog));
        const float a = 1.f / (1.f + expf(-(a0 + la)));
        const size_t m = (size_t)b * S + t; float* VF = (float*)(p->ws + WS_VF) + m * MIX;
        if (layer == 0) VF[ch] = v; else { const float vf = VF[ch]; v = v + (vf - v) / (1.f + expf(-(v0 + lv))); }
        float kk = k * kq; const float nrm = sqrtf(wave_sum64(kk * kk)); kk = kk / fmaxf(nrm, 1e-12f);
        const float k2 = k * (1.f + (a - 1.f) * ka);
        const float bon = wave_sum64(r * k2 * rk);
        ((float*)(p->ws + WS_VV))[m * MIX + ch] = v;
        if (lane == 0) ((float*)(p->ws + WS_BON))[m * RH + hd] = bon;
        { const float an = -kk, bn = kk * a; float sa = 0.f, ov = 0.f;
          const int nt = (t == 0) ? 0 : 2 * t - 1;
#pragma unroll
          for (int i = 0; i < 2 * FX_T - 1; ++i) if (i < nt) { sa += xs[i] * wave_sum64(ys[i] * an); ys[i] *= decay; ov += xs[i] * wave_sum64(ys[i] * r); }
          if (t > 0) { ov += sa * wave_sum64(bn * r); }
          ov += v * wave_sum64(k2 * r);
#pragma unroll
          for (int i = 0; i < 2 * FX_T - 1; ++i) { if (t > 0 && i == nt) { xs[i] = sa; ys[i] = bn; } if (i == ((t == 0) ? 0 : nt + 1)) { xs[i] = v; ys[i] = k2; } }
          ((float*)(p->ws + WS_OEXC))[((size_t)b * FX_T + t) * MIX + ch] = ov; } }
}
DI void fx_hgrn(KP p, int layer, int item, int lane) {
    const int h = item % HH, b = item / HH;
    const float* ZF = (const float*)(p->ws + WS_ZF) + (size_t)b * FX_T * ZLD; const float* LBp = (const float*)(p->ws + SM_LB);
    float q[FX_T][2], kx[FX_T][2], Bc[FX_T][2], iv[FX_T][2];
#pragma unroll
    for (int u = 0; u < 2; ++u) { const int d = h * 128 + lane + 64 * u; const float lb = LBp[(size_t)layer * MIX + d]; float run = 0.f;
#pragma unroll
        for (int t = 0; t < FX_T; ++t) { const float* z = ZF + (size_t)t * ZLD; const float zf = z[C_HF + d]; q[t][u] = z[C_HQ + d]; iv[t][u] = z[C_HI + d];
            const float sg = 1.f / (1.f + expf(-zf)); run += logf(lb + (1.f - lb) * sg); Bc[t][u] = run; kx[t][u] = (1.f - lb) * (1.f - sg); } }
    float* OEX = (float*)(p->ws + WS_OEX) + (size_t)item * FX_T * 128;
#pragma unroll
    for (int t = 0; t < FX_T; ++t) { float o0 = 0.f, o1 = 0.f;
#pragma unroll
        for (int s = 0; s <= t; ++s) { const float c = wave_sum64(q[t][0] * kx[s][0] * expf(Bc[t][0] - Bc[s][0]) + q[t][1] * kx[s][1] * expf(Bc[t][1] - Bc[s][1])); o0 += c * iv[s][0]; o1 += c * iv[s][1]; }
        OEX[t * 128 + lane] = o0; OEX[t * 128 + 64 + lane] = o1; }
}
DI void phase_fx_fix(KP p, int layer) {
    const int tid = TID(), lane = tid & 63, gw = blockIdx.x * 8 + (tid >> 6), NGW = gridDim.x * 8;
    for (int it = gw; it < NB * RH + NB * HH; it += NGW) { if (it < NB * RH) fx_rwkv(p, layer, it, lane); else fx_hgrn(p, layer, it - NB * RH, lane); }
}
constexpr int NWAVES = 8, LDS_RING = 131072, MISC_OFF = LDS_RING + 320, LDS_BYTES = 147456;
constexpr int CW_BAR = 4096, CW_WQ = 16384, CW_ARR = 32768;
enum { PH_INPROJ = 0, PH_RWPREP, PH_RWLOC, PH_MIX, PH_RWPOST, PH_BRANCH, PH_SUM, PH_OUT, PH_LN, PH_COUNT };
constexpr int U_SCAN = NB * RH, U_HG = NB * HH, U_HGC = NB * HH * (S / 64), U_AA = NB * AH * (S / 128), U_AD = NB * SH * (S / 256), U_MIX = U_SCAN + U_HG + U_AA + U_AD;

struct Args { Params p; int do_pro, l_lo, l_hi, ph_lo, ph_hi, mega, pad0, pad1; };

#ifndef EMU
#define XB_TMO      128
#define XB_XCNT(j)  (256  + 64 * (j))
#define XB_XSUB(j)  (1280 + 64 * (j))
#define XB_XGEN(j)  (2304 + 64 * (j))
#define XB_TOP      3328
#define XB_TOPGEN   3392
#define XCD_BAR_WORDS 3456
#define XB_SPIN_CAP (1u << 18)
__device__ __forceinline__ unsigned xb_ld(unsigned* p)              { return __hip_atomic_load(p, __ATOMIC_RELAXED, __HIP_MEMORY_SCOPE_AGENT); }
__device__ __forceinline__ unsigned xb_add(unsigned* p, unsigned v) { return __hip_atomic_fetch_add(p, v, __ATOMIC_RELAXED, __HIP_MEMORY_SCOPE_AGENT); }
__device__ __forceinline__ unsigned xb_xcc_id() { return (unsigned)__builtin_amdgcn_s_getreg((3 << 11) | 20) & 0xFu; }
#define XB_SPIN(cond, bar) do { unsigned _sp = 0; while (cond) { __builtin_amdgcn_s_sleep(1); \
    if ((++_sp & 255u) == 0u) { if (xb_ld(&(bar)[XB_TMO])) break; if (_sp > XB_SPIN_CAP) { atomicAdd(&(bar)[XB_TMO], 1u); break; } } } } while (0)
struct XcdBarrier { unsigned* bar; unsigned x; volatile LAS unsigned* st; };
__device__ __forceinline__ XcdBarrier xcd_barrier_post(unsigned* bar, volatile LAS unsigned* st) {
    XcdBarrier b; b.bar = bar; b.x = xb_xcc_id(); b.st = st;
    if (threadIdx.x == 0) (void)xb_add(&bar[XB_XCNT(b.x)], 1u);
    return b;
}
__device__ __forceinline__ void xcd_barrier_complete(unsigned* bar, unsigned x, unsigned& nloc, unsigned& nx) {
    const unsigned G = gridDim.x * gridDim.y * gridDim.z;
    unsigned sum, cnt, mine, sp = 0u;
    for (;;) {
        sum = 0u; cnt = 0u; mine = 0u;
#pragma unroll
        for (unsigned j = 0; j < 16; ++j) { const unsigned c = xb_ld(&bar[XB_XCNT(j)]); sum += c; cnt += (c > 0u) ? 1u : 0u; mine = (j == x) ? c : mine; }
        if (sum == G) break;
        __builtin_amdgcn_s_sleep(1);
        if ((++sp & 255u) == 0u) { if (xb_ld(&bar[XB_TMO])) break; if (sp > XB_SPIN_CAP) { atomicAdd(&bar[XB_TMO], 1u); break; } }
    }
    nloc = mine > 0u ? mine : 1u; nx = cnt > 0u ? cnt : 1u;
}
__device__ __forceinline__ void xcd_barrier(const XcdBarrier& b) {
    asm volatile("s_waitcnt vmcnt(0)" ::: "memory");
    __syncthreads();
    if (threadIdx.x == 0) {
        unsigned* bar = b.bar;
        __builtin_amdgcn_s_waitcnt(0);
        unsigned nloc = b.st[0], nx = b.st[1];
        if (nloc == 0u) { xcd_barrier_complete(bar, b.x, nloc, nx); b.st[0] = nloc; b.st[1] = nx; }
        const unsigned old = xb_add(&bar[XB_XSUB(b.x)], 1u);
        const unsigned gen = old / nloc;
        if (old + 1u == (gen + 1u) * nloc) {
            __builtin_amdgcn_fence(__ATOMIC_RELEASE, "agent");
            asm volatile("s_waitcnt vmcnt(0)" ::: "memory");
            const unsigned og = xb_add(&bar[XB_TOP], 1u);
            const unsigned tg = og / nx;
            if (og + 1u == (tg + 1u) * nx) xb_add(&bar[XB_TOPGEN], 1u);
            else XB_SPIN(xb_ld(&bar[XB_TOPGEN]) == tg, bar);
            __builtin_amdgcn_fence(__ATOMIC_ACQUIRE, "agent");
            xb_add(&bar[XB_XGEN(b.x)], 1u);
            asm volatile("s_waitcnt vmcnt(0)" ::: "memory");
        } else {
            XB_SPIN(xb_ld(&bar[XB_XGEN(b.x)]) == gen, bar);
            __builtin_amdgcn_fence(__ATOMIC_ACQUIRE, "agent");
            asm volatile("s_waitcnt vmcnt(0)" ::: "memory");
        }
    }
    __syncthreads();
}
#endif

DI int next_unit(unsigned* head, lptr lds) {
    LAS int* slot = (LAS int*)(lds + MISC_OFF + 64);
    __syncthreads();
#ifdef EMU
    if (threadIdx.x == 0) { *slot = (int)(*head); *head += 1; }
#else
    if (threadIdx.x == 0) *slot = (int)__hip_atomic_fetch_add(head, 1u, __ATOMIC_RELAXED, __HIP_MEMORY_SCOPE_AGENT);
#endif
    __syncthreads();
    return *slot;
}

#ifndef DBG_PHMASK
#define DBG_PHMASK 0xffff
#endif
struct BranchOrder {
    pg8::StaticOrder so;
    DM bool next(int i, pg8::Unit& u) const { if (!so.next(i, u)) return false; u.ka = (u.pn / (D / 256)) * MIX; return true; }
    DM void a_ready(const pg8::Unit&) const {}
    DM void done(const pg8::Unit&) const {}
};
#ifndef PROBE_REP
#define PROBE_REP 0
#endif
#ifndef PROBE_PREPSEL
#define PROBE_PREPSEL 7
#endif
#ifndef PROBE_MIXREP
#define PROBE_MIXREP 15
#endif
#ifndef DBG_MIXMASK
#define DBG_MIXMASK 15
#endif
DI void run_phase(KP p, int rep, int l, int ph, lptr lds) {
    unsigned char* ws = p->ws;
    if (!((DBG_PHMASK >> ph) & 1)) return;
    if (ph == PH_INPROJ) {
        pg8::Gemm g{(const bf16_t*)(ws + WS_XN), (const bf16_t*)(ws + WS_WIN) + (size_t)l * NP * D, M, NP, D, D, D};
        EpiInproj E{(bf16_t*)(ws + WS_Z), ZLD, (bf16_t*)(ws + WS_RHO), CG0 / 256};
#ifndef EMU
        pg8::StaticOrder so; so.init(M, NP, gridDim.x, blockIdx.x);
        pg8::gemm_phase<EpiInproj, pg8::StaticOrder, true, true, D, D, D>((LAS unsigned char*)lds, g, so, E);
#endif
        { const int first = (M / 256) * (NP / 256) % (int)gridDim.x;
          for (int s = ((int)blockIdx.x - first + (int)gridDim.x) % (int)gridDim.x; s < FX_NSTRIP; s += gridDim.x) phase_fx_project(p, l, lds, s); }
    } else if (ph == PH_RWPREP) {
    } else if (ph == PH_RWLOC) {
    } else if (ph == PH_MIX) {
        const int psel = rep ? PROBE_PREPSEL : 7;
        if (psel & 1) phase_rw_local(p, l, lds);
        if (psel & 2) phase_fx_fix(p, l);
        if (psel & 4) for (int u = blockIdx.x; u < U_HGC; u += gridDim.x) phase_hg_local(p, l, lds, u);
        unsigned* arrive = (unsigned*)(ws + WS_CTL) + CW_ARR + 64 * l + (rep ? 32 * 64 : 0);
#ifndef EMU
        asm volatile("s_waitcnt vmcnt(0)" ::: "memory");
#endif
        __syncthreads();
#ifdef EMU
        if (threadIdx.x == 0) *arrive += 1;
#else
        if (threadIdx.x == 0) { __builtin_amdgcn_fence(__ATOMIC_RELEASE, "agent"); __hip_atomic_fetch_add(arrive, 1u, __ATOMIC_RELAXED, __HIP_MEMORY_SCOPE_AGENT); }
#endif
        unsigned* head = (unsigned*)(ws + WS_CTL) + CW_WQ + 64 * l + (rep ? 32 * 64 : 0);
        for (;;) { int u = next_unit(head, lds); if (u >= U_MIX) break;
            const int mm = rep ? PROBE_MIXREP : DBG_MIXMASK;
            if (u < U_SCAN + U_HG) {
                if (threadIdx.x == 0) {
#ifdef EMU
                    while (*(volatile unsigned*)arrive < gridDim.x) emu_yield();
#else
                    unsigned sp = 0; while (__hip_atomic_load(arrive, __ATOMIC_RELAXED, __HIP_MEMORY_SCOPE_AGENT) < gridDim.x) { __builtin_amdgcn_s_sleep(2); if (++sp > (1u << 22)) break; }
                    __builtin_amdgcn_fence(__ATOMIC_ACQUIRE, "agent"); asm volatile("s_waitcnt vmcnt(0)" ::: "memory");
#endif
                }
                __syncthreads();
                if (u < U_SCAN) { if (mm & 1) phase_rw_scan(p, lds, u); } else if (mm & 2) phase_hg_scan(p, u - U_SCAN);
                continue; }
            u -= U_SCAN + U_HG;
            if (u < U_AA) { if (mm & 4) phase_att_a(p, l, lds, u); continue; } u -= U_AA;
            if (mm & 8) phase_att_d(p, l, lds, u); }
    } else if (ph == PH_RWPOST) {
        phase_rw_post(p, l);
        for (int u = blockIdx.x; u < U_HGC; u += gridDim.x) phase_hg_out(p, l, lds, u);
    } else if (ph == PH_BRANCH) {
        pg8::Gemm g{(const bf16_t*)(ws + WS_Y), (const bf16_t*)(ws + WS_WBR) + (size_t)l * D * 4 * MIX, M, D, 4 * MIX, 4 * MIX, 4 * MIX};
        EpiMerged E{(bf16_t*)(ws + WS_MG), D, (const bf16_t*)(ws + WS_RHO)};
#ifndef EMU
        pg8::StaticOrder so; so.init(M, D, gridDim.x, blockIdx.x);
        pg8::gemm_phase<EpiMerged, pg8::StaticOrder, true, true, 4 * MIX, 4 * MIX, 4 * MIX>((LAS unsigned char*)lds, g, so, E);
#endif
    } else if (ph == PH_SUM) {
    } else if (ph == PH_OUT) {
        pg8::Gemm g{(const bf16_t*)(ws + WS_MG), (const bf16_t*)(ws + WS_WOUT) + (size_t)l * D * D, M, D, D, D, D};
        EpiF32 E{(float*)(ws + WS_OUTF), D};
#ifndef EMU
        pg8::StaticOrder so; so.init(M, D, gridDim.x, blockIdx.x);
        pg8::gemm_phase<EpiF32, pg8::StaticOrder, true, true, D, D, D>((LAS unsigned char*)lds, g, so, E);
#endif
    } else if (ph == PH_LN) {
        phase_ln(p, l);
    }
}

#ifndef EMU
__global__ void __launch_bounds__(NWAVES * 64, 2) fwd(Args a) {
    extern __shared__ __attribute__((aligned(16))) unsigned char lds_raw[];
    lptr lds = (lptr)lds_raw;
    volatile LAS unsigned* MISC = (volatile LAS unsigned*)(lds + MISC_OFF);
    for (int u = threadIdx.x; u < (LDS_BYTES - LDS_RING) / 4; u += NWAVES * 64) ((LAS unsigned*)(lds + LDS_RING))[u] = 0u;
    __syncthreads();
    typedef const __attribute__((address_space(4))) Args* KA;
    KA ka = (KA)__builtin_amdgcn_kernarg_segment_ptr();
    const int mega = ka->mega, do_pro = ka->do_pro, l_lo = ka->l_lo, l_hi = ka->l_hi, ph_lo = ka->ph_lo, ph_hi = ka->ph_hi;
    auto kp = [&]() -> KP { KA k2 = ka; asm volatile("" : "+s"(k2)); return &k2->p; };
    XcdBarrier bar; bar.bar = (unsigned*)(ka->p.ws + WS_CTL) + CW_BAR; bar.x = 0; bar.st = nullptr;
    if (mega) bar = xcd_barrier_post((unsigned*)(ka->p.ws + WS_CTL) + CW_BAR, MISC + 8);
#define SEAM() do { if (mega) xcd_barrier(bar); } while (0)
    if (do_pro != 0 && ((DBG_PHMASK >> 8) & 1) != 0) { phase_prologue(kp(), lds); SEAM(); }
    for (int l = l_lo; l < l_hi; ++l) {
        if (ph_lo <= PH_INPROJ && PH_INPROJ < ph_hi) { run_phase(kp(), 0, l, PH_INPROJ, lds); SEAM(); if ((PROBE_REP >> PH_INPROJ) & 1) { run_phase(kp(), 1, l, PH_INPROJ, lds); SEAM(); } }
        if (ph_lo <= PH_MIX && PH_MIX < ph_hi) { run_phase(kp(), 0, l, PH_MIX, lds); SEAM(); if ((PROBE_REP >> PH_MIX) & 1) { run_phase(kp(), 1, l, PH_MIX, lds); SEAM(); } }
        if (ph_lo <= PH_RWPOST && PH_RWPOST < ph_hi) { run_phase(kp(), 0, l, PH_RWPOST, lds); SEAM(); if ((PROBE_REP >> PH_RWPOST) & 1) { run_phase(kp(), 1, l, PH_RWPOST, lds); SEAM(); } }
        if (ph_lo <= PH_BRANCH && PH_BRANCH < ph_hi) { run_phase(kp(), 0, l, PH_BRANCH, lds); SEAM(); if ((PROBE_REP >> PH_BRANCH) & 1) { run_phase(kp(), 1, l, PH_BRANCH, lds); SEAM(); } }
        if (ph_lo <= PH_OUT && PH_OUT < ph_hi) { run_phase(kp(), 0, l, PH_OUT, lds); SEAM(); if ((PROBE_REP >> PH_OUT) & 1) { run_phase(kp(), 1, l, PH_OUT, lds); SEAM(); } }
        if (ph_lo <= PH_LN && PH_LN < ph_hi) { run_phase(kp(), 0, l, PH_LN, lds); SEAM(); }
    }
#undef SEAM
}

#ifndef MK_MEGA
#define MK_MEGA 1
#endif
extern "C" void kernel_launch(void* const* d_in, const int* in_sizes, int n_in, void* d_out, int out_size, void* d_ws, size_t ws_size, hipStream_t stream) {
    static int grid = 0;
    if (grid == 0) {
        if (n_in != 25 || in_sizes[0] != M * D || out_size != M * D || ws_size < WS_END) { fprintf(stderr, "kernel_launch: shape/workspace mismatch (n_in %d, in0 %d, out %d, ws %zu need %zu)\n", n_in, n_in > 0 ? in_sizes[0] : -1, out_size, ws_size, (size_t)WS_END); grid = -1; return; }
        int dev = 0, cus = 0, per_cu = 0;
        if (hipGetDevice(&dev) != hipSuccess || hipDeviceGetAttribute(&cus, hipDeviceAttributeMultiprocessorCount, dev) != hipSuccess) { grid = -1; return; }
        if (hipFuncSetAttribute((const void*)fwd, hipFuncAttributeMaxDynamicSharedMemorySize, LDS_BYTES) != hipSuccess) { fprintf(stderr, "kernel_launch: hipFuncSetAttribute failed\n"); grid = -1; return; }
        if (hipOccupancyMaxActiveBlocksPerMultiprocessor(&per_cu, (const void*)fwd, NWAVES * 64, LDS_BYTES) != hipSuccess || per_cu < 1) fprintf(stderr, "kernel_launch: occupancy query says %d\n", per_cu);
        (void)hipGetLastError();
        grid = cus;
    }
    if (grid < 0) return;
    (void)hipMemsetAsync((char*)d_ws + WS_CTL, 0, CTL_BYTES, stream);
    Args a{};
    for (int i = 0; i < 25; ++i) a.p.in[i] = (const float*)d_in[i];
    a.p.out = (float*)d_out; a.p.ws = (unsigned char*)d_ws;
    if (MK_MEGA) {
        a.do_pro = 1; a.l_lo = 0; a.l_hi = L; a.ph_lo = 0; a.ph_hi = PH_COUNT; a.mega = 1;
        hipLaunchKernelGGL(fwd, dim3(grid), dim3(NWAVES * 64), LDS_BYTES, stream, a);
    } else {
        a.mega = 0; a.do_pro = 1; a.l_lo = 0; a.l_hi = 0; a.ph_lo = 0; a.ph_hi = 0;
        hipLaunchKernelGGL(fwd, dim3(grid), dim3(NWAVES * 64), LDS_BYTES, stream, a);
        a.do_pro = 0;
        for (int l = 0; l < L; ++l) for (int ph = 0; ph < PH_COUNT; ++ph) { a.l_lo = l; a.l_hi = l + 1; a.ph_lo = ph; a.ph_hi = ph + 1;
            hipLaunchKernelGGL(fwd, dim3(grid), dim3(NWAVES * 64), LDS_BYTES, stream, a); }
    }
}
#endif
```
